# Optimizing an MI355X kernel written in HIP

```python
import math
import numpy as np
import jax
import jax.numpy as jnp
from jax import lax

D_MODEL = 2048
BATCH = 16
SEQ = 256
DEPTH = 4
DEC_BATCH = 2
DEC_SEQ = 4096
PAST_LEN = 256

GRID_W = 64
N_DIR = 2
A_HEADS = 8
A_HEAD_DIM = 64
A_W = A_HEADS * A_HEAD_DIM
DECAY_LORA = 64
ICLR_LORA = 64
GATE_LORA = 128
B_HEADS = 8
Q_RANK = 512
KV_RANK = 512
NOPE_DIM = 128
ROPE_DIM = 64
V_DIM = 128
B_W = B_HEADS * V_DIM
ROPE_BASE = 10000.0
Q_BLOCK = 128
C_HEADS = 4
C_DK = 128
C_DV = 128
C_W = C_HEADS * C_DV
SHORT_CONV = 3
CHUNK = 64
D_FF = 5632
FFN_CONV = 3
MIX_W = A_W + B_W + C_W
IN_SIZES = (A_W, A_W, A_W, N_DIR * DECAY_LORA, N_DIR * ICLR_LORA, GATE_LORA,
            Q_RANK, KV_RANK, ROPE_DIM,
            C_HEADS * C_DK, C_HEADS * C_DK, C_W, C_W, N_DIR * C_HEADS, N_DIR * C_HEADS)
IN_COLS = sum(IN_SIZES)
RMS_EPS = 1e-6
LNX_EPS = 64e-5
L2_EPS = 1e-6

kernel_name = 'hybrid_rwkv7_mla_gdn_diffusion_step'


def rmsnorm(x, g):
    xf = x.astype(jnp.float32)
    y = xf * lax.rsqrt(jnp.mean(xf * xf, axis=-1, keepdims=True) + RMS_EPS)
    return (y * g.astype(jnp.float32)).astype(x.dtype)


def l2norm(x):
    xf = x.astype(jnp.float32)
    return xf * lax.rsqrt(jnp.sum(xf * xf, axis=-1, keepdims=True) + L2_EPS)


def split_cols(p, sizes):
    offs = np.cumsum((0,) + tuple(sizes))
    return [p[..., int(offs[i]):int(offs[i + 1])] for i in range(len(sizes))]


def centred_dwconv(x, w):
    width = w.shape[0]
    pad = width // 2
    T = x.shape[1]
    xp = jnp.pad(x, ((0, 0), (pad, pad), (0, 0)))
    return sum(xp[:, i:i + T] * w[i] for i in range(width))


def both_dirs(t):
    return jnp.stack([t, jnp.flip(t, 1)], axis=2)


def per_dir(t):
    return jnp.stack([t[:, :, 0], jnp.flip(t[:, :, 1], 1)], axis=2)


def merge_dirs(y):
    return y[:, :, 0] + jnp.flip(y[:, :, 1], 1)


def axial_rope_tables(rows):
    row_id = jnp.repeat(jnp.arange(rows), GRID_W).astype(jnp.float32)
    col_id = jnp.tile(jnp.arange(GRID_W), rows).astype(jnp.float32)
    n_freq = ROPE_DIM // 4
    inv = ROPE_BASE ** (-jnp.arange(n_freq, dtype=jnp.float32) / n_freq)
    ang = jnp.concatenate([row_id[:, None] * inv, col_id[:, None] * inv], axis=-1)
    return jnp.cos(ang), jnp.sin(ang)


def apply_rope(x, cos, sin):
    T = x.shape[1]
    shape = (T,) + (1,) * (x.ndim - 3) + (ROPE_DIM // 2,)
    c, s = cos.reshape(shape), sin.reshape(shape)
    xf = x.astype(jnp.float32)
    xe, xo = xf[..., 0::2], xf[..., 1::2]
    return jnp.stack([xe * c - xo * s, xe * s + xo * c], axis=-1).reshape(x.shape).astype(x.dtype)


def adaln_modulation(cond, ada_w, ada_b):
    m = (jax.nn.silu(cond) @ ada_w + ada_b)[..., None, :]
    return jnp.split(m, 6, axis=-1)


def rwkv7_mixer(r, k, v, w_lo, a_lo, g_lo, p, s0):
    f32 = jnp.float32
    Bn, T, _ = r.shape
    heads = lambda t: t.reshape(t.shape[:-1] + (A_HEADS, A_HEAD_DIM))
    w_lo = w_lo.reshape(Bn, T, N_DIR, DECAY_LORA)
    a_lo = a_lo.reshape(Bn, T, N_DIR, ICLR_LORA)
    w_pre = p['rwkv_w0'] + jnp.einsum('btdr,drc->btdc', jnp.tanh(w_lo), p['rwkv_w2'])
    log_w = -jnp.exp(-jax.nn.softplus(-w_pre.astype(f32)) - 0.5)
    a = jax.nn.sigmoid((p['rwkv_a0'] + jnp.einsum('btdr,drc->btdc', a_lo, p['rwkv_a2'])).astype(f32))
    g = jax.nn.sigmoid(g_lo) @ p['rwkv_g2']
    rf, kf, vf = r.astype(f32), k.astype(f32), v.astype(f32)
    kk = l2norm(heads(kf * p['rwkv_kk']))
    k_dir = kf[:, :, None] * (1.0 + (a - 1.0) * p['rwkv_ka'])
    xs = (both_dirs(heads(rf)), heads(jnp.exp(per_dir(log_w))), heads(per_dir(k_dir)),
          both_dirs(heads(vf)), both_dirs(kk), heads(per_dir(a)))
    xs = tuple(jnp.moveaxis(t, 1, 0) for t in xs)

    def step(S, inp):
        r_t, w_t, k_t, v_t, kk_t, a_t = inp
        sa = jnp.einsum('bdhvk,bdhk->bdhv', S, -kk_t)
        S = S * w_t[..., None, :] + sa[..., None] * (kk_t * a_t)[..., None, :] + v_t[..., None] * k_t[..., None, :]
        return S, jnp.einsum('bdhvk,bdhk->bdhv', S, r_t)

    s_fin, y = lax.scan(step, s0.astype(f32), xs)
    y = merge_dirs(jnp.moveaxis(y, 0, 1))
    mu = jnp.mean(y, axis=-1, keepdims=True)
    var = jnp.mean(jnp.square(y - mu), axis=-1, keepdims=True)
    y = ((y - mu) * lax.rsqrt(var + LNX_EPS)).reshape(Bn, T, A_W) * p['rwkv_lnx_g'] + p['rwkv_lnx_b']
    bonus = jnp.sum(heads(rf)[:, :, None] * heads(k_dir) * p['rwkv_rk'], axis=-1, keepdims=True) * heads(vf)[:, :, None]
    y = y + jnp.sum(bonus, axis=2).reshape(Bn, T, A_W)
    return (y * g).astype(r.dtype), s_fin


def mla_project(cq, ckv, p):
    Bn, T, _ = cq.shape
    q = (rmsnorm(cq, p['mla_qnorm_g']) @ p['mla_w_uq']).reshape(Bn, T, B_HEADS, NOPE_DIM + ROPE_DIM)
    return q[..., :NOPE_DIM], q[..., NOPE_DIM:], rmsnorm(ckv, p['mla_kvnorm_g'])


def mla_attend(q_nope, q_pe, ckv, kpe, p):
    Bn, T = q_nope.shape[:2]
    S = ckv.shape[1]
    k_nope = (ckv @ p['mla_w_uk']).reshape(Bn, S, B_HEADS, NOPE_DIM)
    v = (ckv @ p['mla_w_uv']).reshape(Bn, S, B_HEADS, V_DIM)
    scale = (NOPE_DIM + ROPE_DIM) ** -0.5
    nb = T // Q_BLOCK
    blocks = lambda t: jnp.moveaxis(t.reshape((Bn, nb, Q_BLOCK) + t.shape[2:]), 1, 0)

    def attend(qb):
        qn, qp = qb
        s = (jnp.einsum('bqhd,bkhd->bhqk', qn, k_nope) + jnp.einsum('bqhr,bkr->bhqk', qp, kpe)).astype(jnp.float32) * scale
        pr = jax.nn.softmax(s, axis=-1).astype(v.dtype)
        return jnp.einsum('bhqk,bkhd->bqhd', pr, v)

    o = lax.map(attend, (blocks(q_nope), blocks(q_pe)))
    return jnp.moveaxis(o, 0, 1).reshape(Bn, T, B_W)


def chunk_gated_delta_rule(q, k, v, g, beta, s0):
    lead = q.shape[:-2]
    T = q.shape[-2]
    nc = T // CHUNK
    n_lead = len(lead)
    chunks = lambda t: t.reshape(lead + (nc, CHUNK) + t.shape[n_lead + 1:])
    q, k, v, g, beta = (chunks(t) for t in (q, k, v, g, beta))
    gam = jnp.cumsum(g, axis=-1)
    idx = jnp.arange(CHUNK)
    incl = idx[:, None] >= idx[None, :]
    strict = idx[:, None] > idx[None, :]
    decay = jnp.exp(jnp.where(incl, gam[..., :, None] - gam[..., None, :], -jnp.inf))
    kb = k * beta[..., None]
    lower = jnp.where(strict, jnp.einsum('...id,...jd->...ij', kb, k) * decay, 0.0)
    a_mat = jnp.eye(CHUNK, dtype=jnp.float32) + lower
    w = lax.linalg.triangular_solve(a_mat, kb * jnp.exp(gam)[..., None], left_side=True, lower=True)
    u = lax.linalg.triangular_solve(a_mat, v * beta[..., None], left_side=True, lower=True)
    qk = jnp.einsum('...id,...jd->...ij', q, k) * decay
    q_dec = q * jnp.exp(gam)[..., None]
    k_dec = k * jnp.exp(gam[..., -1:] - gam)[..., None]
    g_tot = jnp.exp(gam[..., -1])

    def step(S, inp):
        w_c, u_c, qd_c, qk_c, kd_c, gt_c = inp
        v_new = u_c - jnp.einsum('...cd,...de->...ce', w_c, S)
        o = jnp.einsum('...cd,...de->...ce', qd_c, S) + jnp.einsum('...cj,...je->...ce', qk_c, v_new)
        S = S * gt_c[..., None, None] + jnp.einsum('...cd,...ce->...de', kd_c, v_new)
        return S, o

    xs = tuple(jnp.moveaxis(t, n_lead, 0) for t in (w, u, q_dec, qk, k_dec, g_tot))
    s_fin, o = lax.scan(step, s0.astype(jnp.float32), xs)
    o = jnp.moveaxis(o, 0, n_lead).reshape(lead + (T, v.shape[-1]))
    return o, s_fin


def gated_deltanet_mixer(q, k, v, z, b_lo, a_lo, p, s0):
    f32 = jnp.float32
    Bn, T, _ = q.shape
    qkv = jax.nn.silu(centred_dwconv(jnp.concatenate([q, k, v], axis=-1), p['gdn_conv']))
    q, k, v = jnp.split(qkv, [C_HEADS * C_DK, 2 * C_HEADS * C_DK], axis=-1)
    q = l2norm(q.reshape(Bn, T, C_HEADS, C_DK)) * (C_DK ** -0.5)
    k = l2norm(k.reshape(Bn, T, C_HEADS, C_DK))
    v = v.reshape(Bn, T, C_HEADS, C_DV).astype(f32)
    beta = jax.nn.sigmoid(b_lo.reshape(Bn, T, N_DIR, C_HEADS).astype(f32))
    g = -jnp.exp(p['gdn_a_log'].astype(f32)) * jax.nn.softplus(a_lo.reshape(Bn, T, N_DIR, C_HEADS).astype(f32) + p['gdn_dt_bias'])
    to_lead = lambda t: jnp.moveaxis(t, 1, 3)
    o, s_fin = chunk_gated_delta_rule(to_lead(both_dirs(q)), to_lead(both_dirs(k)), to_lead(both_dirs(v)),
                                      to_lead(per_dir(g)), to_lead(per_dir(beta)), s0)
    o = merge_dirs(jnp.moveaxis(o, 3, 1))
    o = rmsnorm(o, p['gdn_norm_g']) * jax.nn.silu(z.reshape(Bn, T, C_HEADS, C_DV).astype(f32))
    return o.reshape(Bn, T, C_W).astype(z.dtype), s_fin


def trunk_layer(x, mod, p, rope=None, ctx=None):
    sh1, sc1, gt1, sh2, sc2, gt2 = mod
    Bn = x.shape[0]
    h = rmsnorm(x, p['norm1']) * (1.0 + sc1) + sh1
    (r, k, v, w_lo, a_lo, g_lo, cq, ckv, kpe, gq, gk, gv, gz, gb, ga) = split_cols(h @ p['w_in'], IN_SIZES)
    if ctx is None:
        s0_rwkv = jnp.zeros((Bn, N_DIR, A_HEADS, A_HEAD_DIM, A_HEAD_DIM), jnp.float32)
        s0_gdn = jnp.zeros((Bn, N_DIR, C_HEADS, C_DK, C_DV), jnp.float32)
    else:
        s0_rwkv, s0_gdn, ctx_ckv, ctx_kpe = ctx
    y_a, s_rwkv = rwkv7_mixer(r, k, v, w_lo, a_lo, g_lo, p, s0_rwkv)
    q_nope, q_pe, ckv_n = mla_project(cq, ckv, p)
    if ctx is None:
        y_b = mla_attend(q_nope, q_pe, ckv_n, kpe, p)
    else:
        keys_ckv = jnp.concatenate([ckv_n, ctx_ckv.astype(ckv_n.dtype)], axis=1)
        keys_kpe = jnp.concatenate([apply_rope(kpe, *rope), ctx_kpe.astype(kpe.dtype)], axis=1)
        y_b = mla_attend(q_nope, apply_rope(q_pe, *rope), keys_ckv, keys_kpe, p)
    y_c, s_gdn = gated_deltanet_mixer(gq, gk, gv, gz, gb, ga, p, s0_gdn)
    x = x + gt1 * (jnp.concatenate([y_a, y_b, y_c], axis=-1) @ p['w_out'])
    h = rmsnorm(x, p['norm2']) * (1.0 + sc2) + sh2
    gate, val = jnp.split(h @ p['ffn_up'], 2, axis=-1)
    x = x + gt2 * ((jax.nn.silu(centred_dwconv(gate, p['ffn_conv'])) * val) @ p['ffn_down'])
    cache_out = (s_rwkv, s_gdn, ckv_n, kpe) if ctx is None else None
    return x, cache_out


def setup_inputs(seed: int = 0) -> dict:
    key = jax.random.key(seed)
    ks = iter(jax.random.split(key, 48))
    f32 = jnp.float32
    L, D = DEPTH, D_MODEL

    def nrm(shape, scale):
        return jax.random.normal(next(ks), shape, f32) * scale

    def gain(shape):
        return 1.0 + nrm(shape, 0.02)

    def unif(shape, lo, hi):
        return jax.random.uniform(next(ks), shape, f32, lo, hi)

    dt = jnp.exp(unif((L, N_DIR, C_HEADS), math.log(1e-3), math.log(1e-1)))
    return {
        'x_prompt': nrm((BATCH, SEQ, D), 1.0),
        'x_sample': nrm((DEC_BATCH, DEC_SEQ, D), 1.0),
        'state_rwkv': nrm((DEC_BATCH, L, N_DIR, A_HEADS, A_HEAD_DIM, A_HEAD_DIM), 0.3),
        'state_gdn': nrm((DEC_BATCH, L, N_DIR, C_HEADS, C_DK, C_DV), 0.3),
        'cache_mla_ckv': nrm((DEC_BATCH, L, PAST_LEN, KV_RANK), 1.0),
        'cache_mla_kpe': nrm((DEC_BATCH, L, PAST_LEN, ROPE_DIM), 1.0),
        'c': nrm((DEC_BATCH, D), 1.0),
        'c_ctx': nrm((D,), 1.0),
        'ada_w': nrm((L, D, 6 * D), 0.5 * D ** -0.5),
        'ada_b': nrm((L, 6 * D), 0.02),
        'norm1_g': gain((L, D)),
        'w_in': nrm((L, D, IN_COLS), D ** -0.5),
        'rwkv_w0': unif((L, N_DIR, A_W), -5.0, -1.0),
        'rwkv_w2': nrm((L, N_DIR, DECAY_LORA, A_W), 0.3 * DECAY_LORA ** -0.5),
        'rwkv_a0': nrm((L, N_DIR, A_W), 0.3),
        'rwkv_a2': nrm((L, N_DIR, ICLR_LORA, A_W), 0.3 * ICLR_LORA ** -0.5),
        'rwkv_g2': nrm((L, GATE_LORA, A_W), GATE_LORA ** -0.5),
        'rwkv_kk': 1.0 + nrm((L, A_W), 0.1),
        'rwkv_ka': 1.0 + nrm((L, A_W), 0.1),
        'rwkv_rk': nrm((L, A_HEADS, A_HEAD_DIM), 0.1),
        'rwkv_lnx_g': gain((L, A_W)),
        'rwkv_lnx_b': nrm((L, A_W), 0.02),
        'mla_qnorm_g': gain((L, Q_RANK)),
        'mla_w_uq': nrm((L, Q_RANK, B_HEADS * (NOPE_DIM + ROPE_DIM)), Q_RANK ** -0.5),
        'mla_kvnorm_g': gain((L, KV_RANK)),
        'mla_w_uk': nrm((L, KV_RANK, B_HEADS * NOPE_DIM), KV_RANK ** -0.5),
        'mla_w_uv': nrm((L, KV_RANK, B_HEADS * V_DIM), KV_RANK ** -0.5),
        'gdn_conv': nrm((L, SHORT_CONV, 2 * C_HEADS * C_DK + C_W), SHORT_CONV ** -0.5),
        'gdn_a_log': jnp.log(unif((L, N_DIR, C_HEADS), 1.0, 16.0)),
        'gdn_dt_bias': dt + jnp.log(-jnp.expm1(-dt)),
        'gdn_norm_g': gain((L, C_DV)),
        'w_out': nrm((L, MIX_W, D), MIX_W ** -0.5),
        'norm2_g': gain((L, D)),
        'ffn_up': nrm((L, D, 2 * D_FF), D ** -0.5),
        'ffn_conv': nrm((L, FFN_CONV, D_FF), FFN_CONV ** -0.5),
        'ffn_down': nrm((L, D_FF, D), D_FF ** -0.5),
        'final_norm_g': gain((D,)),
    }


def reference(x_prompt, x_sample, state_rwkv, state_gdn, cache_mla_ckv, cache_mla_kpe, c,
              c_ctx, ada_w, ada_b, norm1_g, w_in, rwkv_w0, rwkv_w2, rwkv_a0, rwkv_a2, rwkv_g2,
              rwkv_kk, rwkv_ka, rwkv_rk, rwkv_lnx_g, rwkv_lnx_b, mla_qnorm_g, mla_w_uq, mla_kvnorm_g,
              mla_w_uk, mla_w_uv, gdn_conv, gdn_a_log, gdn_dt_bias, gdn_norm_g, w_out, norm2_g,
              ffn_up, ffn_conv, ffn_down, final_norm_g):
    rows = x_sample.shape[1] // GRID_W
    rope = axial_rope_tables(rows)
    y_p, y_s = x_prompt, x_sample
    new_rwkv, new_gdn, new_ckv, new_kpe = [], [], [], []
    for l in range(DEPTH):
        p = dict(norm1=norm1_g[l], w_in=w_in[l], rwkv_w0=rwkv_w0[l], rwkv_w2=rwkv_w2[l],
                 rwkv_a0=rwkv_a0[l], rwkv_a2=rwkv_a2[l], rwkv_g2=rwkv_g2[l], rwkv_kk=rwkv_kk[l],
                 rwkv_ka=rwkv_ka[l], rwkv_rk=rwkv_rk[l], rwkv_lnx_g=rwkv_lnx_g[l], rwkv_lnx_b=rwkv_lnx_b[l],
                 mla_qnorm_g=mla_qnorm_g[l], mla_w_uq=mla_w_uq[l], mla_kvnorm_g=mla_kvnorm_g[l],
                 mla_w_uk=mla_w_uk[l], mla_w_uv=mla_w_uv[l], gdn_conv=gdn_conv[l], gdn_a_log=gdn_a_log[l],
                 gdn_dt_bias=gdn_dt_bias[l], gdn_norm_g=gdn_norm_g[l], w_out=w_out[l], norm2=norm2_g[l],
                 ffn_up=ffn_up[l], ffn_conv=ffn_conv[l], ffn_down=ffn_down[l])
        y_p, (s_r, s_g, ck, kp) = trunk_layer(y_p, adaln_modulation(c_ctx, ada_w[l], ada_b[l]), p)
        new_rwkv.append(s_r)
        new_gdn.append(s_g)
        new_ckv.append(ck)
        new_kpe.append(kp)
        ctx = (state_rwkv[:, l], state_gdn[:, l], cache_mla_ckv[:, l], cache_mla_kpe[:, l])
        y_s, _ = trunk_layer(y_s, adaln_modulation(c, ada_w[l], ada_b[l]), p, rope, ctx)
    y_prompt = rmsnorm(y_p, final_norm_g)
    y_sample = rmsnorm(y_s, final_norm_g)
    return (y_prompt, y_sample, jnp.stack(new_rwkv, axis=1), jnp.stack(new_gdn, axis=1),
            jnp.stack(new_ckv, axis=1), jnp.stack(new_kpe, axis=1))
```

```cpp
#include <hip/hip_runtime.h>
#include <cstdio>
#define N_LAUNCH_MODE 0
#define HD __device__ __attribute__((always_inline))
#define UNROLL _Pragma("unroll")
#define CBAR asm volatile("" ::: "memory")
typedef float4 f4;
HD inline f4 ldf4(const float* p) { return *(const float4*)p; }
namespace cfg {
#ifdef SMALL_CFG
constexpr int D = 128, NB = 2, SEQ = 128, L = 2, NDB = 2, DSEQ = 256, PAST = 128, GRIDW = 16;
constexpr int AH = 2, AN = 64, DL = 16, IL = 16, GL = 32;
constexpr int BH = 2, QR = 64, KVR = 64, NOPE = 32, ROPE = 16, VD = 32;
constexpr int CH = 2, DK = 32, DV = 32, CHUNK = 64;
constexpr int DFF = 192;
#else
constexpr int D = 2048, NB = 16, SEQ = 256, L = 4, NDB = 2, DSEQ = 4096, PAST = 256, GRIDW = 64;
constexpr int AH = 8, AN = 64, DL = 64, IL = 64, GL = 128;
constexpr int BH = 8, QR = 512, KVR = 512, NOPE = 128, ROPE = 64, VD = 128;
constexpr int CH = 4, DK = 128, DV = 128, CHUNK = 64;
constexpr int DFF = 5632;
#endif
constexpr int AW = AH * AN, BW = BH * VD, CW = CH * DV, QKD = NOPE + ROPE, MIXW = AW + BW + CW;
constexpr int OFF_R = 0, OFF_K = AW, OFF_V = 2 * AW, OFF_WLO = 3 * AW, OFF_ALO = OFF_WLO + 2 * DL, OFF_GLO = OFF_ALO + 2 * IL,
              OFF_CQ = OFF_GLO + GL, OFF_CKV = OFF_CQ + QR, OFF_KPE = OFF_CKV + KVR, OFF_GQ = OFF_KPE + ROPE, OFF_GK = OFF_GQ + CH * DK,
              OFF_GV = OFF_GK + CH * DK, OFF_GZ = OFF_GV + CW, OFF_GB = OFF_GZ + CW, OFF_GA = OFF_GB + 2 * CH, INC = OFF_GA + 2 * CH;
constexpr int INP = (INC + 255) / 256 * 256;
constexpr int NSEQ = NB + NDB, MCTX = NB * SEQ, MLAT = NDB * DSEQ, MTOK = MCTX + MLAT, MKV = MTOK + NDB * PAST, NCOND = 1 + NDB;
constexpr int NQ = BH * QKD, NKV = BH * NOPE + BH * VD, NUP = 2 * DFF, GC = 2 * CH * DK + CW;
constexpr float RMS_EPS = 1e-6f, LNX_EPS = 64e-5f, L2_EPS = 1e-6f, ROPE_BASE = 10000.0f;
}
using namespace cfg;

#ifdef HOSTEMU
typedef float act_t;
struct act2 { float x, y; };
HD inline float a2f(act_t a) { return a; }
HD inline act_t f2a(float f) { return f; }
HD inline act2 ld2(const act_t* p) { act2 r; r.x = p[0]; r.y = p[1]; return r; }
HD inline act2 mk2(float x, float y) { act2 r; r.x = x; r.y = y; return r; }
HD inline float dot2(act2 a, act2 b, float c) { return c + a.x * b.x + a.y * b.y; }
HD inline float lo2(act2 a) { return a.x; }
HD inline float hi2(act2 a) { return a.y; }
#else
typedef unsigned short act_t;
typedef unsigned act2;
HD inline float a2f(act_t a) { return __uint_as_float(((unsigned)a) << 16); }
HD inline act_t f2a(float f) { unsigned u = __float_as_uint(f); return (act_t)((u + 0x7fffu + ((u >> 16) & 1u)) >> 16); }
HD inline act2 ld2(const act_t* p) { return *(const unsigned*)p; }
HD inline act2 mk2(float x, float y) { return (unsigned)f2a(x) | ((unsigned)f2a(y) << 16); }
HD inline float lo2(act2 a) { return __uint_as_float(a << 16); }
HD inline float hi2(act2 a) { return __uint_as_float(a & 0xffff0000u); }
typedef __bf16 bf16x2_t __attribute__((ext_vector_type(2)));
HD inline float dot2(act2 a, act2 b, float c) { return __builtin_amdgcn_fdot2_f32_bf16(__builtin_bit_cast(bf16x2_t, a), __builtin_bit_cast(bf16x2_t, b), c, false); }
#endif

struct P {
    const float *x_prompt, *x_sample, *state_rwkv, *state_gdn, *cache_ckv, *cache_kpe, *c, *c_ctx, *ada_w, *ada_b, *norm1_g, *w_in,
        *rwkv_w0, *rwkv_w2, *rwkv_a0, *rwkv_a2, *rwkv_g2, *rwkv_kk, *rwkv_ka, *rwkv_rk, *rwkv_lnx_g, *rwkv_lnx_b, *mla_qnorm_g, *mla_w_uq,
        *mla_kvnorm_g, *mla_w_uk, *mla_w_uv, *gdn_conv, *gdn_a_log, *gdn_dt_bias, *gdn_norm_g, *w_out, *norm2_g, *ffn_up, *ffn_conv, *ffn_down,
        *final_norm_g;
    float* out;
    unsigned char* ws;
};

constexpr size_t O_YP = 0, O_YS = O_YP + (size_t)MCTX * D, O_SR = O_YS + (size_t)MLAT * D, O_SG = O_SR + (size_t)NB * L * 2 * AH * AN * AN,
                 O_CK = O_SG + (size_t)NB * L * 2 * CH * DK * DV, O_KP = O_CK + (size_t)NB * L * SEQ * KVR, O_END = O_KP + (size_t)NB * L * SEQ * ROPE;

constexpr size_t al256(size_t x) { return (x + 255) / 256 * 256; }
constexpr size_t WS_CTL = 0, WS_CTL_BYTES = 64 * 1024;
constexpr size_t WS_MOD = WS_CTL + WS_CTL_BYTES;
constexpr size_t WS_X = al256(WS_MOD + (size_t)L * NCOND * 6 * D * 4);
constexpr size_t WS_H = al256(WS_X + (size_t)MTOK * D * 4);
constexpr size_t WS_YMIX = al256(WS_H + (size_t)MTOK * D * sizeof(act_t));
constexpr size_t WT_IN = 0, WT_UQ = WT_IN + (size_t)INP * D, WT_UKV = WT_UQ + (size_t)NQ * QR, WT_OUT = WT_UKV + (size_t)NKV * KVR,
                 WT_UP = WT_OUT + (size_t)D * MIXW, WT_DOWN = WT_UP + (size_t)NUP * D, WT_LAYER = WT_DOWN + (size_t)D * DFF;
constexpr size_t WS_WT = al256(WS_YMIX + (size_t)MTOK * MIXW * sizeof(act_t));
constexpr size_t WS_U0 = al256(WS_WT + (size_t)L * WT_LAYER * 2);
constexpr size_t WS_PP = WS_U0;
constexpr size_t WS_RWDEC = al256(WS_PP + (size_t)MTOK * INP * 4);
constexpr size_t WS_RWKDIR = al256(WS_RWDEC + (size_t)MTOK * 2 * AW * 4);
constexpr size_t WS_RWKKA = al256(WS_RWKDIR + (size_t)MTOK * 2 * AW * 4);
constexpr size_t WS_RWKK = al256(WS_RWKKA + (size_t)MTOK * 2 * AW * 4);
constexpr size_t WS_RWG = al256(WS_RWKK + (size_t)MTOK * AW * 4);
constexpr size_t WS_RWY = al256(WS_RWG + (size_t)MTOK * AW * 4);
constexpr size_t WS_CQN = al256(WS_RWY + (size_t)MTOK * 2 * AW * 4);
constexpr size_t WS_CKVN = al256(WS_CQN + (size_t)MTOK * QR * sizeof(act_t));
constexpr size_t WS_KR = al256(WS_CKVN + (size_t)MKV * KVR * sizeof(act_t));
constexpr size_t WS_QF = al256(WS_KR + (size_t)MKV * ROPE * sizeof(act_t));
constexpr size_t WS_KVUP = al256(WS_QF + (size_t)MTOK * NQ * sizeof(act_t));
constexpr size_t WS_GCONV = al256(WS_KVUP + (size_t)MKV * NKV * sizeof(act_t));
constexpr size_t WS_GBG = al256(WS_GCONV + (size_t)MTOK * GC * 4);
constexpr size_t WS_GO = al256(WS_GBG + (size_t)MTOK * 2 * CH * 2 * 4);
constexpr size_t WS_MIX_END = al256(WS_GO + (size_t)MTOK * 2 * CW * 4);
constexpr size_t WS_UP = WS_U0;
constexpr size_t WS_ACT = al256(WS_UP + (size_t)MTOK * NUP * sizeof(act_t));
constexpr size_t WS_FFN_END = al256(WS_ACT + (size_t)MTOK * DFF * sizeof(act_t));
constexpr size_t WS_END = WS_MIX_END > WS_FFN_END ? WS_MIX_END : WS_FFN_END;

HD inline int seq_of(int m) { return m < MCTX ? m / SEQ : NB + (m - MCTX) / DSEQ; }
HD inline int seq_start(int s) { return s < NB ? s * SEQ : MCTX + (s - NB) * DSEQ; }
HD inline int seq_len(int s) { return s < NB ? SEQ : DSEQ; }
HD inline int cond_of_seq(int s) { return s < NB ? 0 : 1 + (s - NB); }
HD inline float sigmoidf_(float x) { return 1.0f / (1.0f + expf(-x)); }
HD inline float siluf_(float x) { return x / (1.0f + expf(-x)); }
HD inline float softplusf_(float x) { return fmaxf(x, 0.0f) + log1pf(expf(-fabsf(x))); }
HD inline const float* modp(const P& p, int l, int cond, int which) { return (const float*)(p.ws + WS_MOD) + ((size_t)(l * NCOND + cond) * 6 + which) * D; }

HD inline void ph_init(const P& p, long gt, long gs) {
    float* x = (float*)(p.ws + WS_X);
    for (long i = gt; i < (long)MTOK * D; i += gs) x[i] = i < (long)MCTX * D ? p.x_prompt[i] : p.x_sample[i - (long)MCTX * D];
    float* mod = (float*)(p.ws + WS_MOD);
    for (long idx = gt; idx < (long)L * 6 * D; idx += gs) {
        const int l = (int)(idx / (6 * D)), j = (int)(idx % (6 * D));
        float acc[NCOND];
        UNROLL for (int c = 0; c < NCOND; ++c) acc[c] = 0.f;
        for (int i = 0; i < D; ++i) {
            const float w = p.ada_w[((size_t)l * D + i) * 6 * D + j];
            acc[0] += siluf_(p.c_ctx[i]) * w;
            UNROLL for (int c = 1; c < NCOND; ++c) acc[c] += siluf_(p.c[(size_t)(c - 1) * D + i]) * w;
        }
        const float b = p.ada_b[(size_t)l * 6 * D + j];
        UNROLL for (int c = 0; c < NCOND; ++c) mod[((size_t)(l * NCOND + c) * 6) * D + j] = acc[c] + b;
    }
}

HD inline void ph_norm(const P& p, int l, int which, long gt, long gs) {
    const float* x = (const float*)(p.ws + WS_X);
    act_t* h = (act_t*)(p.ws + WS_H);
    const float* g = (which == 0 ? p.norm1_g : p.norm2_g) + (size_t)l * D;
    for (long m = gt; m < MTOK; m += gs) {
        const int cond = cond_of_seq(seq_of((int)m));
        const float* sh = modp(p, l, cond, which * 3 + 0);
        const float* sc = modp(p, l, cond, which * 3 + 1);
        const float* xr = x + (size_t)m * D;
        float ss = 0.f;
        for (int j = 0; j < D; ++j) ss += xr[j] * xr[j];
        const float rs = 1.0f / sqrtf(ss / D + RMS_EPS);
        for (int j = 0; j < D; ++j) h[(size_t)m * D + j] = f2a(xr[j] * rs * g[j] * (1.0f + sc[j]) + sh[j]);
    }
}

HD inline void ph_rwkv_prep(const P& p, int l, long gt, long gs) {
    const float* pp = (const float*)(p.ws + WS_PP);
    float* dec = (float*)(p.ws + WS_RWDEC); float* kdir = (float*)(p.ws + WS_RWKDIR); float* kka = (float*)(p.ws + WS_RWKKA);
    float* kkb = (float*)(p.ws + WS_RWKK); float* gb = (float*)(p.ws + WS_RWG);
    for (long idx = gt; idx < (long)MTOK * AW; idx += gs) {
        const int m = (int)(idx / AW), c = (int)(idx % AW), h = c / AN;
        const float* pr = pp + (size_t)m * INP;
        const float* kksc = p.rwkv_kk + (size_t)l * AW;
        float ss = 0.f;
        for (int j = 0; j < AN; ++j) { const float t = pr[OFF_K + h * AN + j] * kksc[h * AN + j]; ss += t * t; }
        const float kraw = pr[OFF_K + c];
        const float kk = kraw * kksc[c] / sqrtf(ss + L2_EPS);
        kkb[(size_t)m * AW + c] = kk;
        for (int d = 0; d < 2; ++d) {
            float wpre = p.rwkv_w0[((size_t)l * 2 + d) * AW + c];
            for (int r = 0; r < DL; ++r) wpre += tanhf(pr[OFF_WLO + d * DL + r]) * p.rwkv_w2[(((size_t)l * 2 + d) * DL + r) * AW + c];
            const float logw = -expf(-softplusf_(-wpre) - 0.5f);
            float apre = p.rwkv_a0[((size_t)l * 2 + d) * AW + c];
            for (int r = 0; r < IL; ++r) apre += pr[OFF_ALO + d * IL + r] * p.rwkv_a2[(((size_t)l * 2 + d) * IL + r) * AW + c];
            const float a = sigmoidf_(apre);
            const size_t o = ((size_t)m * 2 + d) * AW + c;
            dec[o] = expf(logw);
            kdir[o] = kraw * (1.0f + (a - 1.0f) * p.rwkv_ka[(size_t)l * AW + c]);
            kka[o] = kk * a;
        }
        float g = 0.f;
        for (int r = 0; r < GL; ++r) g += sigmoidf_(pr[OFF_GLO + r]) * p.rwkv_g2[((size_t)l * GL + r) * AW + c];
        gb[(size_t)m * AW + c] = g;
    }
}

HD inline void ph_rwkv_scan(const P& p, int l, long gt, long gs) {
    const float* pp = (const float*)(p.ws + WS_PP);
    const float* dec = (const float*)(p.ws + WS_RWDEC); const float* kdir = (const float*)(p.ws + WS_RWKDIR); const float* kka = (const float*)(p.ws + WS_RWKKA);
    const float* kkb = (const float*)(p.ws + WS_RWKK); float* yb = (float*)(p.ws + WS_RWY);
    for (long idx = gt; idx < (long)NSEQ * 2 * AH * AN; idx += gs) {
        const int i = (int)(idx % AN), h = (int)((idx / AN) % AH), d = (int)((idx / (AN * AH)) % 2), s = (int)(idx / (AN * AH * 2));
        float S[AN];
        if (s >= NB) { const float* s0 = p.state_rwkv + (((((size_t)(s - NB) * L + l) * 2 + d) * AH + h) * AN + i) * AN; UNROLL for (int k = 0; k < AN; ++k) S[k] = s0[k]; }
        else { UNROLL for (int k = 0; k < AN; ++k) S[k] = 0.f; }
        const int T = seq_len(s), base = seq_start(s);
        for (int step = 0; step < T; ++step) {
            const int m = base + (d == 0 ? step : T - 1 - step);
            const float* pr = pp + (size_t)m * INP;
            const float* kk = kkb + (size_t)m * AW + h * AN;
            const size_t o = ((size_t)m * 2 + d) * AW + h * AN;
            float sa = 0.f;
            UNROLL for (int k = 0; k < AN; k += 4) { const f4 t = ldf4(kk + k); sa -= S[k] * t.x + S[k + 1] * t.y + S[k + 2] * t.z + S[k + 3] * t.w; }
            const float vi = pr[OFF_V + h * AN + i];
            float y = 0.f;
            UNROLL for (int k = 0; k < AN; k += 4) {
                const f4 w4 = ldf4(dec + o + k), a4 = ldf4(kka + o + k), k4 = ldf4(kdir + o + k), r4 = ldf4(pr + OFF_R + h * AN + k);
                S[k] = S[k] * w4.x + sa * a4.x + vi * k4.x; y += S[k] * r4.x;
                S[k + 1] = S[k + 1] * w4.y + sa * a4.y + vi * k4.y; y += S[k + 1] * r4.y;
                S[k + 2] = S[k + 2] * w4.z + sa * a4.z + vi * k4.z; y += S[k + 2] * r4.z;
                S[k + 3] = S[k + 3] * w4.w + sa * a4.w + vi * k4.w; y += S[k + 3] * r4.w;
            }
            yb[o + i] = y;
        }
        if (s < NB) { float* so = p.out + O_SR + (((((size_t)s * L + l) * 2 + d) * AH + h) * AN + i) * AN; UNROLL for (int k = 0; k < AN; ++k) so[k] = S[k]; }
    }
}

HD inline void ph_rwkv_post(const P& p, int l, long gt, long gs) {
    const float* pp = (const float*)(p.ws + WS_PP);
    const float* kdir = (const float*)(p.ws + WS_RWKDIR); const float* gb = (const float*)(p.ws + WS_RWG); const float* yb = (const float*)(p.ws + WS_RWY);
    act_t* ymix = (act_t*)(p.ws + WS_YMIX);
    for (long idx = gt; idx < (long)MTOK * AW; idx += gs) {
        const int m = (int)(idx / AW), c = (int)(idx % AW), h = c / AN;
        const float* pr = pp + (size_t)m * INP;
        const float* y0 = yb + ((size_t)m * 2 + 0) * AW + h * AN; const float* y1 = yb + ((size_t)m * 2 + 1) * AW + h * AN;
        float mu = 0.f;
        for (int j = 0; j < AN; ++j) mu += y0[j] + y1[j];
        mu /= AN;
        float var = 0.f;
        for (int j = 0; j < AN; ++j) { const float t = y0[j] + y1[j] - mu; var += t * t; }
        var /= AN;
        const float yc = yb[((size_t)m * 2 + 0) * AW + c] + yb[((size_t)m * 2 + 1) * AW + c];
        float y = (yc - mu) / sqrtf(var + LNX_EPS) * p.rwkv_lnx_g[(size_t)l * AW + c] + p.rwkv_lnx_b[(size_t)l * AW + c];
        float bon = 0.f;
        for (int d = 0; d < 2; ++d) for (int j = 0; j < AN; ++j)
            bon += pr[OFF_R + h * AN + j] * kdir[((size_t)m * 2 + d) * AW + h * AN + j] * p.rwkv_rk[((size_t)l * AH + h) * AN + j];
        y += bon * pr[OFF_V + c];
        ymix[(size_t)m * MIXW + c] = f2a(y * gb[(size_t)m * AW + c]);
    }
}

HD inline void rope_angle(int t, int i, float& cs, float& sn) {
    const int nf = ROPE / 4; const int row = t / GRIDW, col = t % GRIDW;
    const int f = i < nf ? i : i - nf;
    const float inv = powf(ROPE_BASE, -(float)f / (float)nf);
    const float ang = (float)(i < nf ? row : col) * inv;
    cs = cosf(ang); sn = sinf(ang);
}
HD inline void ph_mla_prep(const P& p, int l, long gt, long gs) {
    const float* pp = (const float*)(p.ws + WS_PP);
    act_t* cqn = (act_t*)(p.ws + WS_CQN); act_t* ckvn = (act_t*)(p.ws + WS_CKVN); act_t* kr = (act_t*)(p.ws + WS_KR);
    for (long m = gt; m < MKV; m += gs) {
        if (m < MTOK) {
            const float* pr = pp + (size_t)m * INP;
            const int s = seq_of((int)m), t = (int)m - seq_start(s);
            float ss = 0.f;
            for (int j = 0; j < QR; ++j) ss += pr[OFF_CQ + j] * pr[OFF_CQ + j];
            float rs = 1.0f / sqrtf(ss / QR + RMS_EPS);
            for (int j = 0; j < QR; ++j) cqn[(size_t)m * QR + j] = f2a(pr[OFF_CQ + j] * rs * p.mla_qnorm_g[(size_t)l * QR + j]);
            ss = 0.f;
            for (int j = 0; j < KVR; ++j) ss += pr[OFF_CKV + j] * pr[OFF_CKV + j];
            rs = 1.0f / sqrtf(ss / KVR + RMS_EPS);
            for (int j = 0; j < KVR; ++j) {
                const float v = pr[OFF_CKV + j] * rs * p.mla_kvnorm_g[(size_t)l * KVR + j];
                ckvn[(size_t)m * KVR + j] = f2a(v);
                if (s < NB) p.out[O_CK + (((size_t)s * L + l) * SEQ + t) * KVR + j] = v;
            }
            if (s < NB) {
                for (int j = 0; j < ROPE; ++j) { const float v = pr[OFF_KPE + j]; kr[(size_t)m * ROPE + j] = f2a(v); p.out[O_KP + (((size_t)s * L + l) * SEQ + t) * ROPE + j] = v; }
            } else {
                for (int i = 0; i < ROPE / 2; ++i) {
                    float cs, sn; rope_angle(t, i, cs, sn);
                    const float xe = pr[OFF_KPE + 2 * i], xo = pr[OFF_KPE + 2 * i + 1];
                    kr[(size_t)m * ROPE + 2 * i] = f2a(xe * cs - xo * sn); kr[(size_t)m * ROPE + 2 * i + 1] = f2a(xe * sn + xo * cs);
                }
            }
        } else {
            const int r = (int)m - MTOK, b = r / PAST, j0 = r % PAST;
            const float* ck = p.cache_ckv + (((size_t)b * L + l) * PAST + j0) * KVR;
            for (int j = 0; j < KVR; ++j) ckvn[(size_t)m * KVR + j] = f2a(ck[j]);
            const float* kp = p.cache_kpe + (((size_t)b * L + l) * PAST + j0) * ROPE;
            for (int j = 0; j < ROPE; ++j) kr[(size_t)m * ROPE + j] = f2a(kp[j]);
        }
    }
}

constexpr int VSL = 32, NVS = VD / VSL;
HD inline void ph_attn(const P& p, int l, long gt, long gs) {
    (void)l;
    const act_t* qf = (const act_t*)(p.ws + WS_QF); const act_t* kvup = (const act_t*)(p.ws + WS_KVUP); const act_t* kr = (const act_t*)(p.ws + WS_KR);
    act_t* ymix = (act_t*)(p.ws + WS_YMIX);
    const float scale = 1.0f / sqrtf((float)QKD);
    for (long idx = gt; idx < (long)MTOK * BH * NVS; idx += gs) {
        const int m = (int)(idx % MTOK), vs = (int)((idx / MTOK) % NVS), h = (int)(idx / ((long)MTOK * NVS));
        const int s = seq_of(m), base = seq_start(s), t = m - base, T = seq_len(s);
        const bool lat = s >= NB;
        act2 q[QKD / 2];
        const act_t* qr = qf + (size_t)m * NQ + h * QKD;
        UNROLL for (int i = 0; i < NOPE / 2; ++i) q[i] = ld2(qr + 2 * i);
        UNROLL for (int i = 0; i < ROPE / 2; ++i) {
            const act2 v = ld2(qr + NOPE + 2 * i);
            if (lat) { float cs, sn; rope_angle(t, i, cs, sn); const float xe = lo2(v), xo = hi2(v); q[NOPE / 2 + i] = mk2(xe * cs - xo * sn, xe * sn + xo * cs); }
            else q[NOPE / 2 + i] = v;
        }
        float mx = -1e30f, sum = 0.f, acc[VSL];
        UNROLL for (int e = 0; e < VSL; ++e) acc[e] = 0.f;
        const int nk = T + (lat ? PAST : 0);
        for (int j = 0; j < nk; ++j) {
            const size_t krow = j < T ? (size_t)(base + j) : (size_t)(MTOK + (s - NB) * PAST + (j - T));
            const act_t* kn = kvup + krow * NKV + h * NOPE;
            const act_t* kp = kr + krow * ROPE;
            float sc = 0.f;
            UNROLL for (int i = 0; i < NOPE / 2; ++i) sc = dot2(q[i], ld2(kn + 2 * i), sc);
            UNROLL for (int i = 0; i < ROPE / 2; ++i) sc = dot2(q[NOPE / 2 + i], ld2(kp + 2 * i), sc);
            sc *= scale;
            if (sc > mx) { const float corr = expf(mx - sc); sum *= corr; UNROLL for (int e = 0; e < VSL; ++e) acc[e] *= corr; mx = sc; }
            const float pe = expf(sc - mx);
            sum += pe;
            const act_t* vv = kvup + krow * NKV + BH * NOPE + h * VD + vs * VSL;
            UNROLL for (int e = 0; e < VSL; e += 2) { const act2 v2 = ld2(vv + e); acc[e] += pe * lo2(v2); acc[e + 1] += pe * hi2(v2); }
        }
        const float inv = 1.0f / sum;
        UNROLL for (int e = 0; e < VSL; ++e) ymix[(size_t)m * MIXW + AW + h * VD + vs * VSL + e] = f2a(acc[e] * inv);
    }
}

HD inline void ph_gdn_conv(const P& p, int l, long gt, long gs) {
    const float* pp = (const float*)(p.ws + WS_PP);
    float* gc = (float*)(p.ws + WS_GCONV);
    for (long idx = gt; idx < (long)MTOK * GC; idx += gs) {
        const int m = (int)(idx / GC), c = (int)(idx % GC);
        const int s = seq_of(m), base = seq_start(s), t = m - base, T = seq_len(s);
        const float* w = p.gdn_conv + (size_t)l * 3 * GC;
        float a = w[GC + c] * pp[(size_t)m * INP + OFF_GQ + c];
        if (t > 0) a += w[c] * pp[(size_t)(m - 1) * INP + OFF_GQ + c];
        if (t < T - 1) a += w[2 * GC + c] * pp[(size_t)(m + 1) * INP + OFF_GQ + c];
        gc[(size_t)m * GC + c] = siluf_(a);
    }
}
HD inline void ph_gdn_norm(const P& p, int l, long gt, long gs) {
    const float* pp = (const float*)(p.ws + WS_PP);
    float* gc = (float*)(p.ws + WS_GCONV); float* bg = (float*)(p.ws + WS_GBG);
    for (long idx = gt; idx < (long)MTOK * 4 * CH; idx += gs) {
        const int m = (int)(idx / (4 * CH)), j = (int)(idx % (4 * CH));
        if (j < 2 * CH) {
            float* v = gc + (size_t)m * GC + j * DK;
            float ss = 0.f;
            for (int e = 0; e < DK; ++e) ss += v[e] * v[e];
            const float rs = (1.0f / sqrtf(ss + L2_EPS)) * (j < CH ? 1.0f / sqrtf((float)DK) : 1.0f);
            for (int e = 0; e < DK; ++e) v[e] *= rs;
        } else {
            const int dh = j - 2 * CH;
            const float* pr = pp + (size_t)m * INP;
            const float beta = sigmoidf_(pr[OFF_GB + dh]);
            const float g = -expf(p.gdn_a_log[(size_t)l * 2 * CH + dh]) * softplusf_(pr[OFF_GA + dh] + p.gdn_dt_bias[(size_t)l * 2 * CH + dh]);
            bg[((size_t)m * 2 * CH + dh) * 2 + 0] = beta; bg[((size_t)m * 2 * CH + dh) * 2 + 1] = g;
        }
    }
}
HD inline void ph_gdn_scan(const P& p, int l, long gt, long gs) {
    const float* gc = (const float*)(p.ws + WS_GCONV); const float* bg = (const float*)(p.ws + WS_GBG); float* go = (float*)(p.ws + WS_GO);
    for (long idx = gt; idx < (long)NSEQ * 2 * CH * DV; idx += gs) {
        const int e = (int)(idx % DV), h = (int)((idx / DV) % CH), d = (int)((idx / (DV * CH)) % 2), s = (int)(idx / (DV * CH * 2));
        float S[DK];
        if (s >= NB) { const float* s0 = p.state_gdn + ((((size_t)(s - NB) * L + l) * 2 + d) * CH + h) * DK * DV + e; UNROLL for (int k = 0; k < DK; ++k) S[k] = s0[(size_t)k * DV]; }
        else { UNROLL for (int k = 0; k < DK; ++k) S[k] = 0.f; }
        const int T = seq_len(s), base = seq_start(s);
        for (int step = 0; step < T; ++step) {
            const int m = base + (d == 0 ? step : T - 1 - step);
            const float* q = gc + (size_t)m * GC + h * DK; const float* k = gc + (size_t)m * GC + CH * DK + h * DK;
            const float v = gc[(size_t)m * GC + 2 * CH * DK + h * DV + e];
            const float beta = bg[((size_t)m * 2 * CH + d * CH + h) * 2 + 0], eg = expf(bg[((size_t)m * 2 * CH + d * CH + h) * 2 + 1]);
            float kS = 0.f;
            UNROLL for (int j = 0; j < DK; j += 4) { if ((j & 15) == 0) CBAR; const f4 t = ldf4(k + j); kS += t.x * S[j] + t.y * S[j + 1] + t.z * S[j + 2] + t.w * S[j + 3]; }
            const float coef = beta * (v - eg * kS);
            float o = 0.f;
            UNROLL for (int j = 0; j < DK; j += 4) {
                if ((j & 15) == 0) CBAR;
                const f4 t = ldf4(k + j), u = ldf4(q + j);
                S[j] = eg * S[j] + t.x * coef; o += u.x * S[j];
                S[j + 1] = eg * S[j + 1] + t.y * coef; o += u.y * S[j + 1];
                S[j + 2] = eg * S[j + 2] + t.z * coef; o += u.z * S[j + 2];
                S[j + 3] = eg * S[j + 3] + t.w * coef; o += u.w * S[j + 3];
            }
            go[((size_t)m * 2 + d) * CW + h * DV + e] = o;
        }
        if (s < NB) { float* so = p.out + O_SG + ((((size_t)s * L + l) * 2 + d) * CH + h) * DK * DV + e; UNROLL for (int k = 0; k < DK; ++k) so[(size_t)k * DV] = S[k]; }
    }
}
HD inline void ph_gdn_post(const P& p, int l, long gt, long gs) {
    const float* pp = (const float*)(p.ws + WS_PP); const float* go = (const float*)(p.ws + WS_GO);
    act_t* ymix = (act_t*)(p.ws + WS_YMIX);
    for (long idx = gt; idx < (long)MTOK * CH; idx += gs) {
        const int m = (int)(idx / CH), h = (int)(idx % CH);
        const float* o0 = go + ((size_t)m * 2 + 0) * CW + h * DV; const float* o1 = go + ((size_t)m * 2 + 1) * CW + h * DV;
        float ss = 0.f;
        for (int e = 0; e < DV; ++e) { const float t = o0[e] + o1[e]; ss += t * t; }
        const float rs = 1.0f / sqrtf(ss / DV + RMS_EPS);
        for (int e = 0; e < DV; ++e) {
            const float z = pp[(size_t)m * INP + OFF_GZ + h * DV + e];
            ymix[(size_t)m * MIXW + AW + BW + h * DV + e] = f2a((o0[e] + o1[e]) * rs * p.gdn_norm_g[(size_t)l * DV + e] * siluf_(z));
        }
    }
}
HD inline void ph_ffn_act(const P& p, int l, long gt, long gs) {
    const act_t* up = (const act_t*)(p.ws + WS_UP); act_t* act = (act_t*)(p.ws + WS_ACT);
    for (long idx = gt; idx < (long)MTOK * DFF; idx += gs) {
        const int m = (int)(idx / DFF), c = (int)(idx % DFF);
        const int s = seq_of(m), base = seq_start(s), t = m - base, T = seq_len(s);
        const float* w = p.ffn_conv + (size_t)l * 3 * DFF;
        float a = w[DFF + c] * a2f(up[(size_t)m * NUP + c]);
        if (t > 0) a += w[c] * a2f(up[(size_t)(m - 1) * NUP + c]);
        if (t < T - 1) a += w[2 * DFF + c] * a2f(up[(size_t)(m + 1) * NUP + c]);
        act[(size_t)m * DFF + c] = f2a(siluf_(a) * a2f(up[(size_t)m * NUP + DFF + c]));
    }
}
HD inline void ph_final(const P& p, long gt, long gs) {
    const float* x = (const float*)(p.ws + WS_X);
    for (long m = gt; m < MTOK; m += gs) {
        const float* xr = x + (size_t)m * D;
        float ss = 0.f;
        for (int j = 0; j < D; ++j) ss += xr[j] * xr[j];
        const float rs = 1.0f / sqrtf(ss / D + RMS_EPS);
        for (int j = 0; j < D; ++j) p.out[O_YP + (size_t)m * D + j] = xr[j] * rs * p.final_norm_g[j];
    }
}
HD inline void ph_gemm_naive(const P& p, const act_t* A, int lda, const float* W, int ldw, int M, int N, int K, int mode, float* Cf, act_t* Ca, int ldc, int l, int which,
                             long gt, long gs) {
    for (long idx = gt; idx < (long)M * N; idx += gs) {
        const int m = (int)(idx / N), n = (int)(idx % N);
        float acc = 0.f;
        for (int k = 0; k < K; ++k) acc += a2f(A[(size_t)m * lda + k]) * W[(size_t)k * ldw + n];
        if (mode == 0) Cf[(size_t)m * ldc + n] = acc;
        else if (mode == 1) Ca[(size_t)m * ldc + n] = f2a(acc);
        else { const float* gate = modp(p, l, cond_of_seq(seq_of(m)), which); Cf[(size_t)m * ldc + n] += gate[n] * acc; }
    }
}
namespace pg8 {
#define PG8_LAS __attribute__((address_space(3)))
typedef unsigned short bf16_t;
typedef short bf16x8 __attribute__((ext_vector_type(8)));
typedef float f32x4 __attribute__((ext_vector_type(4)));
typedef unsigned u32x4 __attribute__((ext_vector_type(4)));
constexpr int BM = 256, BK = 64, HALF = 128, HTB = HALF * BK * 2  , STAGE_BYTES = 8 * HTB, NXCD = 8, WGM = 8;

__host__ __device__ __forceinline__ int lds_byte(int r, int c) { const int st = (r >> 4) * 2 + (c >> 5), rr = r & 15, cc = c & 31, ob = rr * 64 + cc * 2; return st * 1024 + (ob ^ (((ob >> 9) & 1) << 5)); }
__host__ __device__ __forceinline__ void stage_rc(int b, int& R, int& C) { const int st = b / 1024, sb = b % 1024, swz = sb ^ (((sb >> 9) & 1) << 5); R = (st >> 1) * 16 + swz / 64; C = (st & 1) * 32 + (swz % 64) / 2; }
__host__ __device__ __forceinline__ int perm32(int rho) { const int n = rho >> 4, i = rho & 15; return 8 * (i >> 2) + 4 * n + (i & 3); }

struct Unit { int pm, pn; };
struct Gemm { const bf16_t* A; const bf16_t* Bt; int M, N, K; };

struct StaticOrder {
    int nM, nN, nwg, G, c;
    __host__ __device__ void init(int M, int N, int G_, int c_) { nM = M / BM; nN = N / BM; nwg = nM * nN; G = G_; c = c_; }
    __host__ __device__ bool next(int i, Unit& u) const {
        const long L = (long)i * G + c; if (L >= nwg) return false;
        int wgid = (int)L; { const int q = nwg / NXCD, r = nwg % NXCD, xcd = wgid % NXCD, off = wgid / NXCD; wgid = (xcd < r ? xcd * (q + 1) : r * (q + 1) + (xcd - r) * q) + off; }
        const int nig = WGM * nN, gid = wgid / nig, fm = gid * WGM, gsz = (nM - fm) < WGM ? (nM - fm) : WGM;
        u.pm = fm + ((wgid % nig) % gsz); u.pn = (wgid % nig) / gsz; return true;
    }
    __device__ __forceinline__ void a_ready(const Unit&) const {}
    __device__ __forceinline__ void done(const Unit&) const {}
};
struct CountedOrder : StaticOrder {
    const unsigned* ready; unsigned need; unsigned* tmo;
    __device__ __forceinline__ void a_ready(const Unit& u) const {
        if (threadIdx.x < 64) {
            const unsigned long long t0 = __builtin_amdgcn_s_memrealtime(); unsigned polls = 0;
            while ((unsigned)__builtin_amdgcn_readfirstlane(__hip_atomic_load(ready + 64 * u.pm, __ATOMIC_RELAXED, __HIP_MEMORY_SCOPE_AGENT)) < need) {
                if ((++polls & 255u) == 0u && __builtin_amdgcn_readfirstlane(__hip_atomic_load(tmo, __ATOMIC_RELAXED, __HIP_MEMORY_SCOPE_AGENT)) != 0u) break;
                if (__builtin_amdgcn_s_memrealtime() - t0 > 2000000ull) {
                    if (threadIdx.x == 0) { unsigned expect = 0u; __hip_atomic_compare_exchange_strong(tmo + 1, &expect, 0x600u | (unsigned)(u.pm & 0xff), __ATOMIC_RELAXED, __ATOMIC_RELAXED, __HIP_MEMORY_SCOPE_AGENT); __hip_atomic_store(tmo, 1u, __ATOMIC_RELAXED, __HIP_MEMORY_SCOPE_AGENT); }
                    break; }
                __builtin_amdgcn_s_sleep(2); }
            __builtin_amdgcn_fence(__ATOMIC_ACQUIRE, "agent");
            asm volatile("s_waitcnt vmcnt(0)" ::: "memory");
        }
#if !defined(BROKEN_HOOK_NO_BARRIER)
        asm volatile("" ::: "memory"); __builtin_amdgcn_s_barrier(); asm volatile("" ::: "memory");
#endif
    }
};

__device__ __forceinline__ unsigned cvt_pk_bf16(float lo, float hi) { unsigned r; asm volatile("v_cvt_pk_bf16_f32 %0, %1, %2" : "=v"(r) : "v"(lo), "v"(hi)); return r; }
typedef float f32x2 __attribute__((ext_vector_type(2)));
__device__ __forceinline__ f32x2 gelu_pk(f32x2 v) {
    const f32x2 av = __builtin_elementwise_abs(v), d = av * 0.2316418882f + 1.0f;
    f32x2 t; t.x = __builtin_amdgcn_rcpf(d.x); t.y = __builtin_amdgcn_rcpf(d.y);
    f32x2 q = t * 0.5307027145f + (-0.7265760135f); q = q * t + 0.7107068705f; q = q * t + (-0.142248368f); q = q * t + 0.127414796f; q = q * t;
    const f32x2 s = (v * v) * (-0.72134752044f);
    f32x2 e; e.x = __builtin_amdgcn_exp2f(s.x); e.y = __builtin_amdgcn_exp2f(s.y);
    const f32x2 m = v * (q * e), r = v - m;
    f32x2 o; o.x = v.x < 0.f ? m.x : r.x; o.y = v.y < 0.f ? m.y : r.y; return o;
}

struct EpiF32 {
    static constexpr bool PERM = false, AFTER_DRAIN = false;
    float* C; int ldc; const float* bias;
    __device__ __forceinline__ void operator()(const f32x4 (&acc)[2][2][4][2], const Unit& u, int wr, int wc, int fr, int fq) const {
        const int row0 = u.pm * BM + wr * 64 + fr, col0 = u.pn * BM + wc * 32 + 4 * fq;
        f32x4 bv[2][2];
#pragma unroll
        for (int bj = 0; bj < 2; ++bj)
#pragma unroll
            for (int n = 0; n < 2; ++n) bv[bj][n] = bias ? *(const f32x4*)(bias + col0 + bj * HALF + n * 16) : (f32x4){0.f, 0.f, 0.f, 0.f};
#pragma unroll
        for (int ai = 0; ai < 2; ++ai)
#pragma unroll
            for (int m = 0; m < 4; ++m) { float* rowp = C + (size_t)(row0 + ai * HALF + m * 16) * ldc + col0;
#pragma unroll
                for (int bj = 0; bj < 2; ++bj)
#pragma unroll
                    for (int n = 0; n < 2; ++n) *(f32x4*)(rowp + bj * HALF + n * 16) = acc[ai][bj][m][n] + bv[bj][n]; }
    }
};
template <int ACT  > struct EpiBf16 {
    static constexpr bool PERM = true, AFTER_DRAIN = false;
    bf16_t* O; int ldc; const float* bias; int split_cols; size_t split_stride;
    __device__ __forceinline__ void operator()(const f32x4 (&acc)[2][2][4][2], const Unit& u, int wr, int wc, int fr, int fq) const {
        const int row0 = u.pm * BM + wr * 64 + fr; int colt = u.pn * BM; bf16_t* base = O;
        if (split_cols) { const int t = colt / split_cols; base += (size_t)t * split_stride; colt -= t * split_cols; }
        const int col0 = colt + wc * 32 + 8 * fq, bcol0 = u.pn * BM + wc * 32 + 8 * fq;
        f32x4 bv[2][2];
#pragma unroll
        for (int bj = 0; bj < 2; ++bj)
#pragma unroll
            for (int n = 0; n < 2; ++n) bv[bj][n] = bias ? *(const f32x4*)(bias + bcol0 + bj * HALF + 4 * n) : (f32x4){0.f, 0.f, 0.f, 0.f};
#pragma unroll
        for (int ai = 0; ai < 2; ++ai)
#pragma unroll
            for (int m = 0; m < 4; ++m) { bf16_t* rowp = base + (size_t)(row0 + ai * HALF + m * 16) * ldc + col0;
#pragma unroll
                for (int bj = 0; bj < 2; ++bj) { f32x4 v0 = acc[ai][bj][m][0] + bv[bj][0], v1 = acc[ai][bj][m][1] + bv[bj][1];
                    if (ACT == 1) { f32x2 a = gelu_pk((f32x2){v0[0], v0[1]}), b = gelu_pk((f32x2){v0[2], v0[3]}), c = gelu_pk((f32x2){v1[0], v1[1]}), d = gelu_pk((f32x2){v1[2], v1[3]});
                        v0 = (f32x4){a.x, a.y, b.x, b.y}; v1 = (f32x4){c.x, c.y, d.x, d.y}; }
                    if (ACT == 2) {
#pragma unroll
                        for (int j = 0; j < 4; ++j) { v0[j] = 0.5f * v0[j] * (1.0f + erff(v0[j] * 0.70710678f)); v1[j] = 0.5f * v1[j] * (1.0f + erff(v1[j] * 0.70710678f)); } }
                    u32x4 w; w.x = cvt_pk_bf16(v0[0], v0[1]); w.y = cvt_pk_bf16(v0[2], v0[3]); w.z = cvt_pk_bf16(v1[0], v1[1]); w.w = cvt_pk_bf16(v1[2], v1[3]);
                    *(u32x4*)(rowp + bj * HALF) = w; } }
    }
};

template <class Epi, class Sched, bool STAMP = false>
__device__ __forceinline__ void gemm_phase(PG8_LAS unsigned char* lds, const Gemm g, const Sched& S, const Epi& E, unsigned long long* stamps) {
    const int tid = threadIdx.x, wid = __builtin_amdgcn_readfirstlane(tid >> 6), lane = tid & 63, wr = wid >> 2, wc = wid & 3, fr = lane & 15, fq = lane >> 4;
    const int K = g.K, nt = K / BK;
    int ts_lo = 0, ts_hi = 0, nts = 0; const unsigned long long rt_entry = STAMP ? (unsigned long long)wall_clock64() : 0ull;
#define PG8_STAMP() do { if (STAMP && wid == 0 && nts < 64) { const unsigned long long _c = (unsigned long long)clock64(); \
        ts_lo = (lane == nts) ? (int)(unsigned)_c : ts_lo; ts_hi = (lane == nts) ? (int)(unsigned)(_c >> 32) : ts_hi; ++nts; } } while (0)
    PG8_STAMP();
    unsigned voffA[2], voffB[2];
#pragma unroll
    for (int i = 0; i < 2; ++i) { int R, C; stage_rc(tid * 16 + i * 8192, R, C); const int Rb = Epi::PERM ? ((R & ~31) + perm32(R & 31)) : R;
        voffA[i] = (unsigned)(R * K + C) * 2u; voffB[i] = (unsigned)(Rb * K + C) * 2u; }
    const size_t kstep = (size_t)(BK * 2);
    const size_t hstep = (size_t)HALF * K * 2;
    const size_t tstep = 2 * hstep;
    const unsigned ldsw = (unsigned)wid * 1024u;
    const int aoff = lds_byte(wr * 64 + fr, fq * 8), boff = lds_byte(wc * 32 + fr, fq * 8);
#define PG8_SA(b, h) (((b) * 2 + (h)) * HTB)
#define PG8_SB(b, h) ((4 + (b) * 2 + (h)) * HTB)
#define PG8_STAGE(bufoff, gbase, voff) do { _Pragma("unroll") for (int _i = 0; _i < 2; ++_i) \
        __builtin_amdgcn_global_load_lds((const unsigned*)((const char*)(gbase) + (voff)[_i]), (PG8_LAS unsigned*)(lds + (bufoff) + ldsw + _i * 8192), 16, 0, 0); } while (0)
#define PG8_LDA(dst, b, h) do { _Pragma("unroll") for (int m = 0; m < 4; ++m) _Pragma("unroll") for (int k = 0; k < 2; ++k) dst[m][k] = *(const PG8_LAS bf16x8*)(lds + PG8_SA(b, h) + aoff + m * 2048 + k * 1024); } while (0)
#define PG8_LDB(dst, b, h) do { _Pragma("unroll") for (int n = 0; n < 2; ++n) _Pragma("unroll") for (int k = 0; k < 2; ++k) dst[n][k] = *(const PG8_LAS bf16x8*)(lds + PG8_SB(b, h) + boff + n * 2048 + k * 1024); } while (0)
#define PG8_MMA(ai, bj, At, Bt) do { __builtin_amdgcn_s_setprio(1); _Pragma("unroll") for (int m = 0; m < 4; ++m) _Pragma("unroll") for (int n = 0; n < 2; ++n) _Pragma("unroll") for (int k = 0; k < 2; ++k) \
        acc[ai][bj][m][n] = __builtin_amdgcn_mfma_f32_16x16x32_bf16(Bt[n][k], At[m][k], acc[ai][bj][m][n], 0, 0, 0); __builtin_amdgcn_s_setprio(0); } while (0)
#define PG8_WAIT_V(n) asm volatile("s_waitcnt vmcnt(" #n ")" ::: "memory")
#define PG8_WAIT_L(n) asm volatile("s_waitcnt lgkmcnt(" #n ")" ::: "memory")
#define PG8_BAR __builtin_amdgcn_s_barrier()
#define PG8_SCHED __builtin_amdgcn_sched_barrier(0)
    Unit cur, nxt; int ui = 0;
    if (!S.next(0, cur)) return;
    f32x4 acc[2][2][4][2];
#pragma unroll
    for (int a = 0; a < 2; ++a)
#pragma unroll
        for (int b = 0; b < 2; ++b)
#pragma unroll
            for (int m = 0; m < 4; ++m)
#pragma unroll
                for (int n = 0; n < 2; ++n) acc[a][b][m][n] = (f32x4){0.f, 0.f, 0.f, 0.f};
    bf16x8 At[4][2], B0[2][2], B1[2][2];
    const char* cA = (const char*)g.A + (size_t)cur.pm * tstep; const char* cB = (const char*)g.Bt + (size_t)cur.pn * tstep;
    S.a_ready(cur);
    PG8_STAGE(PG8_SB(0, 0), cB, voffB); PG8_STAGE(PG8_SA(0, 0), cA, voffA); PG8_STAGE(PG8_SB(0, 1), cB + hstep, voffB); PG8_STAGE(PG8_SA(0, 1), cA + hstep, voffA);
    if (wr == 1) PG8_BAR;
    PG8_WAIT_V(4); PG8_BAR;
    PG8_STAGE(PG8_SB(1, 0), cB + kstep, voffB); PG8_STAGE(PG8_SA(1, 0), cA + kstep, voffA); PG8_STAGE(PG8_SB(1, 1), cB + hstep + kstep, voffB);
    PG8_WAIT_V(6); PG8_BAR;
    PG8_STAMP();
    for (;;) {
        const bool has_next = S.next(ui + 1, nxt);
        const char* nA = has_next ? (const char*)g.A + (size_t)nxt.pm * tstep : cA; const char* nB = has_next ? (const char*)g.Bt + (size_t)nxt.pn * tstep : cB;
        for (int t = 0; t < nt; t += 2) {
            const bool last = (t == nt - 2);
            const char* a1 = cA + (size_t)(t + 1) * kstep;
            const char* a2 = last ? nA : cA + (size_t)(t + 2) * kstep; const char* b2 = last ? nB : cB + (size_t)(t + 2) * kstep;
            const char* a3 = a2 + kstep; const char* b3 = b2 + kstep;
            if (last && has_next) S.a_ready(nxt);
            PG8_LDB(B0, 0, 0); PG8_SCHED; PG8_LDA(At, 0, 0); PG8_STAGE(PG8_SA(1, 1), a1 + hstep, voffA);
            PG8_WAIT_L(8); PG8_BAR; PG8_WAIT_L(0); PG8_MMA(0, 0, At, B0); PG8_BAR; PG8_SCHED;
            PG8_LDB(B1, 0, 1); PG8_STAGE(PG8_SB(0, 0), b2, voffB);
            PG8_BAR; PG8_WAIT_L(0); PG8_MMA(0, 1, At, B1); PG8_BAR;
            PG8_LDA(At, 0, 1); PG8_STAGE(PG8_SA(0, 0), a2, voffA);
            PG8_BAR; PG8_WAIT_L(0); PG8_MMA(1, 0, At, B0); PG8_BAR; PG8_SCHED;
            PG8_STAGE(PG8_SB(0, 1), b2 + hstep, voffB);
            PG8_WAIT_V(6); PG8_BAR; PG8_MMA(1, 1, At, B1); PG8_BAR;
            PG8_LDB(B0, 1, 0); PG8_SCHED; PG8_LDA(At, 1, 0); PG8_STAGE(PG8_SA(0, 1), a2 + hstep, voffA);
            PG8_WAIT_L(8); PG8_BAR; PG8_WAIT_L(0); PG8_MMA(0, 0, At, B0); PG8_BAR; PG8_SCHED;
            PG8_LDB(B1, 1, 1); PG8_STAGE(PG8_SB(1, 0), b3, voffB);
            PG8_BAR; PG8_WAIT_L(0); PG8_MMA(0, 1, At, B1); PG8_BAR;
            PG8_LDA(At, 1, 1); PG8_STAGE(PG8_SA(1, 0), a3, voffA);
            PG8_BAR; PG8_WAIT_L(0); PG8_MMA(1, 0, At, B0); PG8_BAR; PG8_SCHED;
            PG8_STAGE(PG8_SB(1, 1), b3 + hstep, voffB);
            PG8_WAIT_V(6); PG8_BAR; PG8_MMA(1, 1, At, B1); PG8_BAR;
        }
        PG8_STAMP();
        if constexpr (!Epi::AFTER_DRAIN) { E(acc, cur, wr, wc, fr, fq); S.done(cur); }
        PG8_STAMP();
        if (!has_next) break;
#pragma unroll
        for (int a = 0; a < 2; ++a)
#pragma unroll
            for (int b = 0; b < 2; ++b)
#pragma unroll
                for (int m = 0; m < 4; ++m)
#pragma unroll
                    for (int n = 0; n < 2; ++n) acc[a][b][m][n] = (f32x4){0.f, 0.f, 0.f, 0.f};
        cur = nxt; cA = nA; cB = nB; ++ui;
    }
    PG8_WAIT_V(0);
    if (wr == 0) PG8_BAR;
    PG8_BAR;
    if constexpr (Epi::AFTER_DRAIN) { E.fused(acc, cur, wr, wc, fr, fq, lds, wid, lane); S.done(cur); }
    PG8_STAMP();
    if (STAMP && wid == 0) { stamps[lane] = lane < nts ? (((unsigned long long)(unsigned)ts_hi << 32) | (unsigned)ts_lo) : 0ull;
        if (lane == 62) stamps[62] = rt_entry; if (lane == 63) stamps[63] = (unsigned long long)wall_clock64(); }
#undef PG8_STAMP
#undef PG8_SA
#undef PG8_SB
#undef PG8_STAGE
#undef PG8_LDA
#undef PG8_LDB
#undef PG8_MMA
#undef PG8_WAIT_V
#undef PG8_WAIT_L
#undef PG8_BAR
#undef PG8_SCHED
}
}
#define XB_TMO      128
#define XB_XCNT(j)  (256  + 64 * (j))
#define XB_XSUB(j)  (1280 + 64 * (j))
#define XB_XGEN(j)  (2304 + 64 * (j))
#define XB_TOP      3328
#define XB_TOPGEN   3392
#define XCD_BAR_WORDS 3456
#define XB_SPIN_CAP (1u << 22)
#define LAS __attribute__((address_space(3)))

__device__ __forceinline__ unsigned xb_ld(unsigned* p)              { return __hip_atomic_load(p, __ATOMIC_RELAXED, __HIP_MEMORY_SCOPE_AGENT); }
__device__ __forceinline__ unsigned xb_add(unsigned* p, unsigned v) { return __hip_atomic_fetch_add(p, v, __ATOMIC_RELAXED, __HIP_MEMORY_SCOPE_AGENT); }
__device__ __forceinline__ unsigned xb_xcc_id() { return (unsigned)__builtin_amdgcn_s_getreg((3 << 11) | 20) & 0xFu; }
#define XB_SPIN(cond, bar) do { unsigned _sp = 0; while (cond) { __builtin_amdgcn_s_sleep(1); \
    if ((++_sp & 255u) == 0u) { if (xb_ld(&(bar)[XB_TMO])) break; if (_sp > XB_SPIN_CAP) { atomicAdd(&(bar)[XB_TMO], 1u); break; } } } } while (0)

struct XcdBarrier {
    unsigned* bar; unsigned x;
    volatile LAS unsigned* st;
};

__device__ __forceinline__ XcdBarrier xcd_barrier_post(unsigned* bar, volatile LAS unsigned* st) {
    XcdBarrier b; b.bar = bar; b.x = xb_xcc_id(); b.st = st;
    if (threadIdx.x == 0) (void)xb_add(&bar[XB_XCNT(b.x)], 1u);
    return b;
}
__device__ __forceinline__ void xcd_barrier_complete(unsigned* bar, unsigned x, unsigned& nloc, unsigned& nx) {
    const unsigned G = gridDim.x * gridDim.y * gridDim.z;
    unsigned sum, cnt, mine, sp = 0u;
    for (;;) {
        sum = 0u; cnt = 0u; mine = 0u;
#pragma unroll
        for (unsigned j = 0; j < 16; ++j) { const unsigned c = xb_ld(&bar[XB_XCNT(j)]); sum += c; cnt += (c > 0u) ? 1u : 0u; mine = (j == x) ? c : mine; }
        if (sum == G) break;
        __builtin_amdgcn_s_sleep(1);
        if ((++sp & 255u) == 0u) { if (xb_ld(&bar[XB_TMO])) break; if (sp > XB_SPIN_CAP) { atomicAdd(&bar[XB_TMO], 1u); break; } }
    }
    nloc = mine > 0u ? mine : 1u; nx = cnt > 0u ? cnt : 1u;
}

__device__ __forceinline__ void xcd_barrier(const XcdBarrier& b) {
    asm volatile("s_waitcnt vmcnt(0)" ::: "memory");
    __syncthreads();
    if (threadIdx.x == 0) {
        unsigned* bar = b.bar;
        __builtin_amdgcn_s_waitcnt(0);
        unsigned nloc = b.st[0], nx = b.st[1];
        if (nloc == 0u) { xcd_barrier_complete(bar, b.x, nloc, nx); b.st[0] = nloc; b.st[1] = nx; }
        const unsigned old = xb_add(&bar[XB_XSUB(b.x)], 1u);
        const unsigned gen = old / nloc;
        if (old + 1u == (gen + 1u) * nloc) {
            __builtin_amdgcn_fence(__ATOMIC_RELEASE, "agent");
            asm volatile("s_waitcnt vmcnt(0)" ::: "memory");
            const unsigned og = xb_add(&bar[XB_TOP], 1u);
            const unsigned tg = og / nx;
            if (og + 1u == (tg + 1u) * nx) xb_add(&bar[XB_TOPGEN], 1u);
            else XB_SPIN(xb_ld(&bar[XB_TOPGEN]) == tg, bar);
            __builtin_amdgcn_fence(__ATOMIC_ACQUIRE, "agent");
            xb_add(&bar[XB_XGEN(b.x)], 1u);
            asm volatile("s_waitcnt vmcnt(0)" ::: "memory");
        } else {
            XB_SPIN(xb_ld(&bar[XB_XGEN(b.x)]) == gen, bar);
            __builtin_amdgcn_fence(__ATOMIC_ACQUIRE, "agent");
            asm volatile("s_waitcnt vmcnt(0)" ::: "memory");
        }
    }
    __syncthreads();
}
struct EpiResid {
    static constexpr bool PERM = false, AFTER_DRAIN = false;
    float* X; int ldc; const float* mod_l; int which;
    __device__ __forceinline__ void operator()(const pg8::f32x4 (&acc)[2][2][4][2], const pg8::Unit& u, int wr, int wc, int fr, int fq) const {
        using pg8::f32x4; using pg8::BM; using pg8::HALF;
        const int row0 = u.pm * BM + wr * 64 + fr, col0 = u.pn * BM + wc * 32 + 4 * fq;
        const int cond = cond_of_seq(seq_of(u.pm * BM));
        const float* gate = mod_l + ((size_t)cond * 6 + which) * D;
        f32x4 gv[2][2];
#pragma unroll
        for (int bj = 0; bj < 2; ++bj)
#pragma unroll
            for (int n = 0; n < 2; ++n) gv[bj][n] = *(const f32x4*)(gate + col0 + bj * HALF + n * 16);
#pragma unroll
        for (int ai = 0; ai < 2; ++ai)
#pragma unroll
            for (int m = 0; m < 4; ++m) { float* rowp = X + (size_t)(row0 + ai * HALF + m * 16) * ldc + col0;
#pragma unroll
                for (int bj = 0; bj < 2; ++bj)
#pragma unroll
                    for (int n = 0; n < 2; ++n) { f32x4* q = (f32x4*)(rowp + bj * HALF + n * 16); *q = *q + gv[bj][n] * acc[ai][bj][m][n]; } }
    }
};

__device__ __forceinline__ void conv_w(const float* W, int K, int N, int Npad, act_t* Wt, long gt, long gs) {
    const long total = (long)(K / 8) * Npad;
    for (long idx = gt; idx < total; idx += gs) {
        const int n = (int)(idx % Npad), k8 = (int)(idx / Npad);
        unsigned w[4];
#pragma unroll
        for (int j = 0; j < 4; ++j) {
            const float a = n < N ? W[(size_t)(k8 * 8 + 2 * j) * N + n] : 0.f, b = n < N ? W[(size_t)(k8 * 8 + 2 * j + 1) * N + n] : 0.f;
            w[j] = mk2(a, b);
        }
        *(uint4*)(Wt + (size_t)n * K + k8 * 8) = make_uint4(w[0], w[1], w[2], w[3]);
    }
}

constexpr int NTHR = 512;
constexpr int LDS_BYTES = 147456;
constexpr int LDS_MISC = pg8::STAGE_BYTES;
constexpr int PH_PER_LAYER = 11, N_PHASES = 2 + L * PH_PER_LAYER;

struct Args { P p; int ph_lo, ph_hi, use_bar, pad; };

template <class Epi>
__device__ __forceinline__ void run_gemm(PG8_LAS unsigned char* lds, const act_t* A, const act_t* Bt, int M, int N, int K, const Epi& E) {
    pg8::Gemm g{A, Bt, M, N, K}; pg8::StaticOrder S; S.init(M, N, (int)gridDim.x, (int)blockIdx.x);
    pg8::gemm_phase<Epi, pg8::StaticOrder, false>(lds, g, S, E, nullptr);
}

struct Ctx { long gt, gt2, gs; PG8_LAS unsigned char* lds; };
template <int K> __device__ __forceinline__ void phase_body(const P& p, int l, const Ctx& c) {
    const long gt = c.gt, gt2 = c.gt2, gs = c.gs;
    act_t* wt = (act_t*)(p.ws + WS_WT);
    const act_t* w = wt + (size_t)l * WT_LAYER;
    const float* mod_l = (const float*)(p.ws + WS_MOD) + (size_t)l * NCOND * 6 * D;
    if constexpr (K == 0) {
        ph_init(p, gt, gs);
        for (int ll = 0; ll < L; ++ll) {
            act_t* ww = wt + (size_t)ll * WT_LAYER;
            conv_w(p.w_in + (size_t)ll * D * INC, D, INC, INP, ww + WT_IN, gt, gs);
            conv_w(p.mla_w_uq + (size_t)ll * QR * NQ, QR, NQ, NQ, ww + WT_UQ, gt, gs);
            conv_w(p.mla_w_uk + (size_t)ll * KVR * BH * NOPE, KVR, BH * NOPE, BH * NOPE, ww + WT_UKV, gt, gs);
            conv_w(p.mla_w_uv + (size_t)ll * KVR * BH * VD, KVR, BH * VD, BH * VD, ww + WT_UKV + (size_t)BH * NOPE * KVR, gt, gs);
            conv_w(p.w_out + (size_t)ll * MIXW * D, MIXW, D, D, ww + WT_OUT, gt, gs);
            conv_w(p.ffn_up + (size_t)ll * D * NUP, D, NUP, NUP, ww + WT_UP, gt, gs);
            conv_w(p.ffn_down + (size_t)ll * DFF * D, DFF, D, D, ww + WT_DOWN, gt, gs);
        }
    }
    if constexpr (K == 1) ph_norm(p, l, 0, gt, gs);
    if constexpr (K == 2) { pg8::EpiF32 E{(float*)(p.ws + WS_PP), INP, nullptr}; run_gemm(c.lds, (const act_t*)(p.ws + WS_H), w + WT_IN, MTOK, INP, D, E); }
    if constexpr (K == 3) { ph_rwkv_prep(p, l, gt, gs); ph_mla_prep(p, l, gt2, gs); ph_gdn_conv(p, l, gt, gs); }
    if constexpr (K == 4) {
        ph_gdn_norm(p, l, gt, gs);
        { pg8::EpiBf16<0> E{(pg8::bf16_t*)(p.ws + WS_QF), NQ, nullptr, 0, 0}; run_gemm(c.lds, (const act_t*)(p.ws + WS_CQN), w + WT_UQ, MTOK, NQ, QR, E); }
        { pg8::EpiBf16<0> E{(pg8::bf16_t*)(p.ws + WS_KVUP), NKV, nullptr, 0, 0}; run_gemm(c.lds, (const act_t*)(p.ws + WS_CKVN), w + WT_UKV, MKV, NKV, KVR, E); }
    }
    if constexpr (K == 5) { ph_rwkv_scan(p, l, gt, gs); ph_gdn_scan(p, l, gt2, gs); ph_attn(p, l, gt, gs); }
    if constexpr (K == 6) { ph_rwkv_post(p, l, gt, gs); ph_gdn_post(p, l, gt, gs); }
    if constexpr (K == 7) { EpiResid E{(float*)(p.ws + WS_X), D, mod_l, 2}; run_gemm(c.lds, (const act_t*)(p.ws + WS_YMIX), w + WT_OUT, MTOK, D, MIXW, E); }
    if constexpr (K == 8) ph_norm(p, l, 1, gt, gs);
    if constexpr (K == 9) { pg8::EpiBf16<0> E{(pg8::bf16_t*)(p.ws + WS_UP), NUP, nullptr, 0, 0}; run_gemm(c.lds, (const act_t*)(p.ws + WS_H), w + WT_UP, MTOK, NUP, D, E); }
    if constexpr (K == 10) ph_ffn_act(p, l, gt, gs);
    if constexpr (K == 11) { EpiResid E{(float*)(p.ws + WS_X), D, mod_l, 5}; run_gemm(c.lds, (const act_t*)(p.ws + WS_ACT), w + WT_DOWN, MTOK, D, DFF, E); }
    if constexpr (K == 12) ph_final(p, gt, gs);
}
__device__ __forceinline__ Ctx make_ctx(PG8_LAS unsigned char* lds) {
    Ctx c; const int wv = threadIdx.x >> 6, lane = threadIdx.x & 63;
    c.gs = (long)gridDim.x * NTHR;
    c.gt = ((long)wv * gridDim.x + blockIdx.x) * 64 + lane;
    c.gt2 = (c.gt + c.gs / 2) % c.gs;
    c.lds = lds; return c;
}
#if N_LAUNCH_MODE == 1
__global__ void __launch_bounds__(NTHR, 2) fwd(Args a) {
    extern __shared__ __attribute__((aligned(16))) unsigned char lds_raw[];
    PG8_LAS unsigned char* lds = (PG8_LAS unsigned char*)lds_raw;
    const P& p = a.p;
    volatile LAS unsigned* misc = (volatile LAS unsigned*)(lds + LDS_MISC);
    if (threadIdx.x < 4) misc[threadIdx.x] = 0u;
    __syncthreads();
    XcdBarrier bar = xcd_barrier_post((unsigned*)(p.ws + WS_CTL), misc);
    const Ctx c = make_ctx(lds);
    phase_body<0>(p, 0, c); xcd_barrier(bar);
    for (int l = 0; l < L; ++l) {
        phase_body<1>(p, l, c); xcd_barrier(bar);
        phase_body<2>(p, l, c); xcd_barrier(bar);
        phase_body<3>(p, l, c); xcd_barrier(bar);
        phase_body<4>(p, l, c); xcd_barrier(bar);
        phase_body<5>(p, l, c); xcd_barrier(bar);
        phase_body<6>(p, l, c); xcd_barrier(bar);
        phase_body<7>(p, l, c); xcd_barrier(bar);
        phase_body<8>(p, l, c); xcd_barrier(bar);
        phase_body<9>(p, l, c); xcd_barrier(bar);
        phase_body<10>(p, l, c); xcd_barrier(bar);
        phase_body<11>(p, l, c); xcd_barrier(bar);
    }
    phase_body<12>(p, 0, c);
}
#else
template <int K> __global__ void __launch_bounds__(NTHR, 2) k_phase(Args a) {
    extern __shared__ __attribute__((aligned(16))) unsigned char lds_raw[];
    const Ctx c = make_ctx((PG8_LAS unsigned char*)lds_raw);
    phase_body<K>(a.p, a.ph_lo, c);
}
#endif


extern "C" void kernel_launch(void* const* d_in, const int* in_sizes, int n_in, void* d_out, int out_size, void* d_ws, size_t ws_size, hipStream_t stream) {
    static int grid = 0;
    if (grid == 0) {
        if (n_in != 37 || (size_t)out_size != O_END || ws_size < WS_END) { fprintf(stderr, "kernel_launch: unexpected sizes n_in %d out %d ws %zu (need %zu)\n", n_in, out_size, ws_size, (size_t)WS_END); grid = -1; return; }
        int dev = 0, cus = 0, per_cu = 0;
        if (hipGetDevice(&dev) != hipSuccess || hipDeviceGetAttribute(&cus, hipDeviceAttributeMultiprocessorCount, dev) != hipSuccess) { grid = -1; return; }
#if N_LAUNCH_MODE == 1
        bool ok = hipFuncSetAttribute((const void*)fwd, hipFuncAttributeMaxDynamicSharedMemorySize, LDS_BYTES) == hipSuccess;
        if (hipOccupancyMaxActiveBlocksPerMultiprocessor(&per_cu, (const void*)fwd, NTHR, LDS_BYTES) != hipSuccess || per_cu < 1) fprintf(stderr, "kernel_launch: occupancy query says %d\n", per_cu);
#else
        bool ok = true;
#define SA(K) ok = ok && hipFuncSetAttribute((const void*)k_phase<K>, hipFuncAttributeMaxDynamicSharedMemorySize, LDS_BYTES) == hipSuccess
        SA(0); SA(1); SA(2); SA(3); SA(4); SA(5); SA(6); SA(7); SA(8); SA(9); SA(10); SA(11); SA(12);
#undef SA
#endif
        if (!ok) { fprintf(stderr, "kernel_launch: hipFuncSetAttribute failed\n"); grid = -1; return; }
        (void)per_cu; (void)hipGetLastError();
        grid = cus;
    }
    if (grid < 0) return;
    (void)hipMemsetAsync((char*)d_ws + WS_CTL, 0, WS_CTL_BYTES, stream);
    Args a{};
    const float** pin = (const float**)&a.p;
    for (int i = 0; i < 37; ++i) pin[i] = (const float*)d_in[i];
    a.p.out = (float*)d_out; a.p.ws = (unsigned char*)d_ws;
    a.pad = 0;
#if N_LAUNCH_MODE == 1
    a.ph_lo = 0; a.ph_hi = N_PHASES; a.use_bar = 1;
    hipLaunchKernelGGL(fwd, dim3(grid), dim3(NTHR), LDS_BYTES, stream, a);
#else
    a.ph_hi = 0; a.use_bar = 0;
#define LK(K, l) do { a.ph_lo = (l); hipLaunchKernelGGL(k_phase<K>, dim3(grid), dim3(NTHR), LDS_BYTES, stream, a); } while (0)
    LK(0, 0);
    for (int l = 0; l < L; ++l) { LK(1, l); LK(2, l); LK(3, l); LK(4, l); LK(5, l); LK(6, l); LK(7, l); LK(8, l); LK(9, l); LK(10, l); LK(11, l); }
    LK(12, 0);
#undef LK
#endif
}
```

```cpp
#include <hip/hip_runtime.h>
#include <cstdio>
#define N_LAUNCH_MODE 1
#define DUPMASK 0
#define HD __device__ __attribute__((always_inline))
#define UNROLL _Pragma("unroll")
#define CBAR asm volatile("" ::: "memory")
#define ATT_SDEPTH 1
#define ATT_NQREG 6
constexpr int NTHR_ = 512;
typedef float4 f4;
HD inline f4 ldf4(const float* p) { return *(const float4*)p; }
constexpr int LDS_TOTAL_BYTES = 147456, TID_TAB_OFF = LDS_TOTAL_BYTES - 64 - 256;
__device__ __forceinline__ unsigned hw_slot() { return (unsigned)__builtin_amdgcn_s_getreg((5 << 11) | 4) & 63u; }
__device__ __forceinline__ int tidx_() {
    const int w = *(volatile __attribute__((address_space(3))) int*)(__attribute__((address_space(3))) char*)(unsigned long)(TID_TAB_OFF + 4u * hw_slot());
    int lane; asm volatile("v_mbcnt_lo_u32_b32 %0, -1, 0\n\tv_mbcnt_hi_u32_b32 %0, -1, %0" : "=v"(lane));
    return (__builtin_amdgcn_readfirstlane(w) << 6) | lane;
}
#define TIDX tidx_()
namespace cfg {
#ifdef SMALL_CFG
constexpr int D = 128, NB = 2, SEQ = 128, L = 2, NDB = 2, DSEQ = 256, PAST = 128, GRIDW = 16;
constexpr int AH = 2, AN = 64, DL = 16, IL = 16, GL = 32;
constexpr int BH = 2, QR = 64, KVR = 64, NOPE = 32, ROPE = 16, VD = 32;
constexpr int CH = 2, DK = 32, DV = 32, CHUNK = 64;
constexpr int DFF = 192;
#else
constexpr int D = 2048, NB = 16, SEQ = 256, L = 4, NDB = 2, DSEQ = 4096, PAST = 256, GRIDW = 64;
constexpr int AH = 8, AN = 64, DL = 64, IL = 64, GL = 128;
constexpr int BH = 8, QR = 512, KVR = 512, NOPE = 128, ROPE = 64, VD = 128;
constexpr int CH = 4, DK = 128, DV = 128, CHUNK = 64;
constexpr int DFF = 5632;
#endif
constexpr int AW = AH * AN, BW = BH * VD, CW = CH * DV, QKD = NOPE + ROPE, MIXW = AW + BW + CW;
constexpr int OFF_R = 0, OFF_K = AW, OFF_V = 2 * AW, OFF_WLO = 3 * AW, OFF_ALO = OFF_WLO + 2 * DL, OFF_GLO = OFF_ALO + 2 * IL,
              OFF_CQ = OFF_GLO + GL, OFF_CKV = OFF_CQ + QR, OFF_KPE = OFF_CKV + KVR, OFF_GQ = OFF_KPE + ROPE, OFF_GK = OFF_GQ + CH * DK,
              OFF_GV = OFF_GK + CH * DK, OFF_GZ = OFF_GV + CW, OFF_GB = OFF_GZ + CW, OFF_GA = OFF_GB + 2 * CH, INC = OFF_GA + 2 * CH;
constexpr int INP = (INC + 255) / 256 * 256;
constexpr int NSEQ = NB + NDB, MCTX = NB * SEQ, MLAT = NDB * DSEQ, MTOK = MCTX + MLAT, MKV = MTOK + NDB * PAST, NCOND = 1 + NDB;
constexpr int NQ = BH * QKD, NKV = BH * NOPE + BH * VD, NUP = 2 * DFF, GC = 2 * CH * DK + CW;
constexpr int LINK = 2 * DL + 2 * IL + GL, LORAN = 5 * AW;
constexpr float RMS_EPS = 1e-6f, LNX_EPS = 64e-5f, L2_EPS = 1e-6f, ROPE_BASE = 10000.0f;
}
using namespace cfg;

#ifdef HOSTEMU
typedef float act_t;
struct act2 { float x, y; };
HD inline float a2f(act_t a) { return a; }
HD inline act_t f2a(float f) { return f; }
HD inline act2 ld2(const act_t* p) { act2 r; r.x = p[0]; r.y = p[1]; return r; }
HD inline act2 mk2(float x, float y) { act2 r; r.x = x; r.y = y; return r; }
HD inline float dot2(act2 a, act2 b, float c) { return c + a.x * b.x + a.y * b.y; }
HD inline float lo2(act2 a) { return a.x; }
HD inline float hi2(act2 a) { return a.y; }
#else
typedef unsigned short act_t;
typedef unsigned act2;
HD inline float a2f(act_t a) { return __uint_as_float(((unsigned)a) << 16); }
HD inline act_t f2a(float f) { unsigned u = __float_as_uint(f); return (act_t)((u + 0x7fffu + ((u >> 16) & 1u)) >> 16); }
HD inline act2 ld2(const act_t* p) { return *(const unsigned*)p; }
HD inline act2 mk2(float x, float y) { return (unsigned)f2a(x) | ((unsigned)f2a(y) << 16); }
HD inline float lo2(act2 a) { return __uint_as_float(a << 16); }
HD inline float hi2(act2 a) { return __uint_as_float(a & 0xffff0000u); }
typedef __bf16 bf16x2_t __attribute__((ext_vector_type(2)));
HD inline float dot2(act2 a, act2 b, float c) { return __builtin_amdgcn_fdot2_f32_bf16(__builtin_bit_cast(bf16x2_t, a), __builtin_bit_cast(bf16x2_t, b), c, false); }
HD inline float ldp1(const act_t* p) { return a2f(*p); }
HD inline float2 ldp2(const act_t* p) { const unsigned u = *(const unsigned*)p; return make_float2(lo2(u), hi2(u)); }
HD inline float4 ldp4(const act_t* p) { const uint2 u = *(const uint2*)p; return make_float4(lo2(u.x), hi2(u.x), lo2(u.y), hi2(u.y)); }
#endif

struct P {
    const float *x_prompt, *x_sample, *state_rwkv, *state_gdn, *cache_ckv, *cache_kpe, *c, *c_ctx, *ada_w, *ada_b, *norm1_g, *w_in,
        *rwkv_w0, *rwkv_w2, *rwkv_a0, *rwkv_a2, *rwkv_g2, *rwkv_kk, *rwkv_ka, *rwkv_rk, *rwkv_lnx_g, *rwkv_lnx_b, *mla_qnorm_g, *mla_w_uq,
        *mla_kvnorm_g, *mla_w_uk, *mla_w_uv, *gdn_conv, *gdn_a_log, *gdn_dt_bias, *gdn_norm_g, *w_out, *norm2_g, *ffn_up, *ffn_conv, *ffn_down,
        *final_norm_g;
    float* out;
    unsigned char* ws;
};

constexpr size_t O_YP = 0, O_YS = O_YP + (size_t)MCTX * D, O_SR = O_YS + (size_t)MLAT * D, O_SG = O_SR + (size_t)NB * L * 2 * AH * AN * AN,
                 O_CK = O_SG + (size_t)NB * L * 2 * CH * DK * DV, O_KP = O_CK + (size_t)NB * L * SEQ * KVR, O_END = O_KP + (size_t)NB * L * SEQ * ROPE;

constexpr size_t al256(size_t x) { return (x + 255) / 256 * 256; }
constexpr size_t WS_CTL = 0, WS_CTL_BYTES = 64 * 1024;
constexpr size_t WS_MOD = WS_CTL + WS_CTL_BYTES;
constexpr size_t WS_ROPE = al256(WS_MOD + (size_t)L * NCOND * 6 * D * 4);
constexpr size_t WS_X = al256(WS_ROPE + (size_t)DSEQ * ROPE * 4);
constexpr size_t WS_H = al256(WS_X + (size_t)MTOK * D * 4);
constexpr size_t WS_YMIX = al256(WS_H + (size_t)MTOK * D * sizeof(act_t));
constexpr size_t WT_IN = 0, WT_UQ = WT_IN + (size_t)INP * D, WT_UKV = WT_UQ + (size_t)NQ * QR, WT_OUT = WT_UKV + (size_t)NKV * KVR,
                 WT_UP = WT_OUT + (size_t)D * MIXW, WT_DOWN = WT_UP + (size_t)NUP * D, WT_LORA = WT_DOWN + (size_t)D * DFF, WT_LAYER = WT_LORA + (size_t)LORAN * LINK;
constexpr size_t WS_WT = al256(WS_YMIX + (size_t)MTOK * MIXW * sizeof(act_t));
constexpr size_t WS_U0 = al256(WS_WT + (size_t)L * WT_LAYER * 2);
constexpr size_t WS_PP = WS_U0;
#ifdef HOSTEMU
constexpr size_t WS_RWDEC = al256(WS_PP + (size_t)MTOK * INP * 4);
constexpr size_t WS_RWKDIR = al256(WS_RWDEC + (size_t)MTOK * 2 * AW * 4);
constexpr size_t WS_RWKKA = al256(WS_RWKDIR + (size_t)MTOK * 2 * AW * 4);
constexpr size_t WS_RWKK = al256(WS_RWKKA + (size_t)MTOK * 2 * AW * 4);
#ifdef HOSTEMU
constexpr size_t WS_RWG = al256(WS_RWKK + (size_t)MTOK * AW * 4);
constexpr size_t WS_RWY = al256(WS_RWG + (size_t)MTOK * AW * 4);
#else
constexpr size_t WS_RWY = al256(WS_RWKK + (size_t)MTOK * AW * 4);
constexpr size_t WS_RWG = WS_H;
#endif
constexpr size_t WS_CQN = al256(WS_RWY + (size_t)MTOK * 2 * AW * 4);
constexpr size_t WS_CKVN = al256(WS_CQN + (size_t)MTOK * QR * sizeof(act_t));
constexpr size_t WS_KR = al256(WS_CKVN + (size_t)MKV * KVR * sizeof(act_t));
constexpr size_t WS_QF = al256(WS_KR + (size_t)MKV * ROPE * sizeof(act_t));
constexpr size_t WS_KVUP = al256(WS_QF + (size_t)MTOK * NQ * sizeof(act_t));
constexpr size_t WS_GBG = al256(WS_KVUP + (size_t)MKV * NKV * sizeof(act_t));
constexpr size_t WS_GO = al256(WS_GBG + (size_t)MTOK * 2 * CH * 4 * 4);
constexpr size_t WS_GCONV = al256(WS_GO + (size_t)MTOK * 2 * CW * 4);
constexpr size_t WS_LIN = al256(WS_GCONV + (size_t)MTOK * GC * 4);
constexpr size_t WS_LORA = al256(WS_LIN + (size_t)MTOK * LINK * sizeof(act_t));
constexpr size_t WS_GCH = al256(WS_LORA + (size_t)MTOK * LORAN * 4);
constexpr size_t WS_RCH = WS_GCONV;
static_assert((size_t)(MTOK / 64) * 2 * AH * 65792 <= WS_GCH - WS_GCONV, "RWKV chunk slots must fit the dead prep buffers");
constexpr size_t WS_MIX_END = al256(WS_GCH + (size_t)(MTOK / 64) * 2 * CH * 73984);
#else
constexpr size_t WS_RWB = al256(WS_PP + (size_t)MTOK * INP * 4);
constexpr size_t WS_RWY = al256(WS_RWB + (size_t)MTOK * 2 * AH * 4);
constexpr size_t WS_RWG = WS_H;
constexpr size_t WS_CQN = al256(WS_RWY + (size_t)MTOK * 2 * AW * 4);
constexpr size_t WS_CKVN = al256(WS_CQN + (size_t)MTOK * QR * sizeof(act_t));
constexpr size_t WS_KR = al256(WS_CKVN + (size_t)MKV * KVR * sizeof(act_t));
constexpr size_t WS_QF = al256(WS_KR + (size_t)MKV * ROPE * sizeof(act_t));
constexpr size_t WS_KVUP = al256(WS_QF + (size_t)MTOK * NQ * sizeof(act_t));
constexpr size_t WS_GBG = al256(WS_KVUP + (size_t)MKV * NKV * sizeof(act_t));
constexpr size_t WS_GO = al256(WS_GBG + (size_t)MTOK * 2 * CH * 4 * 4);
constexpr size_t WS_LORA = al256(WS_GO + (size_t)MTOK * 2 * CW * 4);
constexpr size_t WS_GCH = al256(WS_LORA + (size_t)MTOK * LORAN * 4);
constexpr size_t WS_GCONV = al256(WS_GCH + (size_t)(MTOK / 64) * 2 * CH * 73984);
constexpr size_t WS_LIN = al256(WS_GCONV + (size_t)MTOK * GC * 4);
constexpr size_t WS_RCH = WS_GCONV;
constexpr size_t WS_MIX_END = al256(WS_RCH + (size_t)(MTOK / 64) * 2 * AH * 65792);
static_assert(WS_LIN + (size_t)MTOK * LINK * sizeof(act_t) <= WS_MIX_END, "LoRA inputs inside the RWKV slot region");
constexpr size_t WS_RWDEC = WS_RWY, WS_RWKDIR = WS_RWY, WS_RWKKA = WS_RWY, WS_RWKK = WS_RWY;
#endif
constexpr size_t WS_UP = WS_U0;
constexpr size_t WS_ACT = al256(WS_UP + (size_t)MTOK * NUP * sizeof(act_t));
constexpr size_t WS_FFN_END = al256(WS_ACT + (size_t)MTOK * DFF * sizeof(act_t));
constexpr size_t WS_SIDE = WS_MIX_END > WS_FFN_END ? WS_MIX_END : WS_FFN_END;
constexpr size_t WS_END = WS_SIDE + (size_t)(MTOK / 64) * 6 * DFF * 4;

HD inline int seq_of(int m) { return m < MCTX ? m / SEQ : NB + (m - MCTX) / DSEQ; }
HD inline int seq_start(int s) { return s < NB ? s * SEQ : MCTX + (s - NB) * DSEQ; }
HD inline int seq_len(int s) { return s < NB ? SEQ : DSEQ; }
HD inline int cond_of_seq(int s) { return s < NB ? 0 : 1 + (s - NB); }
#ifdef HOSTEMU
HD inline float fexp_(float x) { return expf(x); }
HD inline float sigmoidf_(float x) { return 1.0f / (1.0f + expf(-x)); }
HD inline float siluf_(float x) { return x / (1.0f + expf(-x)); }
HD inline float softplusf_(float x) { return fmaxf(x, 0.0f) + log1pf(expf(-fabsf(x))); }
HD inline float ftanh_(float x) { return tanhf(x); }
#else
HD inline float fexp_(float x) { return __builtin_amdgcn_exp2f(x * 1.4426950408889634f); }
HD inline float sigmoidf_(float x) { return __builtin_amdgcn_rcpf(1.0f + fexp_(-x)); }
HD inline float siluf_(float x) { return x * sigmoidf_(x); }
HD inline float softplusf_(float x) { return fmaxf(x, 0.0f) + 0.6931471805599453f * __builtin_amdgcn_logf(1.0f + fexp_(-fabsf(x))); }
HD inline float ftanh_(float x) { return 2.0f * sigmoidf_(2.0f * x) - 1.0f; }
#endif
HD inline const float* modp(const P& p, int l, int cond, int which) { return (const float*)(p.ws + WS_MOD) + ((size_t)(l * NCOND + cond) * 6 + which) * D; }

HD inline void rope_angle(int t, int i, float& cs, float& sn) {
    const int nf = ROPE / 4; const int row = t / GRIDW, col = t % GRIDW;
    const int f = i < nf ? i : i - nf;
    const float inv = powf(ROPE_BASE, -(float)f / (float)nf);
    const float ang = (float)(i < nf ? row : col) * inv;
    cs = cosf(ang); sn = sinf(ang);
}
HD inline void ph_init(const P& p, long gt, long gs) {
    float* x = (float*)(p.ws + WS_X);
    for (long i = gt; i < (long)MTOK * D; i += gs) x[i] = i < (long)MCTX * D ? p.x_prompt[i] : p.x_sample[i - (long)MCTX * D];
    float* rt = (float*)(p.ws + WS_ROPE);
    for (long i = gt; i < (long)DSEQ * (ROPE / 2); i += gs) { float cs, sn; rope_angle((int)(i / (ROPE / 2)), (int)(i % (ROPE / 2)), cs, sn); rt[2 * i] = cs; rt[2 * i + 1] = sn; }
    float* mod = (float*)(p.ws + WS_MOD);
    for (long idx = gt; idx < (long)L * 6 * D; idx += gs) {
        const int l = (int)(idx / (6 * D)), j = (int)(idx % (6 * D));
        float acc[NCOND];
        UNROLL for (int c = 0; c < NCOND; ++c) acc[c] = 0.f;
        for (int i = 0; i < D; ++i) {
            const float w = p.ada_w[((size_t)l * D + i) * 6 * D + j];
            acc[0] += siluf_(p.c_ctx[i]) * w;
            UNROLL for (int c = 1; c < NCOND; ++c) acc[c] += siluf_(p.c[(size_t)(c - 1) * D + i]) * w;
        }
        const float b = p.ada_b[(size_t)l * 6 * D + j];
        UNROLL for (int c = 0; c < NCOND; ++c) mod[((size_t)(l * NCOND + c) * 6) * D + j] = acc[c] + b;
    }
}

HD inline void ph_norm(const P& p, int l, int which, long gt, long gs) {
    const float* x = (const float*)(p.ws + WS_X);
    act_t* h = (act_t*)(p.ws + WS_H);
    const float* g = (which == 0 ? p.norm1_g : p.norm2_g) + (size_t)l * D;
    for (long m = gt; m < MTOK; m += gs) {
        const int cond = cond_of_seq(seq_of((int)m));
        const float* sh = modp(p, l, cond, which * 3 + 0);
        const float* sc = modp(p, l, cond, which * 3 + 1);
        const float* xr = x + (size_t)m * D;
        float ss = 0.f;
        for (int j = 0; j < D; ++j) ss += xr[j] * xr[j];
        const float rs = 1.0f / sqrtf(ss / D + RMS_EPS);
        for (int j = 0; j < D; ++j) h[(size_t)m * D + j] = f2a(xr[j] * rs * g[j] * (1.0f + sc[j]) + sh[j]);
    }
}

HD inline void ph_rwkv_prep(const P& p, int l, long gt, long gs) {
    const float* pp = (const float*)(p.ws + WS_PP);
    float* dec = (float*)(p.ws + WS_RWDEC); float* kdir = (float*)(p.ws + WS_RWKDIR); float* kka = (float*)(p.ws + WS_RWKKA);
    float* kkb = (float*)(p.ws + WS_RWKK); float* gb = (float*)(p.ws + WS_RWG);
    for (long idx = gt; idx < (long)MTOK * AW; idx += gs) {
        const int m = (int)(idx / AW), c = (int)(idx % AW), h = c / AN;
        const float* pr = pp + (size_t)m * INP;
        const float* kksc = p.rwkv_kk + (size_t)l * AW;
        float ss = 0.f;
        for (int j = 0; j < AN; ++j) { const float t = pr[OFF_K + h * AN + j] * kksc[h * AN + j]; ss += t * t; }
        const float kraw = pr[OFF_K + c];
        const float kk = kraw * kksc[c] / sqrtf(ss + L2_EPS);
        kkb[(size_t)m * AW + c] = kk;
        for (int d = 0; d < 2; ++d) {
            float wpre = p.rwkv_w0[((size_t)l * 2 + d) * AW + c];
            for (int r = 0; r < DL; ++r) wpre += tanhf(pr[OFF_WLO + d * DL + r]) * p.rwkv_w2[(((size_t)l * 2 + d) * DL + r) * AW + c];
            const float logw = -expf(-softplusf_(-wpre) - 0.5f);
            float apre = p.rwkv_a0[((size_t)l * 2 + d) * AW + c];
            for (int r = 0; r < IL; ++r) apre += pr[OFF_ALO + d * IL + r] * p.rwkv_a2[(((size_t)l * 2 + d) * IL + r) * AW + c];
            const float a = sigmoidf_(apre);
            const size_t o = ((size_t)m * 2 + d) * AW + c;
            dec[o] = expf(logw);
            kdir[o] = kraw * (1.0f + (a - 1.0f) * p.rwkv_ka[(size_t)l * AW + c]);
            kka[o] = kk * a;
        }
        float g = 0.f;
        for (int r = 0; r < GL; ++r) g += sigmoidf_(pr[OFF_GLO + r]) * p.rwkv_g2[((size_t)l * GL + r) * AW + c];
        gb[(size_t)m * AW + c] = g;
    }
}

HD inline void ph_rwkv_scan(const P& p, int l, long gt, long gs) {
    const float* pp = (const float*)(p.ws + WS_PP);
    const float* dec = (const float*)(p.ws + WS_RWDEC); const float* kdir = (const float*)(p.ws + WS_RWKDIR); const float* kka = (const float*)(p.ws + WS_RWKKA);
    const float* kkb = (const float*)(p.ws + WS_RWKK); float* yb = (float*)(p.ws + WS_RWY);
    for (long idx = gt; idx < (long)NSEQ * 2 * AH * AN; idx += gs) {
        const int i = (int)(idx % AN), h = (int)((idx / AN) % AH), d = (int)((idx / (AN * AH)) % 2), s = (int)(idx / (AN * AH * 2));
        float S[AN];
        if (s >= NB) { const float* s0 = p.state_rwkv + (((((size_t)(s - NB) * L + l) * 2 + d) * AH + h) * AN + i) * AN; UNROLL for (int k = 0; k < AN; ++k) S[k] = s0[k]; }
        else { UNROLL for (int k = 0; k < AN; ++k) S[k] = 0.f; }
        const int T = seq_len(s), base = seq_start(s);
        for (int step = 0; step < T; ++step) {
            const int m = base + (d == 0 ? step : T - 1 - step);
            const float* pr = pp + (size_t)m * INP;
            const float* kk = kkb + (size_t)m * AW + h * AN;
            const size_t o = ((size_t)m * 2 + d) * AW + h * AN;
            float sa = 0.f;
            UNROLL for (int k = 0; k < AN; k += 4) { const f4 t = ldf4(kk + k); sa -= S[k] * t.x + S[k + 1] * t.y + S[k + 2] * t.z + S[k + 3] * t.w; }
            const float vi = pr[OFF_V + h * AN + i];
            float y = 0.f;
            UNROLL for (int k = 0; k < AN; k += 4) {
                const f4 w4 = ldf4(dec + o + k), a4 = ldf4(kka + o + k), k4 = ldf4(kdir + o + k), r4 = ldf4(pr + OFF_R + h * AN + k);
                S[k] = S[k] * w4.x + sa * a4.x + vi * k4.x; y += S[k] * r4.x;
                S[k + 1] = S[k + 1] * w4.y + sa * a4.y + vi * k4.y; y += S[k + 1] * r4.y;
                S[k + 2] = S[k + 2] * w4.z + sa * a4.z + vi * k4.z; y += S[k + 2] * r4.z;
                S[k + 3] = S[k + 3] * w4.w + sa * a4.w + vi * k4.w; y += S[k + 3] * r4.w;
            }
            yb[o + i] = y;
        }
        if (s < NB) { float* so = p.out + O_SR + (((((size_t)s * L + l) * 2 + d) * AH + h) * AN + i) * AN; UNROLL for (int k = 0; k < AN; ++k) so[k] = S[k]; }
    }
}

HD inline void ph_rwkv_post(const P& p, int l, long gt, long gs) {
    const float* pp = (const float*)(p.ws + WS_PP);
    const float* kdir = (const float*)(p.ws + WS_RWKDIR); const float* gb = (const float*)(p.ws + WS_RWG); const float* yb = (const float*)(p.ws + WS_RWY);
    act_t* ymix = (act_t*)(p.ws + WS_YMIX);
    for (long idx = gt; idx < (long)MTOK * AW; idx += gs) {
        const int m = (int)(idx / AW), c = (int)(idx % AW), h = c / AN;
        const float* pr = pp + (size_t)m * INP;
        const float* y0 = yb + ((size_t)m * 2 + 0) * AW + h * AN; const float* y1 = yb + ((size_t)m * 2 + 1) * AW + h * AN;
        float mu = 0.f;
        for (int j = 0; j < AN; ++j) mu += y0[j] + y1[j];
        mu /= AN;
        float var = 0.f;
        for (int j = 0; j < AN; ++j) { const float t = y0[j] + y1[j] - mu; var += t * t; }
        var /= AN;
        const float yc = yb[((size_t)m * 2 + 0) * AW + c] + yb[((size_t)m * 2 + 1) * AW + c];
        float y = (yc - mu) / sqrtf(var + LNX_EPS) * p.rwkv_lnx_g[(size_t)l * AW + c] + p.rwkv_lnx_b[(size_t)l * AW + c];
        float bon = 0.f;
        for (int d = 0; d < 2; ++d) for (int j = 0; j < AN; ++j)
            bon += pr[OFF_R + h * AN + j] * kdir[((size_t)m * 2 + d) * AW + h * AN + j] * p.rwkv_rk[((size_t)l * AH + h) * AN + j];
        y += bon * pr[OFF_V + c];
        ymix[(size_t)m * MIXW + c] = f2a(y * gb[(size_t)m * AW + c]);
    }
}

HD inline void ph_mla_prep(const P& p, int l, long gt, long gs) {
    const float* pp = (const float*)(p.ws + WS_PP);
    act_t* cqn = (act_t*)(p.ws + WS_CQN); act_t* ckvn = (act_t*)(p.ws + WS_CKVN); act_t* kr = (act_t*)(p.ws + WS_KR);
    for (long m = gt; m < MKV; m += gs) {
        if (m < MTOK) {
            const float* pr = pp + (size_t)m * INP;
            const int s = seq_of((int)m), t = (int)m - seq_start(s);
            float ss = 0.f;
            for (int j = 0; j < QR; ++j) ss += pr[OFF_CQ + j] * pr[OFF_CQ + j];
            float rs = 1.0f / sqrtf(ss / QR + RMS_EPS);
            for (int j = 0; j < QR; ++j) cqn[(size_t)m * QR + j] = f2a(pr[OFF_CQ + j] * rs * p.mla_qnorm_g[(size_t)l * QR + j]);
            ss = 0.f;
            for (int j = 0; j < KVR; ++j) ss += pr[OFF_CKV + j] * pr[OFF_CKV + j];
            rs = 1.0f / sqrtf(ss / KVR + RMS_EPS);
            for (int j = 0; j < KVR; ++j) {
                const float v = pr[OFF_CKV + j] * rs * p.mla_kvnorm_g[(size_t)l * KVR + j];
                ckvn[(size_t)m * KVR + j] = f2a(v);
                if (s < NB) p.out[O_CK + (((size_t)s * L + l) * SEQ + t) * KVR + j] = v;
            }
            if (s < NB) {
                for (int j = 0; j < ROPE; ++j) { const float v = pr[OFF_KPE + j]; kr[(size_t)m * ROPE + j] = f2a(v); p.out[O_KP + (((size_t)s * L + l) * SEQ + t) * ROPE + j] = v; }
            } else {
                for (int i = 0; i < ROPE / 2; ++i) {
                    float cs, sn; rope_angle(t, i, cs, sn);
                    const float xe = pr[OFF_KPE + 2 * i], xo = pr[OFF_KPE + 2 * i + 1];
                    kr[(size_t)m * ROPE + 2 * i] = f2a(xe * cs - xo * sn); kr[(size_t)m * ROPE + 2 * i + 1] = f2a(xe * sn + xo * cs);
                }
            }
        } else {
            const int r = (int)m - MTOK, b = r / PAST, j0 = r % PAST;
            const float* ck = p.cache_ckv + (((size_t)b * L + l) * PAST + j0) * KVR;
            for (int j = 0; j < KVR; ++j) ckvn[(size_t)m * KVR + j] = f2a(ck[j]);
            const float* kp = p.cache_kpe + (((size_t)b * L + l) * PAST + j0) * ROPE;
            for (int j = 0; j < ROPE; ++j) kr[(size_t)m * ROPE + j] = f2a(kp[j]);
        }
    }
}

constexpr int VSL = 32, NVS = VD / VSL;
HD inline void ph_attn(const P& p, int l, long gt, long gs) {
    (void)l;
    const act_t* qf = (const act_t*)(p.ws + WS_QF); const act_t* kvup = (const act_t*)(p.ws + WS_KVUP); const act_t* kr = (const act_t*)(p.ws + WS_KR);
    act_t* ymix = (act_t*)(p.ws + WS_YMIX);
    const float scale = 1.0f / sqrtf((float)QKD);
    for (long idx = gt; idx < (long)MTOK * BH * NVS; idx += gs) {
        const int m = (int)(idx % MTOK), vs = (int)((idx / MTOK) % NVS), h = (int)(idx / ((long)MTOK * NVS));
        const int s = seq_of(m), base = seq_start(s), t = m - base, T = seq_len(s);
        const bool lat = s >= NB;
        act2 q[QKD / 2];
        const act_t* qr = qf + (size_t)m * NQ + h * QKD;
        UNROLL for (int i = 0; i < NOPE / 2; ++i) q[i] = ld2(qr + 2 * i);
        UNROLL for (int i = 0; i < ROPE / 2; ++i) {
            const act2 v = ld2(qr + NOPE + 2 * i);
            if (lat) { float cs, sn; rope_angle(t, i, cs, sn); const float xe = lo2(v), xo = hi2(v); q[NOPE / 2 + i] = mk2(xe * cs - xo * sn, xe * sn + xo * cs); }
            else q[NOPE / 2 + i] = v;
        }
        float mx = -1e30f, sum = 0.f, acc[VSL];
        UNROLL for (int e = 0; e < VSL; ++e) acc[e] = 0.f;
        const int nk = T + (lat ? PAST : 0);
        for (int j = 0; j < nk; ++j) {
            const size_t krow = j < T ? (size_t)(base + j) : (size_t)(MTOK + (s - NB) * PAST + (j - T));
            const act_t* kn = kvup + krow * NKV + h * NOPE;
            const act_t* kp = kr + krow * ROPE;
            float sc = 0.f;
            UNROLL for (int i = 0; i < NOPE / 2; ++i) { if ((i & 15) == 0) CBAR; sc = dot2(q[i], ld2(kn + 2 * i), sc); }
            UNROLL for (int i = 0; i < ROPE / 2; ++i) { if ((i & 15) == 0) CBAR; sc = dot2(q[NOPE / 2 + i], ld2(kp + 2 * i), sc); }
            CBAR;
            sc *= scale;
            if (sc > mx) { const float corr = expf(mx - sc); sum *= corr; UNROLL for (int e = 0; e < VSL; ++e) acc[e] *= corr; mx = sc; }
            const float pe = expf(sc - mx);
            sum += pe;
            const act_t* vv = kvup + krow * NKV + BH * NOPE + h * VD + vs * VSL;
            UNROLL for (int e = 0; e < VSL; e += 2) { const act2 v2 = ld2(vv + e); acc[e] += pe * lo2(v2); acc[e + 1] += pe * hi2(v2); }
        }
        const float inv = 1.0f / sum;
        UNROLL for (int e = 0; e < VSL; ++e) ymix[(size_t)m * MIXW + AW + h * VD + vs * VSL + e] = f2a(acc[e] * inv);
    }
}

HD inline void ph_gdn_conv(const P& p, int l, long gt, long gs) {
    const float* pp = (const float*)(p.ws + WS_PP);
    float* gc = (float*)(p.ws + WS_GCONV);
    for (long idx = gt; idx < (long)MTOK * GC; idx += gs) {
        const int m = (int)(idx / GC), c = (int)(idx % GC);
        const int s = seq_of(m), base = seq_start(s), t = m - base, T = seq_len(s);
        const float* w = p.gdn_conv + (size_t)l * 3 * GC;
        float a = w[GC + c] * pp[(size_t)m * INP + OFF_GQ + c];
        if (t > 0) a += w[c] * pp[(size_t)(m - 1) * INP + OFF_GQ + c];
        if (t < T - 1) a += w[2 * GC + c] * pp[(size_t)(m + 1) * INP + OFF_GQ + c];
        gc[(size_t)m * GC + c] = siluf_(a);
    }
}
HD inline void ph_gdn_norm(const P& p, int l, long gt, long gs) {
    const float* pp = (const float*)(p.ws + WS_PP);
    float* gc = (float*)(p.ws + WS_GCONV); float* bg = (float*)(p.ws + WS_GBG);
    for (long idx = gt; idx < (long)MTOK * 4 * CH; idx += gs) {
        const int m = (int)(idx / (4 * CH)), j = (int)(idx % (4 * CH));
        if (j < 2 * CH) {
            float* v = gc + (size_t)m * GC + j * DK;
            float ss = 0.f;
            for (int e = 0; e < DK; ++e) ss += v[e] * v[e];
            const float rs = (1.0f / sqrtf(ss + L2_EPS)) * (j < CH ? 1.0f / sqrtf((float)DK) : 1.0f);
            for (int e = 0; e < DK; ++e) v[e] *= rs;
        } else {
            const int dh = j - 2 * CH;
            const float* pr = pp + (size_t)m * INP;
            const float beta = sigmoidf_(pr[OFF_GB + dh]);
            const float g = -expf(p.gdn_a_log[(size_t)l * 2 * CH + dh]) * softplusf_(pr[OFF_GA + dh] + p.gdn_dt_bias[(size_t)l * 2 * CH + dh]);
            bg[((size_t)m * 2 * CH + dh) * 4 + 0] = beta; bg[((size_t)m * 2 * CH + dh) * 4 + 1] = g;
        }
    }
}
HD inline void ph_gdn_scan(const P& p, int l, long gt, long gs) {
    const float* gc = (const float*)(p.ws + WS_GCONV); const float* bg = (const float*)(p.ws + WS_GBG); float* go = (float*)(p.ws + WS_GO);
    for (long idx = gt; idx < (long)NSEQ * 2 * CH * DV; idx += gs) {
        const int e = (int)(idx % DV), h = (int)((idx / DV) % CH), d = (int)((idx / (DV * CH)) % 2), s = (int)(idx / (DV * CH * 2));
        float S[DK];
        if (s >= NB) { const float* s0 = p.state_gdn + ((((size_t)(s - NB) * L + l) * 2 + d) * CH + h) * DK * DV + e; UNROLL for (int k = 0; k < DK; ++k) S[k] = s0[(size_t)k * DV]; }
        else { UNROLL for (int k = 0; k < DK; ++k) S[k] = 0.f; }
        const int T = seq_len(s), base = seq_start(s);
        for (int step = 0; step < T; ++step) {
            const int m = base + (d == 0 ? step : T - 1 - step);
            const float* q = gc + (size_t)m * GC + h * DK; const float* k = gc + (size_t)m * GC + CH * DK + h * DK;
            const float v = gc[(size_t)m * GC + 2 * CH * DK + h * DV + e];
            const float beta = bg[((size_t)m * 2 * CH + d * CH + h) * 4 + 0], eg = expf(bg[((size_t)m * 2 * CH + d * CH + h) * 4 + 1]);
            float kS = 0.f;
            UNROLL for (int j = 0; j < DK; j += 4) { if ((j & 15) == 0) CBAR; const f4 t = ldf4(k + j); kS += t.x * S[j] + t.y * S[j + 1] + t.z * S[j + 2] + t.w * S[j + 3]; }
            const float coef = beta * (v - eg * kS);
            float o = 0.f;
            UNROLL for (int j = 0; j < DK; j += 4) {
                if ((j & 15) == 0) CBAR;
                const f4 t = ldf4(k + j), u = ldf4(q + j);
                S[j] = eg * S[j] + t.x * coef; o += u.x * S[j];
                S[j + 1] = eg * S[j + 1] + t.y * coef; o += u.y * S[j + 1];
                S[j + 2] = eg * S[j + 2] + t.z * coef; o += u.z * S[j + 2];
                S[j + 3] = eg * S[j + 3] + t.w * coef; o += u.w * S[j + 3];
            }
            go[((size_t)m * 2 + d) * CW + h * DV + e] = o;
        }
        if (s < NB) { float* so = p.out + O_SG + ((((size_t)s * L + l) * 2 + d) * CH + h) * DK * DV + e; UNROLL for (int k = 0; k < DK; ++k) so[(size_t)k * DV] = S[k]; }
    }
}
HD inline void ph_gdn_post(const P& p, int l, long gt, long gs) {
    const float* pp = (const float*)(p.ws + WS_PP); const float* go = (const float*)(p.ws + WS_GO);
    act_t* ymix = (act_t*)(p.ws + WS_YMIX);
    for (long idx = gt; idx < (long)MTOK * CH; idx += gs) {
        const int m = (int)(idx / CH), h = (int)(idx % CH);
        const float* o0 = go + ((size_t)m * 2 + 0) * CW + h * DV; const float* o1 = go + ((size_t)m * 2 + 1) * CW + h * DV;
        float ss = 0.f;
        for (int e = 0; e < DV; ++e) { const float t = o0[e] + o1[e]; ss += t * t; }
        const float rs = 1.0f / sqrtf(ss / DV + RMS_EPS);
        for (int e = 0; e < DV; ++e) {
            const float z = pp[(size_t)m * INP + OFF_GZ + h * DV + e];
            ymix[(size_t)m * MIXW + AW + BW + h * DV + e] = f2a((o0[e] + o1[e]) * rs * p.gdn_norm_g[(size_t)l * DV + e] * siluf_(z));
        }
    }
}
HD inline void ph_ffn_act(const P& p, int l, long gt, long gs) {
    const act_t* up = (const act_t*)(p.ws + WS_UP); act_t* act = (act_t*)(p.ws + WS_ACT);
    for (long idx = gt; idx < (long)MTOK * DFF; idx += gs) {
        const int m = (int)(idx / DFF), c = (int)(idx % DFF);
        const int s = seq_of(m), base = seq_start(s), t = m - base, T = seq_len(s);
        const float* w = p.ffn_conv + (size_t)l * 3 * DFF;
        float a = w[DFF + c] * a2f(up[(size_t)m * NUP + c]);
        if (t > 0) a += w[c] * a2f(up[(size_t)(m - 1) * NUP + c]);
        if (t < T - 1) a += w[2 * DFF + c] * a2f(up[(size_t)(m + 1) * NUP + c]);
        act[(size_t)m * DFF + c] = f2a(siluf_(a) * a2f(up[(size_t)m * NUP + DFF + c]));
    }
}
HD inline void ph_final(const P& p, long gt, long gs) {
    const float* x = (const float*)(p.ws + WS_X);
    for (long m = gt; m < MTOK; m += gs) {
        const float* xr = x + (size_t)m * D;
        float ss = 0.f;
        for (int j = 0; j < D; ++j) ss += xr[j] * xr[j];
        const float rs = 1.0f / sqrtf(ss / D + RMS_EPS);
        for (int j = 0; j < D; ++j) p.out[O_YP + (size_t)m * D + j] = xr[j] * rs * p.final_norm_g[j];
    }
}
HD inline void ph_gemm_naive(const P& p, const act_t* A, int lda, const float* W, int ldw, int M, int N, int K, int mode, float* Cf, act_t* Ca, int ldc, int l, int which,
                             long gt, long gs) {
    for (long idx = gt; idx < (long)M * N; idx += gs) {
        const int m = (int)(idx / N), n = (int)(idx % N);
        float acc = 0.f;
        for (int k = 0; k < K; ++k) acc += a2f(A[(size_t)m * lda + k]) * W[(size_t)k * ldw + n];
        if (mode == 0) Cf[(size_t)m * ldc + n] = acc;
        else if (mode == 1) Ca[(size_t)m * ldc + n] = f2a(acc);
        else { const float* gate = modp(p, l, cond_of_seq(seq_of(m)), which); Cf[(size_t)m * ldc + n] += gate[n] * acc; }
    }
}
namespace pg8 {
#define PG8_LAS __attribute__((address_space(3)))
typedef unsigned short bf16_t;
typedef short bf16x8 __attribute__((ext_vector_type(8)));
typedef float f32x4 __attribute__((ext_vector_type(4)));
typedef unsigned u32x4 __attribute__((ext_vector_type(4)));
constexpr int BM = 256, BK = 64, HALF = 128, HTB = HALF * BK * 2  , STAGE_BYTES = 8 * HTB, NXCD = 8, WGM = 8;

__host__ __device__ __forceinline__ int lds_byte(int r, int c) { const int st = (r >> 4) * 2 + (c >> 5), rr = r & 15, cc = c & 31, ob = rr * 64 + cc * 2; return st * 1024 + (ob ^ (((ob >> 9) & 1) << 5)); }
__host__ __device__ __forceinline__ void stage_rc(int b, int& R, int& C) { const int st = b / 1024, sb = b % 1024, swz = sb ^ (((sb >> 9) & 1) << 5); R = (st >> 1) * 16 + swz / 64; C = (st & 1) * 32 + (swz % 64) / 2; }
__host__ __device__ __forceinline__ int perm32(int rho) { const int n = rho >> 4, i = rho & 15; return 8 * (i >> 2) + 4 * n + (i & 3); }

struct Unit { int pm, pn; };
struct Gemm { const bf16_t* A; const bf16_t* Bt; int M, N, K, ld; };

struct StaticOrder {
    int nM, nN, nwg, G, c;
    __host__ __device__ void init(int M, int N, int G_, int c_) { nM = M / BM; nN = N / BM; nwg = nM * nN; G = G_; c = c_; }
    __host__ __device__ bool next(int i, Unit& u) const {
        const long L = (long)i * G + c; if (L >= nwg) return false;
        int wgid = (int)L; { const int q = nwg / NXCD, r = nwg % NXCD, xcd = wgid % NXCD, off = wgid / NXCD; wgid = (xcd < r ? xcd * (q + 1) : r * (q + 1) + (xcd - r) * q) + off; }
        const int nig = WGM * nN, gid = wgid / nig, fm = gid * WGM, gsz = (nM - fm) < WGM ? (nM - fm) : WGM;
        u.pm = fm + ((wgid % nig) % gsz); u.pn = (wgid % nig) / gsz; return true;
    }
    __device__ __forceinline__ void a_ready(const Unit&) const {}
    __device__ __forceinline__ void done(const Unit&) const {}
};
struct CountedOrder : StaticOrder {
    const unsigned* ready; unsigned need; unsigned* tmo;
    __device__ __forceinline__ void a_ready(const Unit& u) const {
        if (TIDX < 64) {
            const unsigned long long t0 = __builtin_amdgcn_s_memrealtime(); unsigned polls = 0;
            while ((unsigned)__builtin_amdgcn_readfirstlane(__hip_atomic_load(ready + 64 * u.pm, __ATOMIC_RELAXED, __HIP_MEMORY_SCOPE_AGENT)) < need) {
                if ((++polls & 255u) == 0u && __builtin_amdgcn_readfirstlane(__hip_atomic_load(tmo, __ATOMIC_RELAXED, __HIP_MEMORY_SCOPE_AGENT)) != 0u) break;
                if (__builtin_amdgcn_s_memrealtime() - t0 > 2000000ull) {
                    if (TIDX == 0) { unsigned expect = 0u; __hip_atomic_compare_exchange_strong(tmo + 1, &expect, 0x600u | (unsigned)(u.pm & 0xff), __ATOMIC_RELAXED, __ATOMIC_RELAXED, __HIP_MEMORY_SCOPE_AGENT); __hip_atomic_store(tmo, 1u, __ATOMIC_RELAXED, __HIP_MEMORY_SCOPE_AGENT); }
                    break; }
                __builtin_amdgcn_s_sleep(2); }
            __builtin_amdgcn_fence(__ATOMIC_ACQUIRE, "agent");
            asm volatile("s_waitcnt vmcnt(0)" ::: "memory");
        }
#if !defined(BROKEN_HOOK_NO_BARRIER)
        asm volatile("" ::: "memory"); __builtin_amdgcn_s_barrier(); asm volatile("" ::: "memory");
#endif
    }
};

__device__ __forceinline__ unsigned cvt_pk_bf16(float lo, float hi) { unsigned r; asm volatile("v_cvt_pk_bf16_f32 %0, %1, %2" : "=v"(r) : "v"(lo), "v"(hi)); return r; }
typedef float f32x2 __attribute__((ext_vector_type(2)));
__device__ __forceinline__ f32x2 gelu_pk(f32x2 v) {
    const f32x2 av = __builtin_elementwise_abs(v), d = av * 0.2316418882f + 1.0f;
    f32x2 t; t.x = __builtin_amdgcn_rcpf(d.x); t.y = __builtin_amdgcn_rcpf(d.y);
    f32x2 q = t * 0.5307027145f + (-0.7265760135f); q = q * t + 0.7107068705f; q = q * t + (-0.142248368f); q = q * t + 0.127414796f; q = q * t;
    const f32x2 s = (v * v) * (-0.72134752044f);
    f32x2 e; e.x = __builtin_amdgcn_exp2f(s.x); e.y = __builtin_amdgcn_exp2f(s.y);
    const f32x2 m = v * (q * e), r = v - m;
    f32x2 o; o.x = v.x < 0.f ? m.x : r.x; o.y = v.y < 0.f ? m.y : r.y; return o;
}

struct EpiF32 {
    static constexpr bool PERM = false, AFTER_DRAIN = false;
    float* C; int ldc; const float* bias;
    __device__ __forceinline__ void operator()(const f32x4 (&acc)[2][2][4][2], const Unit& u, int wr, int wc, int fr, int fq) const {
        const int row0 = u.pm * BM + wr * 64 + fr, col0 = u.pn * BM + wc * 32 + 4 * fq;
        f32x4 bv[2][2];
#pragma unroll
        for (int bj = 0; bj < 2; ++bj)
#pragma unroll
            for (int n = 0; n < 2; ++n) bv[bj][n] = bias ? *(const f32x4*)(bias + col0 + bj * HALF + n * 16) : (f32x4){0.f, 0.f, 0.f, 0.f};
#pragma unroll
        for (int ai = 0; ai < 2; ++ai)
#pragma unroll
            for (int m = 0; m < 4; ++m) { float* rowp = C + (size_t)(row0 + ai * HALF + m * 16) * ldc + col0;
#pragma unroll
                for (int bj = 0; bj < 2; ++bj)
#pragma unroll
                    for (int n = 0; n < 2; ++n) *(f32x4*)(rowp + bj * HALF + n * 16) = acc[ai][bj][m][n] + bv[bj][n]; }
    }
};
template <int ACT  > struct EpiBf16 {
    static constexpr bool PERM = true, AFTER_DRAIN = false;
    bf16_t* O; int ldc; const float* bias; int split_cols; size_t split_stride;
    __device__ __forceinline__ void operator()(const f32x4 (&acc)[2][2][4][2], const Unit& u, int wr, int wc, int fr, int fq) const {
        const int row0 = u.pm * BM + wr * 64 + fr; int colt = u.pn * BM; bf16_t* base = O;
        if (split_cols) { const int t = colt / split_cols; base += (size_t)t * split_stride; colt -= t * split_cols; }
        const int col0 = colt + wc * 32 + 8 * fq, bcol0 = u.pn * BM + wc * 32 + 8 * fq;
        f32x4 bv[2][2];
#pragma unroll
        for (int bj = 0; bj < 2; ++bj)
#pragma unroll
            for (int n = 0; n < 2; ++n) bv[bj][n] = bias ? *(const f32x4*)(bias + bcol0 + bj * HALF + 4 * n) : (f32x4){0.f, 0.f, 0.f, 0.f};
#pragma unroll
        for (int ai = 0; ai < 2; ++ai)
#pragma unroll
            for (int m = 0; m < 4; ++m) { bf16_t* rowp = base + (size_t)(row0 + ai * HALF + m * 16) * ldc + col0;
#pragma unroll
                for (int bj = 0; bj < 2; ++bj) { f32x4 v0 = acc[ai][bj][m][0] + bv[bj][0], v1 = acc[ai][bj][m][1] + bv[bj][1];
                    if (ACT == 1) { f32x2 a = gelu_pk((f32x2){v0[0], v0[1]}), b = gelu_pk((f32x2){v0[2], v0[3]}), c = gelu_pk((f32x2){v1[0], v1[1]}), d = gelu_pk((f32x2){v1[2], v1[3]});
                        v0 = (f32x4){a.x, a.y, b.x, b.y}; v1 = (f32x4){c.x, c.y, d.x, d.y}; }
                    if (ACT == 2) {
#pragma unroll
                        for (int j = 0; j < 4; ++j) { v0[j] = 0.5f * v0[j] * (1.0f + erff(v0[j] * 0.70710678f)); v1[j] = 0.5f * v1[j] * (1.0f + erff(v1[j] * 0.70710678f)); } }
                    u32x4 w; w.x = cvt_pk_bf16(v0[0], v0[1]); w.y = cvt_pk_bf16(v0[2], v0[3]); w.z = cvt_pk_bf16(v1[0], v1[1]); w.w = cvt_pk_bf16(v1[2], v1[3]);
                    *(u32x4*)(rowp + bj * HALF) = w; } }
    }
};

template <class Epi, class Sched, bool STAMP = false>
__device__ __forceinline__ void gemm_phase(PG8_LAS unsigned char* lds, const Gemm g, const Sched& S, const Epi& E, unsigned long long* stamps) {
    int tid_ = TIDX; asm volatile("" : "+v"(tid_));
    const int tid = tid_, wid = __builtin_amdgcn_readfirstlane(tid >> 6), lane = tid & 63, wr = wid >> 2, wc = wid & 3, fr = lane & 15, fq = lane >> 4;
    const int K = g.ld, nt = g.K / BK;
    int ts_lo = 0, ts_hi = 0, nts = 0; const unsigned long long rt_entry = STAMP ? (unsigned long long)wall_clock64() : 0ull;
#define PG8_STAMP() do { if (STAMP && wid == 0 && nts < 64) { const unsigned long long _c = (unsigned long long)clock64(); \
        ts_lo = (lane == nts) ? (int)(unsigned)_c : ts_lo; ts_hi = (lane == nts) ? (int)(unsigned)(_c >> 32) : ts_hi; ++nts; } } while (0)
    PG8_STAMP();
    unsigned voffA[2], voffB[2];
#pragma unroll
    for (int i = 0; i < 2; ++i) { int R, C; stage_rc(tid * 16 + i * 8192, R, C); const int Rb = Epi::PERM ? ((R & ~31) + perm32(R & 31)) : R;
        voffA[i] = (unsigned)(R * K + C) * 2u; voffB[i] = (unsigned)(Rb * K + C) * 2u; }
    const size_t kstep = (size_t)(BK * 2);
    const size_t hstep = (size_t)HALF * K * 2;
    const size_t tstep = 2 * hstep;
    const unsigned ldsw = (unsigned)wid * 1024u;
    const int aoff = lds_byte(wr * 64 + fr, fq * 8), boff = lds_byte(wc * 32 + fr, fq * 8);
#define PG8_SA(b, h) (((b) * 2 + (h)) * HTB)
#define PG8_SB(b, h) ((4 + (b) * 2 + (h)) * HTB)
#define PG8_STAGE(bufoff, gbase, voff) do { _Pragma("unroll") for (int _i = 0; _i < 2; ++_i) \
        __builtin_amdgcn_global_load_lds((const unsigned*)((const char*)(gbase) + (voff)[_i]), (PG8_LAS unsigned*)(lds + (bufoff) + ldsw + _i * 8192), 16, 0, 0); } while (0)
#define PG8_LDA(dst, b, h) do { _Pragma("unroll") for (int m = 0; m < 4; ++m) _Pragma("unroll") for (int k = 0; k < 2; ++k) dst[m][k] = *(const PG8_LAS bf16x8*)(lds + PG8_SA(b, h) + aoff + m * 2048 + k * 1024); } while (0)
#define PG8_LDB(dst, b, h) do { _Pragma("unroll") for (int n = 0; n < 2; ++n) _Pragma("unroll") for (int k = 0; k < 2; ++k) dst[n][k] = *(const PG8_LAS bf16x8*)(lds + PG8_SB(b, h) + boff + n * 2048 + k * 1024); } while (0)
#define PG8_MMA(ai, bj, At, Bt) do { __builtin_amdgcn_s_setprio(1); _Pragma("unroll") for (int m = 0; m < 4; ++m) _Pragma("unroll") for (int n = 0; n < 2; ++n) _Pragma("unroll") for (int k = 0; k < 2; ++k) \
        acc[ai][bj][m][n] = __builtin_amdgcn_mfma_f32_16x16x32_bf16(Bt[n][k], At[m][k], acc[ai][bj][m][n], 0, 0, 0); __builtin_amdgcn_s_setprio(0); } while (0)
#define PG8_WAIT_V(n) asm volatile("s_waitcnt vmcnt(" #n ")" ::: "memory")
#define PG8_WAIT_L(n) asm volatile("s_waitcnt lgkmcnt(" #n ")" ::: "memory")
#define PG8_BAR __builtin_amdgcn_s_barrier()
#define PG8_SCHED __builtin_amdgcn_sched_barrier(0)
    Unit cur, nxt; int ui = 0;
    if (!S.next(0, cur)) return;
    f32x4 acc[2][2][4][2];
#pragma unroll
    for (int a = 0; a < 2; ++a)
#pragma unroll
        for (int b = 0; b < 2; ++b)
#pragma unroll
            for (int m = 0; m < 4; ++m)
#pragma unroll
                for (int n = 0; n < 2; ++n) acc[a][b][m][n] = (f32x4){0.f, 0.f, 0.f, 0.f};
    bf16x8 At[4][2], B0[2][2], B1[2][2];
    const char* cA = (const char*)g.A + (size_t)cur.pm * tstep; const char* cB = (const char*)g.Bt + (size_t)cur.pn * tstep;
    S.a_ready(cur);
    PG8_STAGE(PG8_SB(0, 0), cB, voffB); PG8_STAGE(PG8_SA(0, 0), cA, voffA); PG8_STAGE(PG8_SB(0, 1), cB + hstep, voffB); PG8_STAGE(PG8_SA(0, 1), cA + hstep, voffA);
    if (wr == 1) PG8_BAR;
    PG8_WAIT_V(4); PG8_BAR;
    PG8_STAGE(PG8_SB(1, 0), cB + kstep, voffB); PG8_STAGE(PG8_SA(1, 0), cA + kstep, voffA); PG8_STAGE(PG8_SB(1, 1), cB + hstep + kstep, voffB);
    PG8_WAIT_V(6); PG8_BAR;
    PG8_STAMP();
    for (;;) {
        const bool has_next = S.next(ui + 1, nxt);
        const char* nA = has_next ? (const char*)g.A + (size_t)nxt.pm * tstep : cA; const char* nB = has_next ? (const char*)g.Bt + (size_t)nxt.pn * tstep : cB;
        for (int t = 0; t < nt; t += 2) {
            const bool last = (t == nt - 2);
            const char* a1 = cA + (size_t)(t + 1) * kstep;
            const char* a2 = last ? nA : cA + (size_t)(t + 2) * kstep; const char* b2 = last ? nB : cB + (size_t)(t + 2) * kstep;
            const char* a3 = a2 + kstep; const char* b3 = b2 + kstep;
            if (last && has_next) S.a_ready(nxt);
            PG8_LDB(B0, 0, 0); PG8_SCHED; PG8_LDA(At, 0, 0); PG8_STAGE(PG8_SA(1, 1), a1 + hstep, voffA);
            PG8_WAIT_L(8); PG8_BAR; PG8_WAIT_L(0); PG8_MMA(0, 0, At, B0); PG8_BAR; PG8_SCHED;
            PG8_LDB(B1, 0, 1); PG8_STAGE(PG8_SB(0, 0), b2, voffB);
            PG8_BAR; PG8_WAIT_L(0); PG8_MMA(0, 1, At, B1); PG8_BAR;
            PG8_LDA(At, 0, 1); PG8_STAGE(PG8_SA(0, 0), a2, voffA);
            PG8_BAR; PG8_WAIT_L(0); PG8_MMA(1, 0, At, B0); PG8_BAR; PG8_SCHED;
            PG8_STAGE(PG8_SB(0, 1), b2 + hstep, voffB);
            PG8_WAIT_V(6); PG8_BAR; PG8_MMA(1, 1, At, B1); PG8_BAR;
            PG8_LDB(B0, 1, 0); PG8_SCHED; PG8_LDA(At, 1, 0); PG8_STAGE(PG8_SA(0, 1), a2 + hstep, voffA);
            PG8_WAIT_L(8); PG8_BAR; PG8_WAIT_L(0); PG8_MMA(0, 0, At, B0); PG8_BAR; PG8_SCHED;
            PG8_LDB(B1, 1, 1); PG8_STAGE(PG8_SB(1, 0), b3, voffB);
            PG8_BAR; PG8_WAIT_L(0); PG8_MMA(0, 1, At, B1); PG8_BAR;
            PG8_LDA(At, 1, 1); PG8_STAGE(PG8_SA(1, 0), a3, voffA);
            PG8_BAR; PG8_WAIT_L(0); PG8_MMA(1, 0, At, B0); PG8_BAR; PG8_SCHED;
            PG8_STAGE(PG8_SB(1, 1), b3 + hstep, voffB);
            PG8_WAIT_V(6); PG8_BAR; PG8_MMA(1, 1, At, B1); PG8_BAR;
        }
        PG8_STAMP();
        if constexpr (!Epi::AFTER_DRAIN) { E(acc, cur, wr, wc, fr, fq); S.done(cur); }
        PG8_STAMP();
        if (!has_next) break;
#pragma unroll
        for (int a = 0; a < 2; ++a)
#pragma unroll
            for (int b = 0; b < 2; ++b)
#pragma unroll
                for (int m = 0; m < 4; ++m)
#pragma unroll
                    for (int n = 0; n < 2; ++n) acc[a][b][m][n] = (f32x4){0.f, 0.f, 0.f, 0.f};
        cur = nxt; cA = nA; cB = nB; ++ui;
    }
    PG8_WAIT_V(0);
    if (wr == 0) PG8_BAR;
    PG8_BAR;
    if constexpr (Epi::AFTER_DRAIN) { E.fused(acc, cur, wr, wc, fr, fq, lds, wid, lane); S.done(cur); }
    PG8_STAMP();
    if (STAMP && wid == 0) { stamps[lane] = lane < nts ? (((unsigned long long)(unsigned)ts_hi << 32) | (unsigned)ts_lo) : 0ull;
        if (lane == 62) stamps[62] = rt_entry; if (lane == 63) stamps[63] = (unsigned long long)wall_clock64(); }
#undef PG8_STAMP
#undef PG8_SA
#undef PG8_SB
#undef PG8_STAGE
#undef PG8_LDA
#undef PG8_LDB
#undef PG8_MMA
#undef PG8_WAIT_V
#undef PG8_WAIT_L
#undef PG8_BAR
#undef PG8_SCHED
}
}
#define XB_TMO      128
#define XB_XCNT(j)  (256  + 64 * (j))
#define XB_XSUB(j)  (1280 + 64 * (j))
#define XB_XGEN(j)  (2304 + 64 * (j))
#define XB_TOP      3328
#define XB_TOPGEN   3392
#define XCD_BAR_WORDS 3456
#define XB_SPIN_CAP (1u << 22)
#define LAS __attribute__((address_space(3)))

__device__ __forceinline__ unsigned xb_ld(unsigned* p)              { return __hip_atomic_load(p, __ATOMIC_RELAXED, __HIP_MEMORY_SCOPE_AGENT); }
__device__ __forceinline__ unsigned xb_add(unsigned* p, unsigned v) { return __hip_atomic_fetch_add(p, v, __ATOMIC_RELAXED, __HIP_MEMORY_SCOPE_AGENT); }
__device__ __forceinline__ unsigned xb_xcc_id() { return (unsigned)__builtin_amdgcn_s_getreg((3 << 11) | 20) & 0xFu; }
#define XB_SPIN(cond, bar) do { unsigned _sp = 0; while (cond) { __builtin_amdgcn_s_sleep(1); \
    if ((++_sp & 255u) == 0u) { if (xb_ld(&(bar)[XB_TMO])) break; if (_sp > XB_SPIN_CAP) { atomicAdd(&(bar)[XB_TMO], 1u); break; } } } } while (0)

struct XcdBarrier {
    unsigned* bar; unsigned x;
    volatile LAS unsigned* st;
};

__device__ __forceinline__ XcdBarrier xcd_barrier_post(unsigned* bar, volatile LAS unsigned* st) {
    XcdBarrier b; b.bar = bar; b.x = xb_xcc_id(); b.st = st;
    if (TIDX == 0) (void)xb_add(&bar[XB_XCNT(b.x)], 1u);
    return b;
}
__device__ __forceinline__ void xcd_barrier_complete(unsigned* bar, unsigned x, unsigned& nloc, unsigned& nx) {
    const unsigned G = gridDim.x * gridDim.y * gridDim.z;
    unsigned sum, cnt, mine, sp = 0u;
    for (;;) {
        sum = 0u; cnt = 0u; mine = 0u;
#pragma unroll
        for (unsigned j = 0; j < 16; ++j) { const unsigned c = xb_ld(&bar[XB_XCNT(j)]); sum += c; cnt += (c > 0u) ? 1u : 0u; mine = (j == x) ? c : mine; }
        if (sum == G) break;
        __builtin_amdgcn_s_sleep(1);
        if ((++sp & 255u) == 0u) { if (xb_ld(&bar[XB_TMO])) break; if (sp > XB_SPIN_CAP) { atomicAdd(&bar[XB_TMO], 1u); break; } }
    }
    nloc = mine > 0u ? mine : 1u; nx = cnt > 0u ? cnt : 1u;
}

__device__ __forceinline__ void xcd_barrier(const XcdBarrier& b) {
    asm volatile("s_waitcnt vmcnt(0)" ::: "memory");
    __syncthreads();
    if (TIDX == 0) {
        unsigned* bar = b.bar;
        __builtin_amdgcn_s_waitcnt(0);
        unsigned nloc = b.st[0], nx = b.st[1];
        if (nloc == 0u) { xcd_barrier_complete(bar, b.x, nloc, nx); b.st[0] = nloc; b.st[1] = nx; }
        const unsigned old = xb_add(&bar[XB_XSUB(b.x)], 1u);
        const unsigned gen = old / nloc;
        if (old + 1u == (gen + 1u) * nloc) {
            __builtin_amdgcn_fence(__ATOMIC_RELEASE, "agent");
            asm volatile("s_waitcnt vmcnt(0)" ::: "memory");
            const unsigned og = xb_add(&bar[XB_TOP], 1u);
            const unsigned tg = og / nx;
            if (og + 1u == (tg + 1u) * nx) xb_add(&bar[XB_TOPGEN], 1u);
            else XB_SPIN(xb_ld(&bar[XB_TOPGEN]) == tg, bar);
            __builtin_amdgcn_fence(__ATOMIC_ACQUIRE, "agent");
            xb_add(&bar[XB_XGEN(b.x)], 1u);
            asm volatile("s_waitcnt vmcnt(0)" ::: "memory");
        } else {
            XB_SPIN(xb_ld(&bar[XB_XGEN(b.x)]) == gen, bar);
            __builtin_amdgcn_fence(__ATOMIC_ACQUIRE, "agent");
            asm volatile("s_waitcnt vmcnt(0)" ::: "memory");
        }
    }
    __syncthreads();
}
namespace att {
constexpr int DQK = QKD, DV_ = VD, NW = 8, QBLK = 32, KVBLK = 64;
static_assert(DQK == 192 && DV_ == 128 && NOPE == 128 && ROPE == 64, "attention body is written for 128 + 64 / 128");
constexpr float SCALE = 0.07216878364870322f;
constexpr float THR = 8.f;
constexpr int SDEPTH = ATT_SDEPTH;
constexpr int NQREG = ATT_NQREG, NQLDS = DQK / 16 - NQREG;
static_assert(NQREG <= NOPE / 16 && NQREG >= 0, "rope fragments live in LDS");
constexpr int KPITCH = DQK * 2;
constexpr size_t SHM_V = KVBLK * DV_ * 2, SHM_K = KVBLK * KPITCH, SHM_QR = 2 * SHM_V + 2 * SHM_K + NW * 64 * 4, SHM_ATTN = SHM_QR + NW * (DQK / 16 - ATT_NQREG) * 1024;
using bf16x8 = __attribute__((ext_vector_type(8))) short;
using s16x4  = __attribute__((ext_vector_type(4))) short;
using f32x16 = __attribute__((ext_vector_type(16))) float;
using u32x4  = __attribute__((ext_vector_type(4))) unsigned;
#define KSWZ(row, colB) ((row) * att::KPITCH + ((colB) ^ (((row) & 7) << 4)))
#define SBAR() __builtin_amdgcn_sched_barrier(0)
__device__ __forceinline__ int crow(int r, int hi) { return (r & 3) + 8 * (r >> 2) + 4 * hi; }
__device__ __forceinline__ unsigned cvtpk(float lo, float hi) { unsigned r; asm volatile("v_cvt_pk_bf16_f32 %0, %1, %2" : "=v"(r) : "v"(lo), "v"(hi)); return r; }

__device__ __forceinline__ void partialSM(f32x16& p0, f32x16& p1, float& m_reg, float& mn, float& alpha) {
  constexpr float C = SCALE * 1.4426950408889634f;
  float pmax = p0[0];
#pragma unroll
  for (int r = 1; r < 16; ++r) pmax = fmaxf(pmax, p0[r]);
#pragma unroll
  for (int r = 0; r < 16; ++r) pmax = fmaxf(pmax, p1[r]);
  { auto rr = __builtin_amdgcn_permlane32_swap(__float_as_uint(pmax), __float_as_uint(pmax), false, false);
    pmax = fmaxf(__uint_as_float(rr[0]), __uint_as_float(rr[1])); }
  if (__builtin_expect(__all(pmax - m_reg <= THR / SCALE), 1)) { mn = m_reg; alpha = 1.f; }
  else { mn = fmaxf(m_reg, pmax); alpha = __builtin_amdgcn_exp2f((m_reg - mn) * C); m_reg = mn; }
  float mnC = -mn * C;
#pragma unroll
  for (int r = 0; r < 16; ++r) p0[r] = fmaf(p0[r], C, mnC);
#pragma unroll
  for (int r = 0; r < 16; ++r) p1[r] = fmaf(p1[r], C, mnC);
#pragma unroll
  for (int r = 0; r < 16; ++r) p0[r] = __builtin_amdgcn_exp2f(p0[r]);
}
__device__ __forceinline__ void finishSM(f32x16& p0, f32x16& p1, float alpha, float& l_reg, bf16x8& pa0, bf16x8& pa1, bf16x8& pa2, bf16x8& pa3) {
#pragma unroll
  for (int r = 0; r < 16; ++r) p1[r] = __builtin_amdgcn_exp2f(p1[r]);
  float ps = 0;
#pragma unroll
  for (int r = 0; r < 16; ++r) ps += p0[r];
#pragma unroll
  for (int r = 0; r < 16; ++r) ps += p1[r];
  { auto rr = __builtin_amdgcn_permlane32_swap(__float_as_uint(ps), __float_as_uint(ps), false, false);
    ps = __uint_as_float(rr[0]) + __uint_as_float(rr[1]); }
  l_reg = l_reg * alpha + ps;
#define PK4(P, BASE, OUT) do { unsigned a0 = cvtpk(P[BASE + 0], P[BASE + 1]), a1 = cvtpk(P[BASE + 2], P[BASE + 3]);   \
    unsigned b0 = cvtpk(P[BASE + 4], P[BASE + 5]), b1 = cvtpk(P[BASE + 6], P[BASE + 7]);                              \
    auto r0 = __builtin_amdgcn_permlane32_swap(a0, b0, false, false); auto r1 = __builtin_amdgcn_permlane32_swap(a1, b1, false, false); \
    u32x4 w = {r0[0], r1[0], r0[1], r1[1]}; OUT = *reinterpret_cast<bf16x8*>(&w); } while (0)
  PK4(p0, 0, pa0); PK4(p0, 8, pa1); PK4(p1, 0, pa2); PK4(p1, 8, pa3);
#undef PK4
}
__device__ __forceinline__ void qkt(f32x16& p0, f32x16& p1, const char* Ks, const bf16x8* qr, const char* qx, int r32, int hi) {
  p0 = f32x16{}; p1 = f32x16{};
#pragma unroll
  for (int d0 = 0; d0 < DQK / 16; ++d0) { int cb = (d0 * 16 + hi * 8) * 2;
    bf16x8 b0 = *reinterpret_cast<const bf16x8*>(Ks + KSWZ(r32, cb));
    bf16x8 b1 = *reinterpret_cast<const bf16x8*>(Ks + KSWZ(32 + r32, cb));
    const bf16x8 q = d0 < NQREG ? qr[d0 < NQREG ? d0 : 0] : *reinterpret_cast<const bf16x8*>(qx + (d0 - NQREG) * 1024);
    p0 = __builtin_amdgcn_mfma_f32_32x32x16_bf16(b0, q, p0, 0, 0, 0);
    p1 = __builtin_amdgcn_mfma_f32_32x32x16_bf16(b1, q, p1, 0, 0, 0); }
}
__device__ __forceinline__ int v_st(int k, int c) { const int kk = (k & ~0xC) | ((k & 4) << 1) | ((k & 8) >> 1); return ((kk >> 3) * 4 + (c >> 5)) * 512 + ((kk & 7) * 32 + (c & 31)) * 2; }
__device__ __forceinline__ int v_rd_base(int lane) { return ((lane & 3) << 3) | (((lane >> 2) & 3) << 6) | (((lane >> 4) & 1) << 5) | (((lane >> 5) & 1) << 8); }
constexpr int v_rd_off(int d0, int ks, int half) { return d0 * 512 + ks * 4096 + half * 2048; }
template <int OFF> __device__ __forceinline__ s16x4 tr_read(int vb) {
  s16x4 r; asm volatile("ds_read_b64_tr_b16 %0, %1 offset:%2" : "=&v"(r) : "v"(vb), "i"(OFF) : "memory"); return r;
}
template <int D0> __device__ __forceinline__ void pv_one(f32x16& od, int vb, bf16x8 pa0, bf16x8 pa1, bf16x8 pa2, bf16x8 pa3) {
  const s16x4 l0 = tr_read<v_rd_off(D0, 0, 0)>(vb), h0 = tr_read<v_rd_off(D0, 0, 1)>(vb), l1 = tr_read<v_rd_off(D0, 1, 0)>(vb), h1 = tr_read<v_rd_off(D0, 1, 1)>(vb);
  const s16x4 l2 = tr_read<v_rd_off(D0, 2, 0)>(vb), h2 = tr_read<v_rd_off(D0, 2, 1)>(vb), l3 = tr_read<v_rd_off(D0, 3, 0)>(vb), h3 = tr_read<v_rd_off(D0, 3, 1)>(vb);
  asm volatile("s_waitcnt lgkmcnt(0)" ::: "memory"); SBAR();
#define PK(L, H) (bf16x8){L[0], L[1], L[2], L[3], H[0], H[1], H[2], H[3]}
  od = __builtin_amdgcn_mfma_f32_32x32x16_bf16(pa0, PK(l0, h0), od, 0, 0, 0);
  od = __builtin_amdgcn_mfma_f32_32x32x16_bf16(pa1, PK(l1, h1), od, 0, 0, 0);
  od = __builtin_amdgcn_mfma_f32_32x32x16_bf16(pa2, PK(l2, h2), od, 0, 0, 0);
  od = __builtin_amdgcn_mfma_f32_32x32x16_bf16(pa3, PK(l3, h3), od, 0, 0, 0);
#undef PK
}
__device__ __forceinline__ void pv_d0(f32x16* o, int vb, bf16x8 pa0, bf16x8 pa1, bf16x8 pa2, bf16x8 pa3) {
  pv_one<0>(o[0], vb, pa0, pa1, pa2, pa3); pv_one<1>(o[1], vb, pa0, pa1, pa2, pa3); pv_one<2>(o[2], vb, pa0, pa1, pa2, pa3); pv_one<3>(o[3], vb, pa0, pa1, pa2, pa3);
}

__device__ __forceinline__ void attn_mla_body(const act_t* __restrict__ Qb, const float2* __restrict__ ropetab, const act_t* __restrict__ Kn, const act_t* __restrict__ Kp,
                                              const act_t* __restrict__ Vh, act_t* __restrict__ Ob, int r0, int nt0, int r1, int NT, char* lds) {
  int tid_ = TIDX; asm volatile("" : "+v"(tid_));
  const int tid = tid_, wid = tid >> 6, lane = tid & 63, r32 = lane & 31, hi = lane >> 5;
  char* V_lds = lds; char* K_lds = lds + 2 * SHM_V;
  float* ws = (float*)(lds + 2 * SHM_V + 2 * SHM_K) + wid * 64; float* li_l = ws; float* al_l = ws + 32;
  float m_reg = -1e30f, l_reg = 0; f32x16 o[4] = {}; bf16x8 qr[NQREG > 0 ? NQREG : 1];
  const act_t* Qw = Qb + (long)(wid * QBLK + r32) * NQ + hi * 8;
  char* qx = lds + SHM_QR + wid * (NQLDS * 1024) + lane * 16;
#pragma unroll
  for (int d0 = 0; d0 < NQREG; ++d0) qr[d0] = *reinterpret_cast<const bf16x8*>(Qw + d0 * 16);
  {
    u32x4 qt[DQK / 16 - NQREG];
#pragma unroll
    for (int d0 = NQREG; d0 < DQK / 16; ++d0) qt[d0 - NQREG] = *reinterpret_cast<const u32x4*>(Qw + d0 * 16);
    const float2* rt = (ropetab ? ropetab : reinterpret_cast<const float2*>(Qb)) + (long)(wid * QBLK + r32) * (ROPE / 2);
    float4 cs4[ROPE / 16][2];
#pragma unroll
    for (int d = 0; d < ROPE / 16; ++d) { cs4[d][0] = *reinterpret_cast<const float4*>(__builtin_assume_aligned(rt + d * 8 + hi * 4, 16)); cs4[d][1] = *reinterpret_cast<const float4*>(__builtin_assume_aligned(rt + d * 8 + hi * 4 + 2, 16)); }
    __builtin_amdgcn_sched_barrier(0);
#pragma unroll
    for (int d = 0; d < ROPE / 16; ++d) {
      asm volatile("" : "+v"(cs4[d][0].x), "+v"(cs4[d][0].y), "+v"(cs4[d][0].z), "+v"(cs4[d][0].w), "+v"(cs4[d][1].x), "+v"(cs4[d][1].y), "+v"(cs4[d][1].z), "+v"(cs4[d][1].w)); }
#pragma unroll
    for (int d0 = NQREG; d0 < NOPE / 16; ++d0) *reinterpret_cast<u32x4*>(qx + (d0 - NQREG) * 1024) = qt[d0 - NQREG];
#pragma unroll
    for (int d0 = NOPE / 16; d0 < DQK / 16; ++d0) {
      u32x4 w = qt[d0 - NQREG];
      {
        const int d = d0 - NOPE / 16; const bool rot = ropetab != nullptr;
        const float2 cs[4] = {make_float2(cs4[d][0].x, cs4[d][0].y), make_float2(cs4[d][0].z, cs4[d][0].w), make_float2(cs4[d][1].x, cs4[d][1].y), make_float2(cs4[d][1].z, cs4[d][1].w)};
#pragma unroll
        for (int j = 0; j < 4; ++j) {
          const float c = rot ? cs[j].x : 1.0f, s = rot ? cs[j].y : 0.0f;
          const float xe = __uint_as_float(w[j] << 16), xo = __uint_as_float(w[j] & 0xffff0000u);
          w[j] = cvtpk(xe * c - xo * s, xe * s + xo * c);
        }
      }
      *reinterpret_cast<u32x4*>(qx + (d0 - NQREG) * 1024) = w;
    }
    asm volatile("s_waitcnt lgkmcnt(0)" ::: "memory");
  }
  const int sr = tid >> 4, sc = (tid & 15) * 8, vst0 = v_st(sr, sc);
  const int pr = tid >> 3, pc = (tid & 7) * 8;
  const int vb0 = (int)(uintptr_t)V_lds + v_rd_base(lane);
  struct { bf16x8 vs0, vs1, ks0, ks1, kp; } sr_[SDEPTH];
#define KROW(j) __builtin_amdgcn_readfirstlane((j) < nt0 ? r0 + (j) * KVBLK : r1 + ((j) - nt0) * KVBLK)
  const unsigned ov0 = sr * NKV + sc, opp = pr * ROPE + pc; const int kst0 = KSWZ(sr, sc * 2), kstp = KSWZ(pr, (NOPE + pc) * 2);
#define SLOAD(i, j) do { const int kr_ = KROW(j); const act_t* vt_ = Vh + (size_t)kr_ * NKV; const act_t* kt_ = Kn + (size_t)kr_ * NKV; const act_t* pt_ = Kp + (size_t)kr_ * ROPE; \
    sr_[i].vs0 = *reinterpret_cast<const bf16x8*>(vt_ + ov0); sr_[i].vs1 = *reinterpret_cast<const bf16x8*>(vt_ + 32 * NKV + ov0); \
    sr_[i].ks0 = *reinterpret_cast<const bf16x8*>(kt_ + ov0); sr_[i].ks1 = *reinterpret_cast<const bf16x8*>(kt_ + 32 * NKV + ov0); \
    sr_[i].kp = *reinterpret_cast<const bf16x8*>(pt_ + opp); } while (0)
#define SWRITE(b, i) do { *(bf16x8*)(V_lds + (b) * SHM_V + vst0) = sr_[i].vs0; *(bf16x8*)(V_lds + (b) * SHM_V + 8192 + vst0) = sr_[i].vs1; \
    *(bf16x8*)(K_lds + (b) * SHM_K + kst0) = sr_[i].ks0; *(bf16x8*)(K_lds + (b) * SHM_K + 32 * KPITCH + kst0) = sr_[i].ks1; \
    *(bf16x8*)(K_lds + (b) * SHM_K + kstp) = sr_[i].kp; } while (0)
#define SWAIT() do { if constexpr (SDEPTH == 2) asm volatile("s_waitcnt vmcnt(5)" ::: "memory"); else asm volatile("s_waitcnt vmcnt(0)" ::: "memory"); } while (0)
#define RESC(a) do { if (__any((a) < 1.f)) { if (hi == 0) al_l[r32] = (a); asm volatile("s_waitcnt lgkmcnt(0)" ::: "memory"); \
    _Pragma("unroll") for (int d = 0; d < 4; ++d) _Pragma("unroll") for (int r = 0; r < 16; ++r) o[d][r] *= al_l[crow(r, hi)]; } } while (0)
  f32x16 pA0, pA1, pB0, pB1; float mnA, mnB, alA, alB; bf16x8 pa0, pa1, pa2, pa3;
  constexpr int SE = 0, SO = SDEPTH - 1;
  SLOAD(SE, 0); asm volatile("s_waitcnt vmcnt(0)" ::: "memory"); SWRITE(0, SE); __syncthreads();
  qkt(pA0, pA1, K_lds, qr, qx, r32, hi); partialSM(pA0, pA1, m_reg, mnA, alA);
  SLOAD(SO, 1); if constexpr (SDEPTH == 2) { if (2 < NT) SLOAD(SE, 2); }
  SWAIT(); SWRITE(1, SO); __syncthreads();
  for (int j = 1; j + 1 < NT; j += 2) {
    SBAR(); qkt(pB0, pB1, K_lds + SHM_K, qr, qx, r32, hi);
    finishSM(pA0, pA1, alA, l_reg, pa0, pa1, pa2, pa3); SBAR();
    SLOAD(SO, j + SDEPTH); SBAR();
    pv_d0(o, vb0, pa0, pa1, pa2, pa3); partialSM(pB0, pB1, m_reg, mnB, alB);
    __syncthreads(); SWAIT(); SWRITE(0, SE);
    RESC(alB); __syncthreads();
    SBAR(); qkt(pA0, pA1, K_lds, qr, qx, r32, hi);
    finishSM(pB0, pB1, alB, l_reg, pa0, pa1, pa2, pa3); SBAR();
    if (SDEPTH == 1 || j + 3 < NT) SLOAD(SE, j + 1 + SDEPTH); SBAR();
    pv_d0(o, vb0 + (int)SHM_V, pa0, pa1, pa2, pa3); partialSM(pA0, pA1, m_reg, mnA, alA);
    __syncthreads(); SWAIT(); SWRITE(1, SO);
    RESC(alA); __syncthreads();
  }
  SBAR(); qkt(pB0, pB1, K_lds + SHM_K, qr, qx, r32, hi);
  finishSM(pA0, pA1, alA, l_reg, pa0, pa1, pa2, pa3); SBAR();
  pv_d0(o, vb0, pa0, pa1, pa2, pa3); partialSM(pB0, pB1, m_reg, mnB, alB);
  __syncthreads(); RESC(alB);
  finishSM(pB0, pB1, alB, l_reg, pa0, pa1, pa2, pa3); SBAR();
  pv_d0(o, vb0 + (int)SHM_V, pa0, pa1, pa2, pa3);
  if (hi == 0) li_l[r32] = l_reg; asm volatile("s_waitcnt lgkmcnt(0)" ::: "memory");
  float rli[16];
#pragma unroll
  for (int r = 0; r < 16; ++r) rli[r] = __builtin_amdgcn_rcpf(li_l[crow(r, hi)]);
  act_t* Ow = Ob + (long)(wid * QBLK) * MIXW;
#pragma unroll
  for (int r = 0; r < 16; ++r) { int orow = crow(r, hi);
#pragma unroll
    for (int d0 = 0; d0 < 4; ++d0) Ow[(long)orow * MIXW + d0 * 32 + r32] = f2a(o[d0][r] * rli[r]); }
#undef KROW
#undef SLOAD
#undef SWRITE
#undef SWAIT
#undef RESC
}
}

constexpr int AT_QB_LAT = DSEQ / 256, AT_NU_LAT = NDB * BH * AT_QB_LAT, AT_NU_CTX = NB * BH * (SEQ / 256);
__device__ __forceinline__ void attn_unit(const P& p, int u, char* lds) {
    const act_t* qf = (const act_t*)(p.ws + WS_QF); const act_t* kvup = (const act_t*)(p.ws + WS_KVUP); const act_t* kr = (const act_t*)(p.ws + WS_KR);
    act_t* ymix = (act_t*)(p.ws + WS_YMIX); const float2* ropetab = (const float2*)(p.ws + WS_ROPE);
    int s, h, qb;
    if (u < AT_NU_LAT) { qb = u % AT_QB_LAT; h = (u / AT_QB_LAT) % BH; s = NB + u / (AT_QB_LAT * BH); }
    else { const int v = u - AT_NU_LAT; qb = 0; h = v % BH; s = v / BH; }
    const int base = seq_start(s), T = seq_len(s), m0 = base + qb * 256;
    const bool lat = s >= NB;
    att::attn_mla_body(qf + (size_t)m0 * NQ + h * QKD, lat ? ropetab + (size_t)(qb * 256) * (ROPE / 2) : nullptr, kvup + h * NOPE, kr, kvup + BH * NOPE + h * VD,
                       ymix + (size_t)m0 * MIXW + AW + h * VD, base, T / 64, lat ? MTOK + (s - NB) * PAST : 0, (T + (lat ? PAST : 0)) / 64, lds);
    __syncthreads();
}
namespace gdnc {
using bf16x8 = __attribute__((ext_vector_type(8))) short;
using f32x16 = __attribute__((ext_vector_type(16))) float;
using f32x4v = __attribute__((ext_vector_type(4))) float;
using u32x4 = __attribute__((ext_vector_type(4))) unsigned;
__device__ __forceinline__ uint4 ldnt16(const uint4* p) { const u32x4 v = __builtin_nontemporal_load((const u32x4*)p); return make_uint4(v[0], v[1], v[2], v[3]); }
typedef float f32x2c __attribute__((ext_vector_type(2)));
typedef __bf16 bf16x2c __attribute__((ext_vector_type(2)));
__device__ __forceinline__ unsigned cvtpk_c(float lo, float hi) { f32x2c v = {lo, hi}; bf16x2c b = __builtin_convertvector(v, bf16x2c); return __builtin_bit_cast(unsigned, b); }
__device__ __forceinline__ int swap23(int x) { return (x & ~12) | ((x & 4) << 1) | ((x & 8) >> 1); }
__device__ __forceinline__ int crow(int r, int hi) { return (r & 3) + 8 * (r >> 2) + 4 * hi; }

__device__ __forceinline__ int npos(int i) { return 16 * (i & 3) + (i >> 2); }
template <int QP> __device__ __forceinline__ float quad_bcast(float v) { return __int_as_float(__builtin_amdgcn_update_dpp(0, __float_as_int(v), QP, 0xf, 0xf, true)); }
__device__ __forceinline__ void solve_quad(const float* Nt, int ntp, float (&x)[16], int q) {
    const float* nrow = Nt + 16 * q;
    int zo = 0;
#pragma unroll
    for (int j = 0; j < 63; ++j) {
        const float xo = x[j >> 2];
        const float xj = (j & 3) == 0 ? quad_bcast<0x00>(xo) : (j & 3) == 1 ? quad_bcast<0x55>(xo) : (j & 3) == 2 ? quad_bcast<0xAA>(xo) : quad_bcast<0xFF>(xo);
        const f32x2c xj2 = {-xj, -xj};
#pragma unroll
        for (int i4 = j >> 4; i4 < 4; ++i4) {
            const f32x4v n4 = *(const f32x4v*)(nrow + j * ntp + 4 * i4 + zo);
            if (4 * i4 + 1 >= (j >> 2)) { f32x2c a = {x[4 * i4], x[4 * i4 + 1]}; a = __builtin_elementwise_fma((f32x2c){n4[0], n4[1]}, xj2, a); x[4 * i4] = a[0]; x[4 * i4 + 1] = a[1]; }
            { f32x2c b = {x[4 * i4 + 2], x[4 * i4 + 3]}; b = __builtin_elementwise_fma((f32x2c){n4[2], n4[3]}, xj2, b); x[4 * i4 + 2] = b[0]; x[4 * i4 + 3] = b[1]; }
        }
        if ((j & 1) == 1) asm volatile("" : "+v"(zo) : "v"(xj));
    }
}
__device__ __forceinline__ void solve_quad2(const float* Nt, int ntp, float (&xa)[16], float (&xb)[16], int q) {
    const float* nrow = Nt + 16 * q;
    int zo = 0;
#pragma unroll
    for (int j = 0; j < 63; ++j) {
        const float ao = xa[j >> 2], bo = xb[j >> 2];
        const float aj = (j & 3) == 0 ? quad_bcast<0x00>(ao) : (j & 3) == 1 ? quad_bcast<0x55>(ao) : (j & 3) == 2 ? quad_bcast<0xAA>(ao) : quad_bcast<0xFF>(ao);
        const float bj = (j & 3) == 0 ? quad_bcast<0x00>(bo) : (j & 3) == 1 ? quad_bcast<0x55>(bo) : (j & 3) == 2 ? quad_bcast<0xAA>(bo) : quad_bcast<0xFF>(bo);
        const f32x2c aj2 = {-aj, -aj}, bj2 = {-bj, -bj};
#pragma unroll
        for (int i4 = j >> 4; i4 < 4; ++i4) {
            const f32x4v n4 = *(const f32x4v*)(nrow + j * ntp + 4 * i4 + zo);
            const f32x2c nlo = {n4[0], n4[1]}, nhi = {n4[2], n4[3]};
            if (4 * i4 + 1 >= (j >> 2)) {
                f32x2c a = {xa[4 * i4], xa[4 * i4 + 1]}; a = __builtin_elementwise_fma(nlo, aj2, a); xa[4 * i4] = a[0]; xa[4 * i4 + 1] = a[1];
                f32x2c b = {xb[4 * i4], xb[4 * i4 + 1]}; b = __builtin_elementwise_fma(nlo, bj2, b); xb[4 * i4] = b[0]; xb[4 * i4 + 1] = b[1];
            }
            { f32x2c a = {xa[4 * i4 + 2], xa[4 * i4 + 3]}; a = __builtin_elementwise_fma(nhi, aj2, a); xa[4 * i4 + 2] = a[0]; xa[4 * i4 + 3] = a[1];
              f32x2c b = {xb[4 * i4 + 2], xb[4 * i4 + 3]}; b = __builtin_elementwise_fma(nhi, bj2, b); xb[4 * i4 + 2] = b[0]; xb[4 * i4 + 3] = b[1]; }
        }
        if ((j & 7) == 7) asm volatile("" : "+v"(zo) : "v"(aj), "v"(bj));
    }
}
template <int CTRL> __device__ __forceinline__ float gdpp(float x) { return __int_as_float(__builtin_amdgcn_update_dpp(0, __float_as_int(x), CTRL, 0xf, 0xf, true)); }
__device__ __forceinline__ float psum32(float x) {
    x += gdpp<0xB1>(x); x += gdpp<0x4E>(x); x += gdpp<0x124>(x); x += gdpp<0x128>(x);
    return x + __int_as_float(__builtin_amdgcn_ds_swizzle(__float_as_int(x), (16 << 10) | 0x1f));
}
constexpr int SL_W = 0, SL_U = 16384, SL_QD = 32768, SL_KDT = 49152, SL_QK = 65536, SL_GT = 73728, SLOT_B = 73984;
constexpr int NSLOT = (MTOK / 64) * 2 * CH;
static_assert(DK == 128 && DV == 128 && CHUNK == 64, "gdnc layout");

constexpr int PA_KP = 132, PA_NP = 68;
constexpr int PA_N = 0, PA_GAM = PA_N + 64 * PA_NP, PA_BET = PA_GAM + 64, PA_EG = PA_BET + 64, PA_EGL = PA_EG + 64, PA_ONE = PA_EGL + 64, PA_K = PA_ONE + 128, PA_Q = PA_K + 64 * PA_KP, PA_V = PA_Q + 64 * PA_KP, PA_END = PA_V + 64 * PA_KP;
constexpr int PA_LDS = PA_END * 4;
__device__ __forceinline__ void prep_chunk(const P& p, int l, int slot, char* lds) {
    int tid_ = TIDX; asm volatile("" : "+v"(tid_));
    const int tid = tid_, lane = tid & 63, wv = __builtin_amdgcn_readfirstlane(tid >> 6);
    const int h = slot % CH, d = (slot / CH) % 2, m0 = (slot / (2 * CH)) * 64;
    const act_t* pp = (const act_t*)(p.ws + WS_PP);
    unsigned char* out = p.ws + WS_GCH + (size_t)slot * SLOT_B;
    float* F = (float*)lds;
    __syncthreads();
    {
        const float* wc = p.gdn_conv + (size_t)l * 3 * GC;
        const int sq = seq_of(m0), sbase = seq_start(sq), send = sbase + seq_len(sq);
        const int f = tid & 31, i0 = tid >> 5;
        uint2 xr[12][3]; float4 wt[3][3];
#pragma unroll
        for (int arr = 0; arr < 3; ++arr) { const int ch = (arr == 0 ? CH * DK : arr == 1 ? 0 : 2 * CH * DK) + h * DK + 4 * f;
#pragma unroll
            for (int tap = 0; tap < 3; ++tap) wt[arr][tap] = *(const float4*)(wc + tap * GC + ch); }
#pragma unroll
        for (int j = 0; j < 12; ++j) {
            const int arr = j >> 2, i = i0 + 16 * (j & 3);
            const int m = d == 0 ? m0 + i : m0 + 63 - i;
            const int ch = (arr == 0 ? CH * DK : arr == 1 ? 0 : 2 * CH * DK) + h * DK + 4 * f;
            const act_t* pr = pp + (size_t)m * INP + OFF_GQ + ch;
            xr[j][1] = *(const uint2*)pr; xr[j][0] = *(const uint2*)(pr - (m > sbase ? INP : 0)); xr[j][2] = *(const uint2*)(pr + (m < send - 1 ? INP : 0));
        }
        __builtin_amdgcn_sched_barrier(0);
#pragma unroll
        for (int j = 0; j < 12; ++j) asm volatile("" : "+v"(xr[j][0].x), "+v"(xr[j][0].y), "+v"(xr[j][1].x), "+v"(xr[j][1].y), "+v"(xr[j][2].x), "+v"(xr[j][2].y));
#pragma unroll
        for (int arr = 0; arr < 3; ++arr) asm volatile("" : "+v"(wt[arr][0].x), "+v"(wt[arr][0].y), "+v"(wt[arr][0].z), "+v"(wt[arr][0].w), "+v"(wt[arr][1].x), "+v"(wt[arr][1].y), "+v"(wt[arr][1].z), "+v"(wt[arr][1].w),
                                                                   "+v"(wt[arr][2].x), "+v"(wt[arr][2].y), "+v"(wt[arr][2].z), "+v"(wt[arr][2].w));
#pragma unroll
        for (int j = 0; j < 12; ++j) {
            const int arr = j >> 2, i = i0 + 16 * (j & 3);
            const int m = d == 0 ? m0 + i : m0 + 63 - i;
            const float s0 = m > sbase ? 1.0f : 0.0f, s2 = m < send - 1 ? 1.0f : 0.0f;
            const float4 w0 = wt[arr][0], w1 = wt[arr][1], w2 = wt[arr][2];
            const float4 x0 = make_float4(lo2(xr[j][0].x) * s0, hi2(xr[j][0].x) * s0, lo2(xr[j][0].y) * s0, hi2(xr[j][0].y) * s0);
            const float4 x1 = make_float4(lo2(xr[j][1].x), hi2(xr[j][1].x), lo2(xr[j][1].y), hi2(xr[j][1].y));
            const float4 x2 = make_float4(lo2(xr[j][2].x) * s2, hi2(xr[j][2].x) * s2, lo2(xr[j][2].y) * s2, hi2(xr[j][2].y) * s2);
            const float4 a = make_float4(w1.x * x1.x + w0.x * x0.x + w2.x * x2.x, w1.y * x1.y + w0.y * x0.y + w2.y * x2.y, w1.z * x1.z + w0.z * x0.z + w2.z * x2.z, w1.w * x1.w + w0.w * x0.w + w2.w * x2.w);
            float4 v = make_float4(siluf_(a.x), siluf_(a.y), siluf_(a.z), siluf_(a.w));
            if (arr < 2) {
                float ss = v.x * v.x + v.y * v.y + v.z * v.z + v.w * v.w;
                ss = psum32(ss);
                const float rs = (1.0f / sqrtf(ss + L2_EPS)) * (arr == 1 ? 0.08838834764831845f : 1.0f);
                v = make_float4(v.x * rs, v.y * rs, v.z * rs, v.w * rs);
            }
            *(float4*)(F + (arr == 0 ? PA_K : arr == 1 ? PA_Q : PA_V) + i * PA_KP + 4 * f) = v;
        }
        if (tid < 64) {
            const size_t m = (size_t)(d == 0 ? m0 + tid : m0 + 63 - tid);
            const act_t* pr = pp + m * INP;
            const int dh = d * CH + h;
            F[PA_BET + tid] = sigmoidf_(ldp1(pr + OFF_GB + dh));
            F[PA_GAM + tid] = -fexp_(p.gdn_a_log[(size_t)l * 2 * CH + dh]) * softplusf_(ldp1(pr + OFF_GA + dh) + p.gdn_dt_bias[(size_t)l * 2 * CH + dh]);
            F[PA_ONE + tid] = 1.0f;
        }
    }
    __syncthreads();
    if (tid < 64) {
        float g = 0.f, gl = 0.f;
#pragma unroll 8
        for (int j = 0; j < 64; ++j) { const float v = F[PA_GAM + j]; g += j <= tid ? v : 0.f; gl += v; }
        F[PA_EG + tid] = fexp_(g); F[PA_EGL + tid] = fexp_(gl - g); F[PA_ONE + 64 + tid] = g;
        if (tid == 63) *(float*)(out + SL_GT) = fexp_(g);
    }
    __syncthreads();
    if (tid < 64) F[PA_GAM + tid] = F[PA_ONE + 64 + tid];
    __syncthreads();
    for (int item = wv; item < 22; item += 8) {
        if (item >= 20) {
            const int ti = (item - 20) * 2, tj = ti + 1;
#pragma unroll
            for (int reg = 0; reg < 4; ++reg) { const int i = 16 * ti + (lane >> 4) * 4 + reg, j = 16 * tj + (lane & 15);
                *(unsigned short*)(out + SL_QK + (i * 64 + (j & ~15) + swap23(j & 15)) * 2) = 0; }
            continue;
        }
        const int mat = item / 10, L10 = item % 10;
        int ti = 0, rem = L10; while (rem > ti) { rem -= ti + 1; ++ti; }
        const int tj = rem;
        const float* X = F + (mat == 0 ? PA_K : PA_Q) + (16 * ti + (lane & 15)) * PA_KP + (lane >> 4);
        const float* Y = F + PA_K + (16 * tj + (lane & 15)) * PA_KP + (lane >> 4);
        f32x4v acc = {0.f, 0.f, 0.f, 0.f};
#pragma unroll 8
        for (int s = 0; s < 32; ++s) acc = __builtin_amdgcn_mfma_f32_16x16x4f32(X[4 * s], Y[4 * s], acc, 0, 0, 0);
#pragma unroll
        for (int reg = 0; reg < 4; ++reg) {
            const int i = 16 * ti + (lane >> 4) * 4 + reg, j = 16 * tj + (lane & 15);
            const float dec = fexp_(F[PA_GAM + i] - F[PA_GAM + j]);
            if (mat == 0) F[PA_N + j * PA_NP + npos(i)] = i > j ? F[PA_BET + i] * acc[reg] * dec : 0.f;
            else *(unsigned short*)(out + SL_QK + (i * 64 + (j & ~15) + swap23(j & 15)) * 2) = f2a(i >= j ? acc[reg] * dec : 0.f);
        }
    }
    __syncthreads();
    float xa[16], xb[16];
    {
        const int q = tid & 3, col = tid >> 2;
        const float* ksrc = F + PA_K + col; const float* vsrc = F + PA_V + col;
#pragma unroll
        for (int ii = 0; ii < 16; ++ii) { const int i = 4 * ii + q; const float b = F[PA_BET + i]; xa[ii] = b * ksrc[i * PA_KP] * F[PA_EG + i]; xb[ii] = b * vsrc[i * PA_KP]; }
        solve_quad2(F + PA_N, PA_NP, xa, xb, q);
    }
    {
#pragma unroll
        for (int j = 0; j < 2; ++j) {
            const int c = tid + 512 * j, i = c >> 4, pos = (c & 15) * 8, g16 = pos & ~15, hh = (pos >> 3) & 1;
            const float e = F[PA_EG + i];
            const float4 a = *(const float4*)(F + PA_Q + i * PA_KP + g16 + 4 * hh), b = *(const float4*)(F + PA_Q + i * PA_KP + g16 + 8 + 4 * hh);
            *(uint4*)(out + SL_QD + (i * 128 + pos) * 2) = make_uint4(cvtpk_c(a.x * e, a.y * e), cvtpk_c(a.z * e, a.w * e), cvtpk_c(b.x * e, b.y * e), cvtpk_c(b.z * e, b.w * e));
        }
#pragma unroll
        for (int j = 0; j < 2; ++j) {
            const int c = tid + 512 * j, dk = c >> 3, pos = (c & 7) * 8, g16 = pos & ~15, hh = (pos >> 3) & 1;
            float v8[8];
#pragma unroll
            for (int e = 0; e < 8; ++e) { const int tok = g16 + 8 * (e >> 2) + 4 * hh + (e & 3); v8[e] = F[PA_K + tok * PA_KP + dk] * F[PA_EGL + tok]; }
            *(uint4*)(out + SL_KDT + (dk * 64 + pos) * 2) = make_uint4(cvtpk_c(v8[0], v8[1]), cvtpk_c(v8[2], v8[3]), cvtpk_c(v8[4], v8[5]), cvtpk_c(v8[6], v8[7]));
        }
    }
    __syncthreads();
    unsigned short* Xs = (unsigned short*)(F + PA_V);
    {
        const int q = tid & 3, ca = tid >> 2, cb = 128 + (tid >> 2), pa = (ca & ~15) + swap23(ca & 15);
#pragma unroll
        for (int ii = 0; ii < 16; ++ii) { Xs[(4 * ii + q) * 256 + pa] = f2a(xa[ii]); Xs[(4 * ii + q) * 256 + cb] = f2a(xb[ii]); }
    }
    __syncthreads();
#pragma unroll
    for (int j = 0; j < 4; ++j) {
        const int c = tid + 512 * j, i = c >> 5, cc = c & 31;
        const uint4 v = *(const uint4*)(Xs + i * 256 + cc * 8);
        *(uint4*)(out + (cc < 16 ? SL_W + (i * 128 + cc * 8) * 2 : SL_U + (i * 128 + (cc - 16) * 8) * 2)) = v;
    }
}

constexpr int PB_WP = 272, PB_KP = 144;
constexpr int PB_W = 0, PB_QD = 64 * PB_WP, PB_KDT = 2 * 64 * PB_WP, PB_QK = PB_KDT + 128 * PB_KP, PB_U = PB_QK + 64 * PB_KP, PB_LDS = PB_U + 64 * 256;
__device__ __forceinline__ bf16x8 pack8(const f32x16& x, int s) {
    u32x4 w = {cvtpk_c(x[8 * s], x[8 * s + 1]), cvtpk_c(x[8 * s + 2], x[8 * s + 3]), cvtpk_c(x[8 * s + 4], x[8 * s + 5]), cvtpk_c(x[8 * s + 6], x[8 * s + 7])};
    return __builtin_bit_cast(bf16x8, w);
}
static_assert((SEQ / 64) % 2 == 0 && (DSEQ / 64) % 2 == 0, "chain_half runs the chunks in pairs");
constexpr int PH_BUF = PB_U + 64 * 128, PH_LDS = 2 * PH_BUF;
__device__ __forceinline__ int gh_dst(int q, int half, int& src) {
    if (q < 3584) {
        const int reg = q < 1024 ? 0 : q < 2048 ? 2 : q < 3072 ? 3 : 4, idx = q < 3072 ? (q & 1023) : q - 3072;
        src = reg * 1024 + idx;
        return reg == 0 ? PB_W + (idx >> 4) * PB_WP + (idx & 15) * 16 : reg == 2 ? PB_QD + (idx >> 4) * PB_WP + (idx & 15) * 16 : reg == 3 ? PB_KDT + (idx >> 3) * PB_KP + (idx & 7) * 16 : PB_QK + (idx >> 3) * PB_KP + (idx & 7) * 16;
    }
    const int idx = q - 3584, row = idx >> 3, pc = idx & 7;
    src = 1024 + row * 16 + half * 8 + pc;
    return PB_U + row * 128 + pc * 16;
}
__device__ __forceinline__ void chain_half(const P& p, int l, int s, int d, int h, int half, char* lds) {
    int tid_ = TIDX; asm volatile("" : "+v"(tid_));
    const int tid = tid_, lane = tid & 63, wv = __builtin_amdgcn_readfirstlane(tid >> 6), r = lane & 31, hi = lane >> 5;
    const int T = seq_len(s), base = seq_start(s), nc = T / 64;
    const unsigned char* gch = p.ws + WS_GCH;
    act_t* go = (act_t*)(p.ws + WS_GO);
#define GH_SLOT(c) (gch + (size_t)((((base >> 6) + (d == 0 ? (c) : nc - 1 - (c))) * 2 + d) * CH + h) * SLOT_B)
    __syncthreads();
    if (wv < 2) __builtin_amdgcn_s_setprio(3);
    if (wv >= 2) {
        const int st = tid - 128;
        int ldst[11], lsrc[11];
#pragma unroll
        for (int j = 0; j < 11; ++j) { const int q = st + 384 * j; int sc; ldst[j] = gh_dst(q < 4096 ? q : 0, half, sc); lsrc[j] = sc; }
        const bool tail = st < 4096 - 10 * 384;
        uint4 sa0, sa1, sa2, sa3, sa4, sa5, sa6, sa7, sa8, sa9, sa10 = make_uint4(0, 0, 0, 0), sb0, sb1, sb2, sb3, sb4, sb5, sb6, sb7, sb8, sb9, sb10 = make_uint4(0, 0, 0, 0);
#define GH_LOAD(c, X) do { const uint4* a_ = (const uint4*)GH_SLOT(c); \
            X##0 = ldnt16(a_ + lsrc[0]); X##1 = ldnt16(a_ + lsrc[1]); X##2 = ldnt16(a_ + lsrc[2]); X##3 = ldnt16(a_ + lsrc[3]); X##4 = ldnt16(a_ + lsrc[4]); X##5 = ldnt16(a_ + lsrc[5]); X##6 = ldnt16(a_ + lsrc[6]); X##7 = ldnt16(a_ + lsrc[7]); X##8 = ldnt16(a_ + lsrc[8]); X##9 = ldnt16(a_ + lsrc[9]); \
            if (tail) X##10 = ldnt16(a_ + lsrc[10]); } while (0)
#define GH_STORE(buf, X) do { char* b_ = lds + (buf) * PH_BUF; *(uint4*)(b_ + ldst[0]) = X##0; *(uint4*)(b_ + ldst[1]) = X##1; *(uint4*)(b_ + ldst[2]) = X##2; *(uint4*)(b_ + ldst[3]) = X##3; \
            *(uint4*)(b_ + ldst[4]) = X##4; *(uint4*)(b_ + ldst[5]) = X##5; *(uint4*)(b_ + ldst[6]) = X##6; *(uint4*)(b_ + ldst[7]) = X##7; *(uint4*)(b_ + ldst[8]) = X##8; *(uint4*)(b_ + ldst[9]) = X##9; \
            if (tail) *(uint4*)(b_ + ldst[10]) = X##10; } while (0)
        GH_LOAD(0, sa); GH_STORE(0, sa); GH_LOAD(1, sa); if (2 < nc) GH_LOAD(2, sb);
        __syncthreads();
#define GH_SITER(cc, X) do { const int c = (cc); if (c + 1 < nc) GH_STORE((c + 1) & 1, X); if (c + 3 < nc) GH_LOAD(c + 3, X); __syncthreads(); } while (0)
        for (int c2 = 0; c2 < nc; c2 += 2) { GH_SITER(c2, sa); GH_SITER(c2 + 1, sb); }
#undef GH_LOAD
#undef GH_STORE
#undef GH_SITER
    } else {
        f32x16 S[4];
        const int col = 64 * half + 32 * wv + r;
        if (s >= NB) {
            const float* s0 = p.state_gdn + ((((size_t)(s - NB) * L + l) * 2 + d) * CH + h) * DK * DV + col;
#pragma unroll
            for (int t = 0; t < 4; ++t)
#pragma unroll
                for (int i = 0; i < 16; ++i) S[t][i] = s0[(size_t)(32 * t + crow(i, hi)) * DV];
        } else {
#pragma unroll
            for (int t = 0; t < 4; ++t)
#pragma unroll
                for (int i = 0; i < 16; ++i) S[t][i] = 0.f;
        }
        __syncthreads();
#define GH_COMPUTE \
        { \
            const float gt = *(const float*)(GH_SLOT(c) + SL_GT); \
            bf16x8 Sb[4][2]; \
_Pragma("unroll") \
            for (int t = 0; t < 4; ++t) { Sb[t][0] = pack8(S[t], 0); Sb[t][1] = pack8(S[t], 1); } \
            f32x16 vn[2]; \
_Pragma("unroll") \
            for (int a = 0; a < 2; ++a) { \
                f32x16 acc = {}; \
_Pragma("unroll") \
                for (int t = 0; t < 4; ++t) \
_Pragma("unroll") \
                    for (int k = 0; k < 2; ++k) acc = __builtin_amdgcn_mfma_f32_32x32x16_bf16(*(const bf16x8*)(LB + PB_W + (32 * a + r) * PB_WP + (32 * t + 16 * k + 8 * hi) * 2), Sb[t][k], acc, 0, 0, 0); \
_Pragma("unroll") \
                for (int i = 0; i < 16; ++i) vn[a][i] = a2f(*(const unsigned short*)(LB + PB_U + (32 * a + crow(i, hi)) * 128 + (32 * wv + r) * 2)) - acc[i]; \
            } \
            bf16x8 Vb[2][2]; \
_Pragma("unroll") \
            for (int b = 0; b < 2; ++b) { Vb[b][0] = pack8(vn[b], 0); Vb[b][1] = pack8(vn[b], 1); } \
_Pragma("unroll") \
            for (int a = 0; a < 2; ++a) { \
                f32x16 acc = {}; \
_Pragma("unroll") \
                for (int t = 0; t < 4; ++t) \
_Pragma("unroll") \
                    for (int k = 0; k < 2; ++k) acc = __builtin_amdgcn_mfma_f32_32x32x16_bf16(*(const bf16x8*)(LB + PB_QD + (32 * a + r) * PB_WP + (32 * t + 16 * k + 8 * hi) * 2), Sb[t][k], acc, 0, 0, 0); \
_Pragma("unroll") \
                for (int b = 0; b <= a; ++b) \
_Pragma("unroll") \
                    for (int k = 0; k < 2; ++k) acc = __builtin_amdgcn_mfma_f32_32x32x16_bf16(*(const bf16x8*)(LB + PB_QK + (32 * a + r) * PB_KP + (32 * b + 16 * k + 8 * hi) * 2), Vb[b][k], acc, 0, 0, 0); \
_Pragma("unroll") \
                for (int i = 0; i < 16; ++i) { \
                    const int it = 64 * c + 32 * a + crow(i, hi); \
                    const size_t m = (size_t)(d == 0 ? base + it : base + T - 1 - it); \
                    go[(m * 2 + d) * CW + h * DV + 64 * half + 32 * wv + r] = f2a(acc[i]); \
                } \
            } \
_Pragma("unroll") \
            for (int t = 0; t < 4; ++t) { \
_Pragma("unroll") \
                for (int i = 0; i < 16; ++i) S[t][i] *= gt; \
_Pragma("unroll") \
                for (int b = 0; b < 2; ++b) \
_Pragma("unroll") \
                    for (int k = 0; k < 2; ++k) S[t] = __builtin_amdgcn_mfma_f32_32x32x16_bf16(*(const bf16x8*)(LB + PB_KDT + (32 * t + r) * PB_KP + (32 * b + 16 * k + 8 * hi) * 2), Vb[b][k], S[t], 0, 0, 0); \
            } \
        }

        for (int c = 0; c < nc; ++c) {
            const char* LB = lds + (c & 1) * PH_BUF;
            GH_COMPUTE
            __syncthreads();
        }
        if (s < NB) {
            float* so = p.out + O_SG + ((((size_t)s * L + l) * 2 + d) * CH + h) * DK * DV + col;
#pragma unroll
            for (int t = 0; t < 4; ++t)
#pragma unroll
                for (int i = 0; i < 16; ++i) so[(size_t)(32 * t + crow(i, hi)) * DV] = S[t][i];
        }
#undef GH_COMPUTE
    }
#undef GH_SLOT
    __builtin_amdgcn_s_setprio(0);
}
}
namespace rwkc {
using gdnc::bf16x8; using gdnc::f32x16; using gdnc::f32x4v; using gdnc::cvtpk_c; using gdnc::swap23; using gdnc::crow; using gdnc::pack8; using gdnc::solve_quad;
constexpr int SL_WN = 0, SL_UT = 8192, SL_RT = 16384, SL_AHT = 24576, SL_RAN = 32768, SL_Y0 = 40960, SL_G = 49152, SL_PC = 65536, SLOT_B = 65792;
constexpr int NSLOT = (MTOK / 64) * 2 * AH;
static_assert(AN == 64 && CHUNK == 64, "rwkc layout");
template <int CTRL> __device__ __forceinline__ float ddpp(float x) { return __int_as_float(__builtin_amdgcn_update_dpp(0, __float_as_int(x), CTRL, 0xf, 0xf, true)); }
__device__ __forceinline__ float dsum16(float x) { x += ddpp<0xB1>(x); x += ddpp<0x4E>(x); x += ddpp<0x124>(x); x += ddpp<0x128>(x); return x; }

constexpr int TP = 68;
constexpr int TSZ = 64 * TP;
constexpr int A_AT = 0, A_PC = TSZ, A_TK = A_PC + 64, A_TA = A_TK + TSZ, A_TKK = A_TA + TSZ, A_TR = A_TKK + TSZ, A_TV = A_TR + TSZ, A_TB = A_TV + TSZ, A_TRK = A_TB + TSZ, A_END = A_TRK + TSZ;
constexpr int PA_LDS = A_END * 4;
__device__ __forceinline__ f32x4v tile_xyT(const float* X, const float* Y, int ti, int tj, int lane) {
    const float* xp = X + (16 * ti + (lane & 15)) * TP + (lane >> 4); const float* yp = Y + (16 * tj + (lane & 15)) * TP + (lane >> 4);
    float xv[16], yv[16];
#pragma unroll
    for (int s = 0; s < 16; ++s) { xv[s] = xp[4 * s]; yv[s] = yp[4 * s]; }
    __builtin_amdgcn_sched_barrier(0);
    f32x4v acc = {0.f, 0.f, 0.f, 0.f};
#pragma unroll
    for (int s = 0; s < 16; ++s) acc = __builtin_amdgcn_mfma_f32_16x16x4f32(xv[s], yv[s], acc, 0, 0, 0);
    return acc;
}
__device__ __forceinline__ f32x4v tile_xv(const float* X, const float* V, int ti, int tj, int lane) {
    const float* xp = X + (16 * ti + (lane & 15)) * TP + (lane >> 4); const float* vp = V + (lane >> 4) * TP + 16 * tj + (lane & 15);
    f32x4v acc = {0.f, 0.f, 0.f, 0.f};
#pragma unroll
    for (int s = 0; s < 16; ++s) acc = __builtin_amdgcn_mfma_f32_16x16x4f32(xp[4 * s], vp[4 * s * TP], acc, 0, 0, 0);
    return acc;
}
__device__ __forceinline__ f32x4v tile_xTv(const float* X, const float* V, int ti, int tj, int lane) {
    const float* xp = X + (lane >> 4) * TP + 16 * ti + (lane & 15); const float* vp = V + (lane >> 4) * TP + 16 * tj + (lane & 15);
    f32x4v acc = {0.f, 0.f, 0.f, 0.f};
#pragma unroll
    for (int s = 0; s < 16; ++s) acc = __builtin_amdgcn_mfma_f32_16x16x4f32(xp[4 * s * TP], vp[4 * s * TP], acc, 0, 0, 0);
    return acc;
}
__device__ __forceinline__ bf16x8 cvt8(const float4 a, const float4 b) { gdnc::u32x4 w = {cvtpk_c(a.x, a.y), cvtpk_c(a.z, a.w), cvtpk_c(b.x, b.y), cvtpk_c(b.z, b.w)}; return __builtin_bit_cast(bf16x8, w); }
__device__ __forceinline__ bf16x8 cvt8s(const float* p, int stride) {
    gdnc::u32x4 w = {cvtpk_c(p[0], p[stride]), cvtpk_c(p[2 * stride], p[3 * stride]), cvtpk_c(p[4 * stride], p[5 * stride]), cvtpk_c(p[6 * stride], p[7 * stride])}; return __builtin_bit_cast(bf16x8, w); }
__device__ __forceinline__ void ld8s(const float* p, int stride, float (&v)[8]) {
#pragma unroll
    for (int e = 0; e < 8; ++e) v[e] = p[e * stride];
}
__device__ __forceinline__ bf16x8 pk8(const float (&v)[8]) { gdnc::u32x4 w = {cvtpk_c(v[0], v[1]), cvtpk_c(v[2], v[3]), cvtpk_c(v[4], v[5]), cvtpk_c(v[6], v[7])}; return __builtin_bit_cast(bf16x8, w); }
__device__ __forceinline__ f32x4v tile_xyT_bf(const float* X, const float* Y, int ti, int tj, int lane) {
    const float* xp = X + (16 * ti + (lane & 15)) * TP + 8 * (lane >> 4); const float* yp = Y + (16 * tj + (lane & 15)) * TP + 8 * (lane >> 4);
    const float4 x0 = *(const float4*)xp, x1 = *(const float4*)(xp + 4), x2 = *(const float4*)(xp + 32), x3 = *(const float4*)(xp + 36);
    const float4 y0 = *(const float4*)yp, y1 = *(const float4*)(yp + 4), y2 = *(const float4*)(yp + 32), y3 = *(const float4*)(yp + 36);
    __builtin_amdgcn_sched_barrier(0);
    f32x4v acc = {0.f, 0.f, 0.f, 0.f};
    acc = __builtin_amdgcn_mfma_f32_16x16x32_bf16(cvt8(x0, x1), cvt8(y0, y1), acc, 0, 0, 0);
    acc = __builtin_amdgcn_mfma_f32_16x16x32_bf16(cvt8(x2, x3), cvt8(y2, y3), acc, 0, 0, 0);
    return acc;
}
__device__ __forceinline__ f32x4v tile_xv_bf(const float* X, const float* V, int ti, int tj, int lane) {
    const float* xp = X + (16 * ti + (lane & 15)) * TP + 8 * (lane >> 4); const float* vp = V + 8 * (lane >> 4) * TP + 16 * tj + (lane & 15);
    const float4 x0 = *(const float4*)xp, x1 = *(const float4*)(xp + 4), x2 = *(const float4*)(xp + 32), x3 = *(const float4*)(xp + 36);
    float v0[8], v1[8]; ld8s(vp, TP, v0); ld8s(vp + 32 * TP, TP, v1);
    __builtin_amdgcn_sched_barrier(0);
    f32x4v acc = {0.f, 0.f, 0.f, 0.f};
    acc = __builtin_amdgcn_mfma_f32_16x16x32_bf16(cvt8(x0, x1), pk8(v0), acc, 0, 0, 0);
    acc = __builtin_amdgcn_mfma_f32_16x16x32_bf16(cvt8(x2, x3), pk8(v1), acc, 0, 0, 0);
    return acc;
}
__device__ __forceinline__ f32x4v tile_xTv_bf(const float* X, const float* V, int ti, int tj, int lane) {
    const float* xp = X + 8 * (lane >> 4) * TP + 16 * ti + (lane & 15); const float* vp = V + 8 * (lane >> 4) * TP + 16 * tj + (lane & 15);
    float a0[8], a1[8], v0[8], v1[8]; ld8s(xp, TP, a0); ld8s(xp + 32 * TP, TP, a1); ld8s(vp, TP, v0); ld8s(vp + 32 * TP, TP, v1);
    __builtin_amdgcn_sched_barrier(0);
    f32x4v acc = {0.f, 0.f, 0.f, 0.f};
    acc = __builtin_amdgcn_mfma_f32_16x16x32_bf16(pk8(a0), pk8(v0), acc, 0, 0, 0);
    acc = __builtin_amdgcn_mfma_f32_16x16x32_bf16(pk8(a1), pk8(v1), acc, 0, 0, 0);
    return acc;
}
__device__ __forceinline__ void prep_chunk(const P& p, int l, int slot, char* lds) {
    int tid_ = TIDX; asm volatile("" : "+v"(tid_));
    const int tid = tid_, lane = tid & 63, wv = __builtin_amdgcn_readfirstlane(tid >> 6);
    const int h = slot % AH, d = (slot / AH) % 2, m0 = (slot / (2 * AH)) * 64;
    const act_t* pp = (const act_t*)(p.ws + WS_PP);
    unsigned char* out = p.ws + WS_RCH + (size_t)slot * SLOT_B;
    float* F = (float*)lds;
    __syncthreads();
    {
        const act_t* lora = (const act_t*)(p.ws + WS_LORA);
        float* rwb = (float*)(p.ws + WS_RWB);
        uint2 dk[2], dr[2], dv[2], dlw[2], dla[2];
        const int f_ = tid & 15, c0_ = h * AN + 4 * f_;
#pragma unroll
        for (int j = 0; j < 2; ++j) {
            const int i = (tid + 512 * j) >> 4; const size_t m = (size_t)(d == 0 ? m0 + i : m0 + 63 - i);
            const act_t* pr = pp + m * INP; const act_t* lr = lora + m * LORAN;
            dk[j] = *(const uint2*)(pr + OFF_K + c0_); dr[j] = *(const uint2*)(pr + OFF_R + c0_); dv[j] = *(const uint2*)(pr + OFF_V + c0_);
            dlw[j] = *(const uint2*)(lr + d * AW + c0_); dla[j] = *(const uint2*)(lr + (2 + d) * AW + c0_);
        }
        float4 w04 = *(const float4*)(p.rwkv_w0 + ((size_t)l * 2 + d) * AW + c0_), a04 = *(const float4*)(p.rwkv_a0 + ((size_t)l * 2 + d) * AW + c0_);
        float4 ka4 = *(const float4*)(p.rwkv_ka + (size_t)l * AW + c0_), ks4 = *(const float4*)(p.rwkv_kk + (size_t)l * AW + c0_), rk4 = *(const float4*)(p.rwkv_rk + ((size_t)l * AH + h) * AN + 4 * f_);
        __builtin_amdgcn_sched_barrier(0);
#pragma unroll
        for (int j = 0; j < 2; ++j) asm volatile("" : "+v"(dk[j].x), "+v"(dk[j].y), "+v"(dr[j].x), "+v"(dr[j].y), "+v"(dv[j].x), "+v"(dv[j].y), "+v"(dlw[j].x), "+v"(dlw[j].y), "+v"(dla[j].x), "+v"(dla[j].y));
        asm volatile("" : "+v"(w04.x), "+v"(w04.y), "+v"(w04.z), "+v"(w04.w), "+v"(a04.x), "+v"(a04.y), "+v"(a04.z), "+v"(a04.w), "+v"(ka4.x), "+v"(ka4.y), "+v"(ka4.z), "+v"(ka4.w));
        asm volatile("" : "+v"(ks4.x), "+v"(ks4.y), "+v"(ks4.z), "+v"(ks4.w), "+v"(rk4.x), "+v"(rk4.y), "+v"(rk4.z), "+v"(rk4.w));
#define RW_U4(u) make_float4(lo2((u).x), hi2((u).x), lo2((u).y), hi2((u).y))
#pragma unroll
        for (int j = 0; j < 2; ++j) {
            const int q = tid + 512 * j, i = q >> 4, f = q & 15, c0 = h * AN + 4 * f;
            const size_t m = (size_t)(d == 0 ? m0 + i : m0 + 63 - i);
            const float4 k4 = RW_U4(dk[j]), r4 = RW_U4(dr[j]), v4 = RW_U4(dv[j]);
            const float4 lw4 = RW_U4(dlw[j]), la4 = RW_U4(dla[j]);
            const float kx[4] = {k4.x, k4.y, k4.z, k4.w}, rx[4] = {r4.x, r4.y, r4.z, r4.w}, lw[4] = {lw4.x, lw4.y, lw4.z, lw4.w}, la[4] = {la4.x, la4.y, la4.z, la4.w};
            const float w0[4] = {w04.x, w04.y, w04.z, w04.w}, a0[4] = {a04.x, a04.y, a04.z, a04.w}, ka[4] = {ka4.x, ka4.y, ka4.z, ka4.w}, ks[4] = {ks4.x, ks4.y, ks4.z, ks4.w}, rk[4] = {rk4.x, rk4.y, rk4.z, rk4.w};
            float kk[4], ss = 0.f;
#pragma unroll
            for (int e = 0; e < 4; ++e) { kk[e] = kx[e] * ks[e]; ss += kk[e] * kk[e]; }
            ss = dsum16(ss);
            const float rs = 1.0f / sqrtf(ss + L2_EPS);
            float al[4], kd[4], lg[4], bon = 0.f;
#pragma unroll
            for (int e = 0; e < 4; ++e) {
                kk[e] *= rs;
                lg[e] = -fexp_(-softplusf_(-(w0[e] + lw[e])) - 0.5f);
                const float a = sigmoidf_(a0[e] + la[e]);
                kd[e] = kx[e] * (1.0f + (a - 1.0f) * ka[e]); al[e] = kk[e] * a;
                bon += rx[e] * kd[e] * rk[e];
            }
            bon = dsum16(bon);
            if (f == 0) rwb[(m * 2 + d) * AH + h] = bon;
            *(float4*)(F + A_TK + i * TP + 4 * f) = make_float4(kk[0], kk[1], kk[2], kk[3]);
            *(float4*)(F + A_TA + i * TP + 4 * f) = make_float4(al[0], al[1], al[2], al[3]);
            *(float4*)(F + A_TKK + i * TP + 4 * f) = make_float4(kd[0], kd[1], kd[2], kd[3]);
            *(float4*)(F + A_TR + i * TP + 4 * f) = r4;
            *(float4*)(F + A_TV + i * TP + 4 * f) = v4;
            *(float4*)(F + A_TB + i * TP + 4 * f) = make_float4(lg[0], lg[1], lg[2], lg[3]);
        }
    }
    __syncthreads();
    {
        const int c = tid & 63, part = tid >> 6;
        float bs = 0.f;
#pragma unroll
        for (int t = 0; t < 8; ++t) bs += F[A_TB + (8 * part + t) * TP + c];
        F[A_TRK + part * TP + c] = bs;
        __syncthreads();
        float lp = 0.f, tot = 0.f;
#pragma unroll
        for (int q = 0; q < 8; ++q) { const float v = F[A_TRK + q * TP + c]; lp += q < part ? v : 0.f; tot += v; }
#pragma unroll
        for (int t = 0; t < 8; ++t) {
            const int tt = 8 * part + t;
            const float e_prev = fexp_(lp);
            lp += F[A_TB + tt * TP + c];
            const float e = fexp_(lp), ei = fexp_(-lp);
            F[A_TK + tt * TP + c] *= e_prev; F[A_TA + tt * TP + c] *= ei; F[A_TKK + tt * TP + c] *= ei; F[A_TR + tt * TP + c] *= e;
        }
        if (part == 0) { const float pc = fexp_(tot); F[A_PC + c] = pc; *(float*)(out + SL_PC + c * 4) = pc; }
    }
    __syncthreads();
    for (int item = wv; item < 42; item += 8) {
        if (item >= 40) {
            const int ti = (item - 40) * 2, tj = ti + 1;
#pragma unroll
            for (int reg = 0; reg < 4; ++reg) { const int i = 16 * ti + (lane >> 4) * 4 + reg, j = 16 * tj + (lane & 15);
                *(unsigned short*)(out + SL_RAN + (i * 64 + (j & ~15) + swap23(j & 15)) * 2) = 0; }
            continue;
        }
        const int mat = item / 10, L10 = item % 10;
        int ti = 0, rem = L10; while (rem > ti) { rem -= ti + 1; ++ti; }
        const int tj = rem;
        const f32x4v acc = mat < 2 ? tile_xyT_bf(F + A_TK, F + (mat == 0 ? A_TA : A_TKK), ti, tj, lane)
                                   : tile_xyT_bf(F + A_TR, F + (mat == 2 ? A_TA : A_TKK), ti, tj, lane);
#pragma unroll
        for (int reg = 0; reg < 4; ++reg) {
            const int i = 16 * ti + (lane >> 4) * 4 + reg, j = 16 * tj + (lane & 15);
            if (mat == 0) F[A_AT + j * TP + gdnc::npos(i)] = i > j ? acc[reg] : 0.f;
            else if (mat == 1) F[A_TB + i * TP + j] = i > j ? acc[reg] : 0.f;
            else if (mat == 2) *(unsigned short*)(out + SL_RAN + (i * 64 + (j & ~15) + swap23(j & 15)) * 2) = f2a(i >= j ? -acc[reg] : 0.f);
            else F[A_TRK + i * TP + j] = i >= j ? acc[reg] : 0.f;
        }
    }
    for (int item = wv; item < 12; item += 8) {
        const int mat = item / 6, L6 = item % 6;
        int tj = 1, rem = L6; while (rem >= tj) { rem -= tj; ++tj; }
        const int ti = rem;
        if (mat < 2) {
#pragma unroll
            for (int reg = 0; reg < 4; ++reg) F[(mat == 0 ? A_TB : A_TRK) + (16 * ti + (lane >> 4) * 4 + reg) * TP + 16 * tj + (lane & 15)] = 0.f;
        }
    }
    {
#pragma unroll
        for (int j = 0; j < 1; ++j) {
            const int c = tid, i = c >> 3, pos = (c & 7) * 8, g16 = pos & ~15, hh = (pos >> 3) & 1;
            const float4 a = *(const float4*)(F + A_TR + i * TP + g16 + 4 * hh), b = *(const float4*)(F + A_TR + i * TP + g16 + 8 + 4 * hh);
            *(uint4*)(out + SL_RT + (i * 64 + pos) * 2) = make_uint4(cvtpk_c(a.x, a.y), cvtpk_c(a.z, a.w), cvtpk_c(b.x, b.y), cvtpk_c(b.z, b.w));
        }
        {
            const int c = tid, dk = c >> 3, pos = (c & 7) * 8, g16 = pos & ~15, hh = (pos >> 3) & 1;
            const float pc = -F[A_PC + dk];
            float v8[8];
#pragma unroll
            for (int e = 0; e < 8; ++e) { const int tok = g16 + 8 * (e >> 2) + 4 * hh + (e & 3); v8[e] = F[A_TA + tok * TP + dk] * pc; }
            *(uint4*)(out + SL_AHT + (dk * 64 + pos) * 2) = make_uint4(cvtpk_c(v8[0], v8[1]), cvtpk_c(v8[2], v8[3]), cvtpk_c(v8[4], v8[5]), cvtpk_c(v8[6], v8[7]));
        }
    }
    __syncthreads();
    for (int item = wv; item < 48; item += 8) {
        const int mat = item >> 4, ti = (item >> 2) & 3, tj = item & 3;
        f32x4v acc;
        if (mat == 0) acc = tile_xv_bf(F + A_TB, F + A_TV, ti, tj, lane);
        else if (mat == 1) acc = tile_xv_bf(F + A_TRK, F + A_TV, ti, tj, lane);
        else acc = tile_xTv_bf(F + A_TKK, F + A_TV, ti, tj, lane);
#pragma unroll
        for (int reg = 0; reg < 4; ++reg) {
            const int i = 16 * ti + (lane >> 4) * 4 + reg, j = 16 * tj + (lane & 15);
            if (mat == 0) F[A_TR + i * TP + j] = acc[reg];
            else if (mat == 1) *(unsigned short*)(out + SL_Y0 + (i * 64 + j) * 2) = f2a(acc[reg]);
            else *(float*)(out + SL_G + (i * 64 + j) * 4) = acc[reg] * F[A_PC + i];
        }
    }
    __syncthreads();
    unsigned short* Xs = (unsigned short*)(F + A_TV);
    if (__builtin_amdgcn_readfirstlane(tid >> 8) == 0) {
        float xa[16], xb[16];
        const int sq = tid & 3, scol = tid >> 2;
#pragma unroll
        for (int ii = 0; ii < 16; ++ii) { xa[ii] = F[A_TK + scol + (4 * ii + sq) * TP]; xb[ii] = F[A_TR + scol + (4 * ii + sq) * TP]; }
        gdnc::solve_quad2(F + A_AT, TP, xa, xb, sq);
        const int pcol = (scol & ~15) + swap23(scol & 15);
#pragma unroll
        for (int ii = 0; ii < 16; ++ii) { Xs[(4 * ii + sq) * 128 + pcol] = f2a(-xa[ii]); Xs[(4 * ii + sq) * 128 + 64 + scol] = f2a(xb[ii]); }
    }
    __syncthreads();
#pragma unroll
    for (int j = 0; j < 2; ++j) {
        const int c = tid + 512 * j, i = c >> 4, cc = c & 15;
        const uint4 v = *(const uint4*)(Xs + i * 128 + cc * 8);
        *(uint4*)(out + (cc < 8 ? SL_WN + (i * 64 + cc * 8) * 2 : SL_UT + (i * 64 + (cc - 8) * 8) * 2)) = v;
    }
}

constexpr int BP = 144;
constexpr int B_WN = 0, B_RT = 64 * BP, B_AHT = 2 * 64 * BP, B_RAN = 3 * 64 * BP, B_UT = 4 * 64 * BP, B_Y0 = B_UT + 8192, B_G = B_Y0 + 8192, B_PC = B_G + 16384, B_DIR = B_PC + 256;
constexpr int PB_LDS = 2 * B_DIR;
static_assert((SEQ / 64) % 2 == 0 && (DSEQ / 64) % 2 == 0, "chain_dir runs the chunks in pairs");
constexpr int PD_LDS = 2 * B_DIR;
__device__ __forceinline__ int rd_dst(int q) {
    if (q < 3072) { const int img = q >> 9, row = (q & 511) >> 3, pc = q & 7;
        return img == 0 ? B_WN + row * BP + pc * 16 : img == 1 ? B_UT + row * 128 + pc * 16 : img == 2 ? B_RT + row * BP + pc * 16 : img == 3 ? B_AHT + row * BP + pc * 16
             : img == 4 ? B_RAN + row * BP + pc * 16 : B_Y0 + row * 128 + pc * 16; }
    return q < 4096 ? B_G + (q - 3072) * 16 : B_PC + (q - 4096) * 16;
}
__device__ __forceinline__ void chain_dir(const P& p, int l, int s, int d, int h, char* lds) {
    int tid_ = TIDX; asm volatile("" : "+v"(tid_));
    const int tid = tid_, lane = tid & 63, wv = __builtin_amdgcn_readfirstlane(tid >> 6), r = lane & 31, hi = lane >> 5;
    const int T = seq_len(s), base = seq_start(s), nc = T / 64;
    const unsigned char* rch = p.ws + WS_RCH;
    act_t* yb = (act_t*)(p.ws + WS_RWY);
#define RD_SLOT(c) (rch + (size_t)((((base >> 6) + (d == 0 ? (c) : nc - 1 - (c))) * 2 + d) * AH + h) * SLOT_B)
    __syncthreads();
    if (wv < 2) __builtin_amdgcn_s_setprio(3);
    if (wv >= 2) {
        const int st = tid - 128;
        int ldst[11];
#pragma unroll
        for (int j = 0; j < 11; ++j) { const int q = st + 384 * j; ldst[j] = rd_dst(q < 4112 ? q : 0); }
        const bool tail = st < 4112 - 10 * 384;
        uint4 sa0, sa1, sa2, sa3, sa4, sa5, sa6, sa7, sa8, sa9, sa10 = make_uint4(0, 0, 0, 0), sb0, sb1, sb2, sb3, sb4, sb5, sb6, sb7, sb8, sb9, sb10 = make_uint4(0, 0, 0, 0);
#define RD_LOAD(c, X) do { const uint4* a_ = (const uint4*)RD_SLOT(c) + st; \
            X##0 = gdnc::ldnt16(a_ + 0); X##1 = gdnc::ldnt16(a_ + 384); X##2 = gdnc::ldnt16(a_ + 768); X##3 = gdnc::ldnt16(a_ + 1152); X##4 = gdnc::ldnt16(a_ + 1536); X##5 = gdnc::ldnt16(a_ + 1920); X##6 = gdnc::ldnt16(a_ + 2304); X##7 = gdnc::ldnt16(a_ + 2688); X##8 = gdnc::ldnt16(a_ + 3072); X##9 = gdnc::ldnt16(a_ + 3456); if (tail) X##10 = gdnc::ldnt16(a_ + 3840); } while (0)
#define RD_STORE(buf, X) do { char* b_ = lds + (buf) * B_DIR; *(uint4*)(b_ + ldst[0]) = X##0; *(uint4*)(b_ + ldst[1]) = X##1; *(uint4*)(b_ + ldst[2]) = X##2; *(uint4*)(b_ + ldst[3]) = X##3; \
            *(uint4*)(b_ + ldst[4]) = X##4; *(uint4*)(b_ + ldst[5]) = X##5; *(uint4*)(b_ + ldst[6]) = X##6; *(uint4*)(b_ + ldst[7]) = X##7; *(uint4*)(b_ + ldst[8]) = X##8; *(uint4*)(b_ + ldst[9]) = X##9; \
            if (tail) *(uint4*)(b_ + ldst[10]) = X##10; } while (0)
        RD_LOAD(0, sa); RD_STORE(0, sa); RD_LOAD(1, sa); if (2 < nc) RD_LOAD(2, sb);
        __syncthreads();
#define RD_SITER(cc, X) do { const int c = (cc); if (c + 1 < nc) RD_STORE((c + 1) & 1, X); if (c + 3 < nc) RD_LOAD(c + 3, X); __syncthreads(); } while (0)
        for (int c2 = 0; c2 < nc; c2 += 2) { RD_SITER(c2, sa); RD_SITER(c2 + 1, sb); }
#undef RD_LOAD
#undef RD_STORE
#undef RD_SITER
    } else {
        const int vb = (wv & 1) * 32;
        f32x16 Z[2];
        if (s >= NB) {
            const float* s0 = p.state_rwkv + ((((size_t)(s - NB) * L + l) * 2 + d) * AH + h) * AN * AN + (size_t)(vb + r) * AN;
#pragma unroll
            for (int t = 0; t < 2; ++t)
#pragma unroll
                for (int i = 0; i < 16; ++i) Z[t][i] = s0[32 * t + crow(i, hi)];
        } else {
#pragma unroll
            for (int t = 0; t < 2; ++t)
#pragma unroll
                for (int i = 0; i < 16; ++i) Z[t][i] = 0.f;
        }
        __syncthreads();
#define RD_COMPUTE \
        if (wv < 2) { \
            bf16x8 Zb[2][2]; \
_Pragma("unroll") \
            for (int t = 0; t < 2; ++t) { Zb[t][0] = pack8(Z[t], 0); Zb[t][1] = pack8(Z[t], 1); } \
            f32x16 U[2]; \
_Pragma("unroll") \
            for (int a = 0; a < 2; ++a) { \
                f32x16 acc = {}; \
_Pragma("unroll") \
                for (int t = 0; t < 2; ++t) \
_Pragma("unroll") \
                    for (int k = 0; k < 2; ++k) acc = __builtin_amdgcn_mfma_f32_32x32x16_bf16(*(const bf16x8*)(LB + B_WN + (32 * a + r) * BP + (32 * t + 16 * k + 8 * hi) * 2), Zb[t][k], acc, 0, 0, 0); \
_Pragma("unroll") \
                for (int i = 0; i < 16; ++i) U[a][i] = a2f(*(const unsigned short*)(LB + B_UT + (32 * a + crow(i, hi)) * 128 + (vb + r) * 2)) - acc[i]; \
            } \
            bf16x8 Ub[2][2]; \
_Pragma("unroll") \
            for (int b = 0; b < 2; ++b) { Ub[b][0] = pack8(U[b], 0); Ub[b][1] = pack8(U[b], 1); } \
_Pragma("unroll") \
            for (int a = 0; a < 2; ++a) { \
                f32x16 acc = {}; \
_Pragma("unroll") \
                for (int t = 0; t < 2; ++t) \
_Pragma("unroll") \
                    for (int k = 0; k < 2; ++k) acc = __builtin_amdgcn_mfma_f32_32x32x16_bf16(*(const bf16x8*)(LB + B_RT + (32 * a + r) * BP + (32 * t + 16 * k + 8 * hi) * 2), Zb[t][k], acc, 0, 0, 0); \
_Pragma("unroll") \
                for (int b = 0; b <= a; ++b) \
_Pragma("unroll") \
                    for (int k = 0; k < 2; ++k) acc = __builtin_amdgcn_mfma_f32_32x32x16_bf16(*(const bf16x8*)(LB + B_RAN + (32 * a + r) * BP + (32 * b + 16 * k + 8 * hi) * 2), Ub[b][k], acc, 0, 0, 0); \
_Pragma("unroll") \
                for (int i = 0; i < 16; ++i) { \
                    const int it = 64 * c + 32 * a + crow(i, hi); \
                    const size_t m = (size_t)(d == 0 ? base + it : base + T - 1 - it); \
                    yb[(m * 2 + d) * AW + h * AN + vb + r] = f2a(acc[i] + a2f(*(const unsigned short*)(LB + B_Y0 + (32 * a + crow(i, hi)) * 128 + (vb + r) * 2))); \
                } \
            } \
_Pragma("unroll") \
            for (int t = 0; t < 2; ++t) { \
_Pragma("unroll") \
                for (int i = 0; i < 16; ++i) { const int dk = 32 * t + crow(i, hi); Z[t][i] = Z[t][i] * *(const float*)(LB + B_PC + dk * 4) + *(const float*)(LB + B_G + (dk * 64 + vb + r) * 4); } \
_Pragma("unroll") \
                for (int b = 0; b < 2; ++b) \
_Pragma("unroll") \
                    for (int k = 0; k < 2; ++k) Z[t] = __builtin_amdgcn_mfma_f32_32x32x16_bf16(*(const bf16x8*)(LB + B_AHT + (32 * t + r) * BP + (32 * b + 16 * k + 8 * hi) * 2), Ub[b][k], Z[t], 0, 0, 0); \
            } \
        }

        for (int c = 0; c < nc; ++c) {
            const char* LB = lds + (c & 1) * B_DIR;
            RD_COMPUTE
            __syncthreads();
        }
        if (s < NB) {
            float* so = p.out + O_SR + ((((size_t)s * L + l) * 2 + d) * AH + h) * AN * AN + (size_t)(vb + r) * AN;
#pragma unroll
            for (int t = 0; t < 2; ++t)
#pragma unroll
                for (int i = 0; i < 16; ++i) so[32 * t + crow(i, hi)] = Z[t][i];
        }
#undef RD_COMPUTE
    }
#undef RD_SLOT
    __builtin_amdgcn_s_setprio(0);
}
}
constexpr int MX_RW_LAT = NDB * AH * 2, MX_G2_LAT = NDB * 2 * CH * 2, MX_AT_LAT = AT_NU_LAT, MX_GD_CTX = NB * 2 * CH * 2, MX_RW_CTX = NB * AH * 2, MX_AT_CTX = AT_NU_CTX;
constexpr int MX_TOTAL = MX_RW_LAT + MX_G2_LAT + MX_AT_LAT + MX_GD_CTX + MX_RW_CTX + MX_AT_CTX;
__device__ __forceinline__ void ph_mixers(const P& p, int l, char* lds, int misc_off, int round = 0) {
    unsigned* head = (unsigned*)(p.ws + WS_CTL + 32768) + (l + round * L) * 64;
    volatile __attribute__((address_space(3))) unsigned* slot = (volatile __attribute__((address_space(3))) unsigned*)((__attribute__((address_space(3))) char*)lds + misc_off + 16);
    for (;;) {
        __syncthreads();
        if (TIDX == 0) *slot = __hip_atomic_fetch_add(head, 1u, __ATOMIC_RELAXED, __HIP_MEMORY_SCOPE_AGENT);
        __syncthreads();
        int t = (int)*slot;
        t = __builtin_amdgcn_readfirstlane(t);
        if (t >= MX_TOTAL) break;
        if (t < MX_RW_LAT) { const int u = t; rwkc::chain_dir(p, l, NB + u / (2 * AH), (u / AH) % 2, u % AH, lds);
            if (DUPMASK & 32) rwkc::chain_dir(p, l, NB + u / (2 * AH), (u / AH) % 2, u % AH, lds); continue; } t -= MX_RW_LAT;
        if (t < MX_G2_LAT) { const int u = t; gdnc::chain_half(p, l, NB + u / (CH * 4), (u / (2 * CH)) % 2, (u / 2) % CH, u % 2, lds); continue; } t -= MX_G2_LAT;
        if (t < MX_AT_LAT) { attn_unit(p, t, lds); if (DUPMASK & 128) attn_unit(p, t, lds); continue; } t -= MX_AT_LAT;
        if (t < MX_GD_CTX) { const int u = t; gdnc::chain_half(p, l, u / (CH * 4), (u / (2 * CH)) % 2, (u / 2) % CH, u % 2, lds); continue; } t -= MX_GD_CTX;
        if (t < MX_RW_CTX) { const int u = t; rwkc::chain_dir(p, l, u / (2 * AH), (u / AH) % 2, u % AH, lds); continue; } t -= MX_RW_CTX;
        attn_unit(p, AT_NU_LAT + t, lds);
    }
}
namespace fastp {
template <int CTRL> __device__ __forceinline__ float dppf(float x) { return __int_as_float(__builtin_amdgcn_update_dpp(0, __float_as_int(x), CTRL, 0xf, 0xf, true)); }
template <int XORM> __device__ __forceinline__ float swzx(float x) { return __int_as_float(__builtin_amdgcn_ds_swizzle(__float_as_int(x), (XORM << 10) | 0x1f)); }
__device__ __forceinline__ float sum4(float x) { x += dppf<0xB1>(x); x += dppf<0x4E>(x); return x; }
__device__ __forceinline__ float sum16(float x) { x = sum4(x); x += dppf<0x124>(x); x += dppf<0x128>(x); return x; }
__device__ __forceinline__ float wsum(float x) {
    x = sum16(x); x += swzx<16>(x);
    auto rr = __builtin_amdgcn_permlane32_swap(__float_as_uint(x), __float_as_uint(x), false, false);
    return __uint_as_float(rr[0]) + __uint_as_float(rr[1]);
}
template <int N> __device__ __forceinline__ float gsumN(float x) {
    static_assert(N == 8 || N == 16 || N == 32, "group size");
    if (N == 8) { x = sum4(x); x += swzx<4>(x); return x; }
    x = sum16(x);
    if (N == 32) x += swzx<16>(x);
    return x;
}
#define gsum(x, n) gsumN<n>(x)
__device__ __forceinline__ uint2 pk4(float a, float b, float c, float d) { return make_uint2(mk2(a, b), mk2(c, d)); }
struct WaveId { int gw, nw, lane; };
__device__ __forceinline__ WaveId wave_id() {
    int tid = TIDX; asm volatile("" : "+v"(tid));
    WaveId w; w.lane = tid & 63; w.gw = __builtin_amdgcn_readfirstlane((tid >> 6) * (int)gridDim.x + (int)blockIdx.x); w.nw = (int)gridDim.x * (NTHR_ / 64); return w;
}

static_assert(D % 256 == 0, "row sweep");
__device__ __forceinline__ void ldx8(const unsigned short* p, float (&v)[8]) {
    const uint4 u = *(const uint4*)p;
    v[0] = __uint_as_float(u.x << 16); v[1] = __uint_as_float(u.x & 0xffff0000u); v[2] = __uint_as_float(u.y << 16); v[3] = __uint_as_float(u.y & 0xffff0000u);
    v[4] = __uint_as_float(u.z << 16); v[5] = __uint_as_float(u.z & 0xffff0000u); v[6] = __uint_as_float(u.w << 16); v[7] = __uint_as_float(u.w & 0xffff0000u);
}
static_assert(D % 512 == 0, "row sweep (8 per lane)");
__device__ __forceinline__ void norm_rows(const P& p, int l, int which) {
    const WaveId w = wave_id();
    const unsigned short* x = (const unsigned short*)(p.ws + WS_X); act_t* h = (act_t*)(p.ws + WS_H);
    const float* g = (which == 0 ? p.norm1_g : p.norm2_g) + (size_t)l * D;
    float A[D / 512][8], B[D / 512][8]; int cond_cur = -1;
    uint4 nx[D / 512];
    int m = w.gw;
    {   const unsigned short* xr = x + (size_t)(m < MTOK ? m : 0) * D;
#pragma unroll
        for (int j = 0; j < D / 512; ++j) nx[j] = *(const uint4*)(xr + j * 512 + w.lane * 8); }
    for (; m < MTOK; m += w.nw) {
        uint4 cur[D / 512];
#pragma unroll
        for (int j = 0; j < D / 512; ++j) { cur[j] = nx[j]; asm volatile("" : "+v"(cur[j].x), "+v"(cur[j].y), "+v"(cur[j].z), "+v"(cur[j].w)); }
        {   const int mn = m + w.nw < MTOK ? m + w.nw : m; const unsigned short* xr = x + (size_t)mn * D;
#pragma unroll
            for (int j = 0; j < D / 512; ++j) nx[j] = *(const uint4*)(xr + j * 512 + w.lane * 8); }
        __builtin_amdgcn_sched_barrier(0);
        const int cond = cond_of_seq(seq_of(m));
        if (cond != cond_cur) {
            cond_cur = cond;
            const float* sh = modp(p, l, cond, which * 3 + 0); const float* sc = modp(p, l, cond, which * 3 + 1);
#pragma unroll
            for (int j = 0; j < D / 512; ++j) { const int c = j * 512 + w.lane * 8;
                const float4 ga = *(const float4*)(g + c), gb = *(const float4*)(g + c + 4), s1a = *(const float4*)(sc + c), s1b = *(const float4*)(sc + c + 4), s0a = *(const float4*)(sh + c), s0b = *(const float4*)(sh + c + 4);
                A[j][0] = ga.x * (1.f + s1a.x); A[j][1] = ga.y * (1.f + s1a.y); A[j][2] = ga.z * (1.f + s1a.z); A[j][3] = ga.w * (1.f + s1a.w);
                A[j][4] = gb.x * (1.f + s1b.x); A[j][5] = gb.y * (1.f + s1b.y); A[j][6] = gb.z * (1.f + s1b.z); A[j][7] = gb.w * (1.f + s1b.w);
                B[j][0] = s0a.x; B[j][1] = s0a.y; B[j][2] = s0a.z; B[j][3] = s0a.w; B[j][4] = s0b.x; B[j][5] = s0b.y; B[j][6] = s0b.z; B[j][7] = s0b.w; }
        }
        float v[D / 512][8]; float ss = 0.f;
#pragma unroll
        for (int j = 0; j < D / 512; ++j) { const uint4 u = cur[j];
            v[j][0] = __uint_as_float(u.x << 16); v[j][1] = __uint_as_float(u.x & 0xffff0000u); v[j][2] = __uint_as_float(u.y << 16); v[j][3] = __uint_as_float(u.y & 0xffff0000u);
            v[j][4] = __uint_as_float(u.z << 16); v[j][5] = __uint_as_float(u.z & 0xffff0000u); v[j][6] = __uint_as_float(u.w << 16); v[j][7] = __uint_as_float(u.w & 0xffff0000u);
#pragma unroll
            for (int e = 0; e < 8; ++e) ss += v[j][e] * v[j][e]; }
        ss = wsum(ss);
        const float rs = 1.0f / sqrtf(ss / D + RMS_EPS);
#pragma unroll
        for (int j = 0; j < D / 512; ++j) { const int c = j * 512 + w.lane * 8;
            const uint2 lo = pk4(v[j][0] * rs * A[j][0] + B[j][0], v[j][1] * rs * A[j][1] + B[j][1], v[j][2] * rs * A[j][2] + B[j][2], v[j][3] * rs * A[j][3] + B[j][3]);
            const uint2 hi = pk4(v[j][4] * rs * A[j][4] + B[j][4], v[j][5] * rs * A[j][5] + B[j][5], v[j][6] * rs * A[j][6] + B[j][6], v[j][7] * rs * A[j][7] + B[j][7]);
            *(uint4*)(h + (size_t)m * D + c) = make_uint4(lo.x, lo.y, hi.x, hi.y); }
    }
}
__device__ __forceinline__ void final_rows(const P& p) {
    const WaveId w = wave_id();
    const unsigned short* x = (const unsigned short*)(p.ws + WS_X);
    for (int m = w.gw; m < MTOK; m += w.nw) {
        const unsigned short* xr = x + (size_t)m * D;
        float v[D / 512][8]; float ss = 0.f;
#pragma unroll
        for (int j = 0; j < D / 512; ++j) { ldx8(xr + j * 512 + w.lane * 8, v[j]);
#pragma unroll
            for (int e = 0; e < 8; ++e) ss += v[j][e] * v[j][e]; }
        ss = wsum(ss);
        const float rs = 1.0f / sqrtf(ss / D + RMS_EPS);
#pragma unroll
        for (int j = 0; j < D / 512; ++j) { const int c = j * 512 + w.lane * 8; const float4 ga = *(const float4*)(p.final_norm_g + c), gb = *(const float4*)(p.final_norm_g + c + 4);
            *(float4*)(p.out + O_YP + (size_t)m * D + c) = make_float4(v[j][0] * rs * ga.x, v[j][1] * rs * ga.y, v[j][2] * rs * ga.z, v[j][3] * rs * ga.w);
            *(float4*)(p.out + O_YP + (size_t)m * D + c + 4) = make_float4(v[j][4] * rs * gb.x, v[j][5] * rs * gb.y, v[j][6] * rs * gb.z, v[j][7] * rs * gb.w); }
    }
}

static_assert(2 * DL == 128 && 2 * IL == 128 && GL == 128 && QR == 512 && KVR == 512 && ROPE == 64 && GC == 1536 && CH == 4, "prep_rows layout");
__device__ __forceinline__ void prep_rows(const P& p, int l) {
    const WaveId w = wave_id(); const int lane = w.lane;
    const act_t* pp = (const act_t*)(p.ws + WS_PP);
    act_t* lin = (act_t*)(p.ws + WS_LIN); act_t* cqn = (act_t*)(p.ws + WS_CQN); act_t* ckvn = (act_t*)(p.ws + WS_CKVN); act_t* kr = (act_t*)(p.ws + WS_KR);
    const float2* ropetab = (const float2*)(p.ws + WS_ROPE);
    for (int m = w.gw; m < MKV; m += w.nw) {
        if (m >= MTOK) {
            const int r = m - MTOK, b = r / PAST, j0 = r % PAST;
            const float* ck = p.cache_ckv + (((size_t)b * L + l) * PAST + j0) * KVR;
            const float4 a = *(const float4*)(ck + lane * 8), c4 = *(const float4*)(ck + lane * 8 + 4);
            *(uint4*)(ckvn + (size_t)m * KVR + lane * 8) = make_uint4(mk2(a.x, a.y), mk2(a.z, a.w), mk2(c4.x, c4.y), mk2(c4.z, c4.w));
            kr[(size_t)m * ROPE + lane] = f2a(p.cache_kpe[(((size_t)b * L + l) * PAST + j0) * ROPE + lane]);
            continue;
        }
        const act_t* pr = pp + (size_t)m * INP;
        const int s = seq_of(m), base = seq_start(s), t = m - base, T = seq_len(s);
        {
            const float2 a = ldp2(pr + OFF_WLO + 2 * lane), b = ldp2(pr + OFF_ALO + 2 * lane), c = ldp2(pr + OFF_GLO + 2 * lane);
            act_t* lo = lin + (size_t)m * LINK;
            *(unsigned*)(lo + 2 * lane) = mk2(ftanh_(a.x), ftanh_(a.y)); *(unsigned*)(lo + 128 + 2 * lane) = mk2(b.x, b.y); *(unsigned*)(lo + 256 + 2 * lane) = mk2(sigmoidf_(c.x), sigmoidf_(c.y));
        }
        {
            const float4 a = ldp4(pr + OFF_CQ + lane * 8), b = ldp4(pr + OFF_CQ + lane * 8 + 4);
            float ss = wsum(a.x * a.x + a.y * a.y + a.z * a.z + a.w * a.w + b.x * b.x + b.y * b.y + b.z * b.z + b.w * b.w);
            float rs = 1.0f / sqrtf(ss / QR + RMS_EPS);
            const float* g = p.mla_qnorm_g + (size_t)l * QR + lane * 8; const float4 g0 = *(const float4*)g, g1 = *(const float4*)(g + 4);
            *(uint4*)(cqn + (size_t)m * QR + lane * 8) = make_uint4(mk2(a.x * rs * g0.x, a.y * rs * g0.y), mk2(a.z * rs * g0.z, a.w * rs * g0.w), mk2(b.x * rs * g1.x, b.y * rs * g1.y), mk2(b.z * rs * g1.z, b.w * rs * g1.w));
            const float4 c = ldp4(pr + OFF_CKV + lane * 8), d = ldp4(pr + OFF_CKV + lane * 8 + 4);
            ss = wsum(c.x * c.x + c.y * c.y + c.z * c.z + c.w * c.w + d.x * d.x + d.y * d.y + d.z * d.z + d.w * d.w);
            rs = 1.0f / sqrtf(ss / KVR + RMS_EPS);
            const float* g2 = p.mla_kvnorm_g + (size_t)l * KVR + lane * 8; const float4 h0 = *(const float4*)g2, h1 = *(const float4*)(g2 + 4);
            const float4 o0 = make_float4(c.x * rs * h0.x, c.y * rs * h0.y, c.z * rs * h0.z, c.w * rs * h0.w), o1 = make_float4(d.x * rs * h1.x, d.y * rs * h1.y, d.z * rs * h1.z, d.w * rs * h1.w);
            *(uint4*)(ckvn + (size_t)m * KVR + lane * 8) = make_uint4(mk2(o0.x, o0.y), mk2(o0.z, o0.w), mk2(o1.x, o1.y), mk2(o1.z, o1.w));
            if (s < NB) { float* oc = p.out + O_CK + (((size_t)s * L + l) * SEQ + t) * KVR + lane * 8; *(float4*)oc = o0; *(float4*)(oc + 4) = o1; }
            if (lane < ROPE / 2) {
                const float2 xe = ldp2(pr + OFF_KPE + 2 * lane);
                if (s < NB) { *(unsigned*)(kr + (size_t)m * ROPE + 2 * lane) = mk2(xe.x, xe.y); *(float2*)(p.out + O_KP + (((size_t)s * L + l) * SEQ + t) * ROPE + 2 * lane) = xe; }
                else { const float2 cs = ropetab[(size_t)t * (ROPE / 2) + lane]; *(unsigned*)(kr + (size_t)m * ROPE + 2 * lane) = mk2(xe.x * cs.x - xe.y * cs.y, xe.x * cs.y + xe.y * cs.x); }
            }
        }
    }
}

static_assert(CW == 512 && DV == 128, "post_rows layout");
__device__ __forceinline__ void post_rows(const P& p, int l) {
    const WaveId w = wave_id(); const int lane = w.lane;
    const act_t* pp = (const act_t*)(p.ws + WS_PP);
    const float* rwb = (const float*)(p.ws + WS_RWB); const act_t* gb = (const act_t*)(p.ws + WS_LORA) + 4 * AW;     const act_t* yb = (const act_t*)(p.ws + WS_RWY);
    const act_t* go = (const act_t*)(p.ws + WS_GO);
    act_t* ymix = (act_t*)(p.ws + WS_YMIX);
    for (int m = w.gw; m < MTOK; m += w.nw) {
        const act_t* pr = pp + (size_t)m * INP;
        const int c0 = 8 * lane, h = lane >> 3;
        {
            float y[8], v[8];
#define LD8N(dst, ptr) do { typedef unsigned u32x4n_ __attribute__((ext_vector_type(4))); const u32x4n_ u_ = __builtin_nontemporal_load((const u32x4n_*)(ptr)); \
        dst[0] = lo2(u_[0]); dst[1] = hi2(u_[0]); dst[2] = lo2(u_[1]); dst[3] = hi2(u_[1]); dst[4] = lo2(u_[2]); dst[5] = hi2(u_[2]); dst[6] = lo2(u_[3]); dst[7] = hi2(u_[3]); } while (0)
#define LD8B(dst, ptr) do { const float4 a_ = ldp4(ptr), b_ = ldp4((ptr) + 4); dst[0] = a_.x; dst[1] = a_.y; dst[2] = a_.z; dst[3] = a_.w; dst[4] = b_.x; dst[5] = b_.y; dst[6] = b_.z; dst[7] = b_.w; } while (0)
#define LD8(dst, ptr) do { const float4 a_ = *(const float4*)(ptr), b_ = *(const float4*)((ptr) + 4); dst[0] = a_.x; dst[1] = a_.y; dst[2] = a_.z; dst[3] = a_.w; dst[4] = b_.x; dst[5] = b_.y; dst[6] = b_.z; dst[7] = b_.w; } while (0)
            { float y1[8]; LD8N(y, yb + ((size_t)m * 2 + 0) * AW + c0); LD8N(y1, yb + ((size_t)m * 2 + 1) * AW + c0);
#pragma unroll
              for (int j = 0; j < 8; ++j) y[j] += y1[j]; }
            { const float4 a_ = ldp4(pr + OFF_V + c0), b_ = ldp4(pr + OFF_V + c0 + 4); v[0] = a_.x; v[1] = a_.y; v[2] = a_.z; v[3] = a_.w; v[4] = b_.x; v[5] = b_.y; v[6] = b_.z; v[7] = b_.w; }
            float mu = 0.f;
#pragma unroll
            for (int j = 0; j < 8; ++j) mu += y[j];
            mu = gsum(mu, 8) * (1.0f / AN);
            float var = 0.f;
#pragma unroll
            for (int j = 0; j < 8; ++j) { const float t = y[j] - mu; var += t * t; }
            var = gsum(var, 8) * (1.0f / AN);
            const float rstd = 1.0f / sqrtf(var + LNX_EPS);
            const float bon = rwb[((size_t)m * 2 + 0) * AH + h] + rwb[((size_t)m * 2 + 1) * AH + h];
            float g[8]; { const float4 a_ = ldp4(gb + (size_t)m * LORAN + c0), b_ = ldp4(gb + (size_t)m * LORAN + c0 + 4); g[0] = a_.x; g[1] = a_.y; g[2] = a_.z; g[3] = a_.w; g[4] = b_.x; g[5] = b_.y; g[6] = b_.z; g[7] = b_.w; }
            float o[8];
#pragma unroll
            for (int j = 0; j < 8; ++j) o[j] = ((y[j] - mu) * rstd * p.rwkv_lnx_g[(size_t)l * AW + c0 + j] + p.rwkv_lnx_b[(size_t)l * AW + c0 + j] + bon * v[j]) * g[j];
            *(uint4*)(ymix + (size_t)m * MIXW + c0) = make_uint4(mk2(o[0], o[1]), mk2(o[2], o[3]), mk2(o[4], o[5]), mk2(o[6], o[7]));
        }
        {
            float o[8], z[8];
            { float o1[8]; LD8N(o, go + ((size_t)m * 2 + 0) * CW + c0); LD8N(o1, go + ((size_t)m * 2 + 1) * CW + c0);
#pragma unroll
              for (int j = 0; j < 8; ++j) o[j] += o1[j]; }
            { const float4 a_ = ldp4(pr + OFF_GZ + c0), b_ = ldp4(pr + OFF_GZ + c0 + 4); z[0] = a_.x; z[1] = a_.y; z[2] = a_.z; z[3] = a_.w; z[4] = b_.x; z[5] = b_.y; z[6] = b_.z; z[7] = b_.w; }
            float ss = 0.f;
#pragma unroll
            for (int j = 0; j < 8; ++j) ss += o[j] * o[j];
            ss = gsum(ss, 16);
            const float rs = 1.0f / sqrtf(ss / DV + RMS_EPS);
            float r[8];
#pragma unroll
            for (int j = 0; j < 8; ++j) r[j] = o[j] * rs * p.gdn_norm_g[(size_t)l * DV + (c0 & 127) + j] * siluf_(z[j]);
            *(uint4*)(ymix + (size_t)m * MIXW + AW + BW + c0) = make_uint4(mk2(r[0], r[1]), mk2(r[2], r[3]), mk2(r[4], r[5]), mk2(r[6], r[7]));
#undef LD8
#undef LD8B
#undef LD8N
        }
    }
}

static_assert(DFF % 8 == 0, "ffn_act8");
__device__ __forceinline__ void ffn_act8(const P& p, int l, long gt, long gs) {
    const act_t* up = (const act_t*)(p.ws + WS_UP); act_t* act = (act_t*)(p.ws + WS_ACT);
    const float* w = p.ffn_conv + (size_t)l * 3 * DFF;
    for (long idx = gt; idx < (long)MTOK * (DFF / 8); idx += gs) {
        const int m = (int)(idx / (DFF / 8)), c = (int)(idx % (DFF / 8)) * 8;
        const int s = seq_of(m), base = seq_start(s), t = m - base, T = seq_len(s);
        const uint4 g1 = *(const uint4*)(up + (size_t)m * NUP + c), vv = *(const uint4*)(up + (size_t)m * NUP + DFF + c);
        uint4 g0 = make_uint4(0, 0, 0, 0), g2 = make_uint4(0, 0, 0, 0);
        if (t > 0) g0 = *(const uint4*)(up + (size_t)(m - 1) * NUP + c);
        if (t < T - 1) g2 = *(const uint4*)(up + (size_t)(m + 1) * NUP + c);
        const unsigned a0[4] = {g0.x, g0.y, g0.z, g0.w}, a1[4] = {g1.x, g1.y, g1.z, g1.w}, a2[4] = {g2.x, g2.y, g2.z, g2.w}, av[4] = {vv.x, vv.y, vv.z, vv.w};
        unsigned o[4];
#pragma unroll
        for (int j = 0; j < 4; ++j) {
            const float lo = w[c + 2 * j] * lo2(a0[j]) + w[DFF + c + 2 * j] * lo2(a1[j]) + w[2 * DFF + c + 2 * j] * lo2(a2[j]);
            const float hi = w[c + 2 * j + 1] * hi2(a0[j]) + w[DFF + c + 2 * j + 1] * hi2(a1[j]) + w[2 * DFF + c + 2 * j + 1] * hi2(a2[j]);
            o[j] = mk2(siluf_(lo) * lo2(av[j]), siluf_(hi) * hi2(av[j]));
        }
        *(uint4*)(act + (size_t)m * DFF + c) = make_uint4(o[0], o[1], o[2], o[3]);
    }
}

__device__ __forceinline__ void ffn_fix(const P& p, int l, long gt, long gs) {
    const float* side = (const float*)(p.ws + WS_SIDE); act_t* act = (act_t*)(p.ws + WS_ACT);
    const float* w = p.ffn_conv + (size_t)l * 3 * DFF;
    for (long idx = gt; idx < (long)(MTOK / 64) * 2 * (DFF / 8); idx += gs) {
        const int c = (int)(idx % (DFF / 8)) * 8, be = (int)(idx / (DFF / 8)), b = be >> 1, e = be & 1;
        const int m = 64 * b + (e ? 63 : 0);
        const int s = seq_of(m), t = m - seq_start(s), T = seq_len(s);
        const float* sb = side + (size_t)b * 6 * DFF + c;
        float g0[8], g1[8], g2[8], vv[8];
#define LD8S(dst, ptr) do { const float4 a_ = *(const float4*)(ptr), b_ = *(const float4*)((ptr) + 4); dst[0] = a_.x; dst[1] = a_.y; dst[2] = a_.z; dst[3] = a_.w; dst[4] = b_.x; dst[5] = b_.y; dst[6] = b_.z; dst[7] = b_.w; } while (0)
#pragma unroll
        for (int j = 0; j < 8; ++j) { g0[j] = 0.f; g2[j] = 0.f; }
        if (e == 0) { LD8S(g1, sb); LD8S(g2, sb + DFF); LD8S(vv, sb + 4 * DFF); if (t > 0) LD8S(g0, sb - 6 * DFF + 3 * DFF); }
        else { LD8S(g1, sb + 3 * DFF); LD8S(g0, sb + 2 * DFF); LD8S(vv, sb + 5 * DFF); if (t < T - 1) LD8S(g2, sb + 6 * DFF); }
#undef LD8S
        float o[8];
#pragma unroll
        for (int j = 0; j < 8; ++j) o[j] = siluf_(w[c + j] * g0[j] + w[DFF + c + j] * g1[j] + w[2 * DFF + c + j] * g2[j]) * vv[j];
        *(uint4*)(act + (size_t)m * DFF + c) = make_uint4(mk2(o[0], o[1]), mk2(o[2], o[3]), mk2(o[4], o[5]), mk2(o[6], o[7]));
    }
}

template <class Src>
__device__ __forceinline__ void conv_tile_load(const Src& src, int K, int N, int unit, int tid, float4 (&v)[2]) {
    const int nk = K / 64, ku = unit % nk, nu = unit / nk, k0 = ku * 64, n0 = nu * 64;
#pragma unroll
    for (int pass = 0; pass < 2; ++pass) {
        const int kk = pass * 32 + (tid >> 4), n4 = (tid & 15) * 4;
        v[pass] = make_float4(0.f, 0.f, 0.f, 0.f);
        if (n0 + n4 < N) v[pass] = src(k0 + kk, n0 + n4);
    }
}
__device__ __forceinline__ void conv_tile_store(int K, act_t* Wt, int unit, int tid, const float4 (&v)[2], char* lds) {
    float* tile = (float*)lds;
    const int nk = K / 64, ku = unit % nk, nu = unit / nk, k0 = ku * 64, n0 = nu * 64;
    __syncthreads();
#pragma unroll
    for (int pass = 0; pass < 2; ++pass) {
        const int kk = pass * 32 + (tid >> 4), n4 = (tid & 15) * 4;
        tile[kk * 65 + n4] = v[pass].x; tile[kk * 65 + n4 + 1] = v[pass].y; tile[kk * 65 + n4 + 2] = v[pass].z; tile[kk * 65 + n4 + 3] = v[pass].w;
    }
    __syncthreads();
    const int n = tid >> 3, k8 = (tid & 7) * 8;
    unsigned o[4];
#pragma unroll
    for (int j = 0; j < 4; ++j) o[j] = mk2(tile[(k8 + 2 * j) * 65 + n], tile[(k8 + 2 * j + 1) * 65 + n]);
    *(uint4*)(Wt + (size_t)(n0 + n) * K + k0 + k8) = make_uint4(o[0], o[1], o[2], o[3]);
}
typedef float f32x4nt __attribute__((ext_vector_type(4)));
__device__ __forceinline__ float4 ldnt4(const float* p) { const f32x4nt v = __builtin_nontemporal_load((const f32x4nt*)p); return make_float4(v[0], v[1], v[2], v[3]); }
struct SrcPlain { const float* W; int N; __device__ __forceinline__ float4 operator()(int k, int n) const { return ldnt4(W + (size_t)k * N + n); } };
struct SrcUpPerm { const float* W; int N; __device__ __forceinline__ float4 operator()(int k, int n) const {
        const int nl = n & 255, col = nl < 128 ? (n >> 8) * 128 + nl : DFF + (n >> 8) * 128 + nl - 128; return ldnt4(W + (size_t)k * N + col); } };
struct SrcLora { const float* w2; const float* a2; const float* g2;
    __device__ __forceinline__ float4 operator()(int k, int n) const {
        const int jb = n / AW, c = n % AW; const float* s = nullptr;
        if (jb < 2) { if (k >= jb * DL && k < (jb + 1) * DL) s = w2 + ((size_t)jb * DL + (k - jb * DL)) * AW + c; }
        else if (jb < 4) { const int d = jb - 2; if (k >= 2 * DL + d * IL && k < 2 * DL + (d + 1) * IL) s = a2 + ((size_t)d * IL + (k - 2 * DL - d * IL)) * AW + c; }
        else { if (k >= 2 * DL + 2 * IL) s = g2 + (size_t)(k - 2 * DL - 2 * IL) * AW + c; }
        return s ? *(const float4*)s : make_float4(0.f, 0.f, 0.f, 0.f);
    } };

__device__ __forceinline__ void adaln_unit(const P& p, int unit, char* lds) {
    int tid = TIDX; asm volatile("" : "+v"(tid));
    float* sil = (float*)lds;
    float* part = sil + NCOND * D;
    const int l = unit / (6 * D / 64), j0 = (unit % (6 * D / 64)) * 64;
    __syncthreads();
    for (int i = tid; i < NCOND * D; i += NTHR_) { const int c = i / D, k = i % D; sil[i] = siluf_(c == 0 ? p.c_ctx[k] : p.c[(size_t)(c - 1) * D + k]); }
    __syncthreads();
    const int cg = tid & 15, rs = tid >> 4;
    float4 acc[NCOND];
#pragma unroll
    for (int c = 0; c < NCOND; ++c) acc[c] = make_float4(0.f, 0.f, 0.f, 0.f);
    const float* wp = p.ada_w + ((size_t)l * D) * 6 * D + j0 + 4 * cg;
    for (int i0 = rs * (D / 32); i0 < (rs + 1) * (D / 32); i0 += 16) {
        float4 wv[16];
#pragma unroll
        for (int e = 0; e < 16; ++e) wv[e] = ldnt4(wp + (size_t)(i0 + e) * 6 * D);
        __builtin_amdgcn_sched_barrier(0);
#pragma unroll
        for (int e = 0; e < 16; e += 4) asm volatile("" : "+v"(wv[e].x), "+v"(wv[e].y), "+v"(wv[e].z), "+v"(wv[e].w), "+v"(wv[e + 1].x), "+v"(wv[e + 1].y), "+v"(wv[e + 1].z), "+v"(wv[e + 1].w),
                                                          "+v"(wv[e + 2].x), "+v"(wv[e + 2].y), "+v"(wv[e + 2].z), "+v"(wv[e + 2].w), "+v"(wv[e + 3].x), "+v"(wv[e + 3].y), "+v"(wv[e + 3].z), "+v"(wv[e + 3].w));
#pragma unroll
        for (int e = 0; e < 16; ++e)
#pragma unroll
            for (int c = 0; c < NCOND; ++c) { const float s = sil[c * D + i0 + e]; acc[c].x += s * wv[e].x; acc[c].y += s * wv[e].y; acc[c].z += s * wv[e].z; acc[c].w += s * wv[e].w; }
    }
#pragma unroll
    for (int c = 0; c < NCOND; ++c) { float* pp_ = part + ((rs * 64 + 4 * cg) * NCOND + c); pp_[0] = acc[c].x; pp_[NCOND] = acc[c].y; pp_[2 * NCOND] = acc[c].z; pp_[3 * NCOND] = acc[c].w; }
    __syncthreads();
    if (tid < 64 * NCOND) {
        const int c = tid / 64, j = tid % 64; float sacc = 0.f;
#pragma unroll 8
        for (int q = 0; q < 32; ++q) sacc += part[(q * 64 + j) * NCOND + c];
        float* mod = (float*)(p.ws + WS_MOD);
        mod[((size_t)(l * NCOND + c) * 6) * D + j0 + j] = sacc + p.ada_b[(size_t)l * 6 * D + j0 + j];
    }
}
}
struct EpiResid {
    static constexpr bool PERM = true, AFTER_DRAIN = false;
    unsigned short* X; int ldc; const float* mod_l; int which;
    __device__ __forceinline__ void operator()(const pg8::f32x4 (&acc)[2][2][4][2], const pg8::Unit& u, int wr, int wc, int fr, int fq) const {
        using pg8::f32x4; using pg8::u32x4; using pg8::BM; using pg8::HALF;
        const int row0 = u.pm * BM + wr * 64 + fr, col0 = u.pn * BM + wc * 32 + 8 * fq;
        const int cond = cond_of_seq(seq_of(u.pm * BM));
        const float* gate = mod_l + ((size_t)cond * 6 + which) * D;
        f32x4 gv[2][2];
#pragma unroll
        for (int bj = 0; bj < 2; ++bj)
#pragma unroll
            for (int n = 0; n < 2; ++n) gv[bj][n] = *(const f32x4*)(gate + col0 + bj * HALF + 4 * n);
        u32x4 o[2][4][2];
#pragma unroll
        for (int ai = 0; ai < 2; ++ai)
#pragma unroll
            for (int m = 0; m < 4; ++m)
#pragma unroll
                for (int bj = 0; bj < 2; ++bj) o[ai][m][bj] = *(const u32x4*)(X + (size_t)(row0 + ai * HALF + m * 16) * ldc + col0 + bj * HALF);
        __builtin_amdgcn_sched_barrier(0);
#pragma unroll
        for (int ai = 0; ai < 2; ++ai)
#pragma unroll
            for (int m = 0; m < 4; ++m) { unsigned short* rowp = X + (size_t)(row0 + ai * HALF + m * 16) * ldc + col0;
#pragma unroll
                for (int bj = 0; bj < 2; ++bj) {
                    const u32x4 ov = o[ai][m][bj];
                    const f32x4 x0 = {__uint_as_float(ov.x << 16), __uint_as_float(ov.x & 0xffff0000u), __uint_as_float(ov.y << 16), __uint_as_float(ov.y & 0xffff0000u)};
                    const f32x4 x1 = {__uint_as_float(ov.z << 16), __uint_as_float(ov.z & 0xffff0000u), __uint_as_float(ov.w << 16), __uint_as_float(ov.w & 0xffff0000u)};
                    const f32x4 v0 = x0 + gv[bj][0] * acc[ai][bj][m][0], v1 = x1 + gv[bj][1] * acc[ai][bj][m][1];
                    u32x4 w; w.x = pg8::cvt_pk_bf16(v0[0], v0[1]); w.y = pg8::cvt_pk_bf16(v0[2], v0[3]); w.z = pg8::cvt_pk_bf16(v1[0], v1[1]); w.w = pg8::cvt_pk_bf16(v1[2], v1[3]);
                    *(u32x4*)(rowp + bj * HALF) = w; } }
    }
};

struct EpiFfnAct {
    static constexpr bool PERM = true, AFTER_DRAIN = false;
    pg8::bf16_t* ACT; float* side; const float* cw;
    __device__ __forceinline__ void operator()(const pg8::f32x4 (&acc)[2][2][4][2], const pg8::Unit& u, int wr, int wc, int, int) const {
        using pg8::f32x4; using pg8::u32x4; using pg8::BM; using pg8::HALF;
        unsigned lane_; asm volatile("v_mbcnt_lo_u32_b32 %0, -1, 0\n\tv_mbcnt_hi_u32_b32 %0, -1, %0" : "=v"(lane_));
        const int fr = (int)(lane_ & 15u), fq = (int)(lane_ >> 4);
        const int colA = u.pn * 128 + wc * 32 + 8 * fq;
        f32x4 w0[2], w1[2], w2[2];
#pragma unroll
        for (int n = 0; n < 2; ++n) { w0[n] = *(const f32x4*)(cw + colA + 4 * n); w1[n] = *(const f32x4*)(cw + DFF + colA + 4 * n); w2[n] = *(const f32x4*)(cw + 2 * DFF + colA + 4 * n); }
        const bool first = fr == 0, last = fr == 15;
#pragma unroll
        for (int ai = 0; ai < 2; ++ai) {
            const int row_b = u.pm * BM + ai * HALF + wr * 64, blk = row_b >> 6;
            f32x4 R[4][2], Ln[4][2];
#pragma unroll
            for (int m = 0; m < 4; ++m)
#pragma unroll
                for (int n = 0; n < 2; ++n)
#pragma unroll
                    for (int e = 0; e < 4; ++e) { R[m][n][e] = fastp::dppf<0x121>(acc[ai][0][m][n][e]); Ln[m][n][e] = fastp::dppf<0x12F>(acc[ai][0][m][n][e]); }
#pragma unroll
            for (int m = 0; m < 4; ++m) {
                u32x4 wout;
#pragma unroll
                for (int n = 0; n < 2; ++n) {
                    f32x4 o;
#pragma unroll
                    for (int e = 0; e < 4; ++e) {
                        const float pv = first ? (m > 0 ? R[m > 0 ? m - 1 : 0][n][e] : 0.f) : R[m][n][e];
                        const float nx = last ? (m < 3 ? Ln[m < 3 ? m + 1 : 3][n][e] : 0.f) : Ln[m][n][e];
                        o[e] = siluf_(w0[n][e] * pv + w1[n][e] * acc[ai][0][m][n][e] + w2[n][e] * nx) * acc[ai][1][m][n][e];
                    }
                    if (n == 0) { wout.x = pg8::cvt_pk_bf16(o[0], o[1]); wout.y = pg8::cvt_pk_bf16(o[2], o[3]); } else { wout.z = pg8::cvt_pk_bf16(o[0], o[1]); wout.w = pg8::cvt_pk_bf16(o[2], o[3]); }
                }
                *(u32x4*)(ACT + (size_t)(row_b + m * 16 + fr) * DFF + colA) = wout;
            }
            float* sb = side + (size_t)blk * 6 * DFF + colA;
            if (fr <= 1) { *(f32x4*)(sb + fr * DFF) = acc[ai][0][0][0]; *(f32x4*)(sb + fr * DFF + 4) = acc[ai][0][0][1]; }
            if (fr >= 14) { *(f32x4*)(sb + (fr - 12) * DFF) = acc[ai][0][3][0]; *(f32x4*)(sb + (fr - 12) * DFF + 4) = acc[ai][0][3][1]; }
            if (first) { *(f32x4*)(sb + 4 * DFF) = acc[ai][1][0][0]; *(f32x4*)(sb + 4 * DFF + 4) = acc[ai][1][0][1]; }
            if (last) { *(f32x4*)(sb + 5 * DFF) = acc[ai][1][3][0]; *(f32x4*)(sb + 5 * DFF + 4) = acc[ai][1][3][1]; }
        }
    }
};

constexpr int NTHR = 512;
constexpr int LDS_BYTES = 147456;
constexpr int LDS_MISC = LDS_BYTES - 64;
constexpr int LDS_USABLE = TID_TAB_OFF;
static_assert(LDS_BYTES == LDS_TOTAL_BYTES, "tidx.h");
static_assert(NTHR == NTHR_ && att::SHM_ATTN <= LDS_USABLE && pg8::STAGE_BYTES <= LDS_USABLE && gdnc::PA_LDS <= LDS_USABLE && gdnc::PH_LDS <= LDS_USABLE && rwkc::PA_LDS <= LDS_USABLE && rwkc::PD_LDS <= LDS_USABLE, "LDS map");
constexpr int PH_PER_LAYER = 11, N_PHASES = 2 + L * PH_PER_LAYER;

struct Args { P p; int ph_lo, ph_hi, use_bar, pad; };

template <class Epi>
__device__ __forceinline__ void run_gemm(PG8_LAS unsigned char* lds, const act_t* A, const act_t* Bt, int M, int N, int K, const Epi& E) {
    pg8::Gemm g{A, Bt, M, N, K, K}; pg8::StaticOrder S; S.init(M, N, (int)gridDim.x, (int)blockIdx.x);
    pg8::gemm_phase<Epi, pg8::StaticOrder, false>(lds, g, S, E, nullptr);
}

constexpr int CV_T_IN = (D / 64) * (INP / 64), CV_T_UQ = (QR / 64) * (NQ / 64), CV_T_UK = (KVR / 64) * (BH * NOPE / 64), CV_T_UV = (KVR / 64) * (BH * VD / 64), CV_T_OUT = (MIXW / 64) * (D / 64),
              CV_T_UP = (D / 64) * (NUP / 64), CV_T_DN = (DFF / 64) * (D / 64), CV_T_LO = (LINK / 64) * (LORAN / 64), CV_TL = CV_T_IN + CV_T_UQ + CV_T_UK + CV_T_UV + CV_T_OUT + CV_T_UP + CV_T_DN + CV_T_LO;
constexpr int AD_PER_LAYER = 6 * D / 64;
__device__ __forceinline__ void layer_prep(const P& p, int ll, int t_lo, int t_hi, bool with_adaln, int w, int nw, char* lds) {
    act_t* ww_ = (act_t*)(p.ws + WS_WT) + (size_t)ll * WT_LAYER;
    if (with_adaln) for (int u = w; u < AD_PER_LAYER; u += nw) fastp::adaln_unit(p, ll * AD_PER_LAYER + u, lds);
    int tidc = TIDX; asm volatile("" : "+v"(tidc));
    asm volatile("" : "+s"(w), "+s"(t_lo));
    float4 vcur[2], vnxt[2];
#define CV_DISPATCH(ridx, OP_PLAIN, OP_LORA, OP_UP) do { int r_ = (ridx); \
        if (r_ < CV_T_IN) { OP_PLAIN(p.w_in + (size_t)ll * D * INC, INC, D, INC, ww_ + WT_IN, r_); break; } r_ -= CV_T_IN; \
        if (r_ < CV_T_UQ) { OP_PLAIN(p.mla_w_uq + (size_t)ll * QR * NQ, NQ, QR, NQ, ww_ + WT_UQ, r_); break; } r_ -= CV_T_UQ; \
        if (r_ < CV_T_UK) { OP_PLAIN(p.mla_w_uk + (size_t)ll * KVR * BH * NOPE, BH * NOPE, KVR, BH * NOPE, ww_ + WT_UKV, r_); break; } r_ -= CV_T_UK; \
        if (r_ < CV_T_UV) { OP_PLAIN(p.mla_w_uv + (size_t)ll * KVR * BH * VD, BH * VD, KVR, BH * VD, ww_ + WT_UKV + (size_t)BH * NOPE * KVR, r_); break; } r_ -= CV_T_UV; \
        if (r_ < CV_T_OUT) { OP_PLAIN(p.w_out + (size_t)ll * MIXW * D, D, MIXW, D, ww_ + WT_OUT, r_); break; } r_ -= CV_T_OUT; \
        if (r_ < CV_T_UP) { OP_UP(p.ffn_up + (size_t)ll * D * NUP, NUP, D, NUP, ww_ + WT_UP, r_); break; } r_ -= CV_T_UP; \
        if (r_ < CV_T_DN) { OP_PLAIN(p.ffn_down + (size_t)ll * DFF * D, D, DFF, D, ww_ + WT_DOWN, r_); break; } r_ -= CV_T_DN; \
        OP_LORA(ww_ + WT_LORA, r_); } while (0)
#define CV_LOAD_PLAIN(W_, ldw_, K_, N_, Wt_, u_) fastp::conv_tile_load(fastp::SrcPlain{W_, ldw_}, K_, N_, u_, tidc, vnxt)
#define CV_LOAD_UP(W_, ldw_, K_, N_, Wt_, u_) fastp::conv_tile_load(fastp::SrcUpPerm{W_, ldw_}, K_, N_, u_, tidc, vnxt)
#define CV_LOAD_LORA(Wt_, u_) fastp::conv_tile_load(fastp::SrcLora{p.rwkv_w2 + (size_t)ll * 2 * DL * AW, p.rwkv_a2 + (size_t)ll * 2 * IL * AW, p.rwkv_g2 + (size_t)ll * GL * AW}, LINK, LORAN, u_, tidc, vnxt)
#define CV_STORE_PLAIN(W_, ldw_, K_, N_, Wt_, u_) fastp::conv_tile_store(K_, Wt_, u_, tidc, vcur, lds)
#define CV_STORE_LORA(Wt_, u_) fastp::conv_tile_store(LINK, Wt_, u_, tidc, vcur, lds)
    const int first = t_lo + w;
    if (first < t_hi) CV_DISPATCH(first, CV_LOAD_PLAIN, CV_LOAD_LORA, CV_LOAD_UP);
    for (int gi = first; gi < t_hi; gi += nw) {
        vcur[0] = vnxt[0]; vcur[1] = vnxt[1];
        if (gi + nw < t_hi) CV_DISPATCH(gi + nw, CV_LOAD_PLAIN, CV_LOAD_LORA, CV_LOAD_UP);
        CV_DISPATCH(gi, CV_STORE_PLAIN, CV_STORE_LORA, CV_STORE_PLAIN);
    }
#undef CV_DISPATCH
#undef CV_LOAD_PLAIN
#undef CV_LOAD_LORA
#undef CV_LOAD_UP
#undef CV_STORE_PLAIN
#undef CV_STORE_LORA
}
constexpr int CVQ = 8, CVQ_TASKS = (CV_TL + CVQ - 1) / CVQ;
__device__ __forceinline__ void conv_queue(const P& p, int ll, char* lds, int misc_off) {
    if (ll >= L) return;
    unsigned* head = (unsigned*)(p.ws + WS_CTL + 32768) + (2 * L + ll) * 64;
    volatile __attribute__((address_space(3))) unsigned* slot = (volatile __attribute__((address_space(3))) unsigned*)((__attribute__((address_space(3))) char*)lds + misc_off + 16);
    for (;;) {
        __syncthreads();
        if (TIDX == 0) *slot = __hip_atomic_fetch_add(head, 1u, __ATOMIC_RELAXED, __HIP_MEMORY_SCOPE_AGENT);
        __syncthreads();
        int t = __builtin_amdgcn_readfirstlane((int)*slot);
        if (t >= AD_PER_LAYER + CVQ_TASKS) break;
        if (t < AD_PER_LAYER) { fastp::adaln_unit(p, ll * AD_PER_LAYER + t, lds); continue; }
        t -= AD_PER_LAYER;
        const int lo = t * CVQ, hi = lo + CVQ < CV_TL ? lo + CVQ : CV_TL;
        layer_prep(p, ll, lo, hi, false, 0, 1, lds);
    }
}
struct Ctx { long gt, gt2, gs; PG8_LAS unsigned char* lds; };
template <int K> __device__ __forceinline__ void phase_body(const P& p, int l, const Ctx& c) {
    const long gt = c.gt, gt2 = c.gt2, gs = c.gs;
    act_t* wt = (act_t*)(p.ws + WS_WT);
    const act_t* w = wt + (size_t)l * WT_LAYER;
    const float* mod_l = (const float*)(p.ws + WS_MOD) + (size_t)l * NCOND * 6 * D;
    if constexpr (K == 0) {
        uint2* x = (uint2*)(p.ws + WS_X);
        for (long i = gt; i < (long)MTOK * D / 4; i += gs) { const float4 v = i < (long)MCTX * D / 4 ? ((const float4*)p.x_prompt)[i] : ((const float4*)p.x_sample)[i - (long)MCTX * D / 4]; x[i] = fastp::pk4(v.x, v.y, v.z, v.w); }
        float* rt = (float*)(p.ws + WS_ROPE);
        for (long i = gt; i < (long)DSEQ * (ROPE / 2); i += gs) { float cs, sn; rope_angle((int)(i / (ROPE / 2)), (int)(i % (ROPE / 2)), cs, sn); rt[2 * i] = cs; rt[2 * i + 1] = sn; }
        for (int u = blockIdx.x; u < AD_PER_LAYER; u += gridDim.x) fastp::adaln_unit(p, u, (char*)c.lds);
        layer_prep(p, 0, 0, CV_TL, false, (int)blockIdx.x, (int)gridDim.x, (char*)c.lds);
    }
    if constexpr (K == 1) fastp::norm_rows(p, l, 0);
    if constexpr (K == 2) { pg8::EpiBf16<0> E{(pg8::bf16_t*)(p.ws + WS_PP), INP, nullptr, 0, 0}; run_gemm(c.lds, (const act_t*)(p.ws + WS_H), w + WT_IN, MTOK, INP, D, E); }
    if constexpr (K == 3) fastp::prep_rows(p, l);
    if constexpr (K == 41) { pg8::EpiBf16<0> E{(pg8::bf16_t*)(p.ws + WS_QF), NQ, nullptr, 0, 0}; run_gemm(c.lds, (const act_t*)(p.ws + WS_CQN), w + WT_UQ, MTOK, NQ, QR, E); }
    if constexpr (K == 42) { pg8::EpiBf16<0> E{(pg8::bf16_t*)(p.ws + WS_KVUP), NKV, nullptr, 0, 0}; run_gemm(c.lds, (const act_t*)(p.ws + WS_CKVN), w + WT_UKV, MKV, NKV, KVR, E); }
    if constexpr (K == 43) { pg8::EpiBf16<0> E{(pg8::bf16_t*)(p.ws + WS_LORA), LORAN, nullptr, 0, 0}; run_gemm(c.lds, (const act_t*)(p.ws + WS_LIN), w + WT_LORA, MTOK, LORAN, LINK, E); }
    if constexpr (K == 46) { for (int rep = 0; rep < ((DUPMASK & 256) ? 2 : 1); ++rep) for (int u = (int)gridDim.x - 1 - (int)blockIdx.x; u < gdnc::NSLOT; u += gridDim.x) gdnc::prep_chunk(p, l, u, (char*)c.lds); }
    if constexpr (K == 45) { for (int rep = 0; rep < ((DUPMASK & 512) ? 2 : 1); ++rep) for (int u = blockIdx.x; u < rwkc::NSLOT; u += gridDim.x) rwkc::prep_chunk(p, l, u, (char*)c.lds); }
    if constexpr (K == 50) ph_mixers(p, l, (char*)c.lds, LDS_MISC);
    if constexpr (K == 52) ph_mixers(p, l, (char*)c.lds, LDS_MISC, 1);
    if constexpr (K == 53) conv_queue(p, l + 1, (char*)c.lds, LDS_MISC);
    if constexpr (K == 6) fastp::post_rows(p, l);
    if constexpr (K == 7) { EpiResid E{(unsigned short*)(p.ws + WS_X), D, mod_l, 2}; run_gemm(c.lds, (const act_t*)(p.ws + WS_YMIX), w + WT_OUT, MTOK, D, MIXW, E); }
    if constexpr (K == 8) fastp::norm_rows(p, l, 1);
    if constexpr (K == 9) { EpiFfnAct E{(pg8::bf16_t*)(p.ws + WS_ACT), (float*)(p.ws + WS_SIDE), p.ffn_conv + (size_t)l * 3 * DFF}; run_gemm(c.lds, (const act_t*)(p.ws + WS_H), w + WT_UP, MTOK, NUP, D, E); }
    if constexpr (K == 10) fastp::ffn_fix(p, l, gt, gs);
    if constexpr (K == 11) { EpiResid E{(unsigned short*)(p.ws + WS_X), D, mod_l, 5}; run_gemm(c.lds, (const act_t*)(p.ws + WS_ACT), w + WT_DOWN, MTOK, D, DFF, E); }
    if constexpr (K == 12) fastp::final_rows(p);
}
__device__ __forceinline__ Ctx make_ctx(PG8_LAS unsigned char* lds) {
    Ctx c; const int wv = TIDX >> 6, lane = TIDX & 63;
    c.gs = (long)gridDim.x * NTHR;
    c.gt = ((long)wv * gridDim.x + blockIdx.x) * 64 + lane;
    c.gt2 = (c.gt + c.gs / 2) % c.gs;
    c.lds = lds; return c;
}
#if N_LAUNCH_MODE == 1
template <int K> __device__ __forceinline__ void phase_site(int l, PG8_LAS unsigned char* lds) {
    const __attribute__((address_space(4))) P* kp = (const __attribute__((address_space(4))) P*)__builtin_amdgcn_kernarg_segment_ptr();
    asm volatile("" : "+s"(kp));
    P p;
#if defined(__HIP_DEVICE_COMPILE__)
    p = *kp;
#endif
    int tid = TIDX, bid = blockIdx.x, nb = gridDim.x;
    asm volatile("" : "+v"(tid), "+s"(bid), "+s"(nb));
    Ctx c; const int wv = tid >> 6, lane = tid & 63;
    c.gs = (long)nb * NTHR;
    c.gt = ((long)wv * nb + bid) * 64 + lane;
    c.gt2 = (c.gt + c.gs / 2) % c.gs;
    c.lds = lds;
    phase_body<K>(p, l, c);
}
#ifndef DUPMASK
#define DUPMASK 0
#endif
#define DUP(bit, ...) do { if (DUPMASK & (1 << (bit))) { __VA_ARGS__; } } while (0)
__device__ __forceinline__ void grid_bar(PG8_LAS unsigned char* lds) {
    const __attribute__((address_space(4))) P* kp = (const __attribute__((address_space(4))) P*)__builtin_amdgcn_kernarg_segment_ptr();
    asm volatile("" : "+s"(kp));
    XcdBarrier b; b.bar = (unsigned*)(kp->ws + WS_CTL); b.x = xb_xcc_id(); b.st = (volatile LAS unsigned*)(lds + LDS_MISC);
    xcd_barrier(b);
    if (DUPMASK & 2048) xcd_barrier(b);
}
__global__ void __launch_bounds__(NTHR, 2) fwd(Args a) {
    extern __shared__ __attribute__((aligned(16))) unsigned char lds_raw[];
    PG8_LAS unsigned char* lds = (PG8_LAS unsigned char*)lds_raw;
    volatile LAS unsigned* misc = (volatile LAS unsigned*)(lds + LDS_MISC);
    if (threadIdx.x < 4) misc[threadIdx.x] = 0u;
    if ((threadIdx.x & 63) == 0) *(volatile LAS int*)(lds + TID_TAB_OFF + 4 * hw_slot()) = (int)(threadIdx.x >> 6);
    __syncthreads();
    (void)xcd_barrier_post((unsigned*)(a.p.ws + WS_CTL), misc);
    phase_site<0>(0, lds); DUP(4, phase_site<0>(0, lds)); grid_bar(lds);
    for (int l = 0; l < L; ++l) {
        phase_site<1>(l, lds); DUP(0, phase_site<1>(l, lds)); grid_bar(lds);
        phase_site<2>(l, lds); DUP(1, phase_site<2>(l, lds)); grid_bar(lds);
        phase_site<3>(l, lds); DUP(0, phase_site<3>(l, lds)); grid_bar(lds);
        phase_site<41>(l, lds); phase_site<42>(l, lds); phase_site<43>(l, lds); DUP(1, phase_site<41>(l, lds); phase_site<42>(l, lds); phase_site<43>(l, lds)); phase_site<46>(l, lds); grid_bar(lds);
        phase_site<45>(l, lds); grid_bar(lds);
        phase_site<50>(l, lds); phase_site<53>(l, lds); DUP(10, grid_bar(lds); phase_site<52>(l, lds)); grid_bar(lds);
        phase_site<6>(l, lds); DUP(0, phase_site<6>(l, lds)); grid_bar(lds);
        phase_site<7>(l, lds); grid_bar(lds);
        phase_site<8>(l, lds); DUP(0, phase_site<8>(l, lds)); grid_bar(lds);
        phase_site<9>(l, lds); DUP(1, phase_site<9>(l, lds)); grid_bar(lds);
        phase_site<10>(l, lds); DUP(0, phase_site<10>(l, lds)); grid_bar(lds);
        phase_site<11>(l, lds); grid_bar(lds);
    }
    phase_site<12>(0, lds);
}
#endif


extern "C" void kernel_launch(void* const* d_in, const int* in_sizes, int n_in, void* d_out, int out_size, void* d_ws, size_t ws_size, hipStream_t stream) {
    static int grid = 0;
    if (grid == 0) {
        if (n_in != 37 || (size_t)out_size != O_END || ws_size < WS_END) { fprintf(stderr, "kernel_launch: unexpected sizes n_in %d out %d ws %zu (need %zu)\n", n_in, out_size, ws_size, (size_t)WS_END); grid = -1; return; }
        int dev = 0, cus = 0, per_cu = 0;
        if (hipGetDevice(&dev) != hipSuccess || hipDeviceGetAttribute(&cus, hipDeviceAttributeMultiprocessorCount, dev) != hipSuccess) { grid = -1; return; }
#if N_LAUNCH_MODE == 1
        bool ok = hipFuncSetAttribute((const void*)fwd, hipFuncAttributeMaxDynamicSharedMemorySize, LDS_BYTES) == hipSuccess;
        if (hipOccupancyMaxActiveBlocksPerMultiprocessor(&per_cu, (const void*)fwd, NTHR, LDS_BYTES) != hipSuccess || per_cu < 1) fprintf(stderr, "kernel_launch: occupancy query says %d\n", per_cu);
#endif
        if (!ok) { fprintf(stderr, "kernel_launch: hipFuncSetAttribute failed\n"); grid = -1; return; }
        (void)per_cu; (void)hipGetLastError();
        grid = cus;
    }
    if (grid < 0) return;
    (void)hipMemsetAsync((char*)d_ws + WS_CTL, 0, WS_CTL_BYTES, stream);
    Args a{};
    const float** pin = (const float**)&a.p;
    for (int i = 0; i < 37; ++i) pin[i] = (const float*)d_in[i];
    a.p.out = (float*)d_out; a.p.ws = (unsigned char*)d_ws;
    a.pad = 0;
#if N_LAUNCH_MODE == 1
    a.ph_lo = 0; a.ph_hi = N_PHASES; a.use_bar = 1;
    hipLaunchKernelGGL(fwd, dim3(grid), dim3(NTHR), LDS_BYTES, stream, a);
#endif
}
```

```cpp
#include <hip/hip_runtime.h>
#include <cstdio>
#define N_LAUNCH_MODE 1
#define DUPMASK 0
#define HD __device__ __attribute__((always_inline))
#define UNROLL _Pragma("unroll")
#define CBAR asm volatile("" ::: "memory")
#define ATT_SDEPTH 1
#define ATT_NQREG 6
constexpr int NTHR_ = 512;
typedef float4 f4;
HD inline f4 ldf4(const float* p) { return *(const float4*)p; }
constexpr int LDS_TOTAL_BYTES = 147456, TID_TAB_OFF = LDS_TOTAL_BYTES - 64 - 256;
__device__ __forceinline__ unsigned hw_slot() { return (unsigned)__builtin_amdgcn_s_getreg((5 << 11) | 4) & 63u; }
__device__ __forceinline__ int tidx_() {
    const int w = *(volatile __attribute__((address_space(3))) int*)(__attribute__((address_space(3))) char*)(unsigned long)(TID_TAB_OFF + 4u * hw_slot());
    int lane; asm volatile("v_mbcnt_lo_u32_b32 %0, -1, 0\n\tv_mbcnt_hi_u32_b32 %0, -1, %0" : "=v"(lane));
    return (__builtin_amdgcn_readfirstlane(w) << 6) | lane;
}
#define TIDX tidx_()
namespace cfg {
#ifdef SMALL_CFG
constexpr int D = 128, NB = 2, SEQ = 128, L = 2, NDB = 2, DSEQ = 256, PAST = 128, GRIDW = 16;
constexpr int AH = 2, AN = 64, DL = 16, IL = 16, GL = 32;
constexpr int BH = 2, QR = 64, KVR = 64, NOPE = 32, ROPE = 16, VD = 32;
constexpr int CH = 2, DK = 32, DV = 32, CHUNK = 64;
constexpr int DFF = 192;
#else
constexpr int D = 2048, NB = 16, SEQ = 256, L = 4, NDB = 2, DSEQ = 4096, PAST = 256, GRIDW = 64;
constexpr int AH = 8, AN = 64, DL = 64, IL = 64, GL = 128;
constexpr int BH = 8, QR = 512, KVR = 512, NOPE = 128, ROPE = 64, VD = 128;
constexpr int CH = 4, DK = 128, DV = 128, CHUNK = 64;
constexpr int DFF = 5632;
#endif
constexpr int AW = AH * AN, BW = BH * VD, CW = CH * DV, QKD = NOPE + ROPE, MIXW = AW + BW + CW;
constexpr int OFF_R = 0, OFF_K = AW, OFF_V = 2 * AW, OFF_WLO = 3 * AW, OFF_ALO = OFF_WLO + 2 * DL, OFF_GLO = OFF_ALO + 2 * IL,
              OFF_CQ = OFF_GLO + GL, OFF_CKV = OFF_CQ + QR, OFF_KPE = OFF_CKV + KVR, OFF_GQ = OFF_KPE + ROPE, OFF_GK = OFF_GQ + CH * DK,
              OFF_GV = OFF_GK + CH * DK, OFF_GZ = OFF_GV + CW, OFF_GB = OFF_GZ + CW, OFF_GA = OFF_GB + 2 * CH, INC = OFF_GA + 2 * CH;
constexpr int INP = (INC + 255) / 256 * 256;
constexpr int NSEQ = NB + NDB, MCTX = NB * SEQ, MLAT = NDB * DSEQ, MTOK = MCTX + MLAT, MKV = MTOK + NDB * PAST, NCOND = 1 + NDB;
constexpr int NQ = BH * QKD, NKV = BH * NOPE + BH * VD, NUP = 2 * DFF, GC = 2 * CH * DK + CW;
constexpr int LINK = 2 * DL + 2 * IL + GL, LORAN = 5 * AW;
constexpr float RMS_EPS = 1e-6f, LNX_EPS = 64e-5f, L2_EPS = 1e-6f, ROPE_BASE = 10000.0f;
}
using namespace cfg;

#ifdef HOSTEMU
typedef float act_t;
struct act2 { float x, y; };
HD inline float a2f(act_t a) { return a; }
HD inline act_t f2a(float f) { return f; }
HD inline act2 ld2(const act_t* p) { act2 r; r.x = p[0]; r.y = p[1]; return r; }
HD inline act2 mk2(float x, float y) { act2 r; r.x = x; r.y = y; return r; }
HD inline float dot2(act2 a, act2 b, float c) { return c + a.x * b.x + a.y * b.y; }
HD inline float lo2(act2 a) { return a.x; }
HD inline float hi2(act2 a) { return a.y; }
#else
typedef unsigned short act_t;
typedef unsigned act2;
HD inline float a2f(act_t a) { return __uint_as_float(((unsigned)a) << 16); }
HD inline act_t f2a(float f) { unsigned u = __float_as_uint(f); return (act_t)((u + 0x7fffu + ((u >> 16) & 1u)) >> 16); }
HD inline act2 ld2(const act_t* p) { return *(const unsigned*)p; }
HD inline act2 mk2(float x, float y) { return (unsigned)f2a(x) | ((unsigned)f2a(y) << 16); }
HD inline float lo2(act2 a) { return __uint_as_float(a << 16); }
HD inline float hi2(act2 a) { return __uint_as_float(a & 0xffff0000u); }
typedef __bf16 bf16x2_t __attribute__((ext_vector_type(2)));
HD inline float dot2(act2 a, act2 b, float c) { return __builtin_amdgcn_fdot2_f32_bf16(__builtin_bit_cast(bf16x2_t, a), __builtin_bit_cast(bf16x2_t, b), c, false); }
HD inline float ldp1(const act_t* p) { return a2f(*p); }
HD inline float2 ldp2(const act_t* p) { const unsigned u = *(const unsigned*)p; return make_float2(lo2(u), hi2(u)); }
HD inline float4 ldp4(const act_t* p) { const uint2 u = *(const uint2*)p; return make_float4(lo2(u.x), hi2(u.x), lo2(u.y), hi2(u.y)); }
#endif

struct P {
    const float *x_prompt, *x_sample, *state_rwkv, *state_gdn, *cache_ckv, *cache_kpe, *c, *c_ctx, *ada_w, *ada_b, *norm1_g, *w_in,
        *rwkv_w0, *rwkv_w2, *rwkv_a0, *rwkv_a2, *rwkv_g2, *rwkv_kk, *rwkv_ka, *rwkv_rk, *rwkv_lnx_g, *rwkv_lnx_b, *mla_qnorm_g, *mla_w_uq,
        *mla_kvnorm_g, *mla_w_uk, *mla_w_uv, *gdn_conv, *gdn_a_log, *gdn_dt_bias, *gdn_norm_g, *w_out, *norm2_g, *ffn_up, *ffn_conv, *ffn_down,
        *final_norm_g;
    float* out;
    unsigned char* ws;
};

constexpr size_t O_YP = 0, O_YS = O_YP + (size_t)MCTX * D, O_SR = O_YS + (size_t)MLAT * D, O_SG = O_SR + (size_t)NB * L * 2 * AH * AN * AN,
                 O_CK = O_SG + (size_t)NB * L * 2 * CH * DK * DV, O_KP = O_CK + (size_t)NB * L * SEQ * KVR, O_END = O_KP + (size_t)NB * L * SEQ * ROPE;

constexpr size_t al256(size_t x) { return (x + 255) / 256 * 256; }
constexpr size_t WS_CTL = 0, WS_CTL_BYTES = 64 * 1024;
constexpr size_t WS_MOD = WS_CTL + WS_CTL_BYTES;
constexpr size_t WS_ROPE = al256(WS_MOD + (size_t)L * NCOND * 6 * D * 4);
constexpr size_t WS_X = al256(WS_ROPE + (size_t)DSEQ * ROPE * 4);
constexpr size_t WS_H = al256(WS_X + (size_t)MTOK * D * 4);
constexpr size_t WS_YMIX = al256(WS_H + (size_t)MTOK * D * sizeof(act_t));
constexpr size_t WT_IN = 0, WT_UQ = WT_IN + (size_t)INP * D, WT_UKV = WT_UQ + (size_t)NQ * QR, WT_OUT = WT_UKV + (size_t)NKV * KVR,
                 WT_UP = WT_OUT + (size_t)D * MIXW, WT_DOWN = WT_UP + (size_t)NUP * D, WT_LORA = WT_DOWN + (size_t)D * DFF, WT_LAYER = WT_LORA + (size_t)LORAN * LINK;
constexpr size_t WS_WT = al256(WS_YMIX + (size_t)MTOK * MIXW * sizeof(act_t));
constexpr size_t WS_U0 = al256(WS_WT + (size_t)L * WT_LAYER * 2);
constexpr size_t WS_PP = WS_U0;
#ifdef HOSTEMU
constexpr size_t WS_RWDEC = al256(WS_PP + (size_t)MTOK * INP * 4);
constexpr size_t WS_RWKDIR = al256(WS_RWDEC + (size_t)MTOK * 2 * AW * 4);
constexpr size_t WS_RWKKA = al256(WS_RWKDIR + (size_t)MTOK * 2 * AW * 4);
constexpr size_t WS_RWKK = al256(WS_RWKKA + (size_t)MTOK * 2 * AW * 4);
#ifdef HOSTEMU
constexpr size_t WS_RWG = al256(WS_RWKK + (size_t)MTOK * AW * 4);
constexpr size_t WS_RWY = al256(WS_RWG + (size_t)MTOK * AW * 4);
#else
constexpr size_t WS_RWY = al256(WS_RWKK + (size_t)MTOK * AW * 4);
constexpr size_t WS_RWG = WS_H;
#endif
constexpr size_t WS_CQN = al256(WS_RWY + (size_t)MTOK * 2 * AW * 4);
constexpr size_t WS_CKVN = al256(WS_CQN + (size_t)MTOK * QR * sizeof(act_t));
constexpr size_t WS_KR = al256(WS_CKVN + (size_t)MKV * KVR * sizeof(act_t));
constexpr size_t WS_QF = al256(WS_KR + (size_t)MKV * ROPE * sizeof(act_t));
constexpr size_t WS_KVUP = al256(WS_QF + (size_t)MTOK * NQ * sizeof(act_t));
constexpr size_t WS_GBG = al256(WS_KVUP + (size_t)MKV * NKV * sizeof(act_t));
constexpr size_t WS_GO = al256(WS_GBG + (size_t)MTOK * 2 * CH * 4 * 4);
constexpr size_t WS_GCONV = al256(WS_GO + (size_t)MTOK * 2 * CW * 4);
constexpr size_t WS_LIN = al256(WS_GCONV + (size_t)MTOK * GC * 4);
constexpr size_t WS_LORA = al256(WS_LIN + (size_t)MTOK * LINK * sizeof(act_t));
constexpr size_t WS_GCH = al256(WS_LORA + (size_t)MTOK * LORAN * 4);
constexpr size_t WS_RCH = WS_GCONV;
static_assert((size_t)(MTOK / 64) * 2 * AH * 65792 <= WS_GCH - WS_GCONV, "RWKV chunk slots must fit the dead prep buffers");
constexpr size_t WS_MIX_END = al256(WS_GCH + (size_t)(MTOK / 64) * 2 * CH * 73984);
#else
constexpr size_t WS_RWB = al256(WS_PP + (size_t)MTOK * INP * 4);
constexpr size_t WS_RWY = al256(WS_RWB + (size_t)MTOK * 2 * AH * 4);
constexpr size_t WS_RWG = WS_H;
constexpr size_t WS_CQN = al256(WS_RWY + (size_t)MTOK * 2 * AW * 4);
constexpr size_t WS_CKVN = al256(WS_CQN + (size_t)MTOK * QR * sizeof(act_t));
constexpr size_t WS_KR = al256(WS_CKVN + (size_t)MKV * KVR * sizeof(act_t));
constexpr size_t WS_QF = al256(WS_KR + (size_t)MKV * ROPE * sizeof(act_t));
constexpr size_t WS_KVUP = al256(WS_QF + (size_t)MTOK * NQ * sizeof(act_t));
constexpr size_t WS_GBG = al256(WS_KVUP + (size_t)MKV * NKV * sizeof(act_t));
constexpr size_t WS_GO = al256(WS_GBG + (size_t)MTOK * 2 * CH * 4 * 4);
constexpr size_t WS_LORA = al256(WS_GO + (size_t)MTOK * 2 * CW * 4);
constexpr size_t WS_GCH = al256(WS_LORA + (size_t)MTOK * LORAN * 4);
constexpr size_t WS_GCONV = al256(WS_GCH + (size_t)(MTOK / 64) * 2 * CH * 73984);
constexpr size_t WS_LIN = al256(WS_GCONV + (size_t)MTOK * GC * 4);
constexpr size_t WS_RCH = WS_GCONV;
constexpr size_t WS_MIX_END = al256(WS_RCH + (size_t)(MTOK / 64) * 2 * AH * 65792);
static_assert(WS_LIN + (size_t)MTOK * LINK * sizeof(act_t) <= WS_MIX_END, "LoRA inputs inside the RWKV slot region");
constexpr size_t WS_RWDEC = WS_RWY, WS_RWKDIR = WS_RWY, WS_RWKKA = WS_RWY, WS_RWKK = WS_RWY;
#endif
constexpr size_t WS_UP = WS_U0;
constexpr size_t WS_ACT = al256(WS_UP + (size_t)MTOK * NUP * sizeof(act_t));
constexpr size_t WS_FFN_END = al256(WS_ACT + (size_t)MTOK * DFF * sizeof(act_t));
constexpr size_t WS_SIDE = WS_MIX_END > WS_FFN_END ? WS_MIX_END : WS_FFN_END;
constexpr size_t WS_END = WS_SIDE + (size_t)(MTOK / 64) * 6 * DFF * 4;

HD inline int seq_of(int m) { return m < MCTX ? m / SEQ : NB + (m - MCTX) / DSEQ; }
HD inline int seq_start(int s) { return s < NB ? s * SEQ : MCTX + (s - NB) * DSEQ; }
HD inline int seq_len(int s) { return s < NB ? SEQ : DSEQ; }
HD inline int cond_of_seq(int s) { return s < NB ? 0 : 1 + (s - NB); }
#ifdef HOSTEMU
HD inline float fexp_(float x) { return expf(x); }
HD inline float sigmoidf_(float x) { return 1.0f / (1.0f + expf(-x)); }
HD inline float siluf_(float x) { return x / (1.0f + expf(-x)); }
HD inline float softplusf_(float x) { return fmaxf(x, 0.0f) + log1pf(expf(-fabsf(x))); }
HD inline float ftanh_(float x) { return tanhf(x); }
#else
HD inline float fexp_(float x) { return __builtin_amdgcn_exp2f(x * 1.4426950408889634f); }
HD inline float sigmoidf_(float x) { return __builtin_amdgcn_rcpf(1.0f + fexp_(-x)); }
HD inline float siluf_(float x) { return x * sigmoidf_(x); }
HD inline float softplusf_(float x) { return fmaxf(x, 0.0f) + 0.6931471805599453f * __builtin_amdgcn_logf(1.0f + fexp_(-fabsf(x))); }
HD inline float ftanh_(float x) { return 2.0f * sigmoidf_(2.0f * x) - 1.0f; }
#endif
HD inline const float* modp(const P& p, int l, int cond, int which) { return (const float*)(p.ws + WS_MOD) + ((size_t)(l * NCOND + cond) * 6 + which) * D; }

HD inline void rope_angle(int t, int i, float& cs, float& sn) {
    const int nf = ROPE / 4; const int row = t / GRIDW, col = t % GRIDW;
    const int f = i < nf ? i : i - nf;
    const float inv = powf(ROPE_BASE, -(float)f / (float)nf);
    const float ang = (float)(i < nf ? row : col) * inv;
    cs = cosf(ang); sn = sinf(ang);
}
HD inline void ph_init(const P& p, long gt, long gs) {
    float* x = (float*)(p.ws + WS_X);
    for (long i = gt; i < (long)MTOK * D; i += gs) x[i] = i < (long)MCTX * D ? p.x_prompt[i] : p.x_sample[i - (long)MCTX * D];
    float* rt = (float*)(p.ws + WS_ROPE);
    for (long i = gt; i < (long)DSEQ * (ROPE / 2); i += gs) { float cs, sn; rope_angle((int)(i / (ROPE / 2)), (int)(i % (ROPE / 2)), cs, sn); rt[2 * i] = cs; rt[2 * i + 1] = sn; }
    float* mod = (float*)(p.ws + WS_MOD);
    for (long idx = gt; idx < (long)L * 6 * D; idx += gs) {
        const int l = (int)(idx / (6 * D)), j = (int)(idx % (6 * D));
        float acc[NCOND];
        UNROLL for (int c = 0; c < NCOND; ++c) acc[c] = 0.f;
        for (int i = 0; i < D; ++i) {
            const float w = p.ada_w[((size_t)l * D + i) * 6 * D + j];
            acc[0] += siluf_(p.c_ctx[i]) * w;
            UNROLL for (int c = 1; c < NCOND; ++c) acc[c] += siluf_(p.c[(size_t)(c - 1) * D + i]) * w;
        }
        const float b = p.ada_b[(size_t)l * 6 * D + j];
        UNROLL for (int c = 0; c < NCOND; ++c) mod[((size_t)(l * NCOND + c) * 6) * D + j] = acc[c] + b;
    }
}

HD inline void ph_norm(const P& p, int l, int which, long gt, long gs) {
    const float* x = (const float*)(p.ws + WS_X);
    act_t* h = (act_t*)(p.ws + WS_H);
    const float* g = (which == 0 ? p.norm1_g : p.norm2_g) + (size_t)l * D;
    for (long m = gt; m < MTOK; m += gs) {
        const int cond = cond_of_seq(seq_of((int)m));
        const float* sh = modp(p, l, cond, which * 3 + 0);
        const float* sc = modp(p, l, cond, which * 3 + 1);
        const float* xr = x + (size_t)m * D;
        float ss = 0.f;
        for (int j = 0; j < D; ++j) ss += xr[j] * xr[j];
        const float rs = 1.0f / sqrtf(ss / D + RMS_EPS);
        for (int j = 0; j < D; ++j) h[(size_t)m * D + j] = f2a(xr[j] * rs * g[j] * (1.0f + sc[j]) + sh[j]);
    }
}

HD inline void ph_rwkv_prep(const P& p, int l, long gt, long gs) {
    const float* pp = (const float*)(p.ws + WS_PP);
    float* dec = (float*)(p.ws + WS_RWDEC); float* kdir = (float*)(p.ws + WS_RWKDIR); float* kka = (float*)(p.ws + WS_RWKKA);
    float* kkb = (float*)(p.ws + WS_RWKK); float* gb = (float*)(p.ws + WS_RWG);
    for (long idx = gt; idx < (long)MTOK * AW; idx += gs) {
        const int m = (int)(idx / AW), c = (int)(idx % AW), h = c / AN;
        const float* pr = pp + (size_t)m * INP;
        const float* kksc = p.rwkv_kk + (size_t)l * AW;
        float ss = 0.f;
        for (int j = 0; j < AN; ++j) { const float t = pr[OFF_K + h * AN + j] * kksc[h * AN + j]; ss += t * t; }
        const float kraw = pr[OFF_K + c];
        const float kk = kraw * kksc[c] / sqrtf(ss + L2_EPS);
        kkb[(size_t)m * AW + c] = kk;
        for (int d = 0; d < 2; ++d) {
            float wpre = p.rwkv_w0[((size_t)l * 2 + d) * AW + c];
            for (int r = 0; r < DL; ++r) wpre += tanhf(pr[OFF_WLO + d * DL + r]) * p.rwkv_w2[(((size_t)l * 2 + d) * DL + r) * AW + c];
            const float logw = -expf(-softplusf_(-wpre) - 0.5f);
            float apre = p.rwkv_a0[((size_t)l * 2 + d) * AW + c];
            for (int r = 0; r < IL; ++r) apre += pr[OFF_ALO + d * IL + r] * p.rwkv_a2[(((size_t)l * 2 + d) * IL + r) * AW + c];
            const float a = sigmoidf_(apre);
            const size_t o = ((size_t)m * 2 + d) * AW + c;
            dec[o] = expf(logw);
            kdir[o] = kraw * (1.0f + (a - 1.0f) * p.rwkv_ka[(size_t)l * AW + c]);
            kka[o] = kk * a;
        }
        float g = 0.f;
        for (int r = 0; r < GL; ++r) g += sigmoidf_(pr[OFF_GLO + r]) * p.rwkv_g2[((size_t)l * GL + r) * AW + c];
        gb[(size_t)m * AW + c] = g;
    }
}

HD inline void ph_rwkv_scan(const P& p, int l, long gt, long gs) {
    const float* pp = (const float*)(p.ws + WS_PP);
    const float* dec = (const float*)(p.ws + WS_RWDEC); const float* kdir = (const float*)(p.ws + WS_RWKDIR); const float* kka = (const float*)(p.ws + WS_RWKKA);
    const float* kkb = (const float*)(p.ws + WS_RWKK); float* yb = (float*)(p.ws + WS_RWY);
    for (long idx = gt; idx < (long)NSEQ * 2 * AH * AN; idx += gs) {
        const int i = (int)(idx % AN), h = (int)((idx / AN) % AH), d = (int)((idx / (AN * AH)) % 2), s = (int)(idx / (AN * AH * 2));
        float S[AN];
        if (s >= NB) { const float* s0 = p.state_rwkv + (((((size_t)(s - NB) * L + l) * 2 + d) * AH + h) * AN + i) * AN; UNROLL for (int k = 0; k < AN; ++k) S[k] = s0[k]; }
        else { UNROLL for (int k = 0; k < AN; ++k) S[k] = 0.f; }
        const int T = seq_len(s), base = seq_start(s);
        for (int step = 0; step < T; ++step) {
            const int m = base + (d == 0 ? step : T - 1 - step);
            const float* pr = pp + (size_t)m * INP;
            const float* kk = kkb + (size_t)m * AW + h * AN;
            const size_t o = ((size_t)m * 2 + d) * AW + h * AN;
            float sa = 0.f;
            UNROLL for (int k = 0; k < AN; k += 4) { const f4 t = ldf4(kk + k); sa -= S[k] * t.x + S[k + 1] * t.y + S[k + 2] * t.z + S[k + 3] * t.w; }
            const float vi = pr[OFF_V + h * AN + i];
            float y = 0.f;
            UNROLL for (int k = 0; k < AN; k += 4) {
                const f4 w4 = ldf4(dec + o + k), a4 = ldf4(kka + o + k), k4 = ldf4(kdir + o + k), r4 = ldf4(pr + OFF_R + h * AN + k);
                S[k] = S[k] * w4.x + sa * a4.x + vi * k4.x; y += S[k] * r4.x;
                S[k + 1] = S[k + 1] * w4.y + sa * a4.y + vi * k4.y; y += S[k + 1] * r4.y;
                S[k + 2] = S[k + 2] * w4.z + sa * a4.z + vi * k4.z; y += S[k + 2] * r4.z;
                S[k + 3] = S[k + 3] * w4.w + sa * a4.w + vi * k4.w; y += S[k + 3] * r4.w;
            }
            yb[o + i] = y;
        }
        if (s < NB) { float* so = p.out + O_SR + (((((size_t)s * L + l) * 2 + d) * AH + h) * AN + i) * AN; UNROLL for (int k = 0; k < AN; ++k) so[k] = S[k]; }
    }
}

HD inline void ph_rwkv_post(const P& p, int l, long gt, long gs) {
    const float* pp = (const float*)(p.ws + WS_PP);
    const float* kdir = (const float*)(p.ws + WS_RWKDIR); const float* gb = (const float*)(p.ws + WS_RWG); const float* yb = (const float*)(p.ws + WS_RWY);
    act_t* ymix = (act_t*)(p.ws + WS_YMIX);
    for (long idx = gt; idx < (long)MTOK * AW; idx += gs) {
        const int m = (int)(idx / AW), c = (int)(idx % AW), h = c / AN;
        const float* pr = pp + (size_t)m * INP;
        const float* y0 = yb + ((size_t)m * 2 + 0) * AW + h * AN; const float* y1 = yb + ((size_t)m * 2 + 1) * AW + h * AN;
        float mu = 0.f;
        for (int j = 0; j < AN; ++j) mu += y0[j] + y1[j];
        mu /= AN;
        float var = 0.f;
        for (int j = 0; j < AN; ++j) { const float t = y0[j] + y1[j] - mu; var += t * t; }
        var /= AN;
        const float yc = yb[((size_t)m * 2 + 0) * AW + c] + yb[((size_t)m * 2 + 1) * AW + c];
        float y = (yc - mu) / sqrtf(var + LNX_EPS) * p.rwkv_lnx_g[(size_t)l * AW + c] + p.rwkv_lnx_b[(size_t)l * AW + c];
        float bon = 0.f;
        for (int d = 0; d < 2; ++d) for (int j = 0; j < AN; ++j)
            bon += pr[OFF_R + h * AN + j] * kdir[((size_t)m * 2 + d) * AW + h * AN + j] * p.rwkv_rk[((size_t)l * AH + h) * AN + j];
        y += bon * pr[OFF_V + c];
        ymix[(size_t)m * MIXW + c] = f2a(y * gb[(size_t)m * AW + c]);
    }
}

HD inline void ph_mla_prep(const P& p, int l, long gt, long gs) {
    const float* pp = (const float*)(p.ws + WS_PP);
    act_t* cqn = (act_t*)(p.ws + WS_CQN); act_t* ckvn = (act_t*)(p.ws + WS_CKVN); act_t* kr = (act_t*)(p.ws + WS_KR);
    for (long m = gt; m < MKV; m += gs) {
        if (m < MTOK) {
            const float* pr = pp + (size_t)m * INP;
            const int s = seq_of((int)m), t = (int)m - seq_start(s);
            float ss = 0.f;
            for (int j = 0; j < QR; ++j) ss += pr[OFF_CQ + j] * pr[OFF_CQ + j];
            float rs = 1.0f / sqrtf(ss / QR + RMS_EPS);
            for (int j = 0; j < QR; ++j) cqn[(size_t)m * QR + j] = f2a(pr[OFF_CQ + j] * rs * p.mla_qnorm_g[(size_t)l * QR + j]);
            ss = 0.f;
            for (int j = 0; j < KVR; ++j) ss += pr[OFF_CKV + j] * pr[OFF_CKV + j];
            rs = 1.0f / sqrtf(ss / KVR + RMS_EPS);
            for (int j = 0; j < KVR; ++j) {
                const float v = pr[OFF_CKV + j] * rs * p.mla_kvnorm_g[(size_t)l * KVR + j];
                ckvn[(size_t)m * KVR + j] = f2a(v);
                if (s < NB) p.out[O_CK + (((size_t)s * L + l) * SEQ + t) * KVR + j] = v;
            }
            if (s < NB) {
                for (int j = 0; j < ROPE; ++j) { const float v = pr[OFF_KPE + j]; kr[(size_t)m * ROPE + j] = f2a(v); p.out[O_KP + (((size_t)s * L + l) * SEQ + t) * ROPE + j] = v; }
            } else {
                for (int i = 0; i < ROPE / 2; ++i) {
                    float cs, sn; rope_angle(t, i, cs, sn);
                    const float xe = pr[OFF_KPE + 2 * i], xo = pr[OFF_KPE + 2 * i + 1];
                    kr[(size_t)m * ROPE + 2 * i] = f2a(xe * cs - xo * sn); kr[(size_t)m * ROPE + 2 * i + 1] = f2a(xe * sn + xo * cs);
                }
            }
        } else {
            const int r = (int)m - MTOK, b = r / PAST, j0 = r % PAST;
            const float* ck = p.cache_ckv + (((size_t)b * L + l) * PAST + j0) * KVR;
            for (int j = 0; j < KVR; ++j) ckvn[(size_t)m * KVR + j] = f2a(ck[j]);
            const float* kp = p.cache_kpe + (((size_t)b * L + l) * PAST + j0) * ROPE;
            for (int j = 0; j < ROPE; ++j) kr[(size_t)m * ROPE + j] = f2a(kp[j]);
        }
    }
}

constexpr int VSL = 32, NVS = VD / VSL;
HD inline void ph_attn(const P& p, int l, long gt, long gs) {
    (void)l;
    const act_t* qf = (const act_t*)(p.ws + WS_QF); const act_t* kvup = (const act_t*)(p.ws + WS_KVUP); const act_t* kr = (const act_t*)(p.ws + WS_KR);
    act_t* ymix = (act_t*)(p.ws + WS_YMIX);
    const float scale = 1.0f / sqrtf((float)QKD);
    for (long idx = gt; idx < (long)MTOK * BH * NVS; idx += gs) {
        const int m = (int)(idx % MTOK), vs = (int)((idx / MTOK) % NVS), h = (int)(idx / ((long)MTOK * NVS));
        const int s = seq_of(m), base = seq_start(s), t = m - base, T = seq_len(s);
        const bool lat = s >= NB;
        act2 q[QKD / 2];
        const act_t* qr = qf + (size_t)m * NQ + h * QKD;
        UNROLL for (int i = 0; i < NOPE / 2; ++i) q[i] = ld2(qr + 2 * i);
        UNROLL for (int i = 0; i < ROPE / 2; ++i) {
            const act2 v = ld2(qr + NOPE + 2 * i);
            if (lat) { float cs, sn; rope_angle(t, i, cs, sn); const float xe = lo2(v), xo = hi2(v); q[NOPE / 2 + i] = mk2(xe * cs - xo * sn, xe * sn + xo * cs); }
            else q[NOPE / 2 + i] = v;
        }
        float mx = -1e30f, sum = 0.f, acc[VSL];
        UNROLL for (int e = 0; e < VSL; ++e) acc[e] = 0.f;
        const int nk = T + (lat ? PAST : 0);
        for (int j = 0; j < nk; ++j) {
            const size_t krow = j < T ? (size_t)(base + j) : (size_t)(MTOK + (s - NB) * PAST + (j - T));
            const act_t* kn = kvup + krow * NKV + h * NOPE;
            const act_t* kp = kr + krow * ROPE;
            float sc = 0.f;
            UNROLL for (int i = 0; i < NOPE / 2; ++i) { if ((i & 15) == 0) CBAR; sc = dot2(q[i], ld2(kn + 2 * i), sc); }
            UNROLL for (int i = 0; i < ROPE / 2; ++i) { if ((i & 15) == 0) CBAR; sc = dot2(q[NOPE / 2 + i], ld2(kp + 2 * i), sc); }
            CBAR;
            sc *= scale;
            if (sc > mx) { const float corr = expf(mx - sc); sum *= corr; UNROLL for (int e = 0; e < VSL; ++e) acc[e] *= corr; mx = sc; }
            const float pe = expf(sc - mx);
            sum += pe;
            const act_t* vv = kvup + krow * NKV + BH * NOPE + h * VD + vs * VSL;
            UNROLL for (int e = 0; e < VSL; e += 2) { const act2 v2 = ld2(vv + e); acc[e] += pe * lo2(v2); acc[e + 1] += pe * hi2(v2); }
        }
        const float inv = 1.0f / sum;
        UNROLL for (int e = 0; e < VSL; ++e) ymix[(size_t)m * MIXW + AW + h * VD + vs * VSL + e] = f2a(acc[e] * inv);
    }
}

HD inline void ph_gdn_conv(const P& p, int l, long gt, long gs) {
    const float* pp = (const float*)(p.ws + WS_PP);
    float* gc = (float*)(p.ws + WS_GCONV);
    for (long idx = gt; idx < (long)MTOK * GC; idx += gs) {
        const int m = (int)(idx / GC), c = (int)(idx % GC);
        const int s = seq_of(m), base = seq_start(s), t = m - base, T = seq_len(s);
        const float* w = p.gdn_conv + (size_t)l * 3 * GC;
        float a = w[GC + c] * pp[(size_t)m * INP + OFF_GQ + c];
        if (t > 0) a += w[c] * pp[(size_t)(m - 1) * INP + OFF_GQ + c];
        if (t < T - 1) a += w[2 * GC + c] * pp[(size_t)(m + 1) * INP + OFF_GQ + c];
        gc[(size_t)m * GC + c] = siluf_(a);
    }
}
HD inline void ph_gdn_norm(const P& p, int l, long gt, long gs) {
    const float* pp = (const float*)(p.ws + WS_PP);
    float* gc = (float*)(p.ws + WS_GCONV); float* bg = (float*)(p.ws + WS_GBG);
    for (long idx = gt; idx < (long)MTOK * 4 * CH; idx += gs) {
        const int m = (int)(idx / (4 * CH)), j = (int)(idx % (4 * CH));
        if (j < 2 * CH) {
            float* v = gc + (size_t)m * GC + j * DK;
            float ss = 0.f;
            for (int e = 0; e < DK; ++e) ss += v[e] * v[e];
            const float rs = (1.0f / sqrtf(ss + L2_EPS)) * (j < CH ? 1.0f / sqrtf((float)DK) : 1.0f);
            for (int e = 0; e < DK; ++e) v[e] *= rs;
        } else {
            const int dh = j - 2 * CH;
            const float* pr = pp + (size_t)m * INP;
            const float beta = sigmoidf_(pr[OFF_GB + dh]);
            const float g = -expf(p.gdn_a_log[(size_t)l * 2 * CH + dh]) * softplusf_(pr[OFF_GA + dh] + p.gdn_dt_bias[(size_t)l * 2 * CH + dh]);
            bg[((size_t)m * 2 * CH + dh) * 4 + 0] = beta; bg[((size_t)m * 2 * CH + dh) * 4 + 1] = g;
        }
    }
}
HD inline void ph_gdn_scan(const P& p, int l, long gt, long gs) {
    const float* gc = (const float*)(p.ws + WS_GCONV); const float* bg = (const float*)(p.ws + WS_GBG); float* go = (float*)(p.ws + WS_GO);
    for (long idx = gt; idx < (long)NSEQ * 2 * CH * DV; idx += gs) {
        const int e = (int)(idx % DV), h = (int)((idx / DV) % CH), d = (int)((idx / (DV * CH)) % 2), s = (int)(idx / (DV * CH * 2));
        float S[DK];
        if (s >= NB) { const float* s0 = p.state_gdn + ((((size_t)(s - NB) * L + l) * 2 + d) * CH + h) * DK * DV + e; UNROLL for (int k = 0; k < DK; ++k) S[k] = s0[(size_t)k * DV]; }
        else { UNROLL for (int k = 0; k < DK; ++k) S[k] = 0.f; }
        const int T = seq_len(s), base = seq_start(s);
        for (int step = 0; step < T; ++step) {
            const int m = base + (d == 0 ? step : T - 1 - step);
            const float* q = gc + (size_t)m * GC + h * DK; const float* k = gc + (size_t)m * GC + CH * DK + h * DK;
            const float v = gc[(size_t)m * GC + 2 * CH * DK + h * DV + e];
            const float beta = bg[((size_t)m * 2 * CH + d * CH + h) * 4 + 0], eg = expf(bg[((size_t)m * 2 * CH + d * CH + h) * 4 + 1]);
            float kS = 0.f;
            UNROLL for (int j = 0; j < DK; j += 4) { if ((j & 15) == 0) CBAR; const f4 t = ldf4(k + j); kS += t.x * S[j] + t.y * S[j + 1] + t.z * S[j + 2] + t.w * S[j + 3]; }
            const float coef = beta * (v - eg * kS);
            float o = 0.f;
            UNROLL for (int j = 0; j < DK; j += 4) {
                if ((j & 15) == 0) CBAR;
                const f4 t = ldf4(k + j), u = ldf4(q + j);
                S[j] = eg * S[j] + t.x * coef; o += u.x * S[j];
                S[j + 1] = eg * S[j + 1] + t.y * coef; o += u.y * S[j + 1];
                S[j + 2] = eg * S[j + 2] + t.z * coef; o += u.z * S[j + 2];
                S[j + 3] = eg * S[j + 3] + t.w * coef; o += u.w * S[j + 3];
            }
            go[((size_t)m * 2 + d) * CW + h * DV + e] = o;
        }
        if (s < NB) { float* so = p.out + O_SG + ((((size_t)s * L + l) * 2 + d) * CH + h) * DK * DV + e; UNROLL for (int k = 0; k < DK; ++k) so[(size_t)k * DV] = S[k]; }
    }
}
HD inline void ph_gdn_post(const P& p, int l, long gt, long gs) {
    const float* pp = (const float*)(p.ws + WS_PP); const float* go = (const float*)(p.ws + WS_GO);
    act_t* ymix = (act_t*)(p.ws + WS_YMIX);
    for (long idx = gt; idx < (long)MTOK * CH; idx += gs) {
        const int m = (int)(idx / CH), h = (int)(idx % CH);
        const float* o0 = go + ((size_t)m * 2 + 0) * CW + h * DV; const float* o1 = go + ((size_t)m * 2 + 1) * CW + h * DV;
        float ss = 0.f;
        for (int e = 0; e < DV; ++e) { const float t = o0[e] + o1[e]; ss += t * t; }
        const float rs = 1.0f / sqrtf(ss / DV + RMS_EPS);
        for (int e = 0; e < DV; ++e) {
            const float z = pp[(size_t)m * INP + OFF_GZ + h * DV + e];
            ymix[(size_t)m * MIXW + AW + BW + h * DV + e] = f2a((o0[e] + o1[e]) * rs * p.gdn_norm_g[(size_t)l * DV + e] * siluf_(z));
        }
    }
}
HD inline void ph_ffn_act(const P& p, int l, long gt, long gs) {
    const act_t* up = (const act_t*)(p.ws + WS_UP); act_t* act = (act_t*)(p.ws + WS_ACT);
    for (long idx = gt; idx < (long)MTOK * DFF; idx += gs) {
        const int m = (int)(idx / DFF), c = (int)(idx % DFF);
        const int s = seq_of(m), base = seq_start(s), t = m - base, T = seq_len(s);
        const float* w = p.ffn_conv + (size_t)l * 3 * DFF;
        float a = w[DFF + c] * a2f(up[(size_t)m * NUP + c]);
        if (t > 0) a += w[c] * a2f(up[(size_t)(m - 1) * NUP + c]);
        if (t < T - 1) a += w[2 * DFF + c] * a2f(up[(size_t)(m + 1) * NUP + c]);
        act[(size_t)m * DFF + c] = f2a(siluf_(a) * a2f(up[(size_t)m * NUP + DFF + c]));
    }
}
HD inline void ph_final(const P& p, long gt, long gs) {
    const float* x = (const float*)(p.ws + WS_X);
    for (long m = gt; m < MTOK; m += gs) {
        const float* xr = x + (size_t)m * D;
        float ss = 0.f;
        for (int j = 0; j < D; ++j) ss += xr[j] * xr[j];
        const float rs = 1.0f / sqrtf(ss / D + RMS_EPS);
        for (int j = 0; j < D; ++j) p.out[O_YP + (size_t)m * D + j] = xr[j] * rs * p.final_norm_g[j];
    }
}
HD inline void ph_gemm_naive(const P& p, const act_t* A, int lda, const float* W, int ldw, int M, int N, int K, int mode, float* Cf, act_t* Ca, int ldc, int l, int which,
                             long gt, long gs) {
    for (long idx = gt; idx < (long)M * N; idx += gs) {
        const int m = (int)(idx / N), n = (int)(idx % N);
        float acc = 0.f;
        for (int k = 0; k < K; ++k) acc += a2f(A[(size_t)m * lda + k]) * W[(size_t)k * ldw + n];
        if (mode == 0) Cf[(size_t)m * ldc + n] = acc;
        else if (mode == 1) Ca[(size_t)m * ldc + n] = f2a(acc);
        else { const float* gate = modp(p, l, cond_of_seq(seq_of(m)), which); Cf[(size_t)m * ldc + n] += gate[n] * acc; }
    }
}
namespace pg8 {
#define PG8_LAS __attribute__((address_space(3)))
typedef unsigned short bf16_t;
typedef short bf16x8 __attribute__((ext_vector_type(8)));
typedef float f32x4 __attribute__((ext_vector_type(4)));
typedef unsigned u32x4 __attribute__((ext_vector_type(4)));
constexpr int BM = 256, BK = 64, HALF = 128, HTB = HALF * BK * 2  , STAGE_BYTES = 8 * HTB, NXCD = 8, WGM = 8;

__host__ __device__ __forceinline__ int lds_byte(int r, int c) { const int st = (r >> 4) * 2 + (c >> 5), rr = r & 15, cc = c & 31, ob = rr * 64 + cc * 2; return st * 1024 + (ob ^ (((ob >> 9) & 1) << 5)); }
__host__ __device__ __forceinline__ void stage_rc(int b, int& R, int& C) { const int st = b / 1024, sb = b % 1024, swz = sb ^ (((sb >> 9) & 1) << 5); R = (st >> 1) * 16 + swz / 64; C = (st & 1) * 32 + (swz % 64) / 2; }
__host__ __device__ __forceinline__ int perm32(int rho) { const int n = rho >> 4, i = rho & 15; return 8 * (i >> 2) + 4 * n + (i & 3); }

struct Unit { int pm, pn; };
struct Gemm { const bf16_t* A; const bf16_t* Bt; int M, N, K, ld; };

struct StaticOrder {
    int nM, nN, nwg, G, c;
    __host__ __device__ void init(int M, int N, int G_, int c_) { nM = M / BM; nN = N / BM; nwg = nM * nN; G = G_; c = c_; }
    __host__ __device__ bool next(int i, Unit& u) const {
        const long L = (long)i * G + c; if (L >= nwg) return false;
        int wgid = (int)L; { const int q = nwg / NXCD, r = nwg % NXCD, xcd = wgid % NXCD, off = wgid / NXCD; wgid = (xcd < r ? xcd * (q + 1) : r * (q + 1) + (xcd - r) * q) + off; }
        const int nig = WGM * nN, gid = wgid / nig, fm = gid * WGM, gsz = (nM - fm) < WGM ? (nM - fm) : WGM;
        u.pm = fm + ((wgid % nig) % gsz); u.pn = (wgid % nig) / gsz; return true;
    }
    __device__ __forceinline__ void a_ready(const Unit&) const {}
    __device__ __forceinline__ void done(const Unit&) const {}
};
struct CountedOrder : StaticOrder {
    const unsigned* ready; unsigned need; unsigned* tmo;
    __device__ __forceinline__ void a_ready(const Unit& u) const {
        if (TIDX < 64) {
            const unsigned long long t0 = __builtin_amdgcn_s_memrealtime(); unsigned polls = 0;
            while ((unsigned)__builtin_amdgcn_readfirstlane(__hip_atomic_load(ready + 64 * u.pm, __ATOMIC_RELAXED, __HIP_MEMORY_SCOPE_AGENT)) < need) {
                if ((++polls & 255u) == 0u && __builtin_amdgcn_readfirstlane(__hip_atomic_load(tmo, __ATOMIC_RELAXED, __HIP_MEMORY_SCOPE_AGENT)) != 0u) break;
                if (__builtin_amdgcn_s_memrealtime() - t0 > 2000000ull) {
                    if (TIDX == 0) { unsigned expect = 0u; __hip_atomic_compare_exchange_strong(tmo + 1, &expect, 0x600u | (unsigned)(u.pm & 0xff), __ATOMIC_RELAXED, __ATOMIC_RELAXED, __HIP_MEMORY_SCOPE_AGENT); __hip_atomic_store(tmo, 1u, __ATOMIC_RELAXED, __HIP_MEMORY_SCOPE_AGENT); }
                    break; }
                __builtin_amdgcn_s_sleep(2); }
            __builtin_amdgcn_fence(__ATOMIC_ACQUIRE, "agent");
            asm volatile("s_waitcnt vmcnt(0)" ::: "memory");
        }
#if !defined(BROKEN_HOOK_NO_BARRIER)
        asm volatile("" ::: "memory"); __builtin_amdgcn_s_barrier(); asm volatile("" ::: "memory");
#endif
    }
};

__device__ __forceinline__ unsigned cvt_pk_bf16(float lo, float hi) { unsigned r; asm volatile("v_cvt_pk_bf16_f32 %0, %1, %2" : "=v"(r) : "v"(lo), "v"(hi)); return r; }
typedef float f32x2 __attribute__((ext_vector_type(2)));
__device__ __forceinline__ f32x2 gelu_pk(f32x2 v) {
    const f32x2 av = __builtin_elementwise_abs(v), d = av * 0.2316418882f + 1.0f;
    f32x2 t; t.x = __builtin_amdgcn_rcpf(d.x); t.y = __builtin_amdgcn_rcpf(d.y);
    f32x2 q = t * 0.5307027145f + (-0.7265760135f); q = q * t + 0.7107068705f; q = q * t + (-0.142248368f); q = q * t + 0.127414796f; q = q * t;
    const f32x2 s = (v * v) * (-0.72134752044f);
    f32x2 e; e.x = __builtin_amdgcn_exp2f(s.x); e.y = __builtin_amdgcn_exp2f(s.y);
    const f32x2 m = v * (q * e), r = v - m;
    f32x2 o; o.x = v.x < 0.f ? m.x : r.x; o.y = v.y < 0.f ? m.y : r.y; return o;
}

struct EpiF32 {
    static constexpr bool PERM = false, AFTER_DRAIN = false;
    float* C; int ldc; const float* bias;
    __device__ __forceinline__ void operator()(const f32x4 (&acc)[2][2][4][2], const Unit& u, int wr, int wc, int fr, int fq) const {
        const int row0 = u.pm * BM + wr * 64 + fr, col0 = u.pn * BM + wc * 32 + 4 * fq;
        f32x4 bv[2][2];
#pragma unroll
        for (int bj = 0; bj < 2; ++bj)
#pragma unroll
            for (int n = 0; n < 2; ++n) bv[bj][n] = bias ? *(const f32x4*)(bias + col0 + bj * HALF + n * 16) : (f32x4){0.f, 0.f, 0.f, 0.f};
#pragma unroll
        for (int ai = 0; ai < 2; ++ai)
#pragma unroll
            for (int m = 0; m < 4; ++m) { float* rowp = C + (size_t)(row0 + ai * HALF + m * 16) * ldc + col0;
#pragma unroll
                for (int bj = 0; bj < 2; ++bj)
#pragma unroll
                    for (int n = 0; n < 2; ++n) *(f32x4*)(rowp + bj * HALF + n * 16) = acc[ai][bj][m][n] + bv[bj][n]; }
    }
};
template <int ACT  > struct EpiBf16 {
    static constexpr bool PERM = true, AFTER_DRAIN = false;
    bf16_t* O; int ldc; const float* bias; int split_cols; size_t split_stride;
    __device__ __forceinline__ void operator()(const f32x4 (&acc)[2][2][4][2], const Unit& u, int wr, int wc, int fr, int fq) const {
        const int row0 = u.pm * BM + wr * 64 + fr; int colt = u.pn * BM; bf16_t* base = O;
        if (split_cols) { const int t = colt / split_cols; base += (size_t)t * split_stride; colt -= t * split_cols; }
        const int col0 = colt + wc * 32 + 8 * fq, bcol0 = u.pn * BM + wc * 32 + 8 * fq;
        f32x4 bv[2][2];
#pragma unroll
        for (int bj = 0; bj < 2; ++bj)
#pragma unroll
            for (int n = 0; n < 2; ++n) bv[bj][n] = bias ? *(const f32x4*)(bias + bcol0 + bj * HALF + 4 * n) : (f32x4){0.f, 0.f, 0.f, 0.f};
#pragma unroll
        for (int ai = 0; ai < 2; ++ai)
#pragma unroll
            for (int m = 0; m < 4; ++m) { bf16_t* rowp = base + (size_t)(row0 + ai * HALF + m * 16) * ldc + col0;
#pragma unroll
                for (int bj = 0; bj < 2; ++bj) { f32x4 v0 = acc[ai][bj][m][0] + bv[bj][0], v1 = acc[ai][bj][m][1] + bv[bj][1];
                    if (ACT == 1) { f32x2 a = gelu_pk((f32x2){v0[0], v0[1]}), b = gelu_pk((f32x2){v0[2], v0[3]}), c = gelu_pk((f32x2){v1[0], v1[1]}), d = gelu_pk((f32x2){v1[2], v1[3]});
                        v0 = (f32x4){a.x, a.y, b.x, b.y}; v1 = (f32x4){c.x, c.y, d.x, d.y}; }
                    if (ACT == 2) {
#pragma unroll
                        for (int j = 0; j < 4; ++j) { v0[j] = 0.5f * v0[j] * (1.0f + erff(v0[j] * 0.70710678f)); v1[j] = 0.5f * v1[j] * (1.0f + erff(v1[j] * 0.70710678f)); } }
                    u32x4 w; w.x = cvt_pk_bf16(v0[0], v0[1]); w.y = cvt_pk_bf16(v0[2], v0[3]); w.z = cvt_pk_bf16(v1[0], v1[1]); w.w = cvt_pk_bf16(v1[2], v1[3]);
                    *(u32x4*)(rowp + bj * HALF) = w; } }
    }
};

template <class Epi, class Sched, bool STAMP = false>
__device__ __forceinline__ void gemm_phase(PG8_LAS unsigned char* lds, const Gemm g, const Sched& S, const Epi& E, unsigned long long* stamps) {
    int tid_ = TIDX; asm volatile("" : "+v"(tid_));
    const int tid = tid_, wid = __builtin_amdgcn_readfirstlane(tid >> 6), lane = tid & 63, wr = wid >> 2, wc = wid & 3, fr = lane & 15, fq = lane >> 4;
    const int K = g.ld, nt = g.K / BK;
    int ts_lo = 0, ts_hi = 0, nts = 0; const unsigned long long rt_entry = STAMP ? (unsigned long long)wall_clock64() : 0ull;
#define PG8_STAMP() do { if (STAMP && wid == 0 && nts < 64) { const unsigned long long _c = (unsigned long long)clock64(); \
        ts_lo = (lane == nts) ? (int)(unsigned)_c : ts_lo; ts_hi = (lane == nts) ? (int)(unsigned)(_c >> 32) : ts_hi; ++nts; } } while (0)
    PG8_STAMP();
    unsigned voffA[2], voffB[2];
#pragma unroll
    for (int i = 0; i < 2; ++i) { int R, C; stage_rc(tid * 16 + i * 8192, R, C); const int Rb = Epi::PERM ? ((R & ~31) + perm32(R & 31)) : R;
        voffA[i] = (unsigned)(R * K + C) * 2u; voffB[i] = (unsigned)(Rb * K + C) * 2u; }
    const size_t kstep = (size_t)(BK * 2);
    const size_t hstep = (size_t)HALF * K * 2;
    const size_t tstep = 2 * hstep;
    const unsigned ldsw = (unsigned)wid * 1024u;
    const int aoff = lds_byte(wr * 64 + fr, fq * 8), boff = lds_byte(wc * 32 + fr, fq * 8);
#define PG8_SA(b, h) (((b) * 2 + (h)) * HTB)
#define PG8_SB(b, h) ((4 + (b) * 2 + (h)) * HTB)
#define PG8_STAGE(bufoff, gbase, voff) do { _Pragma("unroll") for (int _i = 0; _i < 2; ++_i) \
        __builtin_amdgcn_global_load_lds((const unsigned*)((const char*)(gbase) + (voff)[_i]), (PG8_LAS unsigned*)(lds + (bufoff) + ldsw + _i * 8192), 16, 0, 0); } while (0)
#define PG8_LDA(dst, b, h) do { _Pragma("unroll") for (int m = 0; m < 4; ++m) _Pragma("unroll") for (int k = 0; k < 2; ++k) dst[m][k] = *(const PG8_LAS bf16x8*)(lds + PG8_SA(b, h) + aoff + m * 2048 + k * 1024); } while (0)
#define PG8_LDB(dst, b, h) do { _Pragma("unroll") for (int n = 0; n < 2; ++n) _Pragma("unroll") for (int k = 0; k < 2; ++k) dst[n][k] = *(const PG8_LAS bf16x8*)(lds + PG8_SB(b, h) + boff + n * 2048 + k * 1024); } while (0)
#define PG8_MMA(ai, bj, At, Bt) do { __builtin_amdgcn_s_setprio(1); _Pragma("unroll") for (int m = 0; m < 4; ++m) _Pragma("unroll") for (int n = 0; n < 2; ++n) _Pragma("unroll") for (int k = 0; k < 2; ++k) \
        acc[ai][bj][m][n] = __builtin_amdgcn_mfma_f32_16x16x32_bf16(Bt[n][k], At[m][k], acc[ai][bj][m][n], 0, 0, 0); __builtin_amdgcn_s_setprio(0); } while (0)
#define PG8_WAIT_V(n) asm volatile("s_waitcnt vmcnt(" #n ")" ::: "memory")
#define PG8_WAIT_L(n) asm volatile("s_waitcnt lgkmcnt(" #n ")" ::: "memory")
#define PG8_BAR __builtin_amdgcn_s_barrier()
#define PG8_SCHED __builtin_amdgcn_sched_barrier(0)
    Unit cur, nxt; int ui = 0;
    if (!S.next(0, cur)) return;
    f32x4 acc[2][2][4][2];
#pragma unroll
    for (int a = 0; a < 2; ++a)
#pragma unroll
        for (int b = 0; b < 2; ++b)
#pragma unroll
            for (int m = 0; m < 4; ++m)
#pragma unroll
                for (int n = 0; n < 2; ++n) acc[a][b][m][n] = (f32x4){0.f, 0.f, 0.f, 0.f};
    bf16x8 At[4][2], B0[2][2], B1[2][2];
    const char* cA = (const char*)g.A + (size_t)cur.pm * tstep; const char* cB = (const char*)g.Bt + (size_t)cur.pn * tstep;
    S.a_ready(cur);
    PG8_STAGE(PG8_SB(0, 0), cB, voffB); PG8_STAGE(PG8_SA(0, 0), cA, voffA); PG8_STAGE(PG8_SB(0, 1), cB + hstep, voffB); PG8_STAGE(PG8_SA(0, 1), cA + hstep, voffA);
    if (wr == 1) PG8_BAR;
    PG8_WAIT_V(4); PG8_BAR;
    PG8_STAGE(PG8_SB(1, 0), cB + kstep, voffB); PG8_STAGE(PG8_SA(1, 0), cA + kstep, voffA); PG8_STAGE(PG8_SB(1, 1), cB + hstep + kstep, voffB);
    PG8_WAIT_V(6); PG8_BAR;
    PG8_STAMP();
    for (;;) {
        const bool has_next = S.next(ui + 1, nxt);
        const char* nA = has_next ? (const char*)g.A + (size_t)nxt.pm * tstep : cA; const char* nB = has_next ? (const char*)g.Bt + (size_t)nxt.pn * tstep : cB;
        for (int t = 0; t < nt; t += 2) {
            const bool last = (t == nt - 2);
            const char* a1 = cA + (size_t)(t + 1) * kstep;
            const char* a2 = last ? nA : cA + (size_t)(t + 2) * kstep; const char* b2 = last ? nB : cB + (size_t)(t + 2) * kstep;
            const char* a3 = a2 + kstep; const char* b3 = b2 + kstep;
            if (last && has_next) S.a_ready(nxt);
            PG8_LDB(B0, 0, 0); PG8_SCHED; PG8_LDA(At, 0, 0); PG8_STAGE(PG8_SA(1, 1), a1 + hstep, voffA);
            PG8_WAIT_L(8); PG8_BAR; PG8_WAIT_L(0); PG8_MMA(0, 0, At, B0); PG8_BAR; PG8_SCHED;
            PG8_LDB(B1, 0, 1); PG8_STAGE(PG8_SB(0, 0), b2, voffB);
            PG8_BAR; PG8_WAIT_L(0); PG8_MMA(0, 1, At, B1); PG8_BAR;
            PG8_LDA(At, 0, 1); PG8_STAGE(PG8_SA(0, 0), a2, voffA);
            PG8_BAR; PG8_WAIT_L(0); PG8_MMA(1, 0, At, B0); PG8_BAR; PG8_SCHED;
            PG8_STAGE(PG8_SB(0, 1), b2 + hstep, voffB);
            PG8_WAIT_V(6); PG8_BAR; PG8_MMA(1, 1, At, B1); PG8_BAR;
            PG8_LDB(B0, 1, 0); PG8_SCHED; PG8_LDA(At, 1, 0); PG8_STAGE(PG8_SA(0, 1), a2 + hstep, voffA);
            PG8_WAIT_L(8); PG8_BAR; PG8_WAIT_L(0); PG8_MMA(0, 0, At, B0); PG8_BAR; PG8_SCHED;
            PG8_LDB(B1, 1, 1); PG8_STAGE(PG8_SB(1, 0), b3, voffB);
            PG8_BAR; PG8_WAIT_L(0); PG8_MMA(0, 1, At, B1); PG8_BAR;
            PG8_LDA(At, 1, 1); PG8_STAGE(PG8_SA(1, 0), a3, voffA);
            PG8_BAR; PG8_WAIT_L(0); PG8_MMA(1, 0, At, B0); PG8_BAR; PG8_SCHED;
            PG8_STAGE(PG8_SB(1, 1), b3 + hstep, voffB);
            PG8_WAIT_V(6); PG8_BAR; PG8_MMA(1, 1, At, B1); PG8_BAR;
        }
        PG8_STAMP();
        if constexpr (!Epi::AFTER_DRAIN) { E(acc, cur, wr, wc, fr, fq); S.done(cur); }
        PG8_STAMP();
        if (!has_next) break;
#pragma unroll
        for (int a = 0; a < 2; ++a)
#pragma unroll
            for (int b = 0; b < 2; ++b)
#pragma unroll
                for (int m = 0; m < 4; ++m)
#pragma unroll
                    for (int n = 0; n < 2; ++n) acc[a][b][m][n] = (f32x4){0.f, 0.f, 0.f, 0.f};
        cur = nxt; cA = nA; cB = nB; ++ui;
    }
    PG8_WAIT_V(0);
    if (wr == 0) PG8_BAR;
    PG8_BAR;
    if constexpr (Epi::AFTER_DRAIN) { E.fused(acc, cur, wr, wc, fr, fq, lds, wid, lane); S.done(cur); }
    PG8_STAMP();
    if (STAMP && wid == 0) { stamps[lane] = lane < nts ? (((unsigned long long)(unsigned)ts_hi << 32) | (unsigned)ts_lo) : 0ull;
        if (lane == 62) stamps[62] = rt_entry; if (lane == 63) stamps[63] = (unsigned long long)wall_clock64(); }
#undef PG8_STAMP
#undef PG8_SA
#undef PG8_SB
#undef PG8_STAGE
#undef PG8_LDA
#undef PG8_LDB
#undef PG8_MMA
#undef PG8_WAIT_V
#undef PG8_WAIT_L
#undef PG8_BAR
#undef PG8_SCHED
}
}
#define XB_TMO      128
#define XB_XCNT(j)  (256  + 64 * (j))
#define XB_XSUB(j)  (1280 + 64 * (j))
#define XB_XGEN(j)  (2304 + 64 * (j))
#define XB_TOP      3328
#define XB_TOPGEN   3392
#define XCD_BAR_WORDS 3456
#define XB_SPIN_CAP (1u << 22)
#define LAS __attribute__((address_space(3)))

__device__ __forceinline__ unsigned xb_ld(unsigned* p)              { return __hip_atomic_load(p, __ATOMIC_RELAXED, __HIP_MEMORY_SCOPE_AGENT); }
__device__ __forceinline__ unsigned xb_add(unsigned* p, unsigned v) { return __hip_atomic_fetch_add(p, v, __ATOMIC_RELAXED, __HIP_MEMORY_SCOPE_AGENT); }
__device__ __forceinline__ unsigned xb_xcc_id() { return (unsigned)__builtin_amdgcn_s_getreg((3 << 11) | 20) & 0xFu; }
#define XB_SPIN(cond, bar) do { unsigned _sp = 0; while (cond) { __builtin_amdgcn_s_sleep(1); \
    if ((++_sp & 255u) == 0u) { if (xb_ld(&(bar)[XB_TMO])) break; if (_sp > XB_SPIN_CAP) { atomicAdd(&(bar)[XB_TMO], 1u); break; } } } } while (0)

struct XcdBarrier {
    unsigned* bar; unsigned x;
    volatile LAS unsigned* st;
};

__device__ __forceinline__ XcdBarrier xcd_barrier_post(unsigned* bar, volatile LAS unsigned* st) {
    XcdBarrier b; b.bar = bar; b.x = xb_xcc_id(); b.st = st;
    if (TIDX == 0) (void)xb_add(&bar[XB_XCNT(b.x)], 1u);
    return b;
}
__device__ __forceinline__ void xcd_barrier_complete(unsigned* bar, unsigned x, unsigned& nloc, unsigned& nx) {
    const unsigned G = gridDim.x * gridDim.y * gridDim.z;
    unsigned sum, cnt, mine, sp = 0u;
    for (;;) {
        sum = 0u; cnt = 0u; mine = 0u;
#pragma unroll
        for (unsigned j = 0; j < 16; ++j) { const unsigned c = xb_ld(&bar[XB_XCNT(j)]); sum += c; cnt += (c > 0u) ? 1u : 0u; mine = (j == x) ? c : mine; }
        if (sum == G) break;
        __builtin_amdgcn_s_sleep(1);
        if ((++sp & 255u) == 0u) { if (xb_ld(&bar[XB_TMO])) break; if (sp > XB_SPIN_CAP) { atomicAdd(&bar[XB_TMO], 1u); break; } }
    }
    nloc = mine > 0u ? mine : 1u; nx = cnt > 0u ? cnt : 1u;
}

__device__ __forceinline__ void xcd_barrier(const XcdBarrier& b) {
    asm volatile("s_waitcnt vmcnt(0)" ::: "memory");
    __syncthreads();
    if (TIDX == 0) {
        unsigned* bar = b.bar;
        __builtin_amdgcn_s_waitcnt(0);
        unsigned nloc = b.st[0], nx = b.st[1];
        if (nloc == 0u) { xcd_barrier_complete(bar, b.x, nloc, nx); b.st[0] = nloc; b.st[1] = nx; }
        const unsigned old = xb_add(&bar[XB_XSUB(b.x)], 1u);
        const unsigned gen = old / nloc;
        if (old + 1u == (gen + 1u) * nloc) {
            __builtin_amdgcn_fence(__ATOMIC_RELEASE, "agent");
            asm volatile("s_waitcnt vmcnt(0)" ::: "memory");
            const unsigned og = xb_add(&bar[XB_TOP], 1u);
            const unsigned tg = og / nx;
            if (og + 1u == (tg + 1u) * nx) xb_add(&bar[XB_TOPGEN], 1u);
            else XB_SPIN(xb_ld(&bar[XB_TOPGEN]) == tg, bar);
            __builtin_amdgcn_fence(__ATOMIC_ACQUIRE, "agent");
            xb_add(&bar[XB_XGEN(b.x)], 1u);
            asm volatile("s_waitcnt vmcnt(0)" ::: "memory");
        } else {
            XB_SPIN(xb_ld(&bar[XB_XGEN(b.x)]) == gen, bar);
            __builtin_amdgcn_fence(__ATOMIC_ACQUIRE, "agent");
            asm volatile("s_waitcnt vmcnt(0)" ::: "memory");
        }
    }
    __syncthreads();
}
namespace att {
constexpr int DQK = QKD, DV_ = VD, NW = 8, QBLK = 32, KVBLK = 64;
static_assert(DQK == 192 && DV_ == 128 && NOPE == 128 && ROPE == 64, "attention body is written for 128 + 64 / 128");
constexpr float SCALE = 0.07216878364870322f;
constexpr float THR = 8.f;
constexpr int SDEPTH = ATT_SDEPTH;
constexpr int NQREG = ATT_NQREG, NQLDS = DQK / 16 - NQREG;
static_assert(NQREG <= NOPE / 16 && NQREG >= 0, "rope fragments live in LDS");
constexpr int KPITCH = DQK * 2;
constexpr size_t SHM_V = KVBLK * DV_ * 2, SHM_K = KVBLK * KPITCH, SHM_QR = 2 * SHM_V + 2 * SHM_K + NW * 64 * 4, SHM_ATTN = SHM_QR + NW * (DQK / 16 - ATT_NQREG) * 1024;
using bf16x8 = __attribute__((ext_vector_type(8))) short;
using s16x4  = __attribute__((ext_vector_type(4))) short;
using f32x16 = __attribute__((ext_vector_type(16))) float;
using u32x4  = __attribute__((ext_vector_type(4))) unsigned;
#define KSWZ(row, colB) ((row) * att::KPITCH + ((colB) ^ (((row) & 7) << 4)))
#define SBAR() __builtin_amdgcn_sched_barrier(0)
__device__ __forceinline__ int crow(int r, int hi) { return (r & 3) + 8 * (r >> 2) + 4 * hi; }
__device__ __forceinline__ unsigned cvtpk(float lo, float hi) { unsigned r; asm volatile("v_cvt_pk_bf16_f32 %0, %1, %2" : "=v"(r) : "v"(lo), "v"(hi)); return r; }

__device__ __forceinline__ void partialSM(f32x16& p0, f32x16& p1, float& m_reg, float& mn, float& alpha) {
  constexpr float C = SCALE * 1.4426950408889634f;
  float pmax = p0[0];
#pragma unroll
  for (int r = 1; r < 16; ++r) pmax = fmaxf(pmax, p0[r]);
#pragma unroll
  for (int r = 0; r < 16; ++r) pmax = fmaxf(pmax, p1[r]);
  { auto rr = __builtin_amdgcn_permlane32_swap(__float_as_uint(pmax), __float_as_uint(pmax), false, false);
    pmax = fmaxf(__uint_as_float(rr[0]), __uint_as_float(rr[1])); }
  if (__builtin_expect(__all(pmax - m_reg <= THR / SCALE), 1)) { mn = m_reg; alpha = 1.f; }
  else { mn = fmaxf(m_reg, pmax); alpha = __builtin_amdgcn_exp2f((m_reg - mn) * C); m_reg = mn; }
  float mnC = -mn * C;
#pragma unroll
  for (int r = 0; r < 16; ++r) p0[r] = fmaf(p0[r], C, mnC);
#pragma unroll
  for (int r = 0; r < 16; ++r) p1[r] = fmaf(p1[r], C, mnC);
#pragma unroll
  for (int r = 0; r < 16; ++r) p0[r] = __builtin_amdgcn_exp2f(p0[r]);
}
__device__ __forceinline__ void finishSM(f32x16& p0, f32x16& p1, float alpha, float& l_reg, bf16x8& pa0, bf16x8& pa1, bf16x8& pa2, bf16x8& pa3) {
#pragma unroll
  for (int r = 0; r < 16; ++r) p1[r] = __builtin_amdgcn_exp2f(p1[r]);
  float ps = 0;
#pragma unroll
  for (int r = 0; r < 16; ++r) ps += p0[r];
#pragma unroll
  for (int r = 0; r < 16; ++r) ps += p1[r];
  { auto rr = __builtin_amdgcn_permlane32_swap(__float_as_uint(ps), __float_as_uint(ps), false, false);
    ps = __uint_as_float(rr[0]) + __uint_as_float(rr[1]); }
  l_reg = l_reg * alpha + ps;
#define PK4(P, BASE, OUT) do { unsigned a0 = cvtpk(P[BASE + 0], P[BASE + 1]), a1 = cvtpk(P[BASE + 2], P[BASE + 3]);   \
    unsigned b0 = cvtpk(P[BASE + 4], P[BASE + 5]), b1 = cvtpk(P[BASE + 6], P[BASE + 7]);                              \
    auto r0 = __builtin_amdgcn_permlane32_swap(a0, b0, false, false); auto r1 = __builtin_amdgcn_permlane32_swap(a1, b1, false, false); \
    u32x4 w = {r0[0], r1[0], r0[1], r1[1]}; OUT = *reinterpret_cast<bf16x8*>(&w); } while (0)
  PK4(p0, 0, pa0); PK4(p0, 8, pa1); PK4(p1, 0, pa2); PK4(p1, 8, pa3);
#undef PK4
}
__device__ __forceinline__ void qkt(f32x16& p0, f32x16& p1, const char* Ks, const bf16x8* qr, const char* qx, int r32, int hi) {
  p0 = f32x16{}; p1 = f32x16{};
#pragma unroll
  for (int d0 = 0; d0 < DQK / 16; ++d0) { int cb = (d0 * 16 + hi * 8) * 2;
    bf16x8 b0 = *reinterpret_cast<const bf16x8*>(Ks + KSWZ(r32, cb));
    bf16x8 b1 = *reinterpret_cast<const bf16x8*>(Ks + KSWZ(32 + r32, cb));
    const bf16x8 q = d0 < NQREG ? qr[d0 < NQREG ? d0 : 0] : *reinterpret_cast<const bf16x8*>(qx + (d0 - NQREG) * 1024);
    p0 = __builtin_amdgcn_mfma_f32_32x32x16_bf16(b0, q, p0, 0, 0, 0);
    p1 = __builtin_amdgcn_mfma_f32_32x32x16_bf16(b1, q, p1, 0, 0, 0); }
}
__device__ __forceinline__ int v_st(int k, int c) { const int kk = (k & ~0xC) | ((k & 4) << 1) | ((k & 8) >> 1); return ((kk >> 3) * 4 + (c >> 5)) * 512 + ((kk & 7) * 32 + (c & 31)) * 2; }
__device__ __forceinline__ int v_rd_base(int lane) { return ((lane & 3) << 3) | (((lane >> 2) & 3) << 6) | (((lane >> 4) & 1) << 5) | (((lane >> 5) & 1) << 8); }
constexpr int v_rd_off(int d0, int ks, int half) { return d0 * 512 + ks * 4096 + half * 2048; }
template <int OFF> __device__ __forceinline__ s16x4 tr_read(int vb) {
  s16x4 r; asm volatile("ds_read_b64_tr_b16 %0, %1 offset:%2" : "=&v"(r) : "v"(vb), "i"(OFF) : "memory"); return r;
}
template <int D0> __device__ __forceinline__ void pv_one(f32x16& od, int vb, bf16x8 pa0, bf16x8 pa1, bf16x8 pa2, bf16x8 pa3) {
  const s16x4 l0 = tr_read<v_rd_off(D0, 0, 0)>(vb), h0 = tr_read<v_rd_off(D0, 0, 1)>(vb), l1 = tr_read<v_rd_off(D0, 1, 0)>(vb), h1 = tr_read<v_rd_off(D0, 1, 1)>(vb);
  const s16x4 l2 = tr_read<v_rd_off(D0, 2, 0)>(vb), h2 = tr_read<v_rd_off(D0, 2, 1)>(vb), l3 = tr_read<v_rd_off(D0, 3, 0)>(vb), h3 = tr_read<v_rd_off(D0, 3, 1)>(vb);
  asm volatile("s_waitcnt lgkmcnt(0)" ::: "memory"); SBAR();
#define PK(L, H) (bf16x8){L[0], L[1], L[2], L[3], H[0], H[1], H[2], H[3]}
  od = __builtin_amdgcn_mfma_f32_32x32x16_bf16(pa0, PK(l0, h0), od, 0, 0, 0);
  od = __builtin_amdgcn_mfma_f32_32x32x16_bf16(pa1, PK(l1, h1), od, 0, 0, 0);
  od = __builtin_amdgcn_mfma_f32_32x32x16_bf16(pa2, PK(l2, h2), od, 0, 0, 0);
  od = __builtin_amdgcn_mfma_f32_32x32x16_bf16(pa3, PK(l3, h3), od, 0, 0, 0);
#undef PK
}
__device__ __forceinline__ void pv_d0(f32x16* o, int vb, bf16x8 pa0, bf16x8 pa1, bf16x8 pa2, bf16x8 pa3) {
  pv_one<0>(o[0], vb, pa0, pa1, pa2, pa3); pv_one<1>(o[1], vb, pa0, pa1, pa2, pa3); pv_one<2>(o[2], vb, pa0, pa1, pa2, pa3); pv_one<3>(o[3], vb, pa0, pa1, pa2, pa3);
}

__device__ __forceinline__ void attn_mla_body(const act_t* __restrict__ Qb, const float2* __restrict__ ropetab, const act_t* __restrict__ Kn, const act_t* __restrict__ Kp,
                                              const act_t* __restrict__ Vh, act_t* __restrict__ Ob, int r0, int nt0, int r1, int NT, char* lds) {
  int tid_ = TIDX; asm volatile("" : "+v"(tid_));
  const int tid = tid_, wid = tid >> 6, lane = tid & 63, r32 = lane & 31, hi = lane >> 5;
  char* V_lds = lds; char* K_lds = lds + 2 * SHM_V;
  float* ws = (float*)(lds + 2 * SHM_V + 2 * SHM_K) + wid * 64; float* li_l = ws; float* al_l = ws + 32;
  float m_reg = -1e30f, l_reg = 0; f32x16 o[4] = {}; bf16x8 qr[NQREG > 0 ? NQREG : 1];
  const act_t* Qw = Qb + (long)(wid * QBLK + r32) * NQ + hi * 8;
  char* qx = lds + SHM_QR + wid * (NQLDS * 1024) + lane * 16;
#pragma unroll
  for (int d0 = 0; d0 < NQREG; ++d0) qr[d0] = *reinterpret_cast<const bf16x8*>(Qw + d0 * 16);
  {
    u32x4 qt[DQK / 16 - NQREG];
#pragma unroll
    for (int d0 = NQREG; d0 < DQK / 16; ++d0) qt[d0 - NQREG] = *reinterpret_cast<const u32x4*>(Qw + d0 * 16);
    const float2* rt = (ropetab ? ropetab : reinterpret_cast<const float2*>(Qb)) + (long)(wid * QBLK + r32) * (ROPE / 2);
    float4 cs4[ROPE / 16][2];
#pragma unroll
    for (int d = 0; d < ROPE / 16; ++d) { cs4[d][0] = *reinterpret_cast<const float4*>(__builtin_assume_aligned(rt + d * 8 + hi * 4, 16)); cs4[d][1] = *reinterpret_cast<const float4*>(__builtin_assume_aligned(rt + d * 8 + hi * 4 + 2, 16)); }
    __builtin_amdgcn_sched_barrier(0);
#pragma unroll
    for (int d = 0; d < ROPE / 16; ++d) {
      asm volatile("" : "+v"(cs4[d][0].x), "+v"(cs4[d][0].y), "+v"(cs4[d][0].z), "+v"(cs4[d][0].w), "+v"(cs4[d][1].x), "+v"(cs4[d][1].y), "+v"(cs4[d][1].z), "+v"(cs4[d][1].w)); }
#pragma unroll
    for (int d0 = NQREG; d0 < NOPE / 16; ++d0) *reinterpret_cast<u32x4*>(qx + (d0 - NQREG) * 1024) = qt[d0 - NQREG];
#pragma unroll
    for (int d0 = NOPE / 16; d0 < DQK / 16; ++d0) {
      u32x4 w = qt[d0 - NQREG];
      {
        const int d = d0 - NOPE / 16; const bool rot = ropetab != nullptr;
        const float2 cs[4] = {make_float2(cs4[d][0].x, cs4[d][0].y), make_float2(cs4[d][0].z, cs4[d][0].w), make_float2(cs4[d][1].x, cs4[d][1].y), make_float2(cs4[d][1].z, cs4[d][1].w)};
#pragma unroll
        for (int j = 0; j < 4; ++j) {
          const float c = rot ? cs[j].x : 1.0f, s = rot ? cs[j].y : 0.0f;
          const float xe = __uint_as_float(w[j] << 16), xo = __uint_as_float(w[j] & 0xffff0000u);
          w[j] = cvtpk(xe * c - xo * s, xe * s + xo * c);
        }
      }
      *reinterpret_cast<u32x4*>(qx + (d0 - NQREG) * 1024) = w;
    }
    asm volatile("s_waitcnt lgkmcnt(0)" ::: "memory");
  }
  const int sr = tid >> 4, sc = (tid & 15) * 8, vst0 = v_st(sr, sc);
  const int pr = tid >> 3, pc = (tid & 7) * 8;
  const int vb0 = (int)(uintptr_t)V_lds + v_rd_base(lane);
  struct { bf16x8 vs0, vs1, ks0, ks1, kp; } sr_[SDEPTH];
#define KROW(j) __builtin_amdgcn_readfirstlane((j) < nt0 ? r0 + (j) * KVBLK : r1 + ((j) - nt0) * KVBLK)
  const unsigned ov0 = sr * NKV + sc, opp = pr * ROPE + pc; const int kst0 = KSWZ(sr, sc * 2), kstp = KSWZ(pr, (NOPE + pc) * 2);
#define SLOAD(i, j) do { const int kr_ = KROW(j); const act_t* vt_ = Vh + (size_t)kr_ * NKV; const act_t* kt_ = Kn + (size_t)kr_ * NKV; const act_t* pt_ = Kp + (size_t)kr_ * ROPE; \
    sr_[i].vs0 = *reinterpret_cast<const bf16x8*>(vt_ + ov0); sr_[i].vs1 = *reinterpret_cast<const bf16x8*>(vt_ + 32 * NKV + ov0); \
    sr_[i].ks0 = *reinterpret_cast<const bf16x8*>(kt_ + ov0); sr_[i].ks1 = *reinterpret_cast<const bf16x8*>(kt_ + 32 * NKV + ov0); \
    sr_[i].kp = *reinterpret_cast<const bf16x8*>(pt_ + opp); } while (0)
#define SWRITE(b, i) do { *(bf16x8*)(V_lds + (b) * SHM_V + vst0) = sr_[i].vs0; *(bf16x8*)(V_lds + (b) * SHM_V + 8192 + vst0) = sr_[i].vs1; \
    *(bf16x8*)(K_lds + (b) * SHM_K + kst0) = sr_[i].ks0; *(bf16x8*)(K_lds + (b) * SHM_K + 32 * KPITCH + kst0) = sr_[i].ks1; \
    *(bf16x8*)(K_lds + (b) * SHM_K + kstp) = sr_[i].kp; } while (0)
#define SWAIT() do { if constexpr (SDEPTH == 2) asm volatile("s_waitcnt vmcnt(5)" ::: "memory"); else asm volatile("s_waitcnt vmcnt(0)" ::: "memory"); } while (0)
#define RESC(a) do { if (__any((a) < 1.f)) { if (hi == 0) al_l[r32] = (a); asm volatile("s_waitcnt lgkmcnt(0)" ::: "memory"); \
    _Pragma("unroll") for (int d = 0; d < 4; ++d) _Pragma("unroll") for (int r = 0; r < 16; ++r) o[d][r] *= al_l[crow(r, hi)]; } } while (0)
  f32x16 pA0, pA1, pB0, pB1; float mnA, mnB, alA, alB; bf16x8 pa0, pa1, pa2, pa3;
  constexpr int SE = 0, SO = SDEPTH - 1;
  SLOAD(SE, 0); asm volatile("s_waitcnt vmcnt(0)" ::: "memory"); SWRITE(0, SE); __syncthreads();
  qkt(pA0, pA1, K_lds, qr, qx, r32, hi); partialSM(pA0, pA1, m_reg, mnA, alA);
  SLOAD(SO, 1); if constexpr (SDEPTH == 2) { if (2 < NT) SLOAD(SE, 2); }
  SWAIT(); SWRITE(1, SO); __syncthreads();
  for (int j = 1; j + 1 < NT; j += 2) {
    SBAR(); qkt(pB0, pB1, K_lds + SHM_K, qr, qx, r32, hi);
    finishSM(pA0, pA1, alA, l_reg, pa0, pa1, pa2, pa3); SBAR();
    SLOAD(SO, j + SDEPTH); SBAR();
    pv_d0(o, vb0, pa0, pa1, pa2, pa3); partialSM(pB0, pB1, m_reg, mnB, alB);
    __syncthreads(); SWAIT(); SWRITE(0, SE);
    RESC(alB); __syncthreads();
    SBAR(); qkt(pA0, pA1, K_lds, qr, qx, r32, hi);
    finishSM(pB0, pB1, alB, l_reg, pa0, pa1, pa2, pa3); SBAR();
    if (SDEPTH == 1 || j + 3 < NT) SLOAD(SE, j + 1 + SDEPTH); SBAR();
    pv_d0(o, vb0 + (int)SHM_V, pa0, pa1, pa2, pa3); partialSM(pA0, pA1, m_reg, mnA, alA);
    __syncthreads(); SWAIT(); SWRITE(1, SO);
    RESC(alA); __syncthreads();
  }
  SBAR(); qkt(pB0, pB1, K_lds + SHM_K, qr, qx, r32, hi);
  finishSM(pA0, pA1, alA, l_reg, pa0, pa1, pa2, pa3); SBAR();
  pv_d0(o, vb0, pa0, pa1, pa2, pa3); partialSM(pB0, pB1, m_reg, mnB, alB);
  __syncthreads(); RESC(alB);
  finishSM(pB0, pB1, alB, l_reg, pa0, pa1, pa2, pa3); SBAR();
  pv_d0(o, vb0 + (int)SHM_V, pa0, pa1, pa2, pa3);
  if (hi == 0) li_l[r32] = l_reg; asm volatile("s_waitcnt lgkmcnt(0)" ::: "memory");
  float rli[16];
#pragma unroll
  for (int r = 0; r < 16; ++r) rli[r] = __builtin_amdgcn_rcpf(li_l[crow(r, hi)]);
  act_t* Ow = Ob + (long)(wid * QBLK) * MIXW;
#pragma unroll
  for (int r = 0; r < 16; ++r) { int orow = crow(r, hi);
#pragma unroll
    for (int d0 = 0; d0 < 4; ++d0) Ow[(long)orow * MIXW + d0 * 32 + r32] = f2a(o[d0][r] * rli[r]); }
#undef KROW
#undef SLOAD
#undef SWRITE
#undef SWAIT
#undef RESC
}
}

constexpr int AT_QB_LAT = DSEQ / 256, AT_NU_LAT = NDB * BH * AT_QB_LAT, AT_NU_CTX = NB * BH * (SEQ / 256);
__device__ __forceinline__ void attn_unit(const P& p, int u, char* lds) {
    const act_t* qf = (const act_t*)(p.ws + WS_QF); const act_t* kvup = (const act_t*)(p.ws + WS_KVUP); const act_t* kr = (const act_t*)(p.ws + WS_KR);
    act_t* ymix = (act_t*)(p.ws + WS_YMIX); const float2* ropetab = (const float2*)(p.ws + WS_ROPE);
    int s, h, qb;
    if (u < AT_NU_LAT) { qb = u % AT_QB_LAT; h = (u / AT_QB_LAT) % BH; s = NB + u / (AT_QB_LAT * BH); }
    else { const int v = u - AT_NU_LAT; qb = 0; h = v % BH; s = v / BH; }
    const int base = seq_start(s), T = seq_len(s), m0 = base + qb * 256;
    const bool lat = s >= NB;
    att::attn_mla_body(qf + (size_t)m0 * NQ + h * QKD, lat ? ropetab + (size_t)(qb * 256) * (ROPE / 2) : nullptr, kvup + h * NOPE, kr, kvup + BH * NOPE + h * VD,
                       ymix + (size_t)m0 * MIXW + AW + h * VD, base, T / 64, lat ? MTOK + (s - NB) * PAST : 0, (T + (lat ? PAST : 0)) / 64, lds);
    __syncthreads();
}
namespace gdnc {
using bf16x8 = __attribute__((ext_vector_type(8))) short;
using f32x16 = __attribute__((ext_vector_type(16))) float;
using f32x4v = __attribute__((ext_vector_type(4))) float;
using u32x4 = __attribute__((ext_vector_type(4))) unsigned;
__device__ __forceinline__ uint4 ldnt16(const uint4* p) { const u32x4 v = __builtin_nontemporal_load((const u32x4*)p); return make_uint4(v[0], v[1], v[2], v[3]); }
typedef float f32x2c __attribute__((ext_vector_type(2)));
typedef __bf16 bf16x2c __attribute__((ext_vector_type(2)));
__device__ __forceinline__ unsigned cvtpk_c(float lo, float hi) { f32x2c v = {lo, hi}; bf16x2c b = __builtin_convertvector(v, bf16x2c); return __builtin_bit_cast(unsigned, b); }
__device__ __forceinline__ int swap23(int x) { return (x & ~12) | ((x & 4) << 1) | ((x & 8) >> 1); }
__device__ __forceinline__ int crow(int r, int hi) { return (r & 3) + 8 * (r >> 2) + 4 * hi; }

__device__ __forceinline__ int npos(int i) { return 16 * (i & 3) + (i >> 2); }
template <int QP> __device__ __forceinline__ float quad_bcast(float v) { return __int_as_float(__builtin_amdgcn_update_dpp(0, __float_as_int(v), QP, 0xf, 0xf, true)); }
__device__ __forceinline__ void solve_quad(const float* Nt, int ntp, float (&x)[16], int q) {
    const float* nrow = Nt + 16 * q;
    int zo = 0;
#pragma unroll
    for (int j = 0; j < 63; ++j) {
        const float xo = x[j >> 2];
        const float xj = (j & 3) == 0 ? quad_bcast<0x00>(xo) : (j & 3) == 1 ? quad_bcast<0x55>(xo) : (j & 3) == 2 ? quad_bcast<0xAA>(xo) : quad_bcast<0xFF>(xo);
        const f32x2c xj2 = {-xj, -xj};
#pragma unroll
        for (int i4 = j >> 4; i4 < 4; ++i4) {
            const f32x4v n4 = *(const f32x4v*)(nrow + j * ntp + 4 * i4 + zo);
            if (4 * i4 + 1 >= (j >> 2)) { f32x2c a = {x[4 * i4], x[4 * i4 + 1]}; a = __builtin_elementwise_fma((f32x2c){n4[0], n4[1]}, xj2, a); x[4 * i4] = a[0]; x[4 * i4 + 1] = a[1]; }
            { f32x2c b = {x[4 * i4 + 2], x[4 * i4 + 3]}; b = __builtin_elementwise_fma((f32x2c){n4[2], n4[3]}, xj2, b); x[4 * i4 + 2] = b[0]; x[4 * i4 + 3] = b[1]; }
        }
        if ((j & 1) == 1) asm volatile("" : "+v"(zo) : "v"(xj));
    }
}
__device__ __forceinline__ void solve_quad2(const float* Nt, int ntp, float (&xa)[16], float (&xb)[16], int q) {
    const float* nrow = Nt + 16 * q;
    int zo = 0;
#pragma unroll
    for (int j = 0; j < 63; ++j) {
        const float ao = xa[j >> 2], bo = xb[j >> 2];
        const float aj = (j & 3) == 0 ? quad_bcast<0x00>(ao) : (j & 3) == 1 ? quad_bcast<0x55>(ao) : (j & 3) == 2 ? quad_bcast<0xAA>(ao) : quad_bcast<0xFF>(ao);
        const float bj = (j & 3) == 0 ? quad_bcast<0x00>(bo) : (j & 3) == 1 ? quad_bcast<0x55>(bo) : (j & 3) == 2 ? quad_bcast<0xAA>(bo) : quad_bcast<0xFF>(bo);
        const f32x2c aj2 = {-aj, -aj}, bj2 = {-bj, -bj};
#pragma unroll
        for (int i4 = j >> 4; i4 < 4; ++i4) {
            const f32x4v n4 = *(const f32x4v*)(nrow + j * ntp + 4 * i4 + zo);
            const f32x2c nlo = {n4[0], n4[1]}, nhi = {n4[2], n4[3]};
            if (4 * i4 + 1 >= (j >> 2)) {
                f32x2c a = {xa[4 * i4], xa[4 * i4 + 1]}; a = __builtin_elementwise_fma(nlo, aj2, a); xa[4 * i4] = a[0]; xa[4 * i4 + 1] = a[1];
                f32x2c b = {xb[4 * i4], xb[4 * i4 + 1]}; b = __builtin_elementwise_fma(nlo, bj2, b); xb[4 * i4] = b[0]; xb[4 * i4 + 1] = b[1];
            }
            { f32x2c a = {xa[4 * i4 + 2], xa[4 * i4 + 3]}; a = __builtin_elementwise_fma(nhi, aj2, a); xa[4 * i4 + 2] = a[0]; xa[4 * i4 + 3] = a[1];
              f32x2c b = {xb[4 * i4 + 2], xb[4 * i4 + 3]}; b = __builtin_elementwise_fma(nhi, bj2, b); xb[4 * i4 + 2] = b[0]; xb[4 * i4 + 3] = b[1]; }
        }
        if ((j & 7) == 7) asm volatile("" : "+v"(zo) : "v"(aj), "v"(bj));
    }
}
template <int CTRL> __device__ __forceinline__ float gdpp(float x) { return __int_as_float(__builtin_amdgcn_update_dpp(0, __float_as_int(x), CTRL, 0xf, 0xf, true)); }
__device__ __forceinline__ float psum32(float x) {
    x += gdpp<0xB1>(x); x += gdpp<0x4E>(x); x += gdpp<0x124>(x); x += gdpp<0x128>(x);
    return x + __int_as_float(__builtin_amdgcn_ds_swizzle(__float_as_int(x), (16 << 10) | 0x1f));
}
constexpr int SL_W = 0, SL_U = 16384, SL_QD = 32768, SL_KDT = 49152, SL_QK = 65536, SL_GT = 73728, SLOT_B = 73984;
constexpr int NSLOT = (MTOK / 64) * 2 * CH;
static_assert(DK == 128 && DV == 128 && CHUNK == 64, "gdnc layout");

constexpr int PA_KP = 132, PA_NP = 68;
constexpr int PA_N = 0, PA_GAM = PA_N + 64 * PA_NP, PA_BET = PA_GAM + 64, PA_EG = PA_BET + 64, PA_EGL = PA_EG + 64, PA_ONE = PA_EGL + 64, PA_K = PA_ONE + 128, PA_Q = PA_K + 64 * PA_KP, PA_V = PA_Q + 64 * PA_KP, PA_END = PA_V + 64 * PA_KP;
constexpr int PA_LDS = PA_END * 4;
__device__ __forceinline__ void prep_chunk(const P& p, int l, int slot, char* lds) {
    int tid_ = TIDX; asm volatile("" : "+v"(tid_));
    const int tid = tid_, lane = tid & 63, wv = __builtin_amdgcn_readfirstlane(tid >> 6);
    const int h = slot % CH, d = (slot / CH) % 2, m0 = (slot / (2 * CH)) * 64;
    const act_t* pp = (const act_t*)(p.ws + WS_PP);
    unsigned char* out = p.ws + WS_GCH + (size_t)slot * SLOT_B;
    float* F = (float*)lds;
    __syncthreads();
    {
        const float* wc = p.gdn_conv + (size_t)l * 3 * GC;
        const int sq = seq_of(m0), sbase = seq_start(sq), send = sbase + seq_len(sq);
        const int f = tid & 31, i0 = tid >> 5;
        uint2 xr[12][3]; float4 wt[3][3];
#pragma unroll
        for (int arr = 0; arr < 3; ++arr) { const int ch = (arr == 0 ? CH * DK : arr == 1 ? 0 : 2 * CH * DK) + h * DK + 4 * f;
#pragma unroll
            for (int tap = 0; tap < 3; ++tap) wt[arr][tap] = *(const float4*)(wc + tap * GC + ch); }
#pragma unroll
        for (int j = 0; j < 12; ++j) {
            const int arr = j >> 2, i = i0 + 16 * (j & 3);
            const int m = d == 0 ? m0 + i : m0 + 63 - i;
            const int ch = (arr == 0 ? CH * DK : arr == 1 ? 0 : 2 * CH * DK) + h * DK + 4 * f;
            const act_t* pr = pp + (size_t)m * INP + OFF_GQ + ch;
            xr[j][1] = *(const uint2*)pr; xr[j][0] = *(const uint2*)(pr - (m > sbase ? INP : 0)); xr[j][2] = *(const uint2*)(pr + (m < send - 1 ? INP : 0));
        }
        __builtin_amdgcn_sched_barrier(0);
#pragma unroll
        for (int j = 0; j < 12; ++j) asm volatile("" : "+v"(xr[j][0].x), "+v"(xr[j][0].y), "+v"(xr[j][1].x), "+v"(xr[j][1].y), "+v"(xr[j][2].x), "+v"(xr[j][2].y));
#pragma unroll
        for (int arr = 0; arr < 3; ++arr) asm volatile("" : "+v"(wt[arr][0].x), "+v"(wt[arr][0].y), "+v"(wt[arr][0].z), "+v"(wt[arr][0].w), "+v"(wt[arr][1].x), "+v"(wt[arr][1].y), "+v"(wt[arr][1].z), "+v"(wt[arr][1].w),
                                                                   "+v"(wt[arr][2].x), "+v"(wt[arr][2].y), "+v"(wt[arr][2].z), "+v"(wt[arr][2].w));
#pragma unroll
        for (int j = 0; j < 12; ++j) {
            const int arr = j >> 2, i = i0 + 16 * (j & 3);
            const int m = d == 0 ? m0 + i : m0 + 63 - i;
            const float s0 = m > sbase ? 1.0f : 0.0f, s2 = m < send - 1 ? 1.0f : 0.0f;
            const float4 w0 = wt[arr][0], w1 = wt[arr][1], w2 = wt[arr][2];
            const float4 x0 = make_float4(lo2(xr[j][0].x) * s0, hi2(xr[j][0].x) * s0, lo2(xr[j][0].y) * s0, hi2(xr[j][0].y) * s0);
            const float4 x1 = make_float4(lo2(xr[j][1].x), hi2(xr[j][1].x), lo2(xr[j][1].y), hi2(xr[j][1].y));
            const float4 x2 = make_float4(lo2(xr[j][2].x) * s2, hi2(xr[j][2].x) * s2, lo2(xr[j][2].y) * s2, hi2(xr[j][2].y) * s2);
            const float4 a = make_float4(w1.x * x1.x + w0.x * x0.x + w2.x * x2.x, w1.y * x1.y + w0.y * x0.y + w2.y * x2.y, w1.z * x1.z + w0.z * x0.z + w2.z * x2.z, w1.w * x1.w + w0.w * x0.w + w2.w * x2.w);
            float4 v = make_float4(siluf_(a.x), siluf_(a.y), siluf_(a.z), siluf_(a.w));
            if (arr < 2) {
                float ss = v.x * v.x + v.y * v.y + v.z * v.z + v.w * v.w;
                ss = psum32(ss);
                const float rs = (1.0f / sqrtf(ss + L2_EPS)) * (arr == 1 ? 0.08838834764831845f : 1.0f);
                v = make_float4(v.x * rs, v.y * rs, v.z * rs, v.w * rs);
            }
            *(float4*)(F + (arr == 0 ? PA_K : arr == 1 ? PA_Q : PA_V) + i * PA_KP + 4 * f) = v;
        }
        if (tid < 64) {
            const size_t m = (size_t)(d == 0 ? m0 + tid : m0 + 63 - tid);
            const act_t* pr = pp + m * INP;
            const int dh = d * CH + h;
            F[PA_BET + tid] = sigmoidf_(ldp1(pr + OFF_GB + dh));
            F[PA_GAM + tid] = -fexp_(p.gdn_a_log[(size_t)l * 2 * CH + dh]) * softplusf_(ldp1(pr + OFF_GA + dh) + p.gdn_dt_bias[(size_t)l * 2 * CH + dh]);
            F[PA_ONE + tid] = 1.0f;
        }
    }
    __syncthreads();
    if (tid < 64) {
        float g = 0.f, gl = 0.f;
#pragma unroll 8
        for (int j = 0; j < 64; ++j) { const float v = F[PA_GAM + j]; g += j <= tid ? v : 0.f; gl += v; }
        F[PA_EG + tid] = fexp_(g); F[PA_EGL + tid] = fexp_(gl - g); F[PA_ONE + 64 + tid] = g;
        if (tid == 63) *(float*)(out + SL_GT) = fexp_(g);
    }
    __syncthreads();
    if (tid < 64) F[PA_GAM + tid] = F[PA_ONE + 64 + tid];
    __syncthreads();
    for (int item = wv; item < 22; item += 8) {
        if (item >= 20) {
            const int ti = (item - 20) * 2, tj = ti + 1;
#pragma unroll
            for (int reg = 0; reg < 4; ++reg) { const int i = 16 * ti + (lane >> 4) * 4 + reg, j = 16 * tj + (lane & 15);
                *(unsigned short*)(out + SL_QK + (i * 64 + (j & ~15) + swap23(j & 15)) * 2) = 0; }
            continue;
        }
        const int mat = item / 10, L10 = item % 10;
        int ti = 0, rem = L10; while (rem > ti) { rem -= ti + 1; ++ti; }
        const int tj = rem;
        const float* X = F + (mat == 0 ? PA_K : PA_Q) + (16 * ti + (lane & 15)) * PA_KP + (lane >> 4);
        const float* Y = F + PA_K + (16 * tj + (lane & 15)) * PA_KP + (lane >> 4);
        f32x4v acc = {0.f, 0.f, 0.f, 0.f};
#pragma unroll 8
        for (int s = 0; s < 32; ++s) acc = __builtin_amdgcn_mfma_f32_16x16x4f32(X[4 * s], Y[4 * s], acc, 0, 0, 0);
#pragma unroll
        for (int reg = 0; reg < 4; ++reg) {
            const int i = 16 * ti + (lane >> 4) * 4 + reg, j = 16 * tj + (lane & 15);
            const float dec = fexp_(F[PA_GAM + i] - F[PA_GAM + j]);
            if (mat == 0) F[PA_N + j * PA_NP + npos(i)] = i > j ? F[PA_BET + i] * acc[reg] * dec : 0.f;
            else *(unsigned short*)(out + SL_QK + (i * 64 + (j & ~15) + swap23(j & 15)) * 2) = f2a(i >= j ? acc[reg] * dec : 0.f);
        }
    }
    __syncthreads();
    float xa[16], xb[16];
    {
        const int q = tid & 3, col = tid >> 2;
        const float* ksrc = F + PA_K + col; const float* vsrc = F + PA_V + col;
#pragma unroll
        for (int ii = 0; ii < 16; ++ii) { const int i = 4 * ii + q; const float b = F[PA_BET + i]; xa[ii] = b * ksrc[i * PA_KP] * F[PA_EG + i]; xb[ii] = b * vsrc[i * PA_KP]; }
        solve_quad2(F + PA_N, PA_NP, xa, xb, q);
    }
    {
#pragma unroll
        for (int j = 0; j < 2; ++j) {
            const int c = tid + 512 * j, i = c >> 4, pos = (c & 15) * 8, g16 = pos & ~15, hh = (pos >> 3) & 1;
            const float e = F[PA_EG + i];
            const float4 a = *(const float4*)(F + PA_Q + i * PA_KP + g16 + 4 * hh), b = *(const float4*)(F + PA_Q + i * PA_KP + g16 + 8 + 4 * hh);
            *(uint4*)(out + SL_QD + (i * 128 + pos) * 2) = make_uint4(cvtpk_c(a.x * e, a.y * e), cvtpk_c(a.z * e, a.w * e), cvtpk_c(b.x * e, b.y * e), cvtpk_c(b.z * e, b.w * e));
        }
#pragma unroll
        for (int j = 0; j < 2; ++j) {
            const int c = tid + 512 * j, dk = c >> 3, pos = (c & 7) * 8, g16 = pos & ~15, hh = (pos >> 3) & 1;
            float v8[8];
#pragma unroll
            for (int e = 0; e < 8; ++e) { const int tok = g16 + 8 * (e >> 2) + 4 * hh + (e & 3); v8[e] = F[PA_K + tok * PA_KP + dk] * F[PA_EGL + tok]; }
            *(uint4*)(out + SL_KDT + (dk * 64 + pos) * 2) = make_uint4(cvtpk_c(v8[0], v8[1]), cvtpk_c(v8[2], v8[3]), cvtpk_c(v8[4], v8[5]), cvtpk_c(v8[6], v8[7]));
        }
    }
    __syncthreads();
    unsigned short* Xs = (unsigned short*)(F + PA_V);
    {
        const int q = tid & 3, ca = tid >> 2, cb = 128 + (tid >> 2), pa = (ca & ~15) + swap23(ca & 15);
#pragma unroll
        for (int ii = 0; ii < 16; ++ii) { Xs[(4 * ii + q) * 256 + pa] = f2a(xa[ii]); Xs[(4 * ii + q) * 256 + cb] = f2a(xb[ii]); }
    }
    __syncthreads();
#pragma unroll
    for (int j = 0; j < 4; ++j) {
        const int c = tid + 512 * j, i = c >> 5, cc = c & 31;
        const uint4 v = *(const uint4*)(Xs + i * 256 + cc * 8);
        *(uint4*)(out + (cc < 16 ? SL_W + (i * 128 + cc * 8) * 2 : SL_U + (i * 128 + (cc - 16) * 8) * 2)) = v;
    }
}

constexpr int PB_WP = 272, PB_KP = 144;
constexpr int PB_W = 0, PB_QD = 64 * PB_WP, PB_KDT = 2 * 64 * PB_WP, PB_QK = PB_KDT + 128 * PB_KP, PB_U = PB_QK + 64 * PB_KP, PB_LDS = PB_U + 64 * 256;
__device__ __forceinline__ bf16x8 pack8(const f32x16& x, int s) {
    u32x4 w = {cvtpk_c(x[8 * s], x[8 * s + 1]), cvtpk_c(x[8 * s + 2], x[8 * s + 3]), cvtpk_c(x[8 * s + 4], x[8 * s + 5]), cvtpk_c(x[8 * s + 6], x[8 * s + 7])};
    return __builtin_bit_cast(bf16x8, w);
}
static_assert((SEQ / 64) % 2 == 0 && (DSEQ / 64) % 2 == 0, "chain_half runs the chunks in pairs");
constexpr int PH_BUF = PB_U + 64 * 128, PH_LDS = 2 * PH_BUF;
__device__ __forceinline__ int gh_dst(int q, int half, int& src) {
    if (q < 3584) {
        const int reg = q < 1024 ? 0 : q < 2048 ? 2 : q < 3072 ? 3 : 4, idx = q < 3072 ? (q & 1023) : q - 3072;
        src = reg * 1024 + idx;
        return reg == 0 ? PB_W + (idx >> 4) * PB_WP + (idx & 15) * 16 : reg == 2 ? PB_QD + (idx >> 4) * PB_WP + (idx & 15) * 16 : reg == 3 ? PB_KDT + (idx >> 3) * PB_KP + (idx & 7) * 16 : PB_QK + (idx >> 3) * PB_KP + (idx & 7) * 16;
    }
    const int idx = q - 3584, row = idx >> 3, pc = idx & 7;
    src = 1024 + row * 16 + half * 8 + pc;
    return PB_U + row * 128 + pc * 16;
}
__device__ __forceinline__ void chain_half(const P& p, int l, int s, int d, int h, int half, char* lds) {
    int tid_ = TIDX; asm volatile("" : "+v"(tid_));
    const int tid = tid_, lane = tid & 63, wv = __builtin_amdgcn_readfirstlane(tid >> 6), r = lane & 31, hi = lane >> 5;
    const int T = seq_len(s), base = seq_start(s), nc = T / 64;
    const unsigned char* gch = p.ws + WS_GCH;
    act_t* go = (act_t*)(p.ws + WS_GO);
#define GH_SLOT(c) (gch + (size_t)((((base >> 6) + (d == 0 ? (c) : nc - 1 - (c))) * 2 + d) * CH + h) * SLOT_B)
    __syncthreads();
    if (wv < 2) __builtin_amdgcn_s_setprio(3);
    if (wv >= 2) {
        const int st = tid - 128;
        int ldst[11], lsrc[11];
#pragma unroll
        for (int j = 0; j < 11; ++j) { const int q = st + 384 * j; int sc; ldst[j] = gh_dst(q < 4096 ? q : 0, half, sc); lsrc[j] = sc; }
        const bool tail = st < 4096 - 10 * 384;
        uint4 sa0, sa1, sa2, sa3, sa4, sa5, sa6, sa7, sa8, sa9, sa10 = make_uint4(0, 0, 0, 0), sb0, sb1, sb2, sb3, sb4, sb5, sb6, sb7, sb8, sb9, sb10 = make_uint4(0, 0, 0, 0);
#define GH_LOAD(c, X) do { const uint4* a_ = (const uint4*)GH_SLOT(c); \
            X##0 = ldnt16(a_ + lsrc[0]); X##1 = ldnt16(a_ + lsrc[1]); X##2 = ldnt16(a_ + lsrc[2]); X##3 = ldnt16(a_ + lsrc[3]); X##4 = ldnt16(a_ + lsrc[4]); X##5 = ldnt16(a_ + lsrc[5]); X##6 = ldnt16(a_ + lsrc[6]); X##7 = ldnt16(a_ + lsrc[7]); X##8 = ldnt16(a_ + lsrc[8]); X##9 = ldnt16(a_ + lsrc[9]); \
            if (tail) X##10 = ldnt16(a_ + lsrc[10]); } while (0)
#define GH_STORE(buf, X) do { char* b_ = lds + (buf) * PH_BUF; *(uint4*)(b_ + ldst[0]) = X##0; *(uint4*)(b_ + ldst[1]) = X##1; *(uint4*)(b_ + ldst[2]) = X##2; *(uint4*)(b_ + ldst[3]) = X##3; \
            *(uint4*)(b_ + ldst[4]) = X##4; *(uint4*)(b_ + ldst[5]) = X##5; *(uint4*)(b_ + ldst[6]) = X##6; *(uint4*)(b_ + ldst[7]) = X##7; *(uint4*)(b_ + ldst[8]) = X##8; *(uint4*)(b_ + ldst[9]) = X##9; \
            if (tail) *(uint4*)(b_ + ldst[10]) = X##10; } while (0)
        GH_LOAD(0, sa); GH_STORE(0, sa); GH_LOAD(1, sa); if (2 < nc) GH_LOAD(2, sb);
        __syncthreads();
#define GH_SITER(cc, X) do { const int c = (cc); if (c + 1 < nc) GH_STORE((c + 1) & 1, X); if (c + 3 < nc) GH_LOAD(c + 3, X); __syncthreads(); } while (0)
        for (int c2 = 0; c2 < nc; c2 += 2) { GH_SITER(c2, sa); GH_SITER(c2 + 1, sb); }
#undef GH_LOAD
#undef GH_STORE
#undef GH_SITER
    } else {
        f32x16 S[4];
        const int col = 64 * half + 32 * wv + r;
        if (s >= NB) {
            const float* s0 = p.state_gdn + ((((size_t)(s - NB) * L + l) * 2 + d) * CH + h) * DK * DV + col;
#pragma unroll
            for (int t = 0; t < 4; ++t)
#pragma unroll
                for (int i = 0; i < 16; ++i) S[t][i] = s0[(size_t)(32 * t + crow(i, hi)) * DV];
        } else {
#pragma unroll
            for (int t = 0; t < 4; ++t)
#pragma unroll
                for (int i = 0; i < 16; ++i) S[t][i] = 0.f;
        }
        __syncthreads();
#define GH_COMPUTE \
        { \
            const float gt = *(const float*)(GH_SLOT(c) + SL_GT); \
            bf16x8 Sb[4][2]; \
_Pragma("unroll") \
            for (int t = 0; t < 4; ++t) { Sb[t][0] = pack8(S[t], 0); Sb[t][1] = pack8(S[t], 1); } \
            f32x16 vn[2]; \
_Pragma("unroll") \
            for (int a = 0; a < 2; ++a) { \
                f32x16 acc = {}; \
_Pragma("unroll") \
                for (int t = 0; t < 4; ++t) \
_Pragma("unroll") \
                    for (int k = 0; k < 2; ++k) acc = __builtin_amdgcn_mfma_f32_32x32x16_bf16(*(const bf16x8*)(LB + PB_W + (32 * a + r) * PB_WP + (32 * t + 16 * k + 8 * hi) * 2), Sb[t][k], acc, 0, 0, 0); \
_Pragma("unroll") \
                for (int i = 0; i < 16; ++i) vn[a][i] = a2f(*(const unsigned short*)(LB + PB_U + (32 * a + crow(i, hi)) * 128 + (32 * wv + r) * 2)) - acc[i]; \
            } \
            bf16x8 Vb[2][2]; \
_Pragma("unroll") \
            for (int b = 0; b < 2; ++b) { Vb[b][0] = pack8(vn[b], 0); Vb[b][1] = pack8(vn[b], 1); } \
_Pragma("unroll") \
            for (int a = 0; a < 2; ++a) { \
                f32x16 acc = {}; \
_Pragma("unroll") \
                for (int t = 0; t < 4; ++t) \
_Pragma("unroll") \
                    for (int k = 0; k < 2; ++k) acc = __builtin_amdgcn_mfma_f32_32x32x16_bf16(*(const bf16x8*)(LB + PB_QD + (32 * a + r) * PB_WP + (32 * t + 16 * k + 8 * hi) * 2), Sb[t][k], acc, 0, 0, 0); \
_Pragma("unroll") \
                for (int b = 0; b <= a; ++b) \
_Pragma("unroll") \
                    for (int k = 0; k < 2; ++k) acc = __builtin_amdgcn_mfma_f32_32x32x16_bf16(*(const bf16x8*)(LB + PB_QK + (32 * a + r) * PB_KP + (32 * b + 16 * k + 8 * hi) * 2), Vb[b][k], acc, 0, 0, 0); \
_Pragma("unroll") \
                for (int i = 0; i < 16; ++i) { \
                    const int it = 64 * c + 32 * a + crow(i, hi); \
                    const size_t m = (size_t)(d == 0 ? base + it : base + T - 1 - it); \
                    go[(m * 2 + d) * CW + h * DV + 64 * half + 32 * wv + r] = f2a(acc[i]); \
                } \
            } \
_Pragma("unroll") \
            for (int t = 0; t < 4; ++t) { \
_Pragma("unroll") \
                for (int i = 0; i < 16; ++i) S[t][i] *= gt; \
_Pragma("unroll") \
                for (int b = 0; b < 2; ++b) \
_Pragma("unroll") \
                    for (int k = 0; k < 2; ++k) S[t] = __builtin_amdgcn_mfma_f32_32x32x16_bf16(*(const bf16x8*)(LB + PB_KDT + (32 * t + r) * PB_KP + (32 * b + 16 * k + 8 * hi) * 2), Vb[b][k], S[t], 0, 0, 0); \
            } \
        }

        for (int c = 0; c < nc; ++c) {
            const char* LB = lds + (c & 1) * PH_BUF;
            GH_COMPUTE
            __syncthreads();
        }
        if (s < NB) {
            float* so = p.out + O_SG + ((((size_t)s * L + l) * 2 + d) * CH + h) * DK * DV + col;
#pragma unroll
            for (int t = 0; t < 4; ++t)
#pragma unroll
                for (int i = 0; i < 16; ++i) so[(size_t)(32 * t + crow(i, hi)) * DV] = S[t][i];
        }
#undef GH_COMPUTE
    }
#undef GH_SLOT
    __builtin_amdgcn_s_setprio(0);
}
}
namespace rwkc {
using gdnc::bf16x8; using gdnc::f32x16; using gdnc::f32x4v; using gdnc::cvtpk_c; using gdnc::swap23; using gdnc::crow; using gdnc::pack8; using gdnc::solve_quad;
constexpr int SL_WN = 0, SL_UT = 8192, SL_RT = 16384, SL_AHT = 24576, SL_RAN = 32768, SL_Y0 = 40960, SL_G = 49152, SL_PC = 65536, SLOT_B = 65792;
constexpr int NSLOT = (MTOK / 64) * 2 * AH;
static_assert(AN == 64 && CHUNK == 64, "rwkc layout");
template <int CTRL> __device__ __forceinline__ float ddpp(float x) { return __int_as_float(__builtin_amdgcn_update_dpp(0, __float_as_int(x), CTRL, 0xf, 0xf, true)); }
__device__ __forceinline__ float dsum16(float x) { x += ddpp<0xB1>(x); x += ddpp<0x4E>(x); x += ddpp<0x124>(x); x += ddpp<0x128>(x); return x; }

constexpr int TP = 68;
constexpr int TSZ = 64 * TP;
constexpr int A_AT = 0, A_PC = TSZ, A_TK = A_PC + 64, A_TA = A_TK + TSZ, A_TKK = A_TA + TSZ, A_TR = A_TKK + TSZ, A_TV = A_TR + TSZ, A_TB = A_TV + TSZ, A_TRK = A_TB + TSZ, A_END = A_TRK + TSZ;
constexpr int PA_LDS = A_END * 4;
__device__ __forceinline__ f32x4v tile_xyT(const float* X, const float* Y, int ti, int tj, int lane) {
    const float* xp = X + (16 * ti + (lane & 15)) * TP + (lane >> 4); const float* yp = Y + (16 * tj + (lane & 15)) * TP + (lane >> 4);
    float xv[16], yv[16];
#pragma unroll
    for (int s = 0; s < 16; ++s) { xv[s] = xp[4 * s]; yv[s] = yp[4 * s]; }
    __builtin_amdgcn_sched_barrier(0);
    f32x4v acc = {0.f, 0.f, 0.f, 0.f};
#pragma unroll
    for (int s = 0; s < 16; ++s) acc = __builtin_amdgcn_mfma_f32_16x16x4f32(xv[s], yv[s], acc, 0, 0, 0);
    return acc;
}
__device__ __forceinline__ f32x4v tile_xv(const float* X, const float* V, int ti, int tj, int lane) {
    const float* xp = X + (16 * ti + (lane & 15)) * TP + (lane >> 4); const float* vp = V + (lane >> 4) * TP + 16 * tj + (lane & 15);
    f32x4v acc = {0.f, 0.f, 0.f, 0.f};
#pragma unroll
    for (int s = 0; s < 16; ++s) acc = __builtin_amdgcn_mfma_f32_16x16x4f32(xp[4 * s], vp[4 * s * TP], acc, 0, 0, 0);
    return acc;
}
__device__ __forceinline__ f32x4v tile_xTv(const float* X, const float* V, int ti, int tj, int lane) {
    const float* xp = X + (lane >> 4) * TP + 16 * ti + (lane & 15); const float* vp = V + (lane >> 4) * TP + 16 * tj + (lane & 15);
    f32x4v acc = {0.f, 0.f, 0.f, 0.f};
#pragma unroll
    for (int s = 0; s < 16; ++s) acc = __builtin_amdgcn_mfma_f32_16x16x4f32(xp[4 * s * TP], vp[4 * s * TP], acc, 0, 0, 0);
    return acc;
}
__device__ __forceinline__ bf16x8 cvt8(const float4 a, const float4 b) { gdnc::u32x4 w = {cvtpk_c(a.x, a.y), cvtpk_c(a.z, a.w), cvtpk_c(b.x, b.y), cvtpk_c(b.z, b.w)}; return __builtin_bit_cast(bf16x8, w); }
__device__ __forceinline__ bf16x8 cvt8s(const float* p, int stride) {
    gdnc::u32x4 w = {cvtpk_c(p[0], p[stride]), cvtpk_c(p[2 * stride], p[3 * stride]), cvtpk_c(p[4 * stride], p[5 * stride]), cvtpk_c(p[6 * stride], p[7 * stride])}; return __builtin_bit_cast(bf16x8, w); }
__device__ __forceinline__ void ld8s(const float* p, int stride, float (&v)[8]) {
#pragma unroll
    for (int e = 0; e < 8; ++e) v[e] = p[e * stride];
}
__device__ __forceinline__ bf16x8 pk8(const float (&v)[8]) { gdnc::u32x4 w = {cvtpk_c(v[0], v[1]), cvtpk_c(v[2], v[3]), cvtpk_c(v[4], v[5]), cvtpk_c(v[6], v[7])}; return __builtin_bit_cast(bf16x8, w); }
__device__ __forceinline__ f32x4v tile_xyT_bf(const float* X, const float* Y, int ti, int tj, int lane) {
    const float* xp = X + (16 * ti + (lane & 15)) * TP + 8 * (lane >> 4); const float* yp = Y + (16 * tj + (lane & 15)) * TP + 8 * (lane >> 4);
    const float4 x0 = *(const float4*)xp, x1 = *(const float4*)(xp + 4), x2 = *(const float4*)(xp + 32), x3 = *(const float4*)(xp + 36);
    const float4 y0 = *(const float4*)yp, y1 = *(const float4*)(yp + 4), y2 = *(const float4*)(yp + 32), y3 = *(const float4*)(yp + 36);
    __builtin_amdgcn_sched_barrier(0);
    f32x4v acc = {0.f, 0.f, 0.f, 0.f};
    acc = __builtin_amdgcn_mfma_f32_16x16x32_bf16(cvt8(x0, x1), cvt8(y0, y1), acc, 0, 0, 0);
    acc = __builtin_amdgcn_mfma_f32_16x16x32_bf16(cvt8(x2, x3), cvt8(y2, y3), acc, 0, 0, 0);
    return acc;
}
__device__ __forceinline__ f32x4v tile_xv_bf(const float* X, const float* V, int ti, int tj, int lane) {
    const float* xp = X + (16 * ti + (lane & 15)) * TP + 8 * (lane >> 4); const float* vp = V + 8 * (lane >> 4) * TP + 16 * tj + (lane & 15);
    const float4 x0 = *(const float4*)xp, x1 = *(const float4*)(xp + 4), x2 = *(const float4*)(xp + 32), x3 = *(const float4*)(xp + 36);
    float v0[8], v1[8]; ld8s(vp, TP, v0); ld8s(vp + 32 * TP, TP, v1);
    __builtin_amdgcn_sched_barrier(0);
    f32x4v acc = {0.f, 0.f, 0.f, 0.f};
    acc = __builtin_amdgcn_mfma_f32_16x16x32_bf16(cvt8(x0, x1), pk8(v0), acc, 0, 0, 0);
    acc = __builtin_amdgcn_mfma_f32_16x16x32_bf16(cvt8(x2, x3), pk8(v1), acc, 0, 0, 0);
    return acc;
}
__device__ __forceinline__ f32x4v tile_xTv_bf(const float* X, const float* V, int ti, int tj, int lane) {
    const float* xp = X + 8 * (lane >> 4) * TP + 16 * ti + (lane & 15); const float* vp = V + 8 * (lane >> 4) * TP + 16 * tj + (lane & 15);
    float a0[8], a1[8], v0[8], v1[8]; ld8s(xp, TP, a0); ld8s(xp + 32 * TP, TP, a1); ld8s(vp, TP, v0); ld8s(vp + 32 * TP, TP, v1);
    __builtin_amdgcn_sched_barrier(0);
    f32x4v acc = {0.f, 0.f, 0.f, 0.f};
    acc = __builtin_amdgcn_mfma_f32_16x16x32_bf16(pk8(a0), pk8(v0), acc, 0, 0, 0);
    acc = __builtin_amdgcn_mfma_f32_16x16x32_bf16(pk8(a1), pk8(v1), acc, 0, 0, 0);
    return acc;
}
__device__ __forceinline__ void prep_chunk(const P& p, int l, int slot, char* lds) {
    int tid_ = TIDX; asm volatile("" : "+v"(tid_));
    const int tid = tid_, lane = tid & 63, wv = __builtin_amdgcn_readfirstlane(tid >> 6);
    const int h = slot % AH, d = (slot / AH) % 2, m0 = (slot / (2 * AH)) * 64;
    const act_t* pp = (const act_t*)(p.ws + WS_PP);
    unsigned char* out = p.ws + WS_RCH + (size_t)slot * SLOT_B;
    float* F = (float*)lds;
    __syncthreads();
    {
        const act_t* lora = (const act_t*)(p.ws + WS_LORA);
        float* rwb = (float*)(p.ws + WS_RWB);
        uint2 dk[2], dr[2], dv[2], dlw[2], dla[2];
        const int f_ = tid & 15, c0_ = h * AN + 4 * f_;
#pragma unroll
        for (int j = 0; j < 2; ++j) {
            const int i = (tid + 512 * j) >> 4; const size_t m = (size_t)(d == 0 ? m0 + i : m0 + 63 - i);
            const act_t* pr = pp + m * INP; const act_t* lr = lora + m * LORAN;
            dk[j] = *(const uint2*)(pr + OFF_K + c0_); dr[j] = *(const uint2*)(pr + OFF_R + c0_); dv[j] = *(const uint2*)(pr + OFF_V + c0_);
            dlw[j] = *(const uint2*)(lr + d * AW + c0_); dla[j] = *(const uint2*)(lr + (2 + d) * AW + c0_);
        }
        float4 w04 = *(const float4*)(p.rwkv_w0 + ((size_t)l * 2 + d) * AW + c0_), a04 = *(const float4*)(p.rwkv_a0 + ((size_t)l * 2 + d) * AW + c0_);
        float4 ka4 = *(const float4*)(p.rwkv_ka + (size_t)l * AW + c0_), ks4 = *(const float4*)(p.rwkv_kk + (size_t)l * AW + c0_), rk4 = *(const float4*)(p.rwkv_rk + ((size_t)l * AH + h) * AN + 4 * f_);
        __builtin_amdgcn_sched_barrier(0);
#pragma unroll
        for (int j = 0; j < 2; ++j) asm volatile("" : "+v"(dk[j].x), "+v"(dk[j].y), "+v"(dr[j].x), "+v"(dr[j].y), "+v"(dv[j].x), "+v"(dv[j].y), "+v"(dlw[j].x), "+v"(dlw[j].y), "+v"(dla[j].x), "+v"(dla[j].y));
        asm volatile("" : "+v"(w04.x), "+v"(w04.y), "+v"(w04.z), "+v"(w04.w), "+v"(a04.x), "+v"(a04.y), "+v"(a04.z), "+v"(a04.w), "+v"(ka4.x), "+v"(ka4.y), "+v"(ka4.z), "+v"(ka4.w));
        asm volatile("" : "+v"(ks4.x), "+v"(ks4.y), "+v"(ks4.z), "+v"(ks4.w), "+v"(rk4.x), "+v"(rk4.y), "+v"(rk4.z), "+v"(rk4.w));
#define RW_U4(u) make_float4(lo2((u).x), hi2((u).x), lo2((u).y), hi2((u).y))
#pragma unroll
        for (int j = 0; j < 2; ++j) {
            const int q = tid + 512 * j, i = q >> 4, f = q & 15, c0 = h * AN + 4 * f;
            const size_t m = (size_t)(d == 0 ? m0 + i : m0 + 63 - i);
            const float4 k4 = RW_U4(dk[j]), r4 = RW_U4(dr[j]), v4 = RW_U4(dv[j]);
            const float4 lw4 = RW_U4(dlw[j]), la4 = RW_U4(dla[j]);
            const float kx[4] = {k4.x, k4.y, k4.z, k4.w}, rx[4] = {r4.x, r4.y, r4.z, r4.w}, lw[4] = {lw4.x, lw4.y, lw4.z, lw4.w}, la[4] = {la4.x, la4.y, la4.z, la4.w};
            const float w0[4] = {w04.x, w04.y, w04.z, w04.w}, a0[4] = {a04.x, a04.y, a04.z, a04.w}, ka[4] = {ka4.x, ka4.y, ka4.z, ka4.w}, ks[4] = {ks4.x, ks4.y, ks4.z, ks4.w}, rk[4] = {rk4.x, rk4.y, rk4.z, rk4.w};
            float kk[4], ss = 0.f;
#pragma unroll
            for (int e = 0; e < 4; ++e) { kk[e] = kx[e] * ks[e]; ss += kk[e] * kk[e]; }
            ss = dsum16(ss);
            const float rs = 1.0f / sqrtf(ss + L2_EPS);
            float al[4], kd[4], lg[4], bon = 0.f;
#pragma unroll
            for (int e = 0; e < 4; ++e) {
                kk[e] *= rs;
                lg[e] = -fexp_(-softplusf_(-(w0[e] + lw[e])) - 0.5f);
                const float a = sigmoidf_(a0[e] + la[e]);
                kd[e] = kx[e] * (1.0f + (a - 1.0f) * ka[e]); al[e] = kk[e] * a;
                bon += rx[e] * kd[e] * rk[e];
            }
            bon = dsum16(bon);
            if (f == 0) rwb[(m * 2 + d) * AH + h] = bon;
            *(float4*)(F + A_TK + i * TP + 4 * f) = make_float4(kk[0], kk[1], kk[2], kk[3]);
            *(float4*)(F + A_TA + i * TP + 4 * f) = make_float4(al[0], al[1], al[2], al[3]);
            *(float4*)(F + A_TKK + i * TP + 4 * f) = make_float4(kd[0], kd[1], kd[2], kd[3]);
            *(float4*)(F + A_TR + i * TP + 4 * f) = r4;
            *(float4*)(F + A_TV + i * TP + 4 * f) = v4;
            *(float4*)(F + A_TB + i * TP + 4 * f) = make_float4(lg[0], lg[1], lg[2], lg[3]);
        }
    }
    __syncthreads();
    {
        const int c = tid & 63, part = tid >> 6;
        float bs = 0.f;
#pragma unroll
        for (int t = 0; t < 8; ++t) bs += F[A_TB + (8 * part + t) * TP + c];
        F[A_TRK + part * TP + c] = bs;
        __syncthreads();
        float lp = 0.f, tot = 0.f;
#pragma unroll
        for (int q = 0; q < 8; ++q) { const float v = F[A_TRK + q * TP + c]; lp += q < part ? v : 0.f; tot += v; }
#pragma unroll
        for (int t = 0; t < 8; ++t) {
            const int tt = 8 * part + t;
            const float e_prev = fexp_(lp);
            lp += F[A_TB + tt * TP + c];
            const float e = fexp_(lp), ei = fexp_(-lp);
            F[A_TK + tt * TP + c] *= e_prev; F[A_TA + tt * TP + c] *= ei; F[A_TKK + tt * TP + c] *= ei; F[A_TR + tt * TP + c] *= e;
        }
        if (part == 0) { const float pc = fexp_(tot); F[A_PC + c] = pc; *(float*)(out + SL_PC + c * 4) = pc; }
    }
    __syncthreads();
    for (int item = wv; item < 42; item += 8) {
        if (item >= 40) {
            const int ti = (item - 40) * 2, tj = ti + 1;
#pragma unroll
            for (int reg = 0; reg < 4; ++reg) { const int i = 16 * ti + (lane >> 4) * 4 + reg, j = 16 * tj + (lane & 15);
                *(unsigned short*)(out + SL_RAN + (i * 64 + (j & ~15) + swap23(j & 15)) * 2) = 0; }
            continue;
        }
        const int mat = item / 10, L10 = item % 10;
        int ti = 0, rem = L10; while (rem > ti) { rem -= ti + 1; ++ti; }
        const int tj = rem;
        const f32x4v acc = mat < 2 ? tile_xyT_bf(F + A_TK, F + (mat == 0 ? A_TA : A_TKK), ti, tj, lane)
                                   : tile_xyT_bf(F + A_TR, F + (mat == 2 ? A_TA : A_TKK), ti, tj, lane);
#pragma unroll
        for (int reg = 0; reg < 4; ++reg) {
            const int i = 16 * ti + (lane >> 4) * 4 + reg, j = 16 * tj + (lane & 15);
            if (mat == 0) F[A_AT + j * TP + gdnc::npos(i)] = i > j ? acc[reg] : 0.f;
            else if (mat == 1) F[A_TB + i * TP + j] = i > j ? acc[reg] : 0.f;
            else if (mat == 2) *(unsigned short*)(out + SL_RAN + (i * 64 + (j & ~15) + swap23(j & 15)) * 2) = f2a(i >= j ? -acc[reg] : 0.f);
            else F[A_TRK + i * TP + j] = i >= j ? acc[reg] : 0.f;
        }
    }
    for (int item = wv; item < 12; item += 8) {
        const int mat = item / 6, L6 = item % 6;
        int tj = 1, rem = L6; while (rem >= tj) { rem -= tj; ++tj; }
        const int ti = rem;
        if (mat < 2) {
#pragma unroll
            for (int reg = 0; reg < 4; ++reg) F[(mat == 0 ? A_TB : A_TRK) + (16 * ti + (lane >> 4) * 4 + reg) * TP + 16 * tj + (lane & 15)] = 0.f;
        }
    }
    {
#pragma unroll
        for (int j = 0; j < 1; ++j) {
            const int c = tid, i = c >> 3, pos = (c & 7) * 8, g16 = pos & ~15, hh = (pos >> 3) & 1;
            const float4 a = *(const float4*)(F + A_TR + i * TP + g16 + 4 * hh), b = *(const float4*)(F + A_TR + i * TP + g16 + 8 + 4 * hh);
            *(uint4*)(out + SL_RT + (i * 64 + pos) * 2) = make_uint4(cvtpk_c(a.x, a.y), cvtpk_c(a.z, a.w), cvtpk_c(b.x, b.y), cvtpk_c(b.z, b.w));
        }
        {
            const int c = tid, dk = c >> 3, pos = (c & 7) * 8, g16 = pos & ~15, hh = (pos >> 3) & 1;
            const float pc = -F[A_PC + dk];
            float v8[8];
#pragma unroll
            for (int e = 0; e < 8; ++e) { const int tok = g16 + 8 * (e >> 2) + 4 * hh + (e & 3); v8[e] = F[A_TA + tok * TP + dk] * pc; }
            *(uint4*)(out + SL_AHT + (dk * 64 + pos) * 2) = make_uint4(cvtpk_c(v8[0], v8[1]), cvtpk_c(v8[2], v8[3]), cvtpk_c(v8[4], v8[5]), cvtpk_c(v8[6], v8[7]));
        }
    }
    __syncthreads();
    for (int item = wv; item < 48; item += 8) {
        const int mat = item >> 4, ti = (item >> 2) & 3, tj = item & 3;
        f32x4v acc;
        if (mat == 0) acc = tile_xv_bf(F + A_TB, F + A_TV, ti, tj, lane);
        else if (mat == 1) acc = tile_xv_bf(F + A_TRK, F + A_TV, ti, tj, lane);
        else acc = tile_xTv_bf(F + A_TKK, F + A_TV, ti, tj, lane);
#pragma unroll
        for (int reg = 0; reg < 4; ++reg) {
            const int i = 16 * ti + (lane >> 4) * 4 + reg, j = 16 * tj + (lane & 15);
            if (mat == 0) F[A_TR + i * TP + j] = acc[reg];
            else if (mat == 1) *(unsigned short*)(out + SL_Y0 + (i * 64 + j) * 2) = f2a(acc[reg]);
            else *(float*)(out + SL_G + (i * 64 + j) * 4) = acc[reg] * F[A_PC + i];
        }
    }
    __syncthreads();
    unsigned short* Xs = (unsigned short*)(F + A_TV);
    if (__builtin_amdgcn_readfirstlane(tid >> 8) == 0) {
        float xa[16], xb[16];
        const int sq = tid & 3, scol = tid >> 2;
#pragma unroll
        for (int ii = 0; ii < 16; ++ii) { xa[ii] = F[A_TK + scol + (4 * ii + sq) * TP]; xb[ii] = F[A_TR + scol + (4 * ii + sq) * TP]; }
        gdnc::solve_quad2(F + A_AT, TP, xa, xb, sq);
        const int pcol = (scol & ~15) + swap23(scol & 15);
#pragma unroll
        for (int ii = 0; ii < 16; ++ii) { Xs[(4 * ii + sq) * 128 + pcol] = f2a(-xa[ii]); Xs[(4 * ii + sq) * 128 + 64 + scol] = f2a(xb[ii]); }
    }
    __syncthreads();
#pragma unroll
    for (int j = 0; j < 2; ++j) {
        const int c = tid + 512 * j, i = c >> 4, cc = c & 15;
        const uint4 v = *(const uint4*)(Xs + i * 128 + cc * 8);
        *(uint4*)(out + (cc < 8 ? SL_WN + (i * 64 + cc * 8) * 2 : SL_UT + (i * 64 + (cc - 8) * 8) * 2)) = v;
    }
}

constexpr int BP = 144;
constexpr int B_WN = 0, B_RT = 64 * BP, B_AHT = 2 * 64 * BP, B_RAN = 3 * 64 * BP, B_UT = 4 * 64 * BP, B_Y0 = B_UT + 8192, B_G = B_Y0 + 8192, B_PC = B_G + 16384, B_DIR = B_PC + 256;
constexpr int PB_LDS = 2 * B_DIR;
static_assert((SEQ / 64) % 2 == 0 && (DSEQ / 64) % 2 == 0, "chain_dir runs the chunks in pairs");
constexpr int PD_LDS = 2 * B_DIR;
__device__ __forceinline__ int rd_dst(int q) {
    if (q < 3072) { const int img = q >> 9, row = (q & 511) >> 3, pc = q & 7;
        return img == 0 ? B_WN + row * BP + pc * 16 : img == 1 ? B_UT + row * 128 + pc * 16 : img == 2 ? B_RT + row * BP + pc * 16 : img == 3 ? B_AHT + row * BP + pc * 16
             : img == 4 ? B_RAN + row * BP + pc * 16 : B_Y0 + row * 128 + pc * 16; }
    return q < 4096 ? B_G + (q - 3072) * 16 : B_PC + (q - 4096) * 16;
}
__device__ __forceinline__ void chain_dir(const P& p, int l, int s, int d, int h, char* lds) {
    int tid_ = TIDX; asm volatile("" : "+v"(tid_));
    const int tid = tid_, lane = tid & 63, wv = __builtin_amdgcn_readfirstlane(tid >> 6), r = lane & 31, hi = lane >> 5;
    const int T = seq_len(s), base = seq_start(s), nc = T / 64;
    const unsigned char* rch = p.ws + WS_RCH;
    act_t* yb = (act_t*)(p.ws + WS_RWY);
#define RD_SLOT(c) (rch + (size_t)((((base >> 6) + (d == 0 ? (c) : nc - 1 - (c))) * 2 + d) * AH + h) * SLOT_B)
    __syncthreads();
    if (wv < 2) __builtin_amdgcn_s_setprio(3);
    if (wv >= 2) {
        const int st = tid - 128;
        int ldst[11];
#pragma unroll
        for (int j = 0; j < 11; ++j) { const int q = st + 384 * j; ldst[j] = rd_dst(q < 4112 ? q : 0); }
        const bool tail = st < 4112 - 10 * 384;
        uint4 sa0, sa1, sa2, sa3, sa4, sa5, sa6, sa7, sa8, sa9, sa10 = make_uint4(0, 0, 0, 0), sb0, sb1, sb2, sb3, sb4, sb5, sb6, sb7, sb8, sb9, sb10 = make_uint4(0, 0, 0, 0);
#define RD_LOAD(c, X) do { const uint4* a_ = (const uint4*)RD_SLOT(c) + st; \
            X##0 = gdnc::ldnt16(a_ + 0); X##1 = gdnc::ldnt16(a_ + 384); X##2 = gdnc::ldnt16(a_ + 768); X##3 = gdnc::ldnt16(a_ + 1152); X##4 = gdnc::ldnt16(a_ + 1536); X##5 = gdnc::ldnt16(a_ + 1920); X##6 = gdnc::ldnt16(a_ + 2304); X##7 = gdnc::ldnt16(a_ + 2688); X##8 = gdnc::ldnt16(a_ + 3072); X##9 = gdnc::ldnt16(a_ + 3456); if (tail) X##10 = gdnc::ldnt16(a_ + 3840); } while (0)
#define RD_STORE(buf, X) do { char* b_ = lds + (buf) * B_DIR; *(uint4*)(b_ + ldst[0]) = X##0; *(uint4*)(b_ + ldst[1]) = X##1; *(uint4*)(b_ + ldst[2]) = X##2; *(uint4*)(b_ + ldst[3]) = X##3; \
            *(uint4*)(b_ + ldst[4]) = X##4; *(uint4*)(b_ + ldst[5]) = X##5; *(uint4*)(b_ + ldst[6]) = X##6; *(uint4*)(b_ + ldst[7]) = X##7; *(uint4*)(b_ + ldst[8]) = X##8; *(uint4*)(b_ + ldst[9]) = X##9; \
            if (tail) *(uint4*)(b_ + ldst[10]) = X##10; } while (0)
        RD_LOAD(0, sa); RD_STORE(0, sa); RD_LOAD(1, sa); if (2 < nc) RD_LOAD(2, sb);
        __syncthreads();
#define RD_SITER(cc, X) do { const int c = (cc); if (c + 1 < nc) RD_STORE((c + 1) & 1, X); if (c + 3 < nc) RD_LOAD(c + 3, X); __syncthreads(); } while (0)
        for (int c2 = 0; c2 < nc; c2 += 2) { RD_SITER(c2, sa); RD_SITER(c2 + 1, sb); }
#undef RD_LOAD
#undef RD_STORE
#undef RD_SITER
    } else {
        const int vb = (wv & 1) * 32;
        f32x16 Z[2];
        if (s >= NB) {
            const float* s0 = p.state_rwkv + ((((size_t)(s - NB) * L + l) * 2 + d) * AH + h) * AN * AN + (size_t)(vb + r) * AN;
#pragma unroll
            for (int t = 0; t < 2; ++t)
#pragma unroll
                for (int i = 0; i < 16; ++i) Z[t][i] = s0[32 * t + crow(i, hi)];
        } else {
#pragma unroll
            for (int t = 0; t < 2; ++t)
#pragma unroll
                for (int i = 0; i < 16; ++i) Z[t][i] = 0.f;
        }
        __syncthreads();
#define RD_COMPUTE \
        if (wv < 2) { \
            bf16x8 Zb[2][2]; \
_Pragma("unroll") \
            for (int t = 0; t < 2; ++t) { Zb[t][0] = pack8(Z[t], 0); Zb[t][1] = pack8(Z[t], 1); } \
            f32x16 U[2]; \
_Pragma("unroll") \
            for (int a = 0; a < 2; ++a) { \
                f32x16 acc = {}; \
_Pragma("unroll") \
                for (int t = 0; t < 2; ++t) \
_Pragma("unroll") \
                    for (int k = 0; k < 2; ++k) acc = __builtin_amdgcn_mfma_f32_32x32x16_bf16(*(const bf16x8*)(LB + B_WN + (32 * a + r) * BP + (32 * t + 16 * k + 8 * hi) * 2), Zb[t][k], acc, 0, 0, 0); \
_Pragma("unroll") \
                for (int i = 0; i < 16; ++i) U[a][i] = a2f(*(const unsigned short*)(LB + B_UT + (32 * a + crow(i, hi)) * 128 + (vb + r) * 2)) - acc[i]; \
            } \
            bf16x8 Ub[2][2]; \
_Pragma("unroll") \
            for (int b = 0; b < 2; ++b) { Ub[b][0] = pack8(U[b], 0); Ub[b][1] = pack8(U[b], 1); } \
_Pragma("unroll") \
            for (int a = 0; a < 2; ++a) { \
                f32x16 acc = {}; \
_Pragma("unroll") \
                for (int t = 0; t < 2; ++t) \
_Pragma("unroll") \
                    for (int k = 0; k < 2; ++k) acc = __builtin_amdgcn_mfma_f32_32x32x16_bf16(*(const bf16x8*)(LB + B_RT + (32 * a + r) * BP + (32 * t + 16 * k + 8 * hi) * 2), Zb[t][k], acc, 0, 0, 0); \
_Pragma("unroll") \
                for (int b = 0; b <= a; ++b) \
_Pragma("unroll") \
                    for (int k = 0; k < 2; ++k) acc = __builtin_amdgcn_mfma_f32_32x32x16_bf16(*(const bf16x8*)(LB + B_RAN + (32 * a + r) * BP + (32 * b + 16 * k + 8 * hi) * 2), Ub[b][k], acc, 0, 0, 0); \
_Pragma("unroll") \
                for (int i = 0; i < 16; ++i) { \
                    const int it = 64 * c + 32 * a + crow(i, hi); \
                    const size_t m = (size_t)(d == 0 ? base + it : base + T - 1 - it); \
                    yb[(m * 2 + d) * AW + h * AN + vb + r] = f2a(acc[i] + a2f(*(const unsigned short*)(LB + B_Y0 + (32 * a + crow(i, hi)) * 128 + (vb + r) * 2))); \
                } \
            } \
_Pragma("unroll") \
            for (int t = 0; t < 2; ++t) { \
_Pragma("unroll") \
                for (int i = 0; i < 16; ++i) { const int dk = 32 * t + crow(i, hi); Z[t][i] = Z[t][i] * *(const float*)(LB + B_PC + dk * 4) + *(const float*)(LB + B_G + (dk * 64 + vb + r) * 4); } \
_Pragma("unroll") \
                for (int b = 0; b < 2; ++b) \
_Pragma("unroll") \
                    for (int k = 0; k < 2; ++k) Z[t] = __builtin_amdgcn_mfma_f32_32x32x16_bf16(*(const bf16x8*)(LB + B_AHT + (32 * t + r) * BP + (32 * b + 16 * k + 8 * hi) * 2), Ub[b][k], Z[t], 0, 0, 0); \
            } \
        }

        for (int c = 0; c < nc; ++c) {
            const char* LB = lds + (c & 1) * B_DIR;
            RD_COMPUTE
            __syncthreads();
        }
        if (s < NB) {
            float* so = p.out + O_SR + ((((size_t)s * L + l) * 2 + d) * AH + h) * AN * AN + (size_t)(vb + r) * AN;
#pragma unroll
            for (int t = 0; t < 2; ++t)
#pragma unroll
                for (int i = 0; i < 16; ++i) so[32 * t + crow(i, hi)] = Z[t][i];
        }
#undef RD_COMPUTE
    }
#undef RD_SLOT
    __builtin_amdgcn_s_setprio(0);
}
}
constexpr int MX_RW_LAT = NDB * AH * 2, MX_G2_LAT = NDB * 2 * CH * 2, MX_AT_LAT = AT_NU_LAT, MX_GD_CTX = NB * 2 * CH * 2, MX_RW_CTX = NB * AH * 2, MX_AT_CTX = AT_NU_CTX;
constexpr int MX_TOTAL = MX_RW_LAT + MX_G2_LAT + MX_AT_LAT + MX_GD_CTX + MX_RW_CTX + MX_AT_CTX;
__device__ __forceinline__ void ph_mixers(const P& p, int l, char* lds, int misc_off, int round = 0) {
    unsigned* head = (unsigned*)(p.ws + WS_CTL + 32768) + (l + round * L) * 64;
    volatile __attribute__((address_space(3))) unsigned* slot = (volatile __attribute__((address_space(3))) unsigned*)((__attribute__((address_space(3))) char*)lds + misc_off + 16);
    for (;;) {
        __syncthreads();
        if (TIDX == 0) *slot = __hip_atomic_fetch_add(head, 1u, __ATOMIC_RELAXED, __HIP_MEMORY_SCOPE_AGENT);
        __syncthreads();
        int t = (int)*slot;
        t = __builtin_amdgcn_readfirstlane(t);
        if (t >= MX_TOTAL) break;
        if (t < MX_RW_LAT) { const int u = t; rwkc::chain_dir(p, l, NB + u / (2 * AH), (u / AH) % 2, u % AH, lds);
            if (DUPMASK & 32) rwkc::chain_dir(p, l, NB + u / (2 * AH), (u / AH) % 2, u % AH, lds); continue; } t -= MX_RW_LAT;
        if (t < MX_G2_LAT) { const int u = t; gdnc::chain_half(p, l, NB + u / (CH * 4), (u / (2 * CH)) % 2, (u / 2) % CH, u % 2, lds); continue; } t -= MX_G2_LAT;
        if (t < MX_AT_LAT) { attn_unit(p, t, lds); if (DUPMASK & 128) attn_unit(p, t, lds); continue; } t -= MX_AT_LAT;
        if (t < MX_GD_CTX) { const int u = t; gdnc::chain_half(p, l, u / (CH * 4), (u / (2 * CH)) % 2, (u / 2) % CH, u % 2, lds); continue; } t -= MX_GD_CTX;
        if (t < MX_RW_CTX) { const int u = t; rwkc::chain_dir(p, l, u / (2 * AH), (u / AH) % 2, u % AH, lds); continue; } t -= MX_RW_CTX;
        attn_unit(p, AT_NU_LAT + t, lds);
    }
}
namespace fastp {
template <int CTRL> __device__ __forceinline__ float dppf(float x) { return __int_as_float(__builtin_amdgcn_update_dpp(0, __float_as_int(x), CTRL, 0xf, 0xf, true)); }
template <int XORM> __device__ __forceinline__ float swzx(float x) { return __int_as_float(__builtin_amdgcn_ds_swizzle(__float_as_int(x), (XORM << 10) | 0x1f)); }
__device__ __forceinline__ float sum4(float x) { x += dppf<0xB1>(x); x += dppf<0x4E>(x); return x; }
__device__ __forceinline__ float sum16(float x) { x = sum4(x); x += dppf<0x124>(x); x += dppf<0x128>(x); return x; }
__device__ __forceinline__ float wsum(float x) {
    x = sum16(x); x += swzx<16>(x);
    auto rr = __builtin_amdgcn_permlane32_swap(__float_as_uint(x), __float_as_uint(x), false, false);
    return __uint_as_float(rr[0]) + __uint_as_float(rr[1]);
}
template <int N> __device__ __forceinline__ float gsumN(float x) {
    static_assert(N == 8 || N == 16 || N == 32, "group size");
    if (N == 8) { x = sum4(x); x += swzx<4>(x); return x; }
    x = sum16(x);
    if (N == 32) x += swzx<16>(x);
    return x;
}
#define gsum(x, n) gsumN<n>(x)
__device__ __forceinline__ uint2 pk4(float a, float b, float c, float d) { return make_uint2(mk2(a, b), mk2(c, d)); }
struct WaveId { int gw, nw, lane; };
__device__ __forceinline__ WaveId wave_id() {
    int tid = TIDX; asm volatile("" : "+v"(tid));
    WaveId w; w.lane = tid & 63; w.gw = __builtin_amdgcn_readfirstlane((tid >> 6) * (int)gridDim.x + (int)blockIdx.x); w.nw = (int)gridDim.x * (NTHR_ / 64); return w;
}

static_assert(D % 256 == 0, "row sweep");
__device__ __forceinline__ void ldx8(const unsigned short* p, float (&v)[8]) {
    const uint4 u = *(const uint4*)p;
    v[0] = __uint_as_float(u.x << 16); v[1] = __uint_as_float(u.x & 0xffff0000u); v[2] = __uint_as_float(u.y << 16); v[3] = __uint_as_float(u.y & 0xffff0000u);
    v[4] = __uint_as_float(u.z << 16); v[5] = __uint_as_float(u.z & 0xffff0000u); v[6] = __uint_as_float(u.w << 16); v[7] = __uint_as_float(u.w & 0xffff0000u);
}
static_assert(D % 512 == 0, "row sweep (8 per lane)");
__device__ __forceinline__ void norm_rows(const P& p, int l, int which) {
    const WaveId w = wave_id();
    const unsigned short* x = (const unsigned short*)(p.ws + WS_X); act_t* h = (act_t*)(p.ws + WS_H);
    const float* g = (which == 0 ? p.norm1_g : p.norm2_g) + (size_t)l * D;
    float A[D / 512][8], B[D / 512][8]; int cond_cur = -1;
    uint4 nx[D / 512];
    int m = w.gw;
    {   const unsigned short* xr = x + (size_t)(m < MTOK ? m : 0) * D;
#pragma unroll
        for (int j = 0; j < D / 512; ++j) nx[j] = *(const uint4*)(xr + j * 512 + w.lane * 8); }
    for (; m < MTOK; m += w.nw) {
        uint4 cur[D / 512];
#pragma unroll
        for (int j = 0; j < D / 512; ++j) { cur[j] = nx[j]; asm volatile("" : "+v"(cur[j].x), "+v"(cur[j].y), "+v"(cur[j].z), "+v"(cur[j].w)); }
        {   const int mn = m + w.nw < MTOK ? m + w.nw : m; const unsigned short* xr = x + (size_t)mn * D;
#pragma unroll
            for (int j = 0; j < D / 512; ++j) nx[j] = *(const uint4*)(xr + j * 512 + w.lane * 8); }
        __builtin_amdgcn_sched_barrier(0);
        const int cond = cond_of_seq(seq_of(m));
        if (cond != cond_cur) {
            cond_cur = cond;
            const float* sh = modp(p, l, cond, which * 3 + 0); const float* sc = modp(p, l, cond, which * 3 + 1);
#pragma unroll
            for (int j = 0; j < D / 512; ++j) { const int c = j * 512 + w.lane * 8;
                const float4 ga = *(const float4*)(g + c), gb = *(const float4*)(g + c + 4), s1a = *(const float4*)(sc + c), s1b = *(const float4*)(sc + c + 4), s0a = *(const float4*)(sh + c), s0b = *(const float4*)(sh + c + 4);
                A[j][0] = ga.x * (1.f + s1a.x); A[j][1] = ga.y * (1.f + s1a.y); A[j][2] = ga.z * (1.f + s1a.z); A[j][3] = ga.w * (1.f + s1a.w);
                A[j][4] = gb.x * (1.f + s1b.x); A[j][5] = gb.y * (1.f + s1b.y); A[j][6] = gb.z * (1.f + s1b.z); A[j][7] = gb.w * (1.f + s1b.w);
                B[j][0] = s0a.x; B[j][1] = s0a.y; B[j][2] = s0a.z; B[j][3] = s0a.w; B[j][4] = s0b.x; B[j][5] = s0b.y; B[j][6] = s0b.z; B[j][7] = s0b.w; }
        }
        float v[D / 512][8]; float ss = 0.f;
#pragma unroll
        for (int j = 0; j < D / 512; ++j) { const uint4 u = cur[j];
            v[j][0] = __uint_as_float(u.x << 16); v[j][1] = __uint_as_float(u.x & 0xffff0000u); v[j][2] = __uint_as_float(u.y << 16); v[j][3] = __uint_as_float(u.y & 0xffff0000u);
            v[j][4] = __uint_as_float(u.z << 16); v[j][5] = __uint_as_float(u.z & 0xffff0000u); v[j][6] = __uint_as_float(u.w << 16); v[j][7] = __uint_as_float(u.w & 0xffff0000u);
#pragma unroll
            for (int e = 0; e < 8; ++e) ss += v[j][e] * v[j][e]; }
        ss = wsum(ss);
        const float rs = 1.0f / sqrtf(ss / D + RMS_EPS);
#pragma unroll
        for (int j = 0; j < D / 512; ++j) { const int c = j * 512 + w.lane * 8;
            const uint2 lo = pk4(v[j][0] * rs * A[j][0] + B[j][0], v[j][1] * rs * A[j][1] + B[j][1], v[j][2] * rs * A[j][2] + B[j][2], v[j][3] * rs * A[j][3] + B[j][3]);
            const uint2 hi = pk4(v[j][4] * rs * A[j][4] + B[j][4], v[j][5] * rs * A[j][5] + B[j][5], v[j][6] * rs * A[j][6] + B[j][6], v[j][7] * rs * A[j][7] + B[j][7]);
            *(uint4*)(h + (size_t)m * D + c) = make_uint4(lo.x, lo.y, hi.x, hi.y); }
    }
}
__device__ __forceinline__ void final_rows(const P& p) {
    const WaveId w = wave_id();
    const unsigned short* x = (const unsigned short*)(p.ws + WS_X);
    for (int m = w.gw; m < MTOK; m += w.nw) {
        const unsigned short* xr = x + (size_t)m * D;
        float v[D / 512][8]; float ss = 0.f;
#pragma unroll
        for (int j = 0; j < D / 512; ++j) { ldx8(xr + j * 512 + w.lane * 8, v[j]);
#pragma unroll
            for (int e = 0; e < 8; ++e) ss += v[j][e] * v[j][e]; }
        ss = wsum(ss);
        const float rs = 1.0f / sqrtf(ss / D + RMS_EPS);
#pragma unroll
        for (int j = 0; j < D / 512; ++j) { const int c = j * 512 + w.lane * 8; const float4 ga = *(const float4*)(p.final_norm_g + c), gb = *(const float4*)(p.final_norm_g + c + 4);
            *(float4*)(p.out + O_YP + (size_t)m * D + c) = make_float4(v[j][0] * rs * ga.x, v[j][1] * rs * ga.y, v[j][2] * rs * ga.z, v[j][3] * rs * ga.w);
            *(float4*)(p.out + O_YP + (size_t)m * D + c + 4) = make_float4(v[j][4] * rs * gb.x, v[j][5] * rs * gb.y, v[j][6] * rs * gb.z, v[j][7] * rs * gb.w); }
    }
}

static_assert(2 * DL == 128 && 2 * IL == 128 && GL == 128 && QR == 512 && KVR == 512 && ROPE == 64 && GC == 1536 && CH == 4, "prep_rows layout");
__device__ __forceinline__ void prep_rows(const P& p, int l) {
    const WaveId w = wave_id(); const int lane = w.lane;
    const act_t* pp = (const act_t*)(p.ws + WS_PP);
    act_t* lin = (act_t*)(p.ws + WS_LIN); act_t* cqn = (act_t*)(p.ws + WS_CQN); act_t* ckvn = (act_t*)(p.ws + WS_CKVN); act_t* kr = (act_t*)(p.ws + WS_KR);
    const float2* ropetab = (const float2*)(p.ws + WS_ROPE);
    for (int m = w.gw; m < MKV; m += w.nw) {
        if (m >= MTOK) {
            const int r = m - MTOK, b = r / PAST, j0 = r % PAST;
            const float* ck = p.cache_ckv + (((size_t)b * L + l) * PAST + j0) * KVR;
            const float4 a = *(const float4*)(ck + lane * 8), c4 = *(const float4*)(ck + lane * 8 + 4);
            *(uint4*)(ckvn + (size_t)m * KVR + lane * 8) = make_uint4(mk2(a.x, a.y), mk2(a.z, a.w), mk2(c4.x, c4.y), mk2(c4.z, c4.w));
            kr[(size_t)m * ROPE + lane] = f2a(p.cache_kpe[(((size_t)b * L + l) * PAST + j0) * ROPE + lane]);
            continue;
        }
        const act_t* pr = pp + (size_t)m * INP;
        const int s = seq_of(m), base = seq_start(s), t = m - base, T = seq_len(s);
        {
            const float2 a = ldp2(pr + OFF_WLO + 2 * lane), b = ldp2(pr + OFF_ALO + 2 * lane), c = ldp2(pr + OFF_GLO + 2 * lane);
            act_t* lo = lin + (size_t)m * LINK;
            *(unsigned*)(lo + 2 * lane) = mk2(ftanh_(a.x), ftanh_(a.y)); *(unsigned*)(lo + 128 + 2 * lane) = mk2(b.x, b.y); *(unsigned*)(lo + 256 + 2 * lane) = mk2(sigmoidf_(c.x), sigmoidf_(c.y));
        }
        {
            const float4 a = ldp4(pr + OFF_CQ + lane * 8), b = ldp4(pr + OFF_CQ + lane * 8 + 4);
            float ss = wsum(a.x * a.x + a.y * a.y + a.z * a.z + a.w * a.w + b.x * b.x + b.y * b.y + b.z * b.z + b.w * b.w);
            float rs = 1.0f / sqrtf(ss / QR + RMS_EPS);
            const float* g = p.mla_qnorm_g + (size_t)l * QR + lane * 8; const float4 g0 = *(const float4*)g, g1 = *(const float4*)(g + 4);
            *(uint4*)(cqn + (size_t)m * QR + lane * 8) = make_uint4(mk2(a.x * rs * g0.x, a.y * rs * g0.y), mk2(a.z * rs * g0.z, a.w * rs * g0.w), mk2(b.x * rs * g1.x, b.y * rs * g1.y), mk2(b.z * rs * g1.z, b.w * rs * g1.w));
            const float4 c = ldp4(pr + OFF_CKV + lane * 8), d = ldp4(pr + OFF_CKV + lane * 8 + 4);
            ss = wsum(c.x * c.x + c.y * c.y + c.z * c.z + c.w * c.w + d.x * d.x + d.y * d.y + d.z * d.z + d.w * d.w);
            rs = 1.0f / sqrtf(ss / KVR + RMS_EPS);
            const float* g2 = p.mla_kvnorm_g + (size_t)l * KVR + lane * 8; const float4 h0 = *(const float4*)g2, h1 = *(const float4*)(g2 + 4);
            const float4 o0 = make_float4(c.x * rs * h0.x, c.y * rs * h0.y, c.z * rs * h0.z, c.w * rs * h0.w), o1 = make_float4(d.x * rs * h1.x, d.y * rs * h1.y, d.z * rs * h1.z, d.w * rs * h1.w);
            *(uint4*)(ckvn + (size_t)m * KVR + lane * 8) = make_uint4(mk2(o0.x, o0.y), mk2(o0.z, o0.w), mk2(o1.x, o1.y), mk2(o1.z, o1.w));
            if (s < NB) { float* oc = p.out + O_CK + (((size_t)s * L + l) * SEQ + t) * KVR + lane * 8; *(float4*)oc = o0; *(float4*)(oc + 4) = o1; }
            if (lane < ROPE / 2) {
                const float2 xe = ldp2(pr + OFF_KPE + 2 * lane);
                if (s < NB) { *(unsigned*)(kr + (size_t)m * ROPE + 2 * lane) = mk2(xe.x, xe.y); *(float2*)(p.out + O_KP + (((size_t)s * L + l) * SEQ + t) * ROPE + 2 * lane) = xe; }
                else { const float2 cs = ropetab[(size_t)t * (ROPE / 2) + lane]; *(unsigned*)(kr + (size_t)m * ROPE + 2 * lane) = mk2(xe.x * cs.x - xe.y * cs.y, xe.x * cs.y + xe.y * cs.x); }
            }
        }
    }
}

static_assert(CW == 512 && DV == 128, "post_rows layout");
__device__ __forceinline__ void post_rows(const P& p, int l) {
    const WaveId w = wave_id(); const int lane = w.lane;
    const act_t* pp = (const act_t*)(p.ws + WS_PP);
    const float* rwb = (const float*)(p.ws + WS_RWB); const act_t* gb = (const act_t*)(p.ws + WS_LORA) + 4 * AW;     const act_t* yb = (const act_t*)(p.ws + WS_RWY);
    const act_t* go = (const act_t*)(p.ws + WS_GO);
    act_t* ymix = (act_t*)(p.ws + WS_YMIX);
    for (int m = w.gw; m < MTOK; m += w.nw) {
        const act_t* pr = pp + (size_t)m * INP;
        const int c0 = 8 * lane, h = lane >> 3;
        {
            float y[8], v[8];
#define LD8B(dst, ptr) do { const float4 a_ = ldp4(ptr), b_ = ldp4((ptr) + 4); dst[0] = a_.x; dst[1] = a_.y; dst[2] = a_.z; dst[3] = a_.w; dst[4] = b_.x; dst[5] = b_.y; dst[6] = b_.z; dst[7] = b_.w; } while (0)
#define LD8(dst, ptr) do { const float4 a_ = *(const float4*)(ptr), b_ = *(const float4*)((ptr) + 4); dst[0] = a_.x; dst[1] = a_.y; dst[2] = a_.z; dst[3] = a_.w; dst[4] = b_.x; dst[5] = b_.y; dst[6] = b_.z; dst[7] = b_.w; } while (0)
            { float y1[8]; LD8B(y, yb + ((size_t)m * 2 + 0) * AW + c0); LD8B(y1, yb + ((size_t)m * 2 + 1) * AW + c0);
#pragma unroll
              for (int j = 0; j < 8; ++j) y[j] += y1[j]; }
            { const float4 a_ = ldp4(pr + OFF_V + c0), b_ = ldp4(pr + OFF_V + c0 + 4); v[0] = a_.x; v[1] = a_.y; v[2] = a_.z; v[3] = a_.w; v[4] = b_.x; v[5] = b_.y; v[6] = b_.z; v[7] = b_.w; }
            float mu = 0.f;
#pragma unroll
            for (int j = 0; j < 8; ++j) mu += y[j];
            mu = gsum(mu, 8) * (1.0f / AN);
            float var = 0.f;
#pragma unroll
            for (int j = 0; j < 8; ++j) { const float t = y[j] - mu; var += t * t; }
            var = gsum(var, 8) * (1.0f / AN);
            const float rstd = 1.0f / sqrtf(var + LNX_EPS);
            const float bon = rwb[((size_t)m * 2 + 0) * AH + h] + rwb[((size_t)m * 2 + 1) * AH + h];
            float g[8]; { const float4 a_ = ldp4(gb + (size_t)m * LORAN + c0), b_ = ldp4(gb + (size_t)m * LORAN + c0 + 4); g[0] = a_.x; g[1] = a_.y; g[2] = a_.z; g[3] = a_.w; g[4] = b_.x; g[5] = b_.y; g[6] = b_.z; g[7] = b_.w; }
            float o[8];
#pragma unroll
            for (int j = 0; j < 8; ++j) o[j] = ((y[j] - mu) * rstd * p.rwkv_lnx_g[(size_t)l * AW + c0 + j] + p.rwkv_lnx_b[(size_t)l * AW + c0 + j] + bon * v[j]) * g[j];
            *(uint4*)(ymix + (size_t)m * MIXW + c0) = make_uint4(mk2(o[0], o[1]), mk2(o[2], o[3]), mk2(o[4], o[5]), mk2(o[6], o[7]));
        }
        {
            float o[8], z[8];
            { float o1[8]; LD8B(o, go + ((size_t)m * 2 + 0) * CW + c0); LD8B(o1, go + ((size_t)m * 2 + 1) * CW + c0);
#pragma unroll
              for (int j = 0; j < 8; ++j) o[j] += o1[j]; }
            { const float4 a_ = ldp4(pr + OFF_GZ + c0), b_ = ldp4(pr + OFF_GZ + c0 + 4); z[0] = a_.x; z[1] = a_.y; z[2] = a_.z; z[3] = a_.w; z[4] = b_.x; z[5] = b_.y; z[6] = b_.z; z[7] = b_.w; }
            float ss = 0.f;
#pragma unroll
            for (int j = 0; j < 8; ++j) ss += o[j] * o[j];
            ss = gsum(ss, 16);
            const float rs = 1.0f / sqrtf(ss / DV + RMS_EPS);
            float r[8];
#pragma unroll
            for (int j = 0; j < 8; ++j) r[j] = o[j] * rs * p.gdn_norm_g[(size_t)l * DV + (c0 & 127) + j] * siluf_(z[j]);
            *(uint4*)(ymix + (size_t)m * MIXW + AW + BW + c0) = make_uint4(mk2(r[0], r[1]), mk2(r[2], r[3]), mk2(r[4], r[5]), mk2(r[6], r[7]));
#undef LD8
#undef LD8B
        }
    }
}

static_assert(DFF % 8 == 0, "ffn_act8");
__device__ __forceinline__ void ffn_act8(const P& p, int l, long gt, long gs) {
    const act_t* up = (const act_t*)(p.ws + WS_UP); act_t* act = (act_t*)(p.ws + WS_ACT);
    const float* w = p.ffn_conv + (size_t)l * 3 * DFF;
    for (long idx = gt; idx < (long)MTOK * (DFF / 8); idx += gs) {
        const int m = (int)(idx / (DFF / 8)), c = (int)(idx % (DFF / 8)) * 8;
        const int s = seq_of(m), base = seq_start(s), t = m - base, T = seq_len(s);
        const uint4 g1 = *(const uint4*)(up + (size_t)m * NUP + c), vv = *(const uint4*)(up + (size_t)m * NUP + DFF + c);
        uint4 g0 = make_uint4(0, 0, 0, 0), g2 = make_uint4(0, 0, 0, 0);
        if (t > 0) g0 = *(const uint4*)(up + (size_t)(m - 1) * NUP + c);
        if (t < T - 1) g2 = *(const uint4*)(up + (size_t)(m + 1) * NUP + c);
        const unsigned a0[4] = {g0.x, g0.y, g0.z, g0.w}, a1[4] = {g1.x, g1.y, g1.z, g1.w}, a2[4] = {g2.x, g2.y, g2.z, g2.w}, av[4] = {vv.x, vv.y, vv.z, vv.w};
        unsigned o[4];
#pragma unroll
        for (int j = 0; j < 4; ++j) {
            const float lo = w[c + 2 * j] * lo2(a0[j]) + w[DFF + c + 2 * j] * lo2(a1[j]) + w[2 * DFF + c + 2 * j] * lo2(a2[j]);
            const float hi = w[c + 2 * j + 1] * hi2(a0[j]) + w[DFF + c + 2 * j + 1] * hi2(a1[j]) + w[2 * DFF + c + 2 * j + 1] * hi2(a2[j]);
            o[j] = mk2(siluf_(lo) * lo2(av[j]), siluf_(hi) * hi2(av[j]));
        }
        *(uint4*)(act + (size_t)m * DFF + c) = make_uint4(o[0], o[1], o[2], o[3]);
    }
}

__device__ __forceinline__ void ffn_fix(const P& p, int l, long gt, long gs) {
    const float* side = (const float*)(p.ws + WS_SIDE); act_t* act = (act_t*)(p.ws + WS_ACT);
    const float* w = p.ffn_conv + (size_t)l * 3 * DFF;
    for (long idx = gt; idx < (long)(MTOK / 64) * 2 * (DFF / 8); idx += gs) {
        const int c = (int)(idx % (DFF / 8)) * 8, be = (int)(idx / (DFF / 8)), b = be >> 1, e = be & 1;
        const int m = 64 * b + (e ? 63 : 0);
        const int s = seq_of(m), t = m - seq_start(s), T = seq_len(s);
        const float* sb = side + (size_t)b * 6 * DFF + c;
        float g0[8], g1[8], g2[8], vv[8];
#define LD8S(dst, ptr) do { const float4 a_ = *(const float4*)(ptr), b_ = *(const float4*)((ptr) + 4); dst[0] = a_.x; dst[1] = a_.y; dst[2] = a_.z; dst[3] = a_.w; dst[4] = b_.x; dst[5] = b_.y; dst[6] = b_.z; dst[7] = b_.w; } while (0)
#pragma unroll
        for (int j = 0; j < 8; ++j) { g0[j] = 0.f; g2[j] = 0.f; }
        if (e == 0) { LD8S(g1, sb); LD8S(g2, sb + DFF); LD8S(vv, sb + 4 * DFF); if (t > 0) LD8S(g0, sb - 6 * DFF + 3 * DFF); }
        else { LD8S(g1, sb + 3 * DFF); LD8S(g0, sb + 2 * DFF); LD8S(vv, sb + 5 * DFF); if (t < T - 1) LD8S(g2, sb + 6 * DFF); }
#undef LD8S
        float o[8];
#pragma unroll
        for (int j = 0; j < 8; ++j) o[j] = siluf_(w[c + j] * g0[j] + w[DFF + c + j] * g1[j] + w[2 * DFF + c + j] * g2[j]) * vv[j];
        *(uint4*)(act + (size_t)m * DFF + c) = make_uint4(mk2(o[0], o[1]), mk2(o[2], o[3]), mk2(o[4], o[5]), mk2(o[6], o[7]));
    }
}

template <class Src>
__device__ __forceinline__ void conv_tile_load(const Src& src, int K, int N, int unit, int tid, float4 (&v)[2]) {
    const int nk = K / 64, ku = unit % nk, nu = unit / nk, k0 = ku * 64, n0 = nu * 64;
#pragma unroll
    for (int pass = 0; pass < 2; ++pass) {
        const int kk = pass * 32 + (tid >> 4), n4 = (tid & 15) * 4;
        v[pass] = make_float4(0.f, 0.f, 0.f, 0.f);
        if (n0 + n4 < N) v[pass] = src(k0 + kk, n0 + n4);
    }
}
__device__ __forceinline__ void conv_tile_store(int K, act_t* Wt, int unit, int tid, const float4 (&v)[2], char* lds) {
    float* tile = (float*)lds;
    const int nk = K / 64, ku = unit % nk, nu = unit / nk, k0 = ku * 64, n0 = nu * 64;
    asm volatile("s_waitcnt lgkmcnt(0)" ::: "memory"); __builtin_amdgcn_s_barrier(); asm volatile("" ::: "memory");
#pragma unroll
    for (int pass = 0; pass < 2; ++pass) {
        const int kk = pass * 32 + (tid >> 4), n4 = (tid & 15) * 4;
        tile[kk * 65 + n4] = v[pass].x; tile[kk * 65 + n4 + 1] = v[pass].y; tile[kk * 65 + n4 + 2] = v[pass].z; tile[kk * 65 + n4 + 3] = v[pass].w;
    }
    asm volatile("s_waitcnt lgkmcnt(0)" ::: "memory"); __builtin_amdgcn_s_barrier(); asm volatile("" ::: "memory");
    const int n = tid >> 3, k8 = (tid & 7) * 8;
    unsigned o[4];
#pragma unroll
    for (int j = 0; j < 4; ++j) o[j] = mk2(tile[(k8 + 2 * j) * 65 + n], tile[(k8 + 2 * j + 1) * 65 + n]);
    *(uint4*)(Wt + (size_t)(n0 + n) * K + k0 + k8) = make_uint4(o[0], o[1], o[2], o[3]);
}
typedef float f32x4nt __attribute__((ext_vector_type(4)));
__device__ __forceinline__ float4 ldnt4(const float* p) { const f32x4nt v = __builtin_nontemporal_load((const f32x4nt*)p); return make_float4(v[0], v[1], v[2], v[3]); }
struct SrcPlain { const float* W; int N; __device__ __forceinline__ float4 operator()(int k, int n) const { return ldnt4(W + (size_t)k * N + n); } };
struct SrcUpPerm { const float* W; int N; __device__ __forceinline__ float4 operator()(int k, int n) const {
        const int nl = n & 255, col = nl < 128 ? (n >> 8) * 128 + nl : DFF + (n >> 8) * 128 + nl - 128; return ldnt4(W + (size_t)k * N + col); } };
struct SrcLora { const float* w2; const float* a2; const float* g2;
    __device__ __forceinline__ float4 operator()(int k, int n) const {
        const int jb = n / AW, c = n % AW; const float* s = nullptr;
        if (jb < 2) { if (k >= jb * DL && k < (jb + 1) * DL) s = w2 + ((size_t)jb * DL + (k - jb * DL)) * AW + c; }
        else if (jb < 4) { const int d = jb - 2; if (k >= 2 * DL + d * IL && k < 2 * DL + (d + 1) * IL) s = a2 + ((size_t)d * IL + (k - 2 * DL - d * IL)) * AW + c; }
        else { if (k >= 2 * DL + 2 * IL) s = g2 + (size_t)(k - 2 * DL - 2 * IL) * AW + c; }
        return s ? *(const float4*)s : make_float4(0.f, 0.f, 0.f, 0.f);
    } };

__device__ __forceinline__ void adaln_unit(const P& p, int unit, char* lds) {
    int tid = TIDX; asm volatile("" : "+v"(tid));
    float* sil = (float*)lds;
    float* part = sil + NCOND * D;
    const int l = unit / (6 * D / 64), j0 = (unit % (6 * D / 64)) * 64;
    __syncthreads();
    for (int i = tid; i < NCOND * D; i += NTHR_) { const int c = i / D, k = i % D; sil[i] = siluf_(c == 0 ? p.c_ctx[k] : p.c[(size_t)(c - 1) * D + k]); }
    __syncthreads();
    const int cg = tid & 15, rs = tid >> 4;
    float4 acc[NCOND];
#pragma unroll
    for (int c = 0; c < NCOND; ++c) acc[c] = make_float4(0.f, 0.f, 0.f, 0.f);
    const float* wp = p.ada_w + ((size_t)l * D) * 6 * D + j0 + 4 * cg;
    for (int i0 = rs * (D / 32); i0 < (rs + 1) * (D / 32); i0 += 16) {
        float4 wv[16];
#pragma unroll
        for (int e = 0; e < 16; ++e) wv[e] = ldnt4(wp + (size_t)(i0 + e) * 6 * D);
        __builtin_amdgcn_sched_barrier(0);
#pragma unroll
        for (int e = 0; e < 16; e += 4) asm volatile("" : "+v"(wv[e].x), "+v"(wv[e].y), "+v"(wv[e].z), "+v"(wv[e].w), "+v"(wv[e + 1].x), "+v"(wv[e + 1].y), "+v"(wv[e + 1].z), "+v"(wv[e + 1].w),
                                                          "+v"(wv[e + 2].x), "+v"(wv[e + 2].y), "+v"(wv[e + 2].z), "+v"(wv[e + 2].w), "+v"(wv[e + 3].x), "+v"(wv[e + 3].y), "+v"(wv[e + 3].z), "+v"(wv[e + 3].w));
#pragma unroll
        for (int e = 0; e < 16; ++e)
#pragma unroll
            for (int c = 0; c < NCOND; ++c) { const float s = sil[c * D + i0 + e]; acc[c].x += s * wv[e].x; acc[c].y += s * wv[e].y; acc[c].z += s * wv[e].z; acc[c].w += s * wv[e].w; }
    }
#pragma unroll
    for (int c = 0; c < NCOND; ++c) { float* pp_ = part + ((rs * 64 + 4 * cg) * NCOND + c); pp_[0] = acc[c].x; pp_[NCOND] = acc[c].y; pp_[2 * NCOND] = acc[c].z; pp_[3 * NCOND] = acc[c].w; }
    __syncthreads();
    if (tid < 64 * NCOND) {
        const int c = tid / 64, j = tid % 64; float sacc = 0.f;
#pragma unroll 8
        for (int q = 0; q < 32; ++q) sacc += part[(q * 64 + j) * NCOND + c];
        float* mod = (float*)(p.ws + WS_MOD);
        mod[((size_t)(l * NCOND + c) * 6) * D + j0 + j] = sacc + p.ada_b[(size_t)l * 6 * D + j0 + j];
    }
}
}
struct EpiResid {
    static constexpr bool PERM = true, AFTER_DRAIN = false;
    unsigned short* X; int ldc; const float* mod_l; int which;
    __device__ __forceinline__ void operator()(const pg8::f32x4 (&acc)[2][2][4][2], const pg8::Unit& u, int wr, int wc, int fr, int fq) const {
        using pg8::f32x4; using pg8::u32x4; using pg8::BM; using pg8::HALF;
        const int row0 = u.pm * BM + wr * 64 + fr, col0 = u.pn * BM + wc * 32 + 8 * fq;
        const int cond = cond_of_seq(seq_of(u.pm * BM));
        const float* gate = mod_l + ((size_t)cond * 6 + which) * D;
        f32x4 gv[2][2];
#pragma unroll
        for (int bj = 0; bj < 2; ++bj)
#pragma unroll
            for (int n = 0; n < 2; ++n) gv[bj][n] = *(const f32x4*)(gate + col0 + bj * HALF + 4 * n);
        u32x4 o[2][4][2];
#pragma unroll
        for (int ai = 0; ai < 2; ++ai)
#pragma unroll
            for (int m = 0; m < 4; ++m)
#pragma unroll
                for (int bj = 0; bj < 2; ++bj) o[ai][m][bj] = *(const u32x4*)(X + (size_t)(row0 + ai * HALF + m * 16) * ldc + col0 + bj * HALF);
        __builtin_amdgcn_sched_barrier(0);
#pragma unroll
        for (int ai = 0; ai < 2; ++ai)
#pragma unroll
            for (int m = 0; m < 4; ++m) { unsigned short* rowp = X + (size_t)(row0 + ai * HALF + m * 16) * ldc + col0;
#pragma unroll
                for (int bj = 0; bj < 2; ++bj) {
                    const u32x4 ov = o[ai][m][bj];
                    const f32x4 x0 = {__uint_as_float(ov.x << 16), __uint_as_float(ov.x & 0xffff0000u), __uint_as_float(ov.y << 16), __uint_as_float(ov.y & 0xffff0000u)};
                    const f32x4 x1 = {__uint_as_float(ov.z << 16), __uint_as_float(ov.z & 0xffff0000u), __uint_as_float(ov.w << 16), __uint_as_float(ov.w & 0xffff0000u)};
                    const f32x4 v0 = x0 + gv[bj][0] * acc[ai][bj][m][0], v1 = x1 + gv[bj][1] * acc[ai][bj][m][1];
                    u32x4 w; w.x = pg8::cvt_pk_bf16(v0[0], v0[1]); w.y = pg8::cvt_pk_bf16(v0[2], v0[3]); w.z = pg8::cvt_pk_bf16(v1[0], v1[1]); w.w = pg8::cvt_pk_bf16(v1[2], v1[3]);
                    *(u32x4*)(rowp + bj * HALF) = w; } }
    }
};

struct EpiFfnAct {
    static constexpr bool PERM = true, AFTER_DRAIN = false;
    pg8::bf16_t* ACT; float* side; const float* cw;
    __device__ __forceinline__ void operator()(const pg8::f32x4 (&acc)[2][2][4][2], const pg8::Unit& u, int wr, int wc, int, int) const {
        using pg8::f32x4; using pg8::u32x4; using pg8::BM; using pg8::HALF;
        unsigned lane_; asm volatile("v_mbcnt_lo_u32_b32 %0, -1, 0\n\tv_mbcnt_hi_u32_b32 %0, -1, %0" : "=v"(lane_));
        const int fr = (int)(lane_ & 15u), fq = (int)(lane_ >> 4);
        const int colA = u.pn * 128 + wc * 32 + 8 * fq;
        f32x4 w0[2], w1[2], w2[2];
#pragma unroll
        for (int n = 0; n < 2; ++n) { w0[n] = *(const f32x4*)(cw + colA + 4 * n); w1[n] = *(const f32x4*)(cw + DFF + colA + 4 * n); w2[n] = *(const f32x4*)(cw + 2 * DFF + colA + 4 * n); }
        const bool first = fr == 0, last = fr == 15;
#pragma unroll
        for (int ai = 0; ai < 2; ++ai) {
            const int row_b = u.pm * BM + ai * HALF + wr * 64, blk = row_b >> 6;
            f32x4 R[4][2], Ln[4][2];
#pragma unroll
            for (int m = 0; m < 4; ++m)
#pragma unroll
                for (int n = 0; n < 2; ++n)
#pragma unroll
                    for (int e = 0; e < 4; ++e) { R[m][n][e] = fastp::dppf<0x121>(acc[ai][0][m][n][e]); Ln[m][n][e] = fastp::dppf<0x12F>(acc[ai][0][m][n][e]); }
#pragma unroll
            for (int m = 0; m < 4; ++m) {
                u32x4 wout;
#pragma unroll
                for (int n = 0; n < 2; ++n) {
                    f32x4 o;
#pragma unroll
                    for (int e = 0; e < 4; ++e) {
                        const float pv = first ? (m > 0 ? R[m > 0 ? m - 1 : 0][n][e] : 0.f) : R[m][n][e];
                        const float nx = last ? (m < 3 ? Ln[m < 3 ? m + 1 : 3][n][e] : 0.f) : Ln[m][n][e];
                        o[e] = siluf_(w0[n][e] * pv + w1[n][e] * acc[ai][0][m][n][e] + w2[n][e] * nx) * acc[ai][1][m][n][e];
                    }
                    if (n == 0) { wout.x = pg8::cvt_pk_bf16(o[0], o[1]); wout.y = pg8::cvt_pk_bf16(o[2], o[3]); } else { wout.z = pg8::cvt_pk_bf16(o[0], o[1]); wout.w = pg8::cvt_pk_bf16(o[2], o[3]); }
                }
                *(u32x4*)(ACT + (size_t)(row_b + m * 16 + fr) * DFF + colA) = wout;
            }
            float* sb = side + (size_t)blk * 6 * DFF + colA;
            if (fr <= 1) { *(f32x4*)(sb + fr * DFF) = acc[ai][0][0][0]; *(f32x4*)(sb + fr * DFF + 4) = acc[ai][0][0][1]; }
            if (fr >= 14) { *(f32x4*)(sb + (fr - 12) * DFF) = acc[ai][0][3][0]; *(f32x4*)(sb + (fr - 12) * DFF + 4) = acc[ai][0][3][1]; }
            if (first) { *(f32x4*)(sb + 4 * DFF) = acc[ai][1][0][0]; *(f32x4*)(sb + 4 * DFF + 4) = acc[ai][1][0][1]; }
            if (last) { *(f32x4*)(sb + 5 * DFF) = acc[ai][1][3][0]; *(f32x4*)(sb + 5 * DFF + 4) = acc[ai][1][3][1]; }
        }
    }
};

constexpr int NTHR = 512;
constexpr int LDS_BYTES = 147456;
constexpr int LDS_MISC = LDS_BYTES - 64;
constexpr int LDS_USABLE = TID_TAB_OFF;
static_assert(LDS_BYTES == LDS_TOTAL_BYTES, "tidx.h");
static_assert(NTHR == NTHR_ && att::SHM_ATTN <= LDS_USABLE && pg8::STAGE_BYTES <= LDS_USABLE && gdnc::PA_LDS <= LDS_USABLE && gdnc::PH_LDS <= LDS_USABLE && rwkc::PA_LDS <= LDS_USABLE && rwkc::PD_LDS <= LDS_USABLE, "LDS map");
constexpr int PH_PER_LAYER = 11, N_PHASES = 2 + L * PH_PER_LAYER;

struct Args { P p; int ph_lo, ph_hi, use_bar, pad; };

template <class Epi>
__device__ __forceinline__ void run_gemm(PG8_LAS unsigned char* lds, const act_t* A, const act_t* Bt, int M, int N, int K, const Epi& E) {
    pg8::Gemm g{A, Bt, M, N, K, K}; pg8::StaticOrder S; S.init(M, N, (int)gridDim.x, (int)blockIdx.x);
    pg8::gemm_phase<Epi, pg8::StaticOrder, false>(lds, g, S, E, nullptr);
}

constexpr int CV_T_IN = (D / 64) * (INP / 64), CV_T_UQ = (QR / 64) * (NQ / 64), CV_T_UK = (KVR / 64) * (BH * NOPE / 64), CV_T_UV = (KVR / 64) * (BH * VD / 64), CV_T_OUT = (MIXW / 64) * (D / 64),
              CV_T_UP = (D / 64) * (NUP / 64), CV_T_DN = (DFF / 64) * (D / 64), CV_T_LO = (LINK / 64) * (LORAN / 64), CV_TL = CV_T_IN + CV_T_UQ + CV_T_UK + CV_T_UV + CV_T_OUT + CV_T_UP + CV_T_DN + CV_T_LO;
constexpr int AD_PER_LAYER = 6 * D / 64;
__device__ __forceinline__ void layer_prep(const P& p, int ll, int t_lo, int t_hi, bool with_adaln, int w, int nw, char* lds) {
    act_t* ww_ = (act_t*)(p.ws + WS_WT) + (size_t)ll * WT_LAYER;
    if (with_adaln) for (int u = w; u < AD_PER_LAYER; u += nw) fastp::adaln_unit(p, ll * AD_PER_LAYER + u, lds);
    int tidc = TIDX; asm volatile("" : "+v"(tidc));
    asm volatile("" : "+s"(w), "+s"(t_lo));
    float4 vcur[2], vnxt[2];
#define CV_DISPATCH(ridx, OP_PLAIN, OP_LORA, OP_UP) do { int r_ = (ridx); \
        if (r_ < CV_T_IN) { OP_PLAIN(p.w_in + (size_t)ll * D * INC, INC, D, INC, ww_ + WT_IN, r_); break; } r_ -= CV_T_IN; \
        if (r_ < CV_T_UQ) { OP_PLAIN(p.mla_w_uq + (size_t)ll * QR * NQ, NQ, QR, NQ, ww_ + WT_UQ, r_); break; } r_ -= CV_T_UQ; \
        if (r_ < CV_T_UK) { OP_PLAIN(p.mla_w_uk + (size_t)ll * KVR * BH * NOPE, BH * NOPE, KVR, BH * NOPE, ww_ + WT_UKV, r_); break; } r_ -= CV_T_UK; \
        if (r_ < CV_T_UV) { OP_PLAIN(p.mla_w_uv + (size_t)ll * KVR * BH * VD, BH * VD, KVR, BH * VD, ww_ + WT_UKV + (size_t)BH * NOPE * KVR, r_); break; } r_ -= CV_T_UV; \
        if (r_ < CV_T_OUT) { OP_PLAIN(p.w_out + (size_t)ll * MIXW * D, D, MIXW, D, ww_ + WT_OUT, r_); break; } r_ -= CV_T_OUT; \
        if (r_ < CV_T_UP) { OP_UP(p.ffn_up + (size_t)ll * D * NUP, NUP, D, NUP, ww_ + WT_UP, r_); break; } r_ -= CV_T_UP; \
        if (r_ < CV_T_DN) { OP_PLAIN(p.ffn_down + (size_t)ll * DFF * D, D, DFF, D, ww_ + WT_DOWN, r_); break; } r_ -= CV_T_DN; \
        OP_LORA(ww_ + WT_LORA, r_); } while (0)
#define CV_LOAD_PLAIN(W_, ldw_, K_, N_, Wt_, u_) fastp::conv_tile_load(fastp::SrcPlain{W_, ldw_}, K_, N_, u_, tidc, vnxt)
#define CV_LOAD_UP(W_, ldw_, K_, N_, Wt_, u_) fastp::conv_tile_load(fastp::SrcUpPerm{W_, ldw_}, K_, N_, u_, tidc, vnxt)
#define CV_LOAD_LORA(Wt_, u_) fastp::conv_tile_load(fastp::SrcLora{p.rwkv_w2 + (size_t)ll * 2 * DL * AW, p.rwkv_a2 + (size_t)ll * 2 * IL * AW, p.rwkv_g2 + (size_t)ll * GL * AW}, LINK, LORAN, u_, tidc, vnxt)
#define CV_STORE_PLAIN(W_, ldw_, K_, N_, Wt_, u_) fastp::conv_tile_store(K_, Wt_, u_, tidc, vcur, lds)
#define CV_STORE_LORA(Wt_, u_) fastp::conv_tile_store(LINK, Wt_, u_, tidc, vcur, lds)
    const int first = t_lo + w;
    if (first < t_hi) CV_DISPATCH(first, CV_LOAD_PLAIN, CV_LOAD_LORA, CV_LOAD_UP);
    for (int gi = first; gi < t_hi; gi += nw) {
        vcur[0] = vnxt[0]; vcur[1] = vnxt[1];
        if (gi + nw < t_hi) CV_DISPATCH(gi + nw, CV_LOAD_PLAIN, CV_LOAD_LORA, CV_LOAD_UP);
        CV_DISPATCH(gi, CV_STORE_PLAIN, CV_STORE_LORA, CV_STORE_PLAIN);
    }
#undef CV_DISPATCH
#undef CV_LOAD_PLAIN
#undef CV_LOAD_LORA
#undef CV_LOAD_UP
#undef CV_STORE_PLAIN
#undef CV_STORE_LORA
}
constexpr int CVQ = 8, CVQ_TASKS = (CV_TL + CVQ - 1) / CVQ;
__device__ __forceinline__ void conv_queue(const P& p, int ll, char* lds, int misc_off) {
    if (ll >= L) return;
    unsigned* head = (unsigned*)(p.ws + WS_CTL + 32768) + (2 * L + ll) * 64;
    volatile __attribute__((address_space(3))) unsigned* slot = (volatile __attribute__((address_space(3))) unsigned*)((__attribute__((address_space(3))) char*)lds + misc_off + 16);
    for (;;) {
        __syncthreads();
        if (TIDX == 0) *slot = __hip_atomic_fetch_add(head, 1u, __ATOMIC_RELAXED, __HIP_MEMORY_SCOPE_AGENT);
        __syncthreads();
        int t = __builtin_amdgcn_readfirstlane((int)*slot);
        if (t >= AD_PER_LAYER + CVQ_TASKS) break;
        if (t < AD_PER_LAYER) { fastp::adaln_unit(p, ll * AD_PER_LAYER + t, lds); continue; }
        t -= AD_PER_LAYER;
        const int lo = t * CVQ, hi = lo + CVQ < CV_TL ? lo + CVQ : CV_TL;
        layer_prep(p, ll, lo, hi, false, 0, 1, lds);
    }
}
struct Ctx { long gt, gt2, gs; PG8_LAS unsigned char* lds; };
template <int K> __device__ __forceinline__ void phase_body(const P& p, int l, const Ctx& c) {
    const long gt = c.gt, gt2 = c.gt2, gs = c.gs;
    act_t* wt = (act_t*)(p.ws + WS_WT);
    const act_t* w = wt + (size_t)l * WT_LAYER;
    const float* mod_l = (const float*)(p.ws + WS_MOD) + (size_t)l * NCOND * 6 * D;
    if constexpr (K == 0) {
        uint2* x = (uint2*)(p.ws + WS_X);
        for (long i = gt; i < (long)MTOK * D / 4; i += gs) { const float4 v = i < (long)MCTX * D / 4 ? ((const float4*)p.x_prompt)[i] : ((const float4*)p.x_sample)[i - (long)MCTX * D / 4]; x[i] = fastp::pk4(v.x, v.y, v.z, v.w); }
        float* rt = (float*)(p.ws + WS_ROPE);
        for (long i = gt; i < (long)DSEQ * (ROPE / 2); i += gs) { float cs, sn; rope_angle((int)(i / (ROPE / 2)), (int)(i % (ROPE / 2)), cs, sn); rt[2 * i] = cs; rt[2 * i + 1] = sn; }
        for (int u = blockIdx.x; u < AD_PER_LAYER; u += gridDim.x) fastp::adaln_unit(p, u, (char*)c.lds);
        layer_prep(p, 0, 0, CV_TL, false, (int)blockIdx.x, (int)gridDim.x, (char*)c.lds);
    }
    if constexpr (K == 1) fastp::norm_rows(p, l, 0);
    if constexpr (K == 2) { pg8::EpiBf16<0> E{(pg8::bf16_t*)(p.ws + WS_PP), INP, nullptr, 0, 0}; run_gemm(c.lds, (const act_t*)(p.ws + WS_H), w + WT_IN, MTOK, INP, D, E); }
    if constexpr (K == 3) fastp::prep_rows(p, l);
    if constexpr (K == 41) { pg8::EpiBf16<0> E{(pg8::bf16_t*)(p.ws + WS_QF), NQ, nullptr, 0, 0}; run_gemm(c.lds, (const act_t*)(p.ws + WS_CQN), w + WT_UQ, MTOK, NQ, QR, E); }
    if constexpr (K == 42) { pg8::EpiBf16<0> E{(pg8::bf16_t*)(p.ws + WS_KVUP), NKV, nullptr, 0, 0}; run_gemm(c.lds, (const act_t*)(p.ws + WS_CKVN), w + WT_UKV, MKV, NKV, KVR, E); }
    if constexpr (K == 43) { pg8::EpiBf16<0> E{(pg8::bf16_t*)(p.ws + WS_LORA), LORAN, nullptr, 0, 0}; run_gemm(c.lds, (const act_t*)(p.ws + WS_LIN), w + WT_LORA, MTOK, LORAN, LINK, E); }
    if constexpr (K == 46) { for (int rep = 0; rep < ((DUPMASK & 256) ? 2 : 1); ++rep) for (int u = (int)gridDim.x - 1 - (int)blockIdx.x; u < gdnc::NSLOT; u += gridDim.x) gdnc::prep_chunk(p, l, u, (char*)c.lds); }
    if constexpr (K == 45) { for (int rep = 0; rep < ((DUPMASK & 512) ? 2 : 1); ++rep) for (int u = blockIdx.x; u < rwkc::NSLOT; u += gridDim.x) rwkc::prep_chunk(p, l, u, (char*)c.lds); }
    if constexpr (K == 50) ph_mixers(p, l, (char*)c.lds, LDS_MISC);
    if constexpr (K == 52) ph_mixers(p, l, (char*)c.lds, LDS_MISC, 1);
    if constexpr (K == 53) conv_queue(p, l + 1, (char*)c.lds, LDS_MISC);
    if constexpr (K == 6) fastp::post_rows(p, l);
    if constexpr (K == 7) { EpiResid E{(unsigned short*)(p.ws + WS_X), D, mod_l, 2}; run_gemm(c.lds, (const act_t*)(p.ws + WS_YMIX), w + WT_OUT, MTOK, D, MIXW, E); }
    if constexpr (K == 8) fastp::norm_rows(p, l, 1);
    if constexpr (K == 9) { EpiFfnAct E{(pg8::bf16_t*)(p.ws + WS_ACT), (float*)(p.ws + WS_SIDE), p.ffn_conv + (size_t)l * 3 * DFF}; run_gemm(c.lds, (const act_t*)(p.ws + WS_H), w + WT_UP, MTOK, NUP, D, E); }
    if constexpr (K == 10) fastp::ffn_fix(p, l, gt, gs);
    if constexpr (K == 11) { EpiResid E{(unsigned short*)(p.ws + WS_X), D, mod_l, 5}; run_gemm(c.lds, (const act_t*)(p.ws + WS_ACT), w + WT_DOWN, MTOK, D, DFF, E); }
    if constexpr (K == 12) fastp::final_rows(p);
}
__device__ __forceinline__ Ctx make_ctx(PG8_LAS unsigned char* lds) {
    Ctx c; const int wv = TIDX >> 6, lane = TIDX & 63;
    c.gs = (long)gridDim.x * NTHR;
    c.gt = ((long)wv * gridDim.x + blockIdx.x) * 64 + lane;
    c.gt2 = (c.gt + c.gs / 2) % c.gs;
    c.lds = lds; return c;
}
#if N_LAUNCH_MODE == 1
template <int K> __device__ __forceinline__ void phase_site(int l, PG8_LAS unsigned char* lds) {
    const __attribute__((address_space(4))) P* kp = (const __attribute__((address_space(4))) P*)__builtin_amdgcn_kernarg_segment_ptr();
    asm volatile("" : "+s"(kp));
    P p;
#if defined(__HIP_DEVICE_COMPILE__)
    p = *kp;
#endif
    int tid = TIDX, bid = blockIdx.x, nb = gridDim.x;
    asm volatile("" : "+v"(tid), "+s"(bid), "+s"(nb));
    Ctx c; const int wv = tid >> 6, lane = tid & 63;
    c.gs = (long)nb * NTHR;
    c.gt = ((long)wv * nb + bid) * 64 + lane;
    c.gt2 = (c.gt + c.gs / 2) % c.gs;
    c.lds = lds;
    phase_body<K>(p, l, c);
}
#ifndef DUPMASK
#define DUPMASK 0
#endif
#define DUP(bit, ...) do { if (DUPMASK & (1 << (bit))) { __VA_ARGS__; } } while (0)
__device__ __forceinline__ void grid_bar(PG8_LAS unsigned char* lds) {
    const __attribute__((address_space(4))) P* kp = (const __attribute__((address_space(4))) P*)__builtin_amdgcn_kernarg_segment_ptr();
    asm volatile("" : "+s"(kp));
    XcdBarrier b; b.bar = (unsigned*)(kp->ws + WS_CTL); b.x = xb_xcc_id(); b.st = (volatile LAS unsigned*)(lds + LDS_MISC);
    xcd_barrier(b);
    if (DUPMASK & 2048) xcd_barrier(b);
}
__global__ void __launch_bounds__(NTHR, 2) fwd(Args a) {
    extern __shared__ __attribute__((aligned(16))) unsigned char lds_raw[];
    PG8_LAS unsigned char* lds = (PG8_LAS unsigned char*)lds_raw;
    volatile LAS unsigned* misc = (volatile LAS unsigned*)(lds + LDS_MISC);
    if (threadIdx.x < 4) misc[threadIdx.x] = 0u;
    if ((threadIdx.x & 63) == 0) *(volatile LAS int*)(lds + TID_TAB_OFF + 4 * hw_slot()) = (int)(threadIdx.x >> 6);
    __syncthreads();
    (void)xcd_barrier_post((unsigned*)(a.p.ws + WS_CTL), misc);
    phase_site<0>(0, lds); DUP(4, phase_site<0>(0, lds)); grid_bar(lds);
    for (int l = 0; l < L; ++l) {
        phase_site<1>(l, lds); DUP(0, phase_site<1>(l, lds)); grid_bar(lds);
        phase_site<2>(l, lds); DUP(1, phase_site<2>(l, lds)); grid_bar(lds);
        phase_site<3>(l, lds); DUP(0, phase_site<3>(l, lds)); grid_bar(lds);
        phase_site<41>(l, lds); phase_site<42>(l, lds); phase_site<43>(l, lds); DUP(1, phase_site<41>(l, lds); phase_site<42>(l, lds); phase_site<43>(l, lds)); phase_site<46>(l, lds); grid_bar(lds);
        phase_site<45>(l, lds); grid_bar(lds);
        phase_site<50>(l, lds); phase_site<53>(l, lds); DUP(10, grid_bar(lds); phase_site<52>(l, lds)); grid_bar(lds);
        phase_site<6>(l, lds); DUP(0, phase_site<6>(l, lds)); grid_bar(lds);
        phase_site<7>(l, lds); grid_bar(lds);
        phase_site<8>(l, lds); DUP(0, phase_site<8>(l, lds)); grid_bar(lds);
        phase_site<9>(l, lds); DUP(1, phase_site<9>(l, lds)); grid_bar(lds);
        phase_site<10>(l, lds); DUP(0, phase_site<10>(l, lds)); grid_bar(lds);
        phase_site<11>(l, lds); grid_bar(lds);
    }
    phase_site<12>(0, lds);
}
#endif


extern "C" void kernel_launch(void* const* d_in, const int* in_sizes, int n_in, void* d_out, int out_size, void* d_ws, size_t ws_size, hipStream_t stream) {
    static int grid = 0;
    if (grid == 0) {
        if (n_in != 37 || (size_t)out_size != O_END || ws_size < WS_END) { fprintf(stderr, "kernel_launch: unexpected sizes n_in %d out %d ws %zu (need %zu)\n", n_in, out_size, ws_size, (size_t)WS_END); grid = -1; return; }
        int dev = 0, cus = 0, per_cu = 0;
        if (hipGetDevice(&dev) != hipSuccess || hipDeviceGetAttribute(&cus, hipDeviceAttributeMultiprocessorCount, dev) != hipSuccess) { grid = -1; return; }
#if N_LAUNCH_MODE == 1
        bool ok = hipFuncSetAttribute((const void*)fwd, hipFuncAttributeMaxDynamicSharedMemorySize, LDS_BYTES) == hipSuccess;
        if (hipOccupancyMaxActiveBlocksPerMultiprocessor(&per_cu, (const void*)fwd, NTHR, LDS_BYTES) != hipSuccess || per_cu < 1) fprintf(stderr, "kernel_launch: occupancy query says %d\n", per_cu);
#endif
        if (!ok) { fprintf(stderr, "kernel_launch: hipFuncSetAttribute failed\n"); grid = -1; return; }
        (void)per_cu; (void)hipGetLastError();
        grid = cus;
    }
    if (grid < 0) return;
    (void)hipMemsetAsync((char*)d_ws + WS_CTL, 0, WS_CTL_BYTES, stream);
    Args a{};
    const float** pin = (const float**)&a.p;
    for (int i = 0; i < 37; ++i) pin[i] = (const float*)d_in[i];
    a.p.out = (float*)d_out; a.p.ws = (unsigned char*)d_ws;
    a.pad = 0;
#if N_LAUNCH_MODE == 1
    a.ph_lo = 0; a.ph_hi = N_PHASES; a.use_bar = 1;
    hipLaunchKernelGGL(fwd, dim3(grid), dim3(NTHR), LDS_BYTES, stream, a);
#endif
}
```

```cpp
#include <hip/hip_runtime.h>
#include <cstdio>
#define N_LAUNCH_MODE 1
#define DUPMASK 0
#define HD __device__ __attribute__((always_inline))
#define UNROLL _Pragma("unroll")
#define CBAR asm volatile("" ::: "memory")
#define ATT_SDEPTH 1
#define ATT_NQREG 6
constexpr int NTHR_ = 512;
typedef float4 f4;
HD inline f4 ldf4(const float* p) { return *(const float4*)p; }
constexpr int LDS_TOTAL_BYTES = 147456, TID_TAB_OFF = LDS_TOTAL_BYTES - 64 - 256;
__device__ __forceinline__ unsigned hw_slot() { return (unsigned)__builtin_amdgcn_s_getreg((5 << 11) | 4) & 63u; }
__device__ __forceinline__ int tidx_() {
    const int w = *(volatile __attribute__((address_space(3))) int*)(__attribute__((address_space(3))) char*)(unsigned long)(TID_TAB_OFF + 4u * hw_slot());
    int lane; asm volatile("v_mbcnt_lo_u32_b32 %0, -1, 0\n\tv_mbcnt_hi_u32_b32 %0, -1, %0" : "=v"(lane));
    return (__builtin_amdgcn_readfirstlane(w) << 6) | lane;
}
#define TIDX tidx_()
namespace cfg {
#ifdef SMALL_CFG
constexpr int D = 128, NB = 2, SEQ = 128, L = 2, NDB = 2, DSEQ = 256, PAST = 128, GRIDW = 16;
constexpr int AH = 2, AN = 64, DL = 16, IL = 16, GL = 32;
constexpr int BH = 2, QR = 64, KVR = 64, NOPE = 32, ROPE = 16, VD = 32;
constexpr int CH = 2, DK = 32, DV = 32, CHUNK = 64;
constexpr int DFF = 192;
#else
constexpr int D = 2048, NB = 16, SEQ = 256, L = 4, NDB = 2, DSEQ = 4096, PAST = 256, GRIDW = 64;
constexpr int AH = 8, AN = 64, DL = 64, IL = 64, GL = 128;
constexpr int BH = 8, QR = 512, KVR = 512, NOPE = 128, ROPE = 64, VD = 128;
constexpr int CH = 4, DK = 128, DV = 128, CHUNK = 64;
constexpr int DFF = 5632;
#endif
constexpr int AW = AH * AN, BW = BH * VD, CW = CH * DV, QKD = NOPE + ROPE, MIXW = AW + BW + CW;
constexpr int OFF_R = 0, OFF_K = AW, OFF_V = 2 * AW, OFF_WLO = 3 * AW, OFF_ALO = OFF_WLO + 2 * DL, OFF_GLO = OFF_ALO + 2 * IL,
              OFF_CQ = OFF_GLO + GL, OFF_CKV = OFF_CQ + QR, OFF_KPE = OFF_CKV + KVR, OFF_GQ = OFF_KPE + ROPE, OFF_GK = OFF_GQ + CH * DK,
              OFF_GV = OFF_GK + CH * DK, OFF_GZ = OFF_GV + CW, OFF_GB = OFF_GZ + CW, OFF_GA = OFF_GB + 2 * CH, INC = OFF_GA + 2 * CH;
constexpr int INP = (INC + 255) / 256 * 256;
constexpr int NSEQ = NB + NDB, MCTX = NB * SEQ, MLAT = NDB * DSEQ, MTOK = MCTX + MLAT, MKV = MTOK + NDB * PAST, NCOND = 1 + NDB;
constexpr int NQ = BH * QKD, NKV = BH * NOPE + BH * VD, NUP = 2 * DFF, GC = 2 * CH * DK + CW;
constexpr int LINK = 2 * DL + 2 * IL + GL, LORAN = 5 * AW;
constexpr float RMS_EPS = 1e-6f, LNX_EPS = 64e-5f, L2_EPS = 1e-6f, ROPE_BASE = 10000.0f;
}
using namespace cfg;

#ifdef HOSTEMU
typedef float act_t;
struct act2 { float x, y; };
HD inline float a2f(act_t a) { return a; }
HD inline act_t f2a(float f) { return f; }
HD inline act2 ld2(const act_t* p) { act2 r; r.x = p[0]; r.y = p[1]; return r; }
HD inline act2 mk2(float x, float y) { act2 r; r.x = x; r.y = y; return r; }
HD inline float dot2(act2 a, act2 b, float c) { return c + a.x * b.x + a.y * b.y; }
HD inline float lo2(act2 a) { return a.x; }
HD inline float hi2(act2 a) { return a.y; }
#else
typedef unsigned short act_t;
typedef unsigned act2;
HD inline float a2f(act_t a) { return __uint_as_float(((unsigned)a) << 16); }
HD inline act_t f2a(float f) { unsigned u = __float_as_uint(f); return (act_t)((u + 0x7fffu + ((u >> 16) & 1u)) >> 16); }
HD inline act2 ld2(const act_t* p) { return *(const unsigned*)p; }
HD inline act2 mk2(float x, float y) { return (unsigned)f2a(x) | ((unsigned)f2a(y) << 16); }
HD inline float lo2(act2 a) { return __uint_as_float(a << 16); }
HD inline float hi2(act2 a) { return __uint_as_float(a & 0xffff0000u); }
typedef __bf16 bf16x2_t __attribute__((ext_vector_type(2)));
HD inline float dot2(act2 a, act2 b, float c) { return __builtin_amdgcn_fdot2_f32_bf16(__builtin_bit_cast(bf16x2_t, a), __builtin_bit_cast(bf16x2_t, b), c, false); }
HD inline float ldp1(const act_t* p) { return a2f(*p); }
HD inline float2 ldp2(const act_t* p) { const unsigned u = *(const unsigned*)p; return make_float2(lo2(u), hi2(u)); }
HD inline float4 ldp4(const act_t* p) { const uint2 u = *(const uint2*)p; return make_float4(lo2(u.x), hi2(u.x), lo2(u.y), hi2(u.y)); }
#endif

struct P {
    const float *x_prompt, *x_sample, *state_rwkv, *state_gdn, *cache_ckv, *cache_kpe, *c, *c_ctx, *ada_w, *ada_b, *norm1_g, *w_in,
        *rwkv_w0, *rwkv_w2, *rwkv_a0, *rwkv_a2, *rwkv_g2, *rwkv_kk, *rwkv_ka, *rwkv_rk, *rwkv_lnx_g, *rwkv_lnx_b, *mla_qnorm_g, *mla_w_uq,
        *mla_kvnorm_g, *mla_w_uk, *mla_w_uv, *gdn_conv, *gdn_a_log, *gdn_dt_bias, *gdn_norm_g, *w_out, *norm2_g, *ffn_up, *ffn_conv, *ffn_down,
        *final_norm_g;
    float* out;
    unsigned char* ws;
};

constexpr size_t O_YP = 0, O_YS = O_YP + (size_t)MCTX * D, O_SR = O_YS + (size_t)MLAT * D, O_SG = O_SR + (size_t)NB * L * 2 * AH * AN * AN,
                 O_CK = O_SG + (size_t)NB * L * 2 * CH * DK * DV, O_KP = O_CK + (size_t)NB * L * SEQ * KVR, O_END = O_KP + (size_t)NB * L * SEQ * ROPE;

constexpr size_t al256(size_t x) { return (x + 255) / 256 * 256; }
constexpr size_t WS_CTL = 0, WS_CTL_BYTES = 64 * 1024;
constexpr size_t WS_MOD = WS_CTL + WS_CTL_BYTES;
constexpr size_t WS_ROPE = al256(WS_MOD + (size_t)L * NCOND * 6 * D * 4);
constexpr size_t WS_X = al256(WS_ROPE + (size_t)DSEQ * ROPE * 4);
constexpr size_t WS_H = al256(WS_X + (size_t)MTOK * D * 4);
constexpr size_t WS_YMIX = al256(WS_H + (size_t)MTOK * D * sizeof(act_t));
constexpr size_t WT_IN = 0, WT_UQ = WT_IN + (size_t)INP * D, WT_UKV = WT_UQ + (size_t)NQ * QR, WT_OUT = WT_UKV + (size_t)NKV * KVR,
                 WT_UP = WT_OUT + (size_t)D * MIXW, WT_DOWN = WT_UP + (size_t)NUP * D, WT_LORA = WT_DOWN + (size_t)D * DFF, WT_LAYER = WT_LORA + (size_t)LORAN * LINK;
constexpr size_t WS_WT = al256(WS_YMIX + (size_t)MTOK * MIXW * sizeof(act_t));
constexpr size_t WS_U0 = al256(WS_WT + (size_t)L * WT_LAYER * 2);
constexpr size_t WS_PP = WS_U0;
#ifdef HOSTEMU
constexpr size_t WS_RWDEC = al256(WS_PP + (size_t)MTOK * INP * 4);
constexpr size_t WS_RWKDIR = al256(WS_RWDEC + (size_t)MTOK * 2 * AW * 4);
constexpr size_t WS_RWKKA = al256(WS_RWKDIR + (size_t)MTOK * 2 * AW * 4);
constexpr size_t WS_RWKK = al256(WS_RWKKA + (size_t)MTOK * 2 * AW * 4);
#ifdef HOSTEMU
constexpr size_t WS_RWG = al256(WS_RWKK + (size_t)MTOK * AW * 4);
constexpr size_t WS_RWY = al256(WS_RWG + (size_t)MTOK * AW * 4);
#else
constexpr size_t WS_RWY = al256(WS_RWKK + (size_t)MTOK * AW * 4);
constexpr size_t WS_RWG = WS_H;
#endif
constexpr size_t WS_CQN = al256(WS_RWY + (size_t)MTOK * 2 * AW * 4);
constexpr size_t WS_CKVN = al256(WS_CQN + (size_t)MTOK * QR * sizeof(act_t));
constexpr size_t WS_KR = al256(WS_CKVN + (size_t)MKV * KVR * sizeof(act_t));
constexpr size_t WS_QF = al256(WS_KR + (size_t)MKV * ROPE * sizeof(act_t));
constexpr size_t WS_KVUP = al256(WS_QF + (size_t)MTOK * NQ * sizeof(act_t));
constexpr size_t WS_GBG = al256(WS_KVUP + (size_t)MKV * NKV * sizeof(act_t));
constexpr size_t WS_GO = al256(WS_GBG + (size_t)MTOK * 2 * CH * 4 * 4);
constexpr size_t WS_GCONV = al256(WS_GO + (size_t)MTOK * 2 * CW * 4);
constexpr size_t WS_LIN = al256(WS_GCONV + (size_t)MTOK * GC * 4);
constexpr size_t WS_LORA = al256(WS_LIN + (size_t)MTOK * LINK * sizeof(act_t));
constexpr size_t WS_GCH = al256(WS_LORA + (size_t)MTOK * LORAN * 4);
constexpr size_t WS_RCH = WS_GCONV;
static_assert((size_t)(MTOK / 64) * 2 * AH * 65792 <= WS_GCH - WS_GCONV, "RWKV chunk slots must fit the dead prep buffers");
constexpr size_t WS_MIX_END = al256(WS_GCH + (size_t)(MTOK / 64) * 2 * CH * 73984);
#else
constexpr size_t WS_RWB = al256(WS_PP + (size_t)MTOK * INP * 4);
constexpr size_t WS_RWY = al256(WS_RWB + (size_t)MTOK * 2 * AH * 4);
constexpr size_t WS_RWG = WS_H;
constexpr size_t WS_CQN = al256(WS_RWY + (size_t)MTOK * 2 * AW * 4);
constexpr size_t WS_CKVN = al256(WS_CQN + (size_t)MTOK * QR * sizeof(act_t));
constexpr size_t WS_KR = al256(WS_CKVN + (size_t)MKV * KVR * sizeof(act_t));
constexpr size_t WS_QF = al256(WS_KR + (size_t)MKV * ROPE * sizeof(act_t));
constexpr size_t WS_KVUP = al256(WS_QF + (size_t)MTOK * NQ * sizeof(act_t));
constexpr size_t WS_GBG = al256(WS_KVUP + (size_t)MKV * NKV * sizeof(act_t));
constexpr size_t WS_GO = al256(WS_GBG + (size_t)MTOK * 2 * CH * 4 * 4);
constexpr size_t WS_LORA = al256(WS_GO + (size_t)MTOK * 2 * CW * 4);
constexpr size_t WS_GCH = al256(WS_LORA + (size_t)MTOK * LORAN * 4);
constexpr size_t WS_GCONV = al256(WS_GCH + (size_t)(MTOK / 64) * 2 * CH * 73984);
constexpr size_t WS_LIN = al256(WS_GCONV + (size_t)MTOK * GC * 4);
constexpr size_t WS_RCH = WS_GCONV;
constexpr size_t WS_MIX_END = al256(WS_RCH + (size_t)(MTOK / 64) * 2 * AH * 65792);
static_assert(WS_LIN + (size_t)MTOK * LINK * sizeof(act_t) <= WS_MIX_END, "LoRA inputs inside the RWKV slot region");
constexpr size_t WS_RWDEC = WS_RWY, WS_RWKDIR = WS_RWY, WS_RWKKA = WS_RWY, WS_RWKK = WS_RWY;
#endif
constexpr size_t WS_UP = WS_U0;
constexpr size_t WS_ACT = al256(WS_UP + (size_t)MTOK * NUP * sizeof(act_t));
constexpr size_t WS_FFN_END = al256(WS_ACT + (size_t)MTOK * DFF * sizeof(act_t));
constexpr size_t WS_SIDE = WS_MIX_END > WS_FFN_END ? WS_MIX_END : WS_FFN_END;
constexpr size_t WS_END = WS_SIDE + (size_t)(MTOK / 64) * 6 * DFF * 4;

HD inline int seq_of(int m) { return m < MCTX ? m / SEQ : NB + (m - MCTX) / DSEQ; }
HD inline int seq_start(int s) { return s < NB ? s * SEQ : MCTX + (s - NB) * DSEQ; }
HD inline int seq_len(int s) { return s < NB ? SEQ : DSEQ; }
HD inline int cond_of_seq(int s) { return s < NB ? 0 : 1 + (s - NB); }
#ifdef HOSTEMU
HD inline float fexp_(float x) { return expf(x); }
HD inline float sigmoidf_(float x) { return 1.0f / (1.0f + expf(-x)); }
HD inline float siluf_(float x) { return x / (1.0f + expf(-x)); }
HD inline float softplusf_(float x) { return fmaxf(x, 0.0f) + log1pf(expf(-fabsf(x))); }
HD inline float ftanh_(float x) { return tanhf(x); }
#else
HD inline float fexp_(float x) { return __builtin_amdgcn_exp2f(x * 1.4426950408889634f); }
HD inline float sigmoidf_(float x) { return __builtin_amdgcn_rcpf(1.0f + fexp_(-x)); }
HD inline float siluf_(float x) { return x * sigmoidf_(x); }
HD inline float softplusf_(float x) { return fmaxf(x, 0.0f) + 0.6931471805599453f * __builtin_amdgcn_logf(1.0f + fexp_(-fabsf(x))); }
HD inline float ftanh_(float x) { return 2.0f * sigmoidf_(2.0f * x) - 1.0f; }
#endif
HD inline const float* modp(const P& p, int l, int cond, int which) { return (const float*)(p.ws + WS_MOD) + ((size_t)(l * NCOND + cond) * 6 + which) * D; }

HD inline void rope_angle(int t, int i, float& cs, float& sn) {
    const int nf = ROPE / 4; const int row = t / GRIDW, col = t % GRIDW;
    const int f = i < nf ? i : i - nf;
    const float inv = powf(ROPE_BASE, -(float)f / (float)nf);
    const float ang = (float)(i < nf ? row : col) * inv;
    cs = cosf(ang); sn = sinf(ang);
}
HD inline void ph_init(const P& p, long gt, long gs) {
    float* x = (float*)(p.ws + WS_X);
    for (long i = gt; i < (long)MTOK * D; i += gs) x[i] = i < (long)MCTX * D ? p.x_prompt[i] : p.x_sample[i - (long)MCTX * D];
    float* rt = (float*)(p.ws + WS_ROPE);
    for (long i = gt; i < (long)DSEQ * (ROPE / 2); i += gs) { float cs, sn; rope_angle((int)(i / (ROPE / 2)), (int)(i % (ROPE / 2)), cs, sn); rt[2 * i] = cs; rt[2 * i + 1] = sn; }
    float* mod = (float*)(p.ws + WS_MOD);
    for (long idx = gt; idx < (long)L * 6 * D; idx += gs) {
        const int l = (int)(idx / (6 * D)), j = (int)(idx % (6 * D));
        float acc[NCOND];
        UNROLL for (int c = 0; c < NCOND; ++c) acc[c] = 0.f;
        for (int i = 0; i < D; ++i) {
            const float w = p.ada_w[((size_t)l * D + i) * 6 * D + j];
            acc[0] += siluf_(p.c_ctx[i]) * w;
            UNROLL for (int c = 1; c < NCOND; ++c) acc[c] += siluf_(p.c[(size_t)(c - 1) * D + i]) * w;
        }
        const float b = p.ada_b[(size_t)l * 6 * D + j];
        UNROLL for (int c = 0; c < NCOND; ++c) mod[((size_t)(l * NCOND + c) * 6) * D + j] = acc[c] + b;
    }
}

HD inline void ph_norm(const P& p, int l, int which, long gt, long gs) {
    const float* x = (const float*)(p.ws + WS_X);
    act_t* h = (act_t*)(p.ws + WS_H);
    const float* g = (which == 0 ? p.norm1_g : p.norm2_g) + (size_t)l * D;
    for (long m = gt; m < MTOK; m += gs) {
        const int cond = cond_of_seq(seq_of((int)m));
        const float* sh = modp(p, l, cond, which * 3 + 0);
        const float* sc = modp(p, l, cond, which * 3 + 1);
        const float* xr = x + (size_t)m * D;
        float ss = 0.f;
        for (int j = 0; j < D; ++j) ss += xr[j] * xr[j];
        const float rs = 1.0f / sqrtf(ss / D + RMS_EPS);
        for (int j = 0; j < D; ++j) h[(size_t)m * D + j] = f2a(xr[j] * rs * g[j] * (1.0f + sc[j]) + sh[j]);
    }
}

HD inline void ph_rwkv_prep(const P& p, int l, long gt, long gs) {
    const float* pp = (const float*)(p.ws + WS_PP);
    float* dec = (float*)(p.ws + WS_RWDEC); float* kdir = (float*)(p.ws + WS_RWKDIR); float* kka = (float*)(p.ws + WS_RWKKA);
    float* kkb = (float*)(p.ws + WS_RWKK); float* gb = (float*)(p.ws + WS_RWG);
    for (long idx = gt; idx < (long)MTOK * AW; idx += gs) {
        const int m = (int)(idx / AW), c = (int)(idx % AW), h = c / AN;
        const float* pr = pp + (size_t)m * INP;
        const float* kksc = p.rwkv_kk + (size_t)l * AW;
        float ss = 0.f;
        for (int j = 0; j < AN; ++j) { const float t = pr[OFF_K + h * AN + j] * kksc[h * AN + j]; ss += t * t; }
        const float kraw = pr[OFF_K + c];
        const float kk = kraw * kksc[c] / sqrtf(ss + L2_EPS);
        kkb[(size_t)m * AW + c] = kk;
        for (int d = 0; d < 2; ++d) {
            float wpre = p.rwkv_w0[((size_t)l * 2 + d) * AW + c];
            for (int r = 0; r < DL; ++r) wpre += tanhf(pr[OFF_WLO + d * DL + r]) * p.rwkv_w2[(((size_t)l * 2 + d) * DL + r) * AW + c];
            const float logw = -expf(-softplusf_(-wpre) - 0.5f);
            float apre = p.rwkv_a0[((size_t)l * 2 + d) * AW + c];
            for (int r = 0; r < IL; ++r) apre += pr[OFF_ALO + d * IL + r] * p.rwkv_a2[(((size_t)l * 2 + d) * IL + r) * AW + c];
            const float a = sigmoidf_(apre);
            const size_t o = ((size_t)m * 2 + d) * AW + c;
            dec[o] = expf(logw);
            kdir[o] = kraw * (1.0f + (a - 1.0f) * p.rwkv_ka[(size_t)l * AW + c]);
            kka[o] = kk * a;
        }
        float g = 0.f;
        for (int r = 0; r < GL; ++r) g += sigmoidf_(pr[OFF_GLO + r]) * p.rwkv_g2[((size_t)l * GL + r) * AW + c];
        gb[(size_t)m * AW + c] = g;
    }
}

HD inline void ph_rwkv_scan(const P& p, int l, long gt, long gs) {
    const float* pp = (const float*)(p.ws + WS_PP);
    const float* dec = (const float*)(p.ws + WS_RWDEC); const float* kdir = (const float*)(p.ws + WS_RWKDIR); const float* kka = (const float*)(p.ws + WS_RWKKA);
    const float* kkb = (const float*)(p.ws + WS_RWKK); float* yb = (float*)(p.ws + WS_RWY);
    for (long idx = gt; idx < (long)NSEQ * 2 * AH * AN; idx += gs) {
        const int i = (int)(idx % AN), h = (int)((idx / AN) % AH), d = (int)((idx / (AN * AH)) % 2), s = (int)(idx / (AN * AH * 2));
        float S[AN];
        if (s >= NB) { const float* s0 = p.state_rwkv + (((((size_t)(s - NB) * L + l) * 2 + d) * AH + h) * AN + i) * AN; UNROLL for (int k = 0; k < AN; ++k) S[k] = s0[k]; }
        else { UNROLL for (int k = 0; k < AN; ++k) S[k] = 0.f; }
        const int T = seq_len(s), base = seq_start(s);
        for (int step = 0; step < T; ++step) {
            const int m = base + (d == 0 ? step : T - 1 - step);
            const float* pr = pp + (size_t)m * INP;
            const float* kk = kkb + (size_t)m * AW + h * AN;
            const size_t o = ((size_t)m * 2 + d) * AW + h * AN;
            float sa = 0.f;
            UNROLL for (int k = 0; k < AN; k += 4) { const f4 t = ldf4(kk + k); sa -= S[k] * t.x + S[k + 1] * t.y + S[k + 2] * t.z + S[k + 3] * t.w; }
            const float vi = pr[OFF_V + h * AN + i];
            float y = 0.f;
            UNROLL for (int k = 0; k < AN; k += 4) {
                const f4 w4 = ldf4(dec + o + k), a4 = ldf4(kka + o + k), k4 = ldf4(kdir + o + k), r4 = ldf4(pr + OFF_R + h * AN + k);
                S[k] = S[k] * w4.x + sa * a4.x + vi * k4.x; y += S[k] * r4.x;
                S[k + 1] = S[k + 1] * w4.y + sa * a4.y + vi * k4.y; y += S[k + 1] * r4.y;
                S[k + 2] = S[k + 2] * w4.z + sa * a4.z + vi * k4.z; y += S[k + 2] * r4.z;
                S[k + 3] = S[k + 3] * w4.w + sa * a4.w + vi * k4.w; y += S[k + 3] * r4.w;
            }
            yb[o + i] = y;
        }
        if (s < NB) { float* so = p.out + O_SR + (((((size_t)s * L + l) * 2 + d) * AH + h) * AN + i) * AN; UNROLL for (int k = 0; k < AN; ++k) so[k] = S[k]; }
    }
}

HD inline void ph_rwkv_post(const P& p, int l, long gt, long gs) {
    const float* pp = (const float*)(p.ws + WS_PP);
    const float* kdir = (const float*)(p.ws + WS_RWKDIR); const float* gb = (const float*)(p.ws + WS_RWG); const float* yb = (const float*)(p.ws + WS_RWY);
    act_t* ymix = (act_t*)(p.ws + WS_YMIX);
    for (long idx = gt; idx < (long)MTOK * AW; idx += gs) {
        const int m = (int)(idx / AW), c = (int)(idx % AW), h = c / AN;
        const float* pr = pp + (size_t)m * INP;
        const float* y0 = yb + ((size_t)m * 2 + 0) * AW + h * AN; const float* y1 = yb + ((size_t)m * 2 + 1) * AW + h * AN;
        float mu = 0.f;
        for (int j = 0; j < AN; ++j) mu += y0[j] + y1[j];
        mu /= AN;
        float var = 0.f;
        for (int j = 0; j < AN; ++j) { const float t = y0[j] + y1[j] - mu; var += t * t; }
        var /= AN;
        const float yc = yb[((size_t)m * 2 + 0) * AW + c] + yb[((size_t)m * 2 + 1) * AW + c];
        float y = (yc - mu) / sqrtf(var + LNX_EPS) * p.rwkv_lnx_g[(size_t)l * AW + c] + p.rwkv_lnx_b[(size_t)l * AW + c];
        float bon = 0.f;
        for (int d = 0; d < 2; ++d) for (int j = 0; j < AN; ++j)
            bon += pr[OFF_R + h * AN + j] * kdir[((size_t)m * 2 + d) * AW + h * AN + j] * p.rwkv_rk[((size_t)l * AH + h) * AN + j];
        y += bon * pr[OFF_V + c];
        ymix[(size_t)m * MIXW + c] = f2a(y * gb[(size_t)m * AW + c]);
    }
}

HD inline void ph_mla_prep(const P& p, int l, long gt, long gs) {
    const float* pp = (const float*)(p.ws + WS_PP);
    act_t* cqn = (act_t*)(p.ws + WS_CQN); act_t* ckvn = (act_t*)(p.ws + WS_CKVN); act_t* kr = (act_t*)(p.ws + WS_KR);
    for (long m = gt; m < MKV; m += gs) {
        if (m < MTOK) {
            const float* pr = pp + (size_t)m * INP;
            const int s = seq_of((int)m), t = (int)m - seq_start(s);
            float ss = 0.f;
            for (int j = 0; j < QR; ++j) ss += pr[OFF_CQ + j] * pr[OFF_CQ + j];
            float rs = 1.0f / sqrtf(ss / QR + RMS_EPS);
            for (int j = 0; j < QR; ++j) cqn[(size_t)m * QR + j] = f2a(pr[OFF_CQ + j] * rs * p.mla_qnorm_g[(size_t)l * QR + j]);
            ss = 0.f;
            for (int j = 0; j < KVR; ++j) ss += pr[OFF_CKV + j] * pr[OFF_CKV + j];
            rs = 1.0f / sqrtf(ss / KVR + RMS_EPS);
            for (int j = 0; j < KVR; ++j) {
                const float v = pr[OFF_CKV + j] * rs * p.mla_kvnorm_g[(size_t)l * KVR + j];
                ckvn[(size_t)m * KVR + j] = f2a(v);
                if (s < NB) p.out[O_CK + (((size_t)s * L + l) * SEQ + t) * KVR + j] = v;
            }
            if (s < NB) {
                for (int j = 0; j < ROPE; ++j) { const float v = pr[OFF_KPE + j]; kr[(size_t)m * ROPE + j] = f2a(v); p.out[O_KP + (((size_t)s * L + l) * SEQ + t) * ROPE + j] = v; }
            } else {
                for (int i = 0; i < ROPE / 2; ++i) {
                    float cs, sn; rope_angle(t, i, cs, sn);
                    const float xe = pr[OFF_KPE + 2 * i], xo = pr[OFF_KPE + 2 * i + 1];
                    kr[(size_t)m * ROPE + 2 * i] = f2a(xe * cs - xo * sn); kr[(size_t)m * ROPE + 2 * i + 1] = f2a(xe * sn + xo * cs);
                }
            }
        } else {
            const int r = (int)m - MTOK, b = r / PAST, j0 = r % PAST;
            const float* ck = p.cache_ckv + (((size_t)b * L + l) * PAST + j0) * KVR;
            for (int j = 0; j < KVR; ++j) ckvn[(size_t)m * KVR + j] = f2a(ck[j]);
            const float* kp = p.cache_kpe + (((size_t)b * L + l) * PAST + j0) * ROPE;
            for (int j = 0; j < ROPE; ++j) kr[(size_t)m * ROPE + j] = f2a(kp[j]);
        }
    }
}

constexpr int VSL = 32, NVS = VD / VSL;
HD inline void ph_attn(const P& p, int l, long gt, long gs) {
    (void)l;
    const act_t* qf = (const act_t*)(p.ws + WS_QF); const act_t* kvup = (const act_t*)(p.ws + WS_KVUP); const act_t* kr = (const act_t*)(p.ws + WS_KR);
    act_t* ymix = (act_t*)(p.ws + WS_YMIX);
    const float scale = 1.0f / sqrtf((float)QKD);
    for (long idx = gt; idx < (long)MTOK * BH * NVS; idx += gs) {
        const int m = (int)(idx % MTOK), vs = (int)((idx / MTOK) % NVS), h = (int)(idx / ((long)MTOK * NVS));
        const int s = seq_of(m), base = seq_start(s), t = m - base, T = seq_len(s);
        const bool lat = s >= NB;
        act2 q[QKD / 2];
        const act_t* qr = qf + (size_t)m * NQ + h * QKD;
        UNROLL for (int i = 0; i < NOPE / 2; ++i) q[i] = ld2(qr + 2 * i);
        UNROLL for (int i = 0; i < ROPE / 2; ++i) {
            const act2 v = ld2(qr + NOPE + 2 * i);
            if (lat) { float cs, sn; rope_angle(t, i, cs, sn); const float xe = lo2(v), xo = hi2(v); q[NOPE / 2 + i] = mk2(xe * cs - xo * sn, xe * sn + xo * cs); }
            else q[NOPE / 2 + i] = v;
        }
        float mx = -1e30f, sum = 0.f, acc[VSL];
        UNROLL for (int e = 0; e < VSL; ++e) acc[e] = 0.f;
        const int nk = T + (lat ? PAST : 0);
        for (int j = 0; j < nk; ++j) {
            const size_t krow = j < T ? (size_t)(base + j) : (size_t)(MTOK + (s - NB) * PAST + (j - T));
            const act_t* kn = kvup + krow * NKV + h * NOPE;
            const act_t* kp = kr + krow * ROPE;
            float sc = 0.f;
            UNROLL for (int i = 0; i < NOPE / 2; ++i) { if ((i & 15) == 0) CBAR; sc = dot2(q[i], ld2(kn + 2 * i), sc); }
            UNROLL for (int i = 0; i < ROPE / 2; ++i) { if ((i & 15) == 0) CBAR; sc = dot2(q[NOPE / 2 + i], ld2(kp + 2 * i), sc); }
            CBAR;
            sc *= scale;
            if (sc > mx) { const float corr = expf(mx - sc); sum *= corr; UNROLL for (int e = 0; e < VSL; ++e) acc[e] *= corr; mx = sc; }
            const float pe = expf(sc - mx);
            sum += pe;
            const act_t* vv = kvup + krow * NKV + BH * NOPE + h * VD + vs * VSL;
            UNROLL for (int e = 0; e < VSL; e += 2) { const act2 v2 = ld2(vv + e); acc[e] += pe * lo2(v2); acc[e + 1] += pe * hi2(v2); }
        }
        const float inv = 1.0f / sum;
        UNROLL for (int e = 0; e < VSL; ++e) ymix[(size_t)m * MIXW + AW + h * VD + vs * VSL + e] = f2a(acc[e] * inv);
    }
}

HD inline void ph_gdn_conv(const P& p, int l, long gt, long gs) {
    const float* pp = (const float*)(p.ws + WS_PP);
    float* gc = (float*)(p.ws + WS_GCONV);
    for (long idx = gt; idx < (long)MTOK * GC; idx += gs) {
        const int m = (int)(idx / GC), c = (int)(idx % GC);
        const int s = seq_of(m), base = seq_start(s), t = m - base, T = seq_len(s);
        const float* w = p.gdn_conv + (size_t)l * 3 * GC;
        float a = w[GC + c] * pp[(size_t)m * INP + OFF_GQ + c];
        if (t > 0) a += w[c] * pp[(size_t)(m - 1) * INP + OFF_GQ + c];
        if (t < T - 1) a += w[2 * GC + c] * pp[(size_t)(m + 1) * INP + OFF_GQ + c];
        gc[(size_t)m * GC + c] = siluf_(a);
    }
}
HD inline void ph_gdn_norm(const P& p, int l, long gt, long gs) {
    const float* pp = (const float*)(p.ws + WS_PP);
    float* gc = (float*)(p.ws + WS_GCONV); float* bg = (float*)(p.ws + WS_GBG);
    for (long idx = gt; idx < (long)MTOK * 4 * CH; idx += gs) {
        const int m = (int)(idx / (4 * CH)), j = (int)(idx % (4 * CH));
        if (j < 2 * CH) {
            float* v = gc + (size_t)m * GC + j * DK;
            float ss = 0.f;
            for (int e = 0; e < DK; ++e) ss += v[e] * v[e];
            const float rs = (1.0f / sqrtf(ss + L2_EPS)) * (j < CH ? 1.0f / sqrtf((float)DK) : 1.0f);
            for (int e = 0; e < DK; ++e) v[e] *= rs;
        } else {
            const int dh = j - 2 * CH;
            const float* pr = pp + (size_t)m * INP;
            const float beta = sigmoidf_(pr[OFF_GB + dh]);
            const float g = -expf(p.gdn_a_log[(size_t)l * 2 * CH + dh]) * softplusf_(pr[OFF_GA + dh] + p.gdn_dt_bias[(size_t)l * 2 * CH + dh]);
            bg[((size_t)m * 2 * CH + dh) * 4 + 0] = beta; bg[((size_t)m * 2 * CH + dh) * 4 + 1] = g;
        }
    }
}
HD inline void ph_gdn_scan(const P& p, int l, long gt, long gs) {
    const float* gc = (const float*)(p.ws + WS_GCONV); const float* bg = (const float*)(p.ws + WS_GBG); float* go = (float*)(p.ws + WS_GO);
    for (long idx = gt; idx < (long)NSEQ * 2 * CH * DV; idx += gs) {
        const int e = (int)(idx % DV), h = (int)((idx / DV) % CH), d = (int)((idx / (DV * CH)) % 2), s = (int)(idx / (DV * CH * 2));
        float S[DK];
        if (s >= NB) { const float* s0 = p.state_gdn + ((((size_t)(s - NB) * L + l) * 2 + d) * CH + h) * DK * DV + e; UNROLL for (int k = 0; k < DK; ++k) S[k] = s0[(size_t)k * DV]; }
        else { UNROLL for (int k = 0; k < DK; ++k) S[k] = 0.f; }
        const int T = seq_len(s), base = seq_start(s);
        for (int step = 0; step < T; ++step) {
            const int m = base + (d == 0 ? step : T - 1 - step);
            const float* q = gc + (size_t)m * GC + h * DK; const float* k = gc + (size_t)m * GC + CH * DK + h * DK;
            const float v = gc[(size_t)m * GC + 2 * CH * DK + h * DV + e];
            const float beta = bg[((size_t)m * 2 * CH + d * CH + h) * 4 + 0], eg = expf(bg[((size_t)m * 2 * CH + d * CH + h) * 4 + 1]);
            float kS = 0.f;
            UNROLL for (int j = 0; j < DK; j += 4) { if ((j & 15) == 0) CBAR; const f4 t = ldf4(k + j); kS += t.x * S[j] + t.y * S[j + 1] + t.z * S[j + 2] + t.w * S[j + 3]; }
            const float coef = beta * (v - eg * kS);
            float o = 0.f;
            UNROLL for (int j = 0; j < DK; j += 4) {
                if ((j & 15) == 0) CBAR;
                const f4 t = ldf4(k + j), u = ldf4(q + j);
                S[j] = eg * S[j] + t.x * coef; o += u.x * S[j];
                S[j + 1] = eg * S[j + 1] + t.y * coef; o += u.y * S[j + 1];
                S[j + 2] = eg * S[j + 2] + t.z * coef; o += u.z * S[j + 2];
                S[j + 3] = eg * S[j + 3] + t.w * coef; o += u.w * S[j + 3];
            }
            go[((size_t)m * 2 + d) * CW + h * DV + e] = o;
        }
        if (s < NB) { float* so = p.out + O_SG + ((((size_t)s * L + l) * 2 + d) * CH + h) * DK * DV + e; UNROLL for (int k = 0; k < DK; ++k) so[(size_t)k * DV] = S[k]; }
    }
}
HD inline void ph_gdn_post(const P& p, int l, long gt, long gs) {
    const float* pp = (const float*)(p.ws + WS_PP); const float* go = (const float*)(p.ws + WS_GO);
    act_t* ymix = (act_t*)(p.ws + WS_YMIX);
    for (long idx = gt; idx < (long)MTOK * CH; idx += gs) {
        const int m = (int)(idx / CH), h = (int)(idx % CH);
        const float* o0 = go + ((size_t)m * 2 + 0) * CW + h * DV; const float* o1 = go + ((size_t)m * 2 + 1) * CW + h * DV;
        float ss = 0.f;
        for (int e = 0; e < DV; ++e) { const float t = o0[e] + o1[e]; ss += t * t; }
        const float rs = 1.0f / sqrtf(ss / DV + RMS_EPS);
        for (int e = 0; e < DV; ++e) {
            const float z = pp[(size_t)m * INP + OFF_GZ + h * DV + e];
            ymix[(size_t)m * MIXW + AW + BW + h * DV + e] = f2a((o0[e] + o1[e]) * rs * p.gdn_norm_g[(size_t)l * DV + e] * siluf_(z));
        }
    }
}
HD inline void ph_ffn_act(const P& p, int l, long gt, long gs) {
    const act_t* up = (const act_t*)(p.ws + WS_UP); act_t* act = (act_t*)(p.ws + WS_ACT);
    for (long idx = gt; idx < (long)MTOK * DFF; idx += gs) {
        const int m = (int)(idx / DFF), c = (int)(idx % DFF);
        const int s = seq_of(m), base = seq_start(s), t = m - base, T = seq_len(s);
        const float* w = p.ffn_conv + (size_t)l * 3 * DFF;
        float a = w[DFF + c] * a2f(up[(size_t)m * NUP + c]);
        if (t > 0) a += w[c] * a2f(up[(size_t)(m - 1) * NUP + c]);
        if (t < T - 1) a += w[2 * DFF + c] * a2f(up[(size_t)(m + 1) * NUP + c]);
        act[(size_t)m * DFF + c] = f2a(siluf_(a) * a2f(up[(size_t)m * NUP + DFF + c]));
    }
}
HD inline void ph_final(const P& p, long gt, long gs) {
    const float* x = (const float*)(p.ws + WS_X);
    for (long m = gt; m < MTOK; m += gs) {
        const float* xr = x + (size_t)m * D;
        float ss = 0.f;
        for (int j = 0; j < D; ++j) ss += xr[j] * xr[j];
        const float rs = 1.0f / sqrtf(ss / D + RMS_EPS);
        for (int j = 0; j < D; ++j) p.out[O_YP + (size_t)m * D + j] = xr[j] * rs * p.final_norm_g[j];
    }
}
HD inline void ph_gemm_naive(const P& p, const act_t* A, int lda, const float* W, int ldw, int M, int N, int K, int mode, float* Cf, act_t* Ca, int ldc, int l, int which,
                             long gt, long gs) {
    for (long idx = gt; idx < (long)M * N; idx += gs) {
        const int m = (int)(idx / N), n = (int)(idx % N);
        float acc = 0.f;
        for (int k = 0; k < K; ++k) acc += a2f(A[(size_t)m * lda + k]) * W[(size_t)k * ldw + n];
        if (mode == 0) Cf[(size_t)m * ldc + n] = acc;
        else if (mode == 1) Ca[(size_t)m * ldc + n] = f2a(acc);
        else { const float* gate = modp(p, l, cond_of_seq(seq_of(m)), which); Cf[(size_t)m * ldc + n] += gate[n] * acc; }
    }
}
namespace pg8 {
#define PG8_LAS __attribute__((address_space(3)))
typedef unsigned short bf16_t;
typedef short bf16x8 __attribute__((ext_vector_type(8)));
typedef float f32x4 __attribute__((ext_vector_type(4)));
typedef unsigned u32x4 __attribute__((ext_vector_type(4)));
constexpr int BM = 256, BK = 64, HALF = 128, HTB = HALF * BK * 2  , STAGE_BYTES = 8 * HTB, NXCD = 8, WGM = 8;

__host__ __device__ __forceinline__ int lds_byte(int r, int c) { const int st = (r >> 4) * 2 + (c >> 5), rr = r & 15, cc = c & 31, ob = rr * 64 + cc * 2; return st * 1024 + (ob ^ (((ob >> 9) & 1) << 5)); }
__host__ __device__ __forceinline__ void stage_rc(int b, int& R, int& C) { const int st = b / 1024, sb = b % 1024, swz = sb ^ (((sb >> 9) & 1) << 5); R = (st >> 1) * 16 + swz / 64; C = (st & 1) * 32 + (swz % 64) / 2; }
__host__ __device__ __forceinline__ int perm32(int rho) { const int n = rho >> 4, i = rho & 15; return 8 * (i >> 2) + 4 * n + (i & 3); }

struct Unit { int pm, pn; };
struct Gemm { const bf16_t* A; const bf16_t* Bt; int M, N, K, ld; };

struct StaticOrder {
    int nM, nN, nwg, G, c;
    __host__ __device__ void init(int M, int N, int G_, int c_) { nM = M / BM; nN = N / BM; nwg = nM * nN; G = G_; c = c_; }
    __host__ __device__ bool next(int i, Unit& u) const {
        const long L = (long)i * G + c; if (L >= nwg) return false;
        int wgid = (int)L; { const int q = nwg / NXCD, r = nwg % NXCD, xcd = wgid % NXCD, off = wgid / NXCD; wgid = (xcd < r ? xcd * (q + 1) : r * (q + 1) + (xcd - r) * q) + off; }
        const int nig = WGM * nN, gid = wgid / nig, fm = gid * WGM, gsz = (nM - fm) < WGM ? (nM - fm) : WGM;
        u.pm = fm + ((wgid % nig) % gsz); u.pn = (wgid % nig) / gsz; return true;
    }
    __device__ __forceinline__ void a_ready(const Unit&) const {}
    __device__ __forceinline__ void done(const Unit&) const {}
};
struct CountedOrder : StaticOrder {
    const unsigned* ready; unsigned need; unsigned* tmo;
    __device__ __forceinline__ void a_ready(const Unit& u) const {
        if (TIDX < 64) {
            const unsigned long long t0 = __builtin_amdgcn_s_memrealtime(); unsigned polls = 0;
            while ((unsigned)__builtin_amdgcn_readfirstlane(__hip_atomic_load(ready + 64 * u.pm, __ATOMIC_RELAXED, __HIP_MEMORY_SCOPE_AGENT)) < need) {
                if ((++polls & 255u) == 0u && __builtin_amdgcn_readfirstlane(__hip_atomic_load(tmo, __ATOMIC_RELAXED, __HIP_MEMORY_SCOPE_AGENT)) != 0u) break;
                if (__builtin_amdgcn_s_memrealtime() - t0 > 2000000ull) {
                    if (TIDX == 0) { unsigned expect = 0u; __hip_atomic_compare_exchange_strong(tmo + 1, &expect, 0x600u | (unsigned)(u.pm & 0xff), __ATOMIC_RELAXED, __ATOMIC_RELAXED, __HIP_MEMORY_SCOPE_AGENT); __hip_atomic_store(tmo, 1u, __ATOMIC_RELAXED, __HIP_MEMORY_SCOPE_AGENT); }
                    break; }
                __builtin_amdgcn_s_sleep(2); }
            __builtin_amdgcn_fence(__ATOMIC_ACQUIRE, "agent");
            asm volatile("s_waitcnt vmcnt(0)" ::: "memory");
        }
#if !defined(BROKEN_HOOK_NO_BARRIER)
        asm volatile("" ::: "memory"); __builtin_amdgcn_s_barrier(); asm volatile("" ::: "memory");
#endif
    }
};

__device__ __forceinline__ unsigned cvt_pk_bf16(float lo, float hi) { unsigned r; asm volatile("v_cvt_pk_bf16_f32 %0, %1, %2" : "=v"(r) : "v"(lo), "v"(hi)); return r; }
typedef float f32x2 __attribute__((ext_vector_type(2)));
__device__ __forceinline__ f32x2 gelu_pk(f32x2 v) {
    const f32x2 av = __builtin_elementwise_abs(v), d = av * 0.2316418882f + 1.0f;
    f32x2 t; t.x = __builtin_amdgcn_rcpf(d.x); t.y = __builtin_amdgcn_rcpf(d.y);
    f32x2 q = t * 0.5307027145f + (-0.7265760135f); q = q * t + 0.7107068705f; q = q * t + (-0.142248368f); q = q * t + 0.127414796f; q = q * t;
    const f32x2 s = (v * v) * (-0.72134752044f);
    f32x2 e; e.x = __builtin_amdgcn_exp2f(s.x); e.y = __builtin_amdgcn_exp2f(s.y);
    const f32x2 m = v * (q * e), r = v - m;
    f32x2 o; o.x = v.x < 0.f ? m.x : r.x; o.y = v.y < 0.f ? m.y : r.y; return o;
}

struct EpiF32 {
    static constexpr bool PERM = false, AFTER_DRAIN = false;
    float* C; int ldc; const float* bias;
    __device__ __forceinline__ void operator()(const f32x4 (&acc)[2][2][4][2], const Unit& u, int wr, int wc, int fr, int fq) const {
        const int row0 = u.pm * BM + wr * 64 + fr, col0 = u.pn * BM + wc * 32 + 4 * fq;
        f32x4 bv[2][2];
#pragma unroll
        for (int bj = 0; bj < 2; ++bj)
#pragma unroll
            for (int n = 0; n < 2; ++n) bv[bj][n] = bias ? *(const f32x4*)(bias + col0 + bj * HALF + n * 16) : (f32x4){0.f, 0.f, 0.f, 0.f};
#pragma unroll
        for (int ai = 0; ai < 2; ++ai)
#pragma unroll
            for (int m = 0; m < 4; ++m) { float* rowp = C + (size_t)(row0 + ai * HALF + m * 16) * ldc + col0;
#pragma unroll
                for (int bj = 0; bj < 2; ++bj)
#pragma unroll
                    for (int n = 0; n < 2; ++n) *(f32x4*)(rowp + bj * HALF + n * 16) = acc[ai][bj][m][n] + bv[bj][n]; }
    }
};
template <int ACT  > struct EpiBf16 {
    static constexpr bool PERM = true, AFTER_DRAIN = false;
    bf16_t* O; int ldc; const float* bias; int split_cols; size_t split_stride;
    __device__ __forceinline__ void operator()(const f32x4 (&acc)[2][2][4][2], const Unit& u, int wr, int wc, int fr, int fq) const {
        const int row0 = u.pm * BM + wr * 64 + fr; int colt = u.pn * BM; bf16_t* base = O;
        if (split_cols) { const int t = colt / split_cols; base += (size_t)t * split_stride; colt -= t * split_cols; }
        const int col0 = colt + wc * 32 + 8 * fq, bcol0 = u.pn * BM + wc * 32 + 8 * fq;
        f32x4 bv[2][2];
#pragma unroll
        for (int bj = 0; bj < 2; ++bj)
#pragma unroll
            for (int n = 0; n < 2; ++n) bv[bj][n] = bias ? *(const f32x4*)(bias + bcol0 + bj * HALF + 4 * n) : (f32x4){0.f, 0.f, 0.f, 0.f};
#pragma unroll
        for (int ai = 0; ai < 2; ++ai)
#pragma unroll
            for (int m = 0; m < 4; ++m) { bf16_t* rowp = base + (size_t)(row0 + ai * HALF + m * 16) * ldc + col0;
#pragma unroll
                for (int bj = 0; bj < 2; ++bj) { f32x4 v0 = acc[ai][bj][m][0] + bv[bj][0], v1 = acc[ai][bj][m][1] + bv[bj][1];
                    if (ACT == 1) { f32x2 a = gelu_pk((f32x2){v0[0], v0[1]}), b = gelu_pk((f32x2){v0[2], v0[3]}), c = gelu_pk((f32x2){v1[0], v1[1]}), d = gelu_pk((f32x2){v1[2], v1[3]});
                        v0 = (f32x4){a.x, a.y, b.x, b.y}; v1 = (f32x4){c.x, c.y, d.x, d.y}; }
                    if (ACT == 2) {
#pragma unroll
                        for (int j = 0; j < 4; ++j) { v0[j] = 0.5f * v0[j] * (1.0f + erff(v0[j] * 0.70710678f)); v1[j] = 0.5f * v1[j] * (1.0f + erff(v1[j] * 0.70710678f)); } }
                    u32x4 w; w.x = cvt_pk_bf16(v0[0], v0[1]); w.y = cvt_pk_bf16(v0[2], v0[3]); w.z = cvt_pk_bf16(v1[0], v1[1]); w.w = cvt_pk_bf16(v1[2], v1[3]);
                    *(u32x4*)(rowp + bj * HALF) = w; } }
    }
};

template <class Epi, class Sched, bool STAMP = false>
__device__ __forceinline__ void gemm_phase(PG8_LAS unsigned char* lds, const Gemm g, const Sched& S, const Epi& E, unsigned long long* stamps) {
    int tid_ = TIDX; asm volatile("" : "+v"(tid_));
    const int tid = tid_, wid = __builtin_amdgcn_readfirstlane(tid >> 6), lane = tid & 63, wr = wid >> 2, wc = wid & 3, fr = lane & 15, fq = lane >> 4;
    const int K = g.ld, nt = g.K / BK;
    int ts_lo = 0, ts_hi = 0, nts = 0; const unsigned long long rt_entry = STAMP ? (unsigned long long)wall_clock64() : 0ull;
#define PG8_STAMP() do { if (STAMP && wid == 0 && nts < 64) { const unsigned long long _c = (unsigned long long)clock64(); \
        ts_lo = (lane == nts) ? (int)(unsigned)_c : ts_lo; ts_hi = (lane == nts) ? (int)(unsigned)(_c >> 32) : ts_hi; ++nts; } } while (0)
    PG8_STAMP();
    unsigned voffA[2], voffB[2];
#pragma unroll
    for (int i = 0; i < 2; ++i) { int R, C; stage_rc(tid * 16 + i * 8192, R, C); const int Rb = Epi::PERM ? ((R & ~31) + perm32(R & 31)) : R;
        voffA[i] = (unsigned)(R * K + C) * 2u; voffB[i] = (unsigned)(Rb * K + C) * 2u; }
    const size_t kstep = (size_t)(BK * 2);
    const size_t hstep = (size_t)HALF * K * 2;
    const size_t tstep = 2 * hstep;
    const unsigned ldsw = (unsigned)wid * 1024u;
    const int aoff = lds_byte(wr * 64 + fr, fq * 8), boff = lds_byte(wc * 32 + fr, fq * 8);
#define PG8_SA(b, h) (((b) * 2 + (h)) * HTB)
#define PG8_SB(b, h) ((4 + (b) * 2 + (h)) * HTB)
#define PG8_STAGE(bufoff, gbase, voff) do { _Pragma("unroll") for (int _i = 0; _i < 2; ++_i) \
        __builtin_amdgcn_global_load_lds((const unsigned*)((const char*)(gbase) + (voff)[_i]), (PG8_LAS unsigned*)(lds + (bufoff) + ldsw + _i * 8192), 16, 0, 0); } while (0)
#define PG8_LDA(dst, b, h) do { _Pragma("unroll") for (int m = 0; m < 4; ++m) _Pragma("unroll") for (int k = 0; k < 2; ++k) dst[m][k] = *(const PG8_LAS bf16x8*)(lds + PG8_SA(b, h) + aoff + m * 2048 + k * 1024); } while (0)
#define PG8_LDB(dst, b, h) do { _Pragma("unroll") for (int n = 0; n < 2; ++n) _Pragma("unroll") for (int k = 0; k < 2; ++k) dst[n][k] = *(const PG8_LAS bf16x8*)(lds + PG8_SB(b, h) + boff + n * 2048 + k * 1024); } while (0)
#define PG8_MMA(ai, bj, At, Bt) do { __builtin_amdgcn_s_setprio(1); _Pragma("unroll") for (int m = 0; m < 4; ++m) _Pragma("unroll") for (int n = 0; n < 2; ++n) _Pragma("unroll") for (int k = 0; k < 2; ++k) \
        acc[ai][bj][m][n] = __builtin_amdgcn_mfma_f32_16x16x32_bf16(Bt[n][k], At[m][k], acc[ai][bj][m][n], 0, 0, 0); __builtin_amdgcn_s_setprio(0); } while (0)
#define PG8_WAIT_V(n) asm volatile("s_waitcnt vmcnt(" #n ")" ::: "memory")
#define PG8_WAIT_L(n) asm volatile("s_waitcnt lgkmcnt(" #n ")" ::: "memory")
#define PG8_BAR __builtin_amdgcn_s_barrier()
#define PG8_SCHED __builtin_amdgcn_sched_barrier(0)
    Unit cur, nxt; int ui = 0;
    if (!S.next(0, cur)) return;
    f32x4 acc[2][2][4][2];
#pragma unroll
    for (int a = 0; a < 2; ++a)
#pragma unroll
        for (int b = 0; b < 2; ++b)
#pragma unroll
            for (int m = 0; m < 4; ++m)
#pragma unroll
                for (int n = 0; n < 2; ++n) acc[a][b][m][n] = (f32x4){0.f, 0.f, 0.f, 0.f};
    bf16x8 At[4][2], B0[2][2], B1[2][2];
    const char* cA = (const char*)g.A + (size_t)cur.pm * tstep; const char* cB = (const char*)g.Bt + (size_t)cur.pn * tstep;
    S.a_ready(cur);
    PG8_STAGE(PG8_SB(0, 0), cB, voffB); PG8_STAGE(PG8_SA(0, 0), cA, voffA); PG8_STAGE(PG8_SB(0, 1), cB + hstep, voffB); PG8_STAGE(PG8_SA(0, 1), cA + hstep, voffA);
    if (wr == 1) PG8_BAR;
    PG8_WAIT_V(4); PG8_BAR;
    PG8_STAGE(PG8_SB(1, 0), cB + kstep, voffB); PG8_STAGE(PG8_SA(1, 0), cA + kstep, voffA); PG8_STAGE(PG8_SB(1, 1), cB + hstep + kstep, voffB);
    PG8_WAIT_V(6); PG8_BAR;
    PG8_STAMP();
    for (;;) {
        const bool has_next = S.next(ui + 1, nxt);
        const char* nA = has_next ? (const char*)g.A + (size_t)nxt.pm * tstep : cA; const char* nB = has_next ? (const char*)g.Bt + (size_t)nxt.pn * tstep : cB;
        for (int t = 0; t < nt; t += 2) {
            const bool last = (t == nt - 2);
            const char* a1 = cA + (size_t)(t + 1) * kstep;
            const char* a2 = last ? nA : cA + (size_t)(t + 2) * kstep; const char* b2 = last ? nB : cB + (size_t)(t + 2) * kstep;
            const char* a3 = a2 + kstep; const char* b3 = b2 + kstep;
            if (last && has_next) S.a_ready(nxt);
            PG8_LDB(B0, 0, 0); PG8_SCHED; PG8_LDA(At, 0, 0); PG8_STAGE(PG8_SA(1, 1), a1 + hstep, voffA);
            PG8_WAIT_L(8); PG8_BAR; PG8_WAIT_L(0); PG8_MMA(0, 0, At, B0); PG8_BAR; PG8_SCHED;
            PG8_LDB(B1, 0, 1); PG8_STAGE(PG8_SB(0, 0), b2, voffB);
            PG8_BAR; PG8_WAIT_L(0); PG8_MMA(0, 1, At, B1); PG8_BAR;
            PG8_LDA(At, 0, 1); PG8_STAGE(PG8_SA(0, 0), a2, voffA);
            PG8_BAR; PG8_WAIT_L(0); PG8_MMA(1, 0, At, B0); PG8_BAR; PG8_SCHED;
            PG8_STAGE(PG8_SB(0, 1), b2 + hstep, voffB);
            PG8_WAIT_V(6); PG8_BAR; PG8_MMA(1, 1, At, B1); PG8_BAR;
            PG8_LDB(B0, 1, 0); PG8_SCHED; PG8_LDA(At, 1, 0); PG8_STAGE(PG8_SA(0, 1), a2 + hstep, voffA);
            PG8_WAIT_L(8); PG8_BAR; PG8_WAIT_L(0); PG8_MMA(0, 0, At, B0); PG8_BAR; PG8_SCHED;
            PG8_LDB(B1, 1, 1); PG8_STAGE(PG8_SB(1, 0), b3, voffB);
            PG8_BAR; PG8_WAIT_L(0); PG8_MMA(0, 1, At, B1); PG8_BAR;
            PG8_LDA(At, 1, 1); PG8_STAGE(PG8_SA(1, 0), a3, voffA);
            PG8_BAR; PG8_WAIT_L(0); PG8_MMA(1, 0, At, B0); PG8_BAR; PG8_SCHED;
            PG8_STAGE(PG8_SB(1, 1), b3 + hstep, voffB);
            PG8_WAIT_V(6); PG8_BAR; PG8_MMA(1, 1, At, B1); PG8_BAR;
        }
        PG8_STAMP();
        if constexpr (!Epi::AFTER_DRAIN) { E(acc, cur, wr, wc, fr, fq); S.done(cur); }
        PG8_STAMP();
        if (!has_next) break;
#pragma unroll
        for (int a = 0; a < 2; ++a)
#pragma unroll
            for (int b = 0; b < 2; ++b)
#pragma unroll
                for (int m = 0; m < 4; ++m)
#pragma unroll
                    for (int n = 0; n < 2; ++n) acc[a][b][m][n] = (f32x4){0.f, 0.f, 0.f, 0.f};
        cur = nxt; cA = nA; cB = nB; ++ui;
    }
    PG8_WAIT_V(0);
    if (wr == 0) PG8_BAR;
    PG8_BAR;
    if constexpr (Epi::AFTER_DRAIN) { E.fused(acc, cur, wr, wc, fr, fq, lds, wid, lane); S.done(cur); }
    PG8_STAMP();
    if (STAMP && wid == 0) { stamps[lane] = lane < nts ? (((unsigned long long)(unsigned)ts_hi << 32) | (unsigned)ts_lo) : 0ull;
        if (lane == 62) stamps[62] = rt_entry; if (lane == 63) stamps[63] = (unsigned long long)wall_clock64(); }
#undef PG8_STAMP
#undef PG8_SA
#undef PG8_SB
#undef PG8_STAGE
#undef PG8_LDA
#undef PG8_LDB
#undef PG8_MMA
#undef PG8_WAIT_V
#undef PG8_WAIT_L
#undef PG8_BAR
#undef PG8_SCHED
}
}
#define XB_TMO      128
#define XB_XCNT(j)  (256  + 64 * (j))
#define XB_XSUB(j)  (1280 + 64 * (j))
#define XB_XGEN(j)  (2304 + 64 * (j))
#define XB_TOP      3328
#define XB_TOPGEN   3392
#define XCD_BAR_WORDS 3456
#define XB_SPIN_CAP (1u << 22)
#define LAS __attribute__((address_space(3)))

__device__ __forceinline__ unsigned xb_ld(unsigned* p)              { return __hip_atomic_load(p, __ATOMIC_RELAXED, __HIP_MEMORY_SCOPE_AGENT); }
__device__ __forceinline__ unsigned xb_add(unsigned* p, unsigned v) { return __hip_atomic_fetch_add(p, v, __ATOMIC_RELAXED, __HIP_MEMORY_SCOPE_AGENT); }
__device__ __forceinline__ unsigned xb_xcc_id() { return (unsigned)__builtin_amdgcn_s_getreg((3 << 11) | 20) & 0xFu; }
#define XB_SPIN(cond, bar) do { unsigned _sp = 0; while (cond) { __builtin_amdgcn_s_sleep(1); \
    if ((++_sp & 255u) == 0u) { if (xb_ld(&(bar)[XB_TMO])) break; if (_sp > XB_SPIN_CAP) { atomicAdd(&(bar)[XB_TMO], 1u); break; } } } } while (0)

struct XcdBarrier {
    unsigned* bar; unsigned x;
    volatile LAS unsigned* st;
};

__device__ __forceinline__ XcdBarrier xcd_barrier_post(unsigned* bar, volatile LAS unsigned* st) {
    XcdBarrier b; b.bar = bar; b.x = xb_xcc_id(); b.st = st;
    if (TIDX == 0) (void)xb_add(&bar[XB_XCNT(b.x)], 1u);
    return b;
}
__device__ __forceinline__ void xcd_barrier_complete(unsigned* bar, unsigned x, unsigned& nloc, unsigned& nx) {
    const unsigned G = gridDim.x * gridDim.y * gridDim.z;
    unsigned sum, cnt, mine, sp = 0u;
    for (;;) {
        sum = 0u; cnt = 0u; mine = 0u;
#pragma unroll
        for (unsigned j = 0; j < 16; ++j) { const unsigned c = xb_ld(&bar[XB_XCNT(j)]); sum += c; cnt += (c > 0u) ? 1u : 0u; mine = (j == x) ? c : mine; }
        if (sum == G) break;
        __builtin_amdgcn_s_sleep(1);
        if ((++sp & 255u) == 0u) { if (xb_ld(&bar[XB_TMO])) break; if (sp > XB_SPIN_CAP) { atomicAdd(&bar[XB_TMO], 1u); break; } }
    }
    nloc = mine > 0u ? mine : 1u; nx = cnt > 0u ? cnt : 1u;
}

__device__ __forceinline__ void xcd_barrier(const XcdBarrier& b) {
    asm volatile("s_waitcnt vmcnt(0)" ::: "memory");
    __syncthreads();
    if (TIDX == 0) {
        unsigned* bar = b.bar;
        __builtin_amdgcn_s_waitcnt(0);
        unsigned nloc = b.st[0], nx = b.st[1];
        if (nloc == 0u) { xcd_barrier_complete(bar, b.x, nloc, nx); b.st[0] = nloc; b.st[1] = nx; }
        const unsigned old = xb_add(&bar[XB_XSUB(b.x)], 1u);
        const unsigned gen = old / nloc;
        if (old + 1u == (gen + 1u) * nloc) {
            __builtin_amdgcn_fence(__ATOMIC_RELEASE, "agent");
            asm volatile("s_waitcnt vmcnt(0)" ::: "memory");
            const unsigned og = xb_add(&bar[XB_TOP], 1u);
            const unsigned tg = og / nx;
            if (og + 1u == (tg + 1u) * nx) xb_add(&bar[XB_TOPGEN], 1u);
            else XB_SPIN(xb_ld(&bar[XB_TOPGEN]) == tg, bar);
            __builtin_amdgcn_fence(__ATOMIC_ACQUIRE, "agent");
            xb_add(&bar[XB_XGEN(b.x)], 1u);
            asm volatile("s_waitcnt vmcnt(0)" ::: "memory");
        } else {
            XB_SPIN(xb_ld(&bar[XB_XGEN(b.x)]) == gen, bar);
            __builtin_amdgcn_fence(__ATOMIC_ACQUIRE, "agent");
            asm volatile("s_waitcnt vmcnt(0)" ::: "memory");
        }
    }
    __syncthreads();
}
namespace att {
constexpr int DQK = QKD, DV_ = VD, NW = 8, QBLK = 32, KVBLK = 64;
static_assert(DQK == 192 && DV_ == 128 && NOPE == 128 && ROPE == 64, "attention body is written for 128 + 64 / 128");
constexpr float SCALE = 0.07216878364870322f;
constexpr float THR = 8.f;
constexpr int SDEPTH = ATT_SDEPTH;
constexpr int NQREG = ATT_NQREG, NQLDS = DQK / 16 - NQREG;
static_assert(NQREG <= NOPE / 16 && NQREG >= 0, "rope fragments live in LDS");
constexpr int KPITCH = DQK * 2;
constexpr size_t SHM_V = KVBLK * DV_ * 2, SHM_K = KVBLK * KPITCH, SHM_QR = 2 * SHM_V + 2 * SHM_K + NW * 64 * 4, SHM_ATTN = SHM_QR + NW * (DQK / 16 - ATT_NQREG) * 1024;
using bf16x8 = __attribute__((ext_vector_type(8))) short;
using s16x4  = __attribute__((ext_vector_type(4))) short;
using f32x16 = __attribute__((ext_vector_type(16))) float;
using u32x4  = __attribute__((ext_vector_type(4))) unsigned;
#define KSWZ(row, colB) ((row) * att::KPITCH + ((colB) ^ (((row) & 7) << 4)))
#define SBAR() __builtin_amdgcn_sched_barrier(0)
__device__ __forceinline__ int crow(int r, int hi) { return (r & 3) + 8 * (r >> 2) + 4 * hi; }
__device__ __forceinline__ unsigned cvtpk(float lo, float hi) { unsigned r; asm volatile("v_cvt_pk_bf16_f32 %0, %1, %2" : "=v"(r) : "v"(lo), "v"(hi)); return r; }

__device__ __forceinline__ void partialSM(f32x16& p0, f32x16& p1, float& m_reg, float& mn, float& alpha) {
  constexpr float C = SCALE * 1.4426950408889634f;
  float pmax = p0[0];
#pragma unroll
  for (int r = 1; r < 16; ++r) pmax = fmaxf(pmax, p0[r]);
#pragma unroll
  for (int r = 0; r < 16; ++r) pmax = fmaxf(pmax, p1[r]);
  { auto rr = __builtin_amdgcn_permlane32_swap(__float_as_uint(pmax), __float_as_uint(pmax), false, false);
    pmax = fmaxf(__uint_as_float(rr[0]), __uint_as_float(rr[1])); }
  if (__builtin_expect(__all(pmax - m_reg <= THR / SCALE), 1)) { mn = m_reg; alpha = 1.f; }
  else { mn = fmaxf(m_reg, pmax); alpha = __builtin_amdgcn_exp2f((m_reg - mn) * C); m_reg = mn; }
  float mnC = -mn * C;
#pragma unroll
  for (int r = 0; r < 16; ++r) p0[r] = fmaf(p0[r], C, mnC);
#pragma unroll
  for (int r = 0; r < 16; ++r) p1[r] = fmaf(p1[r], C, mnC);
#pragma unroll
  for (int r = 0; r < 16; ++r) p0[r] = __builtin_amdgcn_exp2f(p0[r]);
}
__device__ __forceinline__ void finishSM(f32x16& p0, f32x16& p1, float alpha, float& l_reg, bf16x8& pa0, bf16x8& pa1, bf16x8& pa2, bf16x8& pa3) {
#pragma unroll
  for (int r = 0; r < 16; ++r) p1[r] = __builtin_amdgcn_exp2f(p1[r]);
  float ps = 0;
#pragma unroll
  for (int r = 0; r < 16; ++r) ps += p0[r];
#pragma unroll
  for (int r = 0; r < 16; ++r) ps += p1[r];
  { auto rr = __builtin_amdgcn_permlane32_swap(__float_as_uint(ps), __float_as_uint(ps), false, false);
    ps = __uint_as_float(rr[0]) + __uint_as_float(rr[1]); }
  l_reg = l_reg * alpha + ps;
#define PK4(P, BASE, OUT) do { unsigned a0 = cvtpk(P[BASE + 0], P[BASE + 1]), a1 = cvtpk(P[BASE + 2], P[BASE + 3]);   \
    unsigned b0 = cvtpk(P[BASE + 4], P[BASE + 5]), b1 = cvtpk(P[BASE + 6], P[BASE + 7]);                              \
    auto r0 = __builtin_amdgcn_permlane32_swap(a0, b0, false, false); auto r1 = __builtin_amdgcn_permlane32_swap(a1, b1, false, false); \
    u32x4 w = {r0[0], r1[0], r0[1], r1[1]}; OUT = *reinterpret_cast<bf16x8*>(&w); } while (0)
  PK4(p0, 0, pa0); PK4(p0, 8, pa1); PK4(p1, 0, pa2); PK4(p1, 8, pa3);
#undef PK4
}
__device__ __forceinline__ void qkt(f32x16& p0, f32x16& p1, const char* Ks, const bf16x8* qr, const char* qx, int r32, int hi) {
  p0 = f32x16{}; p1 = f32x16{};
#pragma unroll
  for (int d0 = 0; d0 < DQK / 16; ++d0) { int cb = (d0 * 16 + hi * 8) * 2;
    bf16x8 b0 = *reinterpret_cast<const bf16x8*>(Ks + KSWZ(r32, cb));
    bf16x8 b1 = *reinterpret_cast<const bf16x8*>(Ks + KSWZ(32 + r32, cb));
    const bf16x8 q = d0 < NQREG ? qr[d0 < NQREG ? d0 : 0] : *reinterpret_cast<const bf16x8*>(qx + (d0 - NQREG) * 1024);
    p0 = __builtin_amdgcn_mfma_f32_32x32x16_bf16(b0, q, p0, 0, 0, 0);
    p1 = __builtin_amdgcn_mfma_f32_32x32x16_bf16(b1, q, p1, 0, 0, 0); }
}
__device__ __forceinline__ int v_st(int k, int c) { const int kk = (k & ~0xC) | ((k & 4) << 1) | ((k & 8) >> 1); return ((kk >> 3) * 4 + (c >> 5)) * 512 + ((kk & 7) * 32 + (c & 31)) * 2; }
__device__ __forceinline__ int v_rd_base(int lane) { return ((lane & 3) << 3) | (((lane >> 2) & 3) << 6) | (((lane >> 4) & 1) << 5) | (((lane >> 5) & 1) << 8); }
constexpr int v_rd_off(int d0, int ks, int half) { return d0 * 512 + ks * 4096 + half * 2048; }
template <int OFF> __device__ __forceinline__ s16x4 tr_read(int vb) {
  s16x4 r; asm volatile("ds_read_b64_tr_b16 %0, %1 offset:%2" : "=&v"(r) : "v"(vb), "i"(OFF) : "memory"); return r;
}
template <int D0> __device__ __forceinline__ void pv_one(f32x16& od, int vb, bf16x8 pa0, bf16x8 pa1, bf16x8 pa2, bf16x8 pa3) {
  const s16x4 l0 = tr_read<v_rd_off(D0, 0, 0)>(vb), h0 = tr_read<v_rd_off(D0, 0, 1)>(vb), l1 = tr_read<v_rd_off(D0, 1, 0)>(vb), h1 = tr_read<v_rd_off(D0, 1, 1)>(vb);
  const s16x4 l2 = tr_read<v_rd_off(D0, 2, 0)>(vb), h2 = tr_read<v_rd_off(D0, 2, 1)>(vb), l3 = tr_read<v_rd_off(D0, 3, 0)>(vb), h3 = tr_read<v_rd_off(D0, 3, 1)>(vb);
  asm volatile("s_waitcnt lgkmcnt(0)" ::: "memory"); SBAR();
#define PK(L, H) (bf16x8){L[0], L[1], L[2], L[3], H[0], H[1], H[2], H[3]}
  od = __builtin_amdgcn_mfma_f32_32x32x16_bf16(pa0, PK(l0, h0), od, 0, 0, 0);
  od = __builtin_amdgcn_mfma_f32_32x32x16_bf16(pa1, PK(l1, h1), od, 0, 0, 0);
  od = __builtin_amdgcn_mfma_f32_32x32x16_bf16(pa2, PK(l2, h2), od, 0, 0, 0);
  od = __builtin_amdgcn_mfma_f32_32x32x16_bf16(pa3, PK(l3, h3), od, 0, 0, 0);
#undef PK
}
__device__ __forceinline__ void pv_d0(f32x16* o, int vb, bf16x8 pa0, bf16x8 pa1, bf16x8 pa2, bf16x8 pa3) {
  pv_one<0>(o[0], vb, pa0, pa1, pa2, pa3); pv_one<1>(o[1], vb, pa0, pa1, pa2, pa3); pv_one<2>(o[2], vb, pa0, pa1, pa2, pa3); pv_one<3>(o[3], vb, pa0, pa1, pa2, pa3);
}

__device__ __forceinline__ void attn_mla_body(const act_t* __restrict__ Qb, const float2* __restrict__ ropetab, const act_t* __restrict__ Kn, const act_t* __restrict__ Kp,
                                              const act_t* __restrict__ Vh, act_t* __restrict__ Ob, int r0, int nt0, int r1, int NT, char* lds) {
  int tid_ = TIDX; asm volatile("" : "+v"(tid_));
  const int tid = tid_, wid = tid >> 6, lane = tid & 63, r32 = lane & 31, hi = lane >> 5;
  char* V_lds = lds; char* K_lds = lds + 2 * SHM_V;
  float* ws = (float*)(lds + 2 * SHM_V + 2 * SHM_K) + wid * 64; float* li_l = ws; float* al_l = ws + 32;
  float m_reg = -1e30f, l_reg = 0; f32x16 o[4] = {}; bf16x8 qr[NQREG > 0 ? NQREG : 1];
  const act_t* Qw = Qb + (long)(wid * QBLK + r32) * NQ + hi * 8;
  char* qx = lds + SHM_QR + wid * (NQLDS * 1024) + lane * 16;
#pragma unroll
  for (int d0 = 0; d0 < NQREG; ++d0) qr[d0] = *reinterpret_cast<const bf16x8*>(Qw + d0 * 16);
  {
    u32x4 qt[DQK / 16 - NQREG];
#pragma unroll
    for (int d0 = NQREG; d0 < DQK / 16; ++d0) qt[d0 - NQREG] = *reinterpret_cast<const u32x4*>(Qw + d0 * 16);
    const float2* rt = (ropetab ? ropetab : reinterpret_cast<const float2*>(Qb)) + (long)(wid * QBLK + r32) * (ROPE / 2);
    float4 cs4[ROPE / 16][2];
#pragma unroll
    for (int d = 0; d < ROPE / 16; ++d) { cs4[d][0] = *reinterpret_cast<const float4*>(__builtin_assume_aligned(rt + d * 8 + hi * 4, 16)); cs4[d][1] = *reinterpret_cast<const float4*>(__builtin_assume_aligned(rt + d * 8 + hi * 4 + 2, 16)); }
    __builtin_amdgcn_sched_barrier(0);
#pragma unroll
    for (int d = 0; d < ROPE / 16; ++d) {
      asm volatile("" : "+v"(cs4[d][0].x), "+v"(cs4[d][0].y), "+v"(cs4[d][0].z), "+v"(cs4[d][0].w), "+v"(cs4[d][1].x), "+v"(cs4[d][1].y), "+v"(cs4[d][1].z), "+v"(cs4[d][1].w)); }
#pragma unroll
    for (int d0 = NQREG; d0 < NOPE / 16; ++d0) *reinterpret_cast<u32x4*>(qx + (d0 - NQREG) * 1024) = qt[d0 - NQREG];
#pragma unroll
    for (int d0 = NOPE / 16; d0 < DQK / 16; ++d0) {
      u32x4 w = qt[d0 - NQREG];
      {
        const int d = d0 - NOPE / 16; const bool rot = ropetab != nullptr;
        const float2 cs[4] = {make_float2(cs4[d][0].x, cs4[d][0].y), make_float2(cs4[d][0].z, cs4[d][0].w), make_float2(cs4[d][1].x, cs4[d][1].y), make_float2(cs4[d][1].z, cs4[d][1].w)};
#pragma unroll
        for (int j = 0; j < 4; ++j) {
          const float c = rot ? cs[j].x : 1.0f, s = rot ? cs[j].y : 0.0f;
          const float xe = __uint_as_float(w[j] << 16), xo = __uint_as_float(w[j] & 0xffff0000u);
          w[j] = cvtpk(xe * c - xo * s, xe * s + xo * c);
        }
      }
      *reinterpret_cast<u32x4*>(qx + (d0 - NQREG) * 1024) = w;
    }
    asm volatile("s_waitcnt lgkmcnt(0)" ::: "memory");
  }
  const int sr = tid >> 4, sc = (tid & 15) * 8, vst0 = v_st(sr, sc);
  const int pr = tid >> 3, pc = (tid & 7) * 8;
  const int vb0 = (int)(uintptr_t)V_lds + v_rd_base(lane);
  struct { bf16x8 vs0, vs1, ks0, ks1, kp; } sr_[SDEPTH];
#define KROW(j) __builtin_amdgcn_readfirstlane((j) < nt0 ? r0 + (j) * KVBLK : r1 + ((j) - nt0) * KVBLK)
  const unsigned ov0 = sr * NKV + sc, opp = pr * ROPE + pc; const int kst0 = KSWZ(sr, sc * 2), kstp = KSWZ(pr, (NOPE + pc) * 2);
#define SLOAD(i, j) do { const int kr_ = KROW(j); const act_t* vt_ = Vh + (size_t)kr_ * NKV; const act_t* kt_ = Kn + (size_t)kr_ * NKV; const act_t* pt_ = Kp + (size_t)kr_ * ROPE; \
    sr_[i].vs0 = *reinterpret_cast<const bf16x8*>(vt_ + ov0); sr_[i].vs1 = *reinterpret_cast<const bf16x8*>(vt_ + 32 * NKV + ov0); \
    sr_[i].ks0 = *reinterpret_cast<const bf16x8*>(kt_ + ov0); sr_[i].ks1 = *reinterpret_cast<const bf16x8*>(kt_ + 32 * NKV + ov0); \
    sr_[i].kp = *reinterpret_cast<const bf16x8*>(pt_ + opp); } while (0)
#define SWRITE(b, i) do { *(bf16x8*)(V_lds + (b) * SHM_V + vst0) = sr_[i].vs0; *(bf16x8*)(V_lds + (b) * SHM_V + 8192 + vst0) = sr_[i].vs1; \
    *(bf16x8*)(K_lds + (b) * SHM_K + kst0) = sr_[i].ks0; *(bf16x8*)(K_lds + (b) * SHM_K + 32 * KPITCH + kst0) = sr_[i].ks1; \
    *(bf16x8*)(K_lds + (b) * SHM_K + kstp) = sr_[i].kp; } while (0)
#define SWAIT() do { if constexpr (SDEPTH == 2) asm volatile("s_waitcnt vmcnt(5)" ::: "memory"); else asm volatile("s_waitcnt vmcnt(0)" ::: "memory"); } while (0)
#define RESC(a) do { if (__any((a) < 1.f)) { if (hi == 0) al_l[r32] = (a); asm volatile("s_waitcnt lgkmcnt(0)" ::: "memory"); \
    _Pragma("unroll") for (int d = 0; d < 4; ++d) _Pragma("unroll") for (int r = 0; r < 16; ++r) o[d][r] *= al_l[crow(r, hi)]; } } while (0)
  f32x16 pA0, pA1, pB0, pB1; float mnA, mnB, alA, alB; bf16x8 pa0, pa1, pa2, pa3;
  constexpr int SE = 0, SO = SDEPTH - 1;
  SLOAD(SE, 0); asm volatile("s_waitcnt vmcnt(0)" ::: "memory"); SWRITE(0, SE); __syncthreads();
  qkt(pA0, pA1, K_lds, qr, qx, r32, hi); partialSM(pA0, pA1, m_reg, mnA, alA);
  SLOAD(SO, 1); if constexpr (SDEPTH == 2) { if (2 < NT) SLOAD(SE, 2); }
  SWAIT(); SWRITE(1, SO); __syncthreads();
  for (int j = 1; j + 1 < NT; j += 2) {
    SBAR(); qkt(pB0, pB1, K_lds + SHM_K, qr, qx, r32, hi);
    finishSM(pA0, pA1, alA, l_reg, pa0, pa1, pa2, pa3); SBAR();
    SLOAD(SO, j + SDEPTH); SBAR();
    pv_d0(o, vb0, pa0, pa1, pa2, pa3); partialSM(pB0, pB1, m_reg, mnB, alB);
    __syncthreads(); SWAIT(); SWRITE(0, SE);
    RESC(alB); __syncthreads();
    SBAR(); qkt(pA0, pA1, K_lds, qr, qx, r32, hi);
    finishSM(pB0, pB1, alB, l_reg, pa0, pa1, pa2, pa3); SBAR();
    if (SDEPTH == 1 || j + 3 < NT) SLOAD(SE, j + 1 + SDEPTH); SBAR();
    pv_d0(o, vb0 + (int)SHM_V, pa0, pa1, pa2, pa3); partialSM(pA0, pA1, m_reg, mnA, alA);
    __syncthreads(); SWAIT(); SWRITE(1, SO);
    RESC(alA); __syncthreads();
  }
  SBAR(); qkt(pB0, pB1, K_lds + SHM_K, qr, qx, r32, hi);
  finishSM(pA0, pA1, alA, l_reg, pa0, pa1, pa2, pa3); SBAR();
  pv_d0(o, vb0, pa0, pa1, pa2, pa3); partialSM(pB0, pB1, m_reg, mnB, alB);
  __syncthreads(); RESC(alB);
  finishSM(pB0, pB1, alB, l_reg, pa0, pa1, pa2, pa3); SBAR();
  pv_d0(o, vb0 + (int)SHM_V, pa0, pa1, pa2, pa3);
  if (hi == 0) li_l[r32] = l_reg; asm volatile("s_waitcnt lgkmcnt(0)" ::: "memory");
  float rli[16];
#pragma unroll
  for (int r = 0; r < 16; ++r) rli[r] = __builtin_amdgcn_rcpf(li_l[crow(r, hi)]);
  act_t* Ow = Ob + (long)(wid * QBLK) * MIXW;
#pragma unroll
  for (int r = 0; r < 16; ++r) { int orow = crow(r, hi);
#pragma unroll
    for (int d0 = 0; d0 < 4; ++d0) Ow[(long)orow * MIXW + d0 * 32 + r32] = f2a(o[d0][r] * rli[r]); }
#undef KROW
#undef SLOAD
#undef SWRITE
#undef SWAIT
#undef RESC
}
}

constexpr int AT_QB_LAT = DSEQ / 256, AT_NU_LAT = NDB * BH * AT_QB_LAT, AT_NU_CTX = NB * BH * (SEQ / 256);
__device__ __forceinline__ void attn_unit(const P& p, int u, char* lds) {
    const act_t* qf = (const act_t*)(p.ws + WS_QF); const act_t* kvup = (const act_t*)(p.ws + WS_KVUP); const act_t* kr = (const act_t*)(p.ws + WS_KR);
    act_t* ymix = (act_t*)(p.ws + WS_YMIX); const float2* ropetab = (const float2*)(p.ws + WS_ROPE);
    int s, h, qb;
    if (u < AT_NU_LAT) { qb = u % AT_QB_LAT; h = (u / AT_QB_LAT) % BH; s = NB + u / (AT_QB_LAT * BH); }
    else { const int v = u - AT_NU_LAT; qb = 0; h = v % BH; s = v / BH; }
    const int base = seq_start(s), T = seq_len(s), m0 = base + qb * 256;
    const bool lat = s >= NB;
    att::attn_mla_body(qf + (size_t)m0 * NQ + h * QKD, lat ? ropetab + (size_t)(qb * 256) * (ROPE / 2) : nullptr, kvup + h * NOPE, kr, kvup + BH * NOPE + h * VD,
                       ymix + (size_t)m0 * MIXW + AW + h * VD, base, T / 64, lat ? MTOK + (s - NB) * PAST : 0, (T + (lat ? PAST : 0)) / 64, lds);
    __syncthreads();
}
namespace gdnc {
using bf16x8 = __attribute__((ext_vector_type(8))) short;
using f32x16 = __attribute__((ext_vector_type(16))) float;
using f32x4v = __attribute__((ext_vector_type(4))) float;
using u32x4 = __attribute__((ext_vector_type(4))) unsigned;
__device__ __forceinline__ uint4 ldnt16(const uint4* p) { const u32x4 v = __builtin_nontemporal_load((const u32x4*)p); return make_uint4(v[0], v[1], v[2], v[3]); }
typedef float f32x2c __attribute__((ext_vector_type(2)));
typedef __bf16 bf16x2c __attribute__((ext_vector_type(2)));
__device__ __forceinline__ unsigned cvtpk_c(float lo, float hi) { f32x2c v = {lo, hi}; bf16x2c b = __builtin_convertvector(v, bf16x2c); return __builtin_bit_cast(unsigned, b); }
__device__ __forceinline__ int swap23(int x) { return (x & ~12) | ((x & 4) << 1) | ((x & 8) >> 1); }
__device__ __forceinline__ int crow(int r, int hi) { return (r & 3) + 8 * (r >> 2) + 4 * hi; }

__device__ __forceinline__ int npos(int i) { return 16 * (i & 3) + (i >> 2); }
template <int QP> __device__ __forceinline__ float quad_bcast(float v) { return __int_as_float(__builtin_amdgcn_update_dpp(0, __float_as_int(v), QP, 0xf, 0xf, true)); }
__device__ __forceinline__ void solve_quad(const float* Nt, int ntp, float (&x)[16], int q) {
    const float* nrow = Nt + 16 * q;
    int zo = 0;
#pragma unroll
    for (int j = 0; j < 63; ++j) {
        const float xo = x[j >> 2];
        const float xj = (j & 3) == 0 ? quad_bcast<0x00>(xo) : (j & 3) == 1 ? quad_bcast<0x55>(xo) : (j & 3) == 2 ? quad_bcast<0xAA>(xo) : quad_bcast<0xFF>(xo);
        const f32x2c xj2 = {-xj, -xj};
#pragma unroll
        for (int i4 = j >> 4; i4 < 4; ++i4) {
            const f32x4v n4 = *(const f32x4v*)(nrow + j * ntp + 4 * i4 + zo);
            if (4 * i4 + 1 >= (j >> 2)) { f32x2c a = {x[4 * i4], x[4 * i4 + 1]}; a = __builtin_elementwise_fma((f32x2c){n4[0], n4[1]}, xj2, a); x[4 * i4] = a[0]; x[4 * i4 + 1] = a[1]; }
            { f32x2c b = {x[4 * i4 + 2], x[4 * i4 + 3]}; b = __builtin_elementwise_fma((f32x2c){n4[2], n4[3]}, xj2, b); x[4 * i4 + 2] = b[0]; x[4 * i4 + 3] = b[1]; }
        }
        if ((j & 1) == 1) asm volatile("" : "+v"(zo) : "v"(xj));
    }
}
__device__ __forceinline__ void solve_quad2(const float* Nt, int ntp, float (&xa)[16], float (&xb)[16], int q) {
    const float* nrow = Nt + 16 * q;
    int zo = 0;
#pragma unroll
    for (int j = 0; j < 63; ++j) {
        const float ao = xa[j >> 2], bo = xb[j >> 2];
        const float aj = (j & 3) == 0 ? quad_bcast<0x00>(ao) : (j & 3) == 1 ? quad_bcast<0x55>(ao) : (j & 3) == 2 ? quad_bcast<0xAA>(ao) : quad_bcast<0xFF>(ao);
        const float bj = (j & 3) == 0 ? quad_bcast<0x00>(bo) : (j & 3) == 1 ? quad_bcast<0x55>(bo) : (j & 3) == 2 ? quad_bcast<0xAA>(bo) : quad_bcast<0xFF>(bo);
        const f32x2c aj2 = {-aj, -aj}, bj2 = {-bj, -bj};
#pragma unroll
        for (int i4 = j >> 4; i4 < 4; ++i4) {
            const f32x4v n4 = *(const f32x4v*)(nrow + j * ntp + 4 * i4 + zo);
            const f32x2c nlo = {n4[0], n4[1]}, nhi = {n4[2], n4[3]};
            if (4 * i4 + 1 >= (j >> 2)) {
                f32x2c a = {xa[4 * i4], xa[4 * i4 + 1]}; a = __builtin_elementwise_fma(nlo, aj2, a); xa[4 * i4] = a[0]; xa[4 * i4 + 1] = a[1];
                f32x2c b = {xb[4 * i4], xb[4 * i4 + 1]}; b = __builtin_elementwise_fma(nlo, bj2, b); xb[4 * i4] = b[0]; xb[4 * i4 + 1] = b[1];
            }
            { f32x2c a = {xa[4 * i4 + 2], xa[4 * i4 + 3]}; a = __builtin_elementwise_fma(nhi, aj2, a); xa[4 * i4 + 2] = a[0]; xa[4 * i4 + 3] = a[1];
              f32x2c b = {xb[4 * i4 + 2], xb[4 * i4 + 3]}; b = __builtin_elementwise_fma(nhi, bj2, b); xb[4 * i4 + 2] = b[0]; xb[4 * i4 + 3] = b[1]; }
        }
        if ((j & 7) == 7) asm volatile("" : "+v"(zo) : "v"(aj), "v"(bj));
    }
}
template <int CTRL> __device__ __forceinline__ float gdpp(float x) { return __int_as_float(__builtin_amdgcn_update_dpp(0, __float_as_int(x), CTRL, 0xf, 0xf, true)); }
__device__ __forceinline__ float psum32(float x) {
    x += gdpp<0xB1>(x); x += gdpp<0x4E>(x); x += gdpp<0x124>(x); x += gdpp<0x128>(x);
    return x + __int_as_float(__builtin_amdgcn_ds_swizzle(__float_as_int(x), (16 << 10) | 0x1f));
}
constexpr int SL_W = 0, SL_U = 16384, SL_QD = 32768, SL_KDT = 49152, SL_QK = 65536, SL_GT = 73728, SLOT_B = 73984;
constexpr int NSLOT = (MTOK / 64) * 2 * CH;
static_assert(DK == 128 && DV == 128 && CHUNK == 64, "gdnc layout");

constexpr int PA_KP = 132, PA_NP = 68;
constexpr int PA_N = 0, PA_GAM = PA_N + 64 * PA_NP, PA_BET = PA_GAM + 64, PA_EG = PA_BET + 64, PA_EGL = PA_EG + 64, PA_ONE = PA_EGL + 64, PA_K = PA_ONE + 128, PA_Q = PA_K + 64 * PA_KP, PA_V = PA_Q + 64 * PA_KP, PA_END = PA_V + 64 * PA_KP;
constexpr int PA_LDS = PA_END * 4;
__device__ __forceinline__ void prep_chunk(const P& p, int l, int slot, char* lds) {
    int tid_ = TIDX; asm volatile("" : "+v"(tid_));
    const int tid = tid_, lane = tid & 63, wv = __builtin_amdgcn_readfirstlane(tid >> 6);
    const int h = slot % CH, d = (slot / CH) % 2, m0 = (slot / (2 * CH)) * 64;
    const act_t* pp = (const act_t*)(p.ws + WS_PP);
    unsigned char* out = p.ws + WS_GCH + (size_t)slot * SLOT_B;
    float* F = (float*)lds;
    __syncthreads();
    {
        const float* wc = p.gdn_conv + (size_t)l * 3 * GC;
        const int sq = seq_of(m0), sbase = seq_start(sq), send = sbase + seq_len(sq);
        const int f = tid & 31, i0 = tid >> 5;
        uint2 xr[12][3]; float4 wt[3][3];
#pragma unroll
        for (int arr = 0; arr < 3; ++arr) { const int ch = (arr == 0 ? CH * DK : arr == 1 ? 0 : 2 * CH * DK) + h * DK + 4 * f;
#pragma unroll
            for (int tap = 0; tap < 3; ++tap) wt[arr][tap] = *(const float4*)(wc + tap * GC + ch); }
#pragma unroll
        for (int j = 0; j < 12; ++j) {
            const int arr = j >> 2, i = i0 + 16 * (j & 3);
            const int m = d == 0 ? m0 + i : m0 + 63 - i;
            const int ch = (arr == 0 ? CH * DK : arr == 1 ? 0 : 2 * CH * DK) + h * DK + 4 * f;
            const act_t* pr = pp + (size_t)m * INP + OFF_GQ + ch;
            xr[j][1] = *(const uint2*)pr; xr[j][0] = *(const uint2*)(pr - (m > sbase ? INP : 0)); xr[j][2] = *(const uint2*)(pr + (m < send - 1 ? INP : 0));
        }
        __builtin_amdgcn_sched_barrier(0);
#pragma unroll
        for (int j = 0; j < 12; ++j) asm volatile("" : "+v"(xr[j][0].x), "+v"(xr[j][0].y), "+v"(xr[j][1].x), "+v"(xr[j][1].y), "+v"(xr[j][2].x), "+v"(xr[j][2].y));
#pragma unroll
        for (int arr = 0; arr < 3; ++arr) asm volatile("" : "+v"(wt[arr][0].x), "+v"(wt[arr][0].y), "+v"(wt[arr][0].z), "+v"(wt[arr][0].w), "+v"(wt[arr][1].x), "+v"(wt[arr][1].y), "+v"(wt[arr][1].z), "+v"(wt[arr][1].w),
                                                                   "+v"(wt[arr][2].x), "+v"(wt[arr][2].y), "+v"(wt[arr][2].z), "+v"(wt[arr][2].w));
#pragma unroll
        for (int j = 0; j < 12; ++j) {
            const int arr = j >> 2, i = i0 + 16 * (j & 3);
            const int m = d == 0 ? m0 + i : m0 + 63 - i;
            const float s0 = m > sbase ? 1.0f : 0.0f, s2 = m < send - 1 ? 1.0f : 0.0f;
            const float4 w0 = wt[arr][0], w1 = wt[arr][1], w2 = wt[arr][2];
            const float4 x0 = make_float4(lo2(xr[j][0].x) * s0, hi2(xr[j][0].x) * s0, lo2(xr[j][0].y) * s0, hi2(xr[j][0].y) * s0);
            const float4 x1 = make_float4(lo2(xr[j][1].x), hi2(xr[j][1].x), lo2(xr[j][1].y), hi2(xr[j][1].y));
            const float4 x2 = make_float4(lo2(xr[j][2].x) * s2, hi2(xr[j][2].x) * s2, lo2(xr[j][2].y) * s2, hi2(xr[j][2].y) * s2);
            const float4 a = make_float4(w1.x * x1.x + w0.x * x0.x + w2.x * x2.x, w1.y * x1.y + w0.y * x0.y + w2.y * x2.y, w1.z * x1.z + w0.z * x0.z + w2.z * x2.z, w1.w * x1.w + w0.w * x0.w + w2.w * x2.w);
            float4 v = make_float4(siluf_(a.x), siluf_(a.y), siluf_(a.z), siluf_(a.w));
            if (arr < 2) {
                float ss = v.x * v.x + v.y * v.y + v.z * v.z + v.w * v.w;
                ss = psum32(ss);
                const float rs = (1.0f / sqrtf(ss + L2_EPS)) * (arr == 1 ? 0.08838834764831845f : 1.0f);
                v = make_float4(v.x * rs, v.y * rs, v.z * rs, v.w * rs);
            }
            *(float4*)(F + (arr == 0 ? PA_K : arr == 1 ? PA_Q : PA_V) + i * PA_KP + 4 * f) = v;
        }
        if (tid < 64) {
            const size_t m = (size_t)(d == 0 ? m0 + tid : m0 + 63 - tid);
            const act_t* pr = pp + m * INP;
            const int dh = d * CH + h;
            F[PA_BET + tid] = sigmoidf_(ldp1(pr + OFF_GB + dh));
            F[PA_GAM + tid] = -fexp_(p.gdn_a_log[(size_t)l * 2 * CH + dh]) * softplusf_(ldp1(pr + OFF_GA + dh) + p.gdn_dt_bias[(size_t)l * 2 * CH + dh]);
            F[PA_ONE + tid] = 1.0f;
        }
    }
    __syncthreads();
    if (tid < 64) {
        float g = 0.f, gl = 0.f;
#pragma unroll 8
        for (int j = 0; j < 64; ++j) { const float v = F[PA_GAM + j]; g += j <= tid ? v : 0.f; gl += v; }
        F[PA_EG + tid] = fexp_(g); F[PA_EGL + tid] = fexp_(gl - g); F[PA_ONE + 64 + tid] = g;
        if (tid == 63) *(float*)(out + SL_GT) = fexp_(g);
    }
    __syncthreads();
    if (tid < 64) F[PA_GAM + tid] = F[PA_ONE + 64 + tid];
    __syncthreads();
    for (int item = wv; item < 22; item += 8) {
        if (item >= 20) {
            const int ti = (item - 20) * 2, tj = ti + 1;
#pragma unroll
            for (int reg = 0; reg < 4; ++reg) { const int i = 16 * ti + (lane >> 4) * 4 + reg, j = 16 * tj + (lane & 15);
                *(unsigned short*)(out + SL_QK + (i * 64 + (j & ~15) + swap23(j & 15)) * 2) = 0; }
            continue;
        }
        const int mat = item / 10, L10 = item % 10;
        int ti = 0, rem = L10; while (rem > ti) { rem -= ti + 1; ++ti; }
        const int tj = rem;
        const float* X = F + (mat == 0 ? PA_K : PA_Q) + (16 * ti + (lane & 15)) * PA_KP + (lane >> 4);
        const float* Y = F + PA_K + (16 * tj + (lane & 15)) * PA_KP + (lane >> 4);
        f32x4v acc = {0.f, 0.f, 0.f, 0.f};
#pragma unroll 8
        for (int s = 0; s < 32; ++s) acc = __builtin_amdgcn_mfma_f32_16x16x4f32(X[4 * s], Y[4 * s], acc, 0, 0, 0);
#pragma unroll
        for (int reg = 0; reg < 4; ++reg) {
            const int i = 16 * ti + (lane >> 4) * 4 + reg, j = 16 * tj + (lane & 15);
            const float dec = fexp_(F[PA_GAM + i] - F[PA_GAM + j]);
            if (mat == 0) F[PA_N + j * PA_NP + npos(i)] = i > j ? F[PA_BET + i] * acc[reg] * dec : 0.f;
            else *(unsigned short*)(out + SL_QK + (i * 64 + (j & ~15) + swap23(j & 15)) * 2) = f2a(i >= j ? acc[reg] * dec : 0.f);
        }
    }
    __syncthreads();
    float xa[16], xb[16];
    {
        const int q = tid & 3, col = tid >> 2;
        const float* ksrc = F + PA_K + col; const float* vsrc = F + PA_V + col;
#pragma unroll
        for (int ii = 0; ii < 16; ++ii) { const int i = 4 * ii + q; const float b = F[PA_BET + i]; xa[ii] = b * ksrc[i * PA_KP] * F[PA_EG + i]; xb[ii] = b * vsrc[i * PA_KP]; }
        solve_quad2(F + PA_N, PA_NP, xa, xb, q);
    }
    {
#pragma unroll
        for (int j = 0; j < 2; ++j) {
            const int c = tid + 512 * j, i = c >> 4, pos = (c & 15) * 8, g16 = pos & ~15, hh = (pos >> 3) & 1;
            const float e = F[PA_EG + i];
            const float4 a = *(const float4*)(F + PA_Q + i * PA_KP + g16 + 4 * hh), b = *(const float4*)(F + PA_Q + i * PA_KP + g16 + 8 + 4 * hh);
            *(uint4*)(out + SL_QD + (i * 128 + pos) * 2) = make_uint4(cvtpk_c(a.x * e, a.y * e), cvtpk_c(a.z * e, a.w * e), cvtpk_c(b.x * e, b.y * e), cvtpk_c(b.z * e, b.w * e));
        }
#pragma unroll
        for (int j = 0; j < 2; ++j) {
            const int c = tid + 512 * j, dk = c >> 3, pos = (c & 7) * 8, g16 = pos & ~15, hh = (pos >> 3) & 1;
            float v8[8];
#pragma unroll
            for (int e = 0; e < 8; ++e) { const int tok = g16 + 8 * (e >> 2) + 4 * hh + (e & 3); v8[e] = F[PA_K + tok * PA_KP + dk] * F[PA_EGL + tok]; }
            *(uint4*)(out + SL_KDT + (dk * 64 + pos) * 2) = make_uint4(cvtpk_c(v8[0], v8[1]), cvtpk_c(v8[2], v8[3]), cvtpk_c(v8[4], v8[5]), cvtpk_c(v8[6], v8[7]));
        }
    }
    __syncthreads();
    unsigned short* Xs = (unsigned short*)(F + PA_V);
    {
        const int q = tid & 3, ca = tid >> 2, cb = 128 + (tid >> 2), pa = (ca & ~15) + swap23(ca & 15);
#pragma unroll
        for (int ii = 0; ii < 16; ++ii) { Xs[(4 * ii + q) * 256 + pa] = f2a(xa[ii]); Xs[(4 * ii + q) * 256 + cb] = f2a(xb[ii]); }
    }
    __syncthreads();
#pragma unroll
    for (int j = 0; j < 4; ++j) {
        const int c = tid + 512 * j, i = c >> 5, cc = c & 31;
        const uint4 v = *(const uint4*)(Xs + i * 256 + cc * 8);
        *(uint4*)(out + (cc < 16 ? SL_W + (i * 128 + cc * 8) * 2 : SL_U + (i * 128 + (cc - 16) * 8) * 2)) = v;
    }
}

constexpr int PB_WP = 272, PB_KP = 144;
constexpr int PB_W = 0, PB_QD = 64 * PB_WP, PB_KDT = 2 * 64 * PB_WP, PB_QK = PB_KDT + 128 * PB_KP, PB_U = PB_QK + 64 * PB_KP, PB_LDS = PB_U + 64 * 256;
__device__ __forceinline__ bf16x8 pack8(const f32x16& x, int s) {
    u32x4 w = {cvtpk_c(x[8 * s], x[8 * s + 1]), cvtpk_c(x[8 * s + 2], x[8 * s + 3]), cvtpk_c(x[8 * s + 4], x[8 * s + 5]), cvtpk_c(x[8 * s + 6], x[8 * s + 7])};
    return __builtin_bit_cast(bf16x8, w);
}
static_assert((SEQ / 64) % 2 == 0 && (DSEQ / 64) % 2 == 0, "chain_half runs the chunks in pairs");
constexpr int PH_BUF = PB_U + 64 * 128, PH_LDS = 2 * PH_BUF;
__device__ __forceinline__ int gh_dst(int q, int half, int& src) {
    if (q < 3584) {
        const int reg = q < 1024 ? 0 : q < 2048 ? 2 : q < 3072 ? 3 : 4, idx = q < 3072 ? (q & 1023) : q - 3072;
        src = reg * 1024 + idx;
        return reg == 0 ? PB_W + (idx >> 4) * PB_WP + (idx & 15) * 16 : reg == 2 ? PB_QD + (idx >> 4) * PB_WP + (idx & 15) * 16 : reg == 3 ? PB_KDT + (idx >> 3) * PB_KP + (idx & 7) * 16 : PB_QK + (idx >> 3) * PB_KP + (idx & 7) * 16;
    }
    const int idx = q - 3584, row = idx >> 3, pc = idx & 7;
    src = 1024 + row * 16 + half * 8 + pc;
    return PB_U + row * 128 + pc * 16;
}
__device__ __forceinline__ void chain_half(const P& p, int l, int s, int d, int h, int half, char* lds) {
    int tid_ = TIDX; asm volatile("" : "+v"(tid_));
    const int tid = tid_, lane = tid & 63, wv = __builtin_amdgcn_readfirstlane(tid >> 6), r = lane & 31, hi = lane >> 5;
    const int T = seq_len(s), base = seq_start(s), nc = T / 64;
    const unsigned char* gch = p.ws + WS_GCH;
    act_t* go = (act_t*)(p.ws + WS_GO);
#define GH_SLOT(c) (gch + (size_t)((((base >> 6) + (d == 0 ? (c) : nc - 1 - (c))) * 2 + d) * CH + h) * SLOT_B)
    __syncthreads();
    if (wv < 2) __builtin_amdgcn_s_setprio(3);
    if (wv >= 2) {
        const int st = tid - 128;
        int ldst[11], lsrc[11];
#pragma unroll
        for (int j = 0; j < 11; ++j) { const int q = st + 384 * j; int sc; ldst[j] = gh_dst(q < 4096 ? q : 0, half, sc); lsrc[j] = sc; }
        const bool tail = st < 4096 - 10 * 384;
        uint4 sa0, sa1, sa2, sa3, sa4, sa5, sa6, sa7, sa8, sa9, sa10 = make_uint4(0, 0, 0, 0), sb0, sb1, sb2, sb3, sb4, sb5, sb6, sb7, sb8, sb9, sb10 = make_uint4(0, 0, 0, 0);
#define GH_LOAD(c, X) do { const uint4* a_ = (const uint4*)GH_SLOT(c); \
            X##0 = ldnt16(a_ + lsrc[0]); X##1 = ldnt16(a_ + lsrc[1]); X##2 = ldnt16(a_ + lsrc[2]); X##3 = ldnt16(a_ + lsrc[3]); X##4 = ldnt16(a_ + lsrc[4]); X##5 = ldnt16(a_ + lsrc[5]); X##6 = ldnt16(a_ + lsrc[6]); X##7 = ldnt16(a_ + lsrc[7]); X##8 = ldnt16(a_ + lsrc[8]); X##9 = ldnt16(a_ + lsrc[9]); \
            if (tail) X##10 = ldnt16(a_ + lsrc[10]); } while (0)
#define GH_STORE(buf, X) do { char* b_ = lds + (buf) * PH_BUF; *(uint4*)(b_ + ldst[0]) = X##0; *(uint4*)(b_ + ldst[1]) = X##1; *(uint4*)(b_ + ldst[2]) = X##2; *(uint4*)(b_ + ldst[3]) = X##3; \
            *(uint4*)(b_ + ldst[4]) = X##4; *(uint4*)(b_ + ldst[5]) = X##5; *(uint4*)(b_ + ldst[6]) = X##6; *(uint4*)(b_ + ldst[7]) = X##7; *(uint4*)(b_ + ldst[8]) = X##8; *(uint4*)(b_ + ldst[9]) = X##9; \
            if (tail) *(uint4*)(b_ + ldst[10]) = X##10; } while (0)
        GH_LOAD(0, sa); GH_STORE(0, sa); GH_LOAD(1, sa); if (2 < nc) GH_LOAD(2, sb);
        __syncthreads();
#define GH_SITER(cc, X) do { const int c = (cc); if (c + 1 < nc) GH_STORE((c + 1) & 1, X); if (c + 3 < nc) GH_LOAD(c + 3, X); __syncthreads(); } while (0)
        for (int c2 = 0; c2 < nc; c2 += 2) { GH_SITER(c2, sa); GH_SITER(c2 + 1, sb); }
#undef GH_LOAD
#undef GH_STORE
#undef GH_SITER
    } else {
        f32x16 S[4];
        const int col = 64 * half + 32 * wv + r;
        if (s >= NB) {
            const float* s0 = p.state_gdn + ((((size_t)(s - NB) * L + l) * 2 + d) * CH + h) * DK * DV + col;
#pragma unroll
            for (int t = 0; t < 4; ++t)
#pragma unroll
                for (int i = 0; i < 16; ++i) S[t][i] = s0[(size_t)(32 * t + crow(i, hi)) * DV];
        } else {
#pragma unroll
            for (int t = 0; t < 4; ++t)
#pragma unroll
                for (int i = 0; i < 16; ++i) S[t][i] = 0.f;
        }
        __syncthreads();
#define GH_COMPUTE \
        { \
            const float gt = *(const float*)(GH_SLOT(c) + SL_GT); \
            bf16x8 Sb[4][2]; \
_Pragma("unroll") \
            for (int t = 0; t < 4; ++t) { Sb[t][0] = pack8(S[t], 0); Sb[t][1] = pack8(S[t], 1); } \
            f32x16 vn[2]; \
_Pragma("unroll") \
            for (int a = 0; a < 2; ++a) { \
                f32x16 acc = {}; \
_Pragma("unroll") \
                for (int t = 0; t < 4; ++t) \
_Pragma("unroll") \
                    for (int k = 0; k < 2; ++k) acc = __builtin_amdgcn_mfma_f32_32x32x16_bf16(*(const bf16x8*)(LB + PB_W + (32 * a + r) * PB_WP + (32 * t + 16 * k + 8 * hi) * 2), Sb[t][k], acc, 0, 0, 0); \
_Pragma("unroll") \
                for (int i = 0; i < 16; ++i) vn[a][i] = a2f(*(const unsigned short*)(LB + PB_U + (32 * a + crow(i, hi)) * 128 + (32 * wv + r) * 2)) - acc[i]; \
            } \
            bf16x8 Vb[2][2]; \
_Pragma("unroll") \
            for (int b = 0; b < 2; ++b) { Vb[b][0] = pack8(vn[b], 0); Vb[b][1] = pack8(vn[b], 1); } \
_Pragma("unroll") \
            for (int a = 0; a < 2; ++a) { \
                f32x16 acc = {}; \
_Pragma("unroll") \
                for (int t = 0; t < 4; ++t) \
_Pragma("unroll") \
                    for (int k = 0; k < 2; ++k) acc = __builtin_amdgcn_mfma_f32_32x32x16_bf16(*(const bf16x8*)(LB + PB_QD + (32 * a + r) * PB_WP + (32 * t + 16 * k + 8 * hi) * 2), Sb[t][k], acc, 0, 0, 0); \
_Pragma("unroll") \
                for (int b = 0; b <= a; ++b) \
_Pragma("unroll") \
                    for (int k = 0; k < 2; ++k) acc = __builtin_amdgcn_mfma_f32_32x32x16_bf16(*(const bf16x8*)(LB + PB_QK + (32 * a + r) * PB_KP + (32 * b + 16 * k + 8 * hi) * 2), Vb[b][k], acc, 0, 0, 0); \
_Pragma("unroll") \
                for (int i = 0; i < 16; ++i) { \
                    const int it = 64 * c + 32 * a + crow(i, hi); \
                    const size_t m = (size_t)(d == 0 ? base + it : base + T - 1 - it); \
                    go[(m * 2 + d) * CW + h * DV + 64 * half + 32 * wv + r] = f2a(acc[i]); \
                } \
            } \
_Pragma("unroll") \
            for (int t = 0; t < 4; ++t) { \
_Pragma("unroll") \
                for (int i = 0; i < 16; ++i) S[t][i] *= gt; \
_Pragma("unroll") \
                for (int b = 0; b < 2; ++b) \
_Pragma("unroll") \
                    for (int k = 0; k < 2; ++k) S[t] = __builtin_amdgcn_mfma_f32_32x32x16_bf16(*(const bf16x8*)(LB + PB_KDT + (32 * t + r) * PB_KP + (32 * b + 16 * k + 8 * hi) * 2), Vb[b][k], S[t], 0, 0, 0); \
            } \
        }

        for (int c = 0; c < nc; ++c) {
            const char* LB = lds + (c & 1) * PH_BUF;
            GH_COMPUTE
            __syncthreads();
        }
        if (s < NB) {
            float* so = p.out + O_SG + ((((size_t)s * L + l) * 2 + d) * CH + h) * DK * DV + col;
#pragma unroll
            for (int t = 0; t < 4; ++t)
#pragma unroll
                for (int i = 0; i < 16; ++i) so[(size_t)(32 * t + crow(i, hi)) * DV] = S[t][i];
        }
#undef GH_COMPUTE
    }
#undef GH_SLOT
    __builtin_amdgcn_s_setprio(0);
}
}
namespace rwkc {
using gdnc::bf16x8; using gdnc::f32x16; using gdnc::f32x4v; using gdnc::cvtpk_c; using gdnc::swap23; using gdnc::crow; using gdnc::pack8; using gdnc::solve_quad;
constexpr int SL_WN = 0, SL_UT = 8192, SL_RT = 16384, SL_AHT = 24576, SL_RAN = 32768, SL_Y0 = 40960, SL_G = 49152, SL_PC = 65536, SLOT_B = 65792;
constexpr int NSLOT = (MTOK / 64) * 2 * AH;
static_assert(AN == 64 && CHUNK == 64, "rwkc layout");
template <int CTRL> __device__ __forceinline__ float ddpp(float x) { return __int_as_float(__builtin_amdgcn_update_dpp(0, __float_as_int(x), CTRL, 0xf, 0xf, true)); }
__device__ __forceinline__ float dsum16(float x) { x += ddpp<0xB1>(x); x += ddpp<0x4E>(x); x += ddpp<0x124>(x); x += ddpp<0x128>(x); return x; }

constexpr int TP = 68;
constexpr int TSZ = 64 * TP;
constexpr int A_AT = 0, A_PC = TSZ, A_TK = A_PC + 64, A_TA = A_TK + TSZ, A_TKK = A_TA + TSZ, A_TR = A_TKK + TSZ, A_TV = A_TR + TSZ, A_TB = A_TV + TSZ, A_TRK = A_TB + TSZ, A_END = A_TRK + TSZ;
constexpr int PA_LDS = A_END * 4;
__device__ __forceinline__ f32x4v tile_xyT(const float* X, const float* Y, int ti, int tj, int lane) {
    const float* xp = X + (16 * ti + (lane & 15)) * TP + (lane >> 4); const float* yp = Y + (16 * tj + (lane & 15)) * TP + (lane >> 4);
    float xv[16], yv[16];
#pragma unroll
    for (int s = 0; s < 16; ++s) { xv[s] = xp[4 * s]; yv[s] = yp[4 * s]; }
    __builtin_amdgcn_sched_barrier(0);
    f32x4v acc = {0.f, 0.f, 0.f, 0.f};
#pragma unroll
    for (int s = 0; s < 16; ++s) acc = __builtin_amdgcn_mfma_f32_16x16x4f32(xv[s], yv[s], acc, 0, 0, 0);
    return acc;
}
__device__ __forceinline__ f32x4v tile_xv(const float* X, const float* V, int ti, int tj, int lane) {
    const float* xp = X + (16 * ti + (lane & 15)) * TP + (lane >> 4); const float* vp = V + (lane >> 4) * TP + 16 * tj + (lane & 15);
    f32x4v acc = {0.f, 0.f, 0.f, 0.f};
#pragma unroll
    for (int s = 0; s < 16; ++s) acc = __builtin_amdgcn_mfma_f32_16x16x4f32(xp[4 * s], vp[4 * s * TP], acc, 0, 0, 0);
    return acc;
}
__device__ __forceinline__ f32x4v tile_xTv(const float* X, const float* V, int ti, int tj, int lane) {
    const float* xp = X + (lane >> 4) * TP + 16 * ti + (lane & 15); const float* vp = V + (lane >> 4) * TP + 16 * tj + (lane & 15);
    f32x4v acc = {0.f, 0.f, 0.f, 0.f};
#pragma unroll
    for (int s = 0; s < 16; ++s) acc = __builtin_amdgcn_mfma_f32_16x16x4f32(xp[4 * s * TP], vp[4 * s * TP], acc, 0, 0, 0);
    return acc;
}
__device__ __forceinline__ bf16x8 cvt8(const float4 a, const float4 b) { gdnc::u32x4 w = {cvtpk_c(a.x, a.y), cvtpk_c(a.z, a.w), cvtpk_c(b.x, b.y), cvtpk_c(b.z, b.w)}; return __builtin_bit_cast(bf16x8, w); }
__device__ __forceinline__ bf16x8 cvt8s(const float* p, int stride) {
    gdnc::u32x4 w = {cvtpk_c(p[0], p[stride]), cvtpk_c(p[2 * stride], p[3 * stride]), cvtpk_c(p[4 * stride], p[5 * stride]), cvtpk_c(p[6 * stride], p[7 * stride])}; return __builtin_bit_cast(bf16x8, w); }
__device__ __forceinline__ void ld8s(const float* p, int stride, float (&v)[8]) {
#pragma unroll
    for (int e = 0; e < 8; ++e) v[e] = p[e * stride];
}
__device__ __forceinline__ bf16x8 pk8(const float (&v)[8]) { gdnc::u32x4 w = {cvtpk_c(v[0], v[1]), cvtpk_c(v[2], v[3]), cvtpk_c(v[4], v[5]), cvtpk_c(v[6], v[7])}; return __builtin_bit_cast(bf16x8, w); }
__device__ __forceinline__ f32x4v tile_xyT_bf(const float* X, const float* Y, int ti, int tj, int lane) {
    const float* xp = X + (16 * ti + (lane & 15)) * TP + 8 * (lane >> 4); const float* yp = Y + (16 * tj + (lane & 15)) * TP + 8 * (lane >> 4);
    const float4 x0 = *(const float4*)xp, x1 = *(const float4*)(xp + 4), x2 = *(const float4*)(xp + 32), x3 = *(const float4*)(xp + 36);
    const float4 y0 = *(const float4*)yp, y1 = *(const float4*)(yp + 4), y2 = *(const float4*)(yp + 32), y3 = *(const float4*)(yp + 36);
    __builtin_amdgcn_sched_barrier(0);
    f32x4v acc = {0.f, 0.f, 0.f, 0.f};
    acc = __builtin_amdgcn_mfma_f32_16x16x32_bf16(cvt8(x0, x1), cvt8(y0, y1), acc, 0, 0, 0);
    acc = __builtin_amdgcn_mfma_f32_16x16x32_bf16(cvt8(x2, x3), cvt8(y2, y3), acc, 0, 0, 0);
    return acc;
}
__device__ __forceinline__ f32x4v tile_xv_bf(const float* X, const float* V, int ti, int tj, int lane) {
    const float* xp = X + (16 * ti + (lane & 15)) * TP + 8 * (lane >> 4); const float* vp = V + 8 * (lane >> 4) * TP + 16 * tj + (lane & 15);
    const float4 x0 = *(const float4*)xp, x1 = *(const float4*)(xp + 4), x2 = *(const float4*)(xp + 32), x3 = *(const float4*)(xp + 36);
    float v0[8], v1[8]; ld8s(vp, TP, v0); ld8s(vp + 32 * TP, TP, v1);
    __builtin_amdgcn_sched_barrier(0);
    f32x4v acc = {0.f, 0.f, 0.f, 0.f};
    acc = __builtin_amdgcn_mfma_f32_16x16x32_bf16(cvt8(x0, x1), pk8(v0), acc, 0, 0, 0);
    acc = __builtin_amdgcn_mfma_f32_16x16x32_bf16(cvt8(x2, x3), pk8(v1), acc, 0, 0, 0);
    return acc;
}
__device__ __forceinline__ f32x4v tile_xTv_bf(const float* X, const float* V, int ti, int tj, int lane) {
    const float* xp = X + 8 * (lane >> 4) * TP + 16 * ti + (lane & 15); const float* vp = V + 8 * (lane >> 4) * TP + 16 * tj + (lane & 15);
    float a0[8], a1[8], v0[8], v1[8]; ld8s(xp, TP, a0); ld8s(xp + 32 * TP, TP, a1); ld8s(vp, TP, v0); ld8s(vp + 32 * TP, TP, v1);
    __builtin_amdgcn_sched_barrier(0);
    f32x4v acc = {0.f, 0.f, 0.f, 0.f};
    acc = __builtin_amdgcn_mfma_f32_16x16x32_bf16(pk8(a0), pk8(v0), acc, 0, 0, 0);
    acc = __builtin_amdgcn_mfma_f32_16x16x32_bf16(pk8(a1), pk8(v1), acc, 0, 0, 0);
    return acc;
}
__device__ __forceinline__ void prep_chunk(const P& p, int l, int slot, char* lds) {
    int tid_ = TIDX; asm volatile("" : "+v"(tid_));
    const int tid = tid_, lane = tid & 63, wv = __builtin_amdgcn_readfirstlane(tid >> 6);
    const int h = slot % AH, d = (slot / AH) % 2, m0 = (slot / (2 * AH)) * 64;
    const act_t* pp = (const act_t*)(p.ws + WS_PP);
    unsigned char* out = p.ws + WS_RCH + (size_t)slot * SLOT_B;
    float* F = (float*)lds;
    __syncthreads();
    {
        const act_t* lora = (const act_t*)(p.ws + WS_LORA);
        float* rwb = (float*)(p.ws + WS_RWB);
        uint2 dk[2], dr[2], dv[2], dlw[2], dla[2];
        const int f_ = tid & 15, c0_ = h * AN + 4 * f_;
#pragma unroll
        for (int j = 0; j < 2; ++j) {
            const int i = (tid + 512 * j) >> 4; const size_t m = (size_t)(d == 0 ? m0 + i : m0 + 63 - i);
            const act_t* pr = pp + m * INP; const act_t* lr = lora + m * LORAN;
            dk[j] = *(const uint2*)(pr + OFF_K + c0_); dr[j] = *(const uint2*)(pr + OFF_R + c0_); dv[j] = *(const uint2*)(pr + OFF_V + c0_);
            dlw[j] = *(const uint2*)(lr + d * AW + c0_); dla[j] = *(const uint2*)(lr + (2 + d) * AW + c0_);
        }
        float4 w04 = *(const float4*)(p.rwkv_w0 + ((size_t)l * 2 + d) * AW + c0_), a04 = *(const float4*)(p.rwkv_a0 + ((size_t)l * 2 + d) * AW + c0_);
        float4 ka4 = *(const float4*)(p.rwkv_ka + (size_t)l * AW + c0_), ks4 = *(const float4*)(p.rwkv_kk + (size_t)l * AW + c0_), rk4 = *(const float4*)(p.rwkv_rk + ((size_t)l * AH + h) * AN + 4 * f_);
        __builtin_amdgcn_sched_barrier(0);
#pragma unroll
        for (int j = 0; j < 2; ++j) asm volatile("" : "+v"(dk[j].x), "+v"(dk[j].y), "+v"(dr[j].x), "+v"(dr[j].y), "+v"(dv[j].x), "+v"(dv[j].y), "+v"(dlw[j].x), "+v"(dlw[j].y), "+v"(dla[j].x), "+v"(dla[j].y));
        asm volatile("" : "+v"(w04.x), "+v"(w04.y), "+v"(w04.z), "+v"(w04.w), "+v"(a04.x), "+v"(a04.y), "+v"(a04.z), "+v"(a04.w), "+v"(ka4.x), "+v"(ka4.y), "+v"(ka4.z), "+v"(ka4.w));
        asm volatile("" : "+v"(ks4.x), "+v"(ks4.y), "+v"(ks4.z), "+v"(ks4.w), "+v"(rk4.x), "+v"(rk4.y), "+v"(rk4.z), "+v"(rk4.w));
#define RW_U4(u) make_float4(lo2((u).x), hi2((u).x), lo2((u).y), hi2((u).y))
#pragma unroll
        for (int j = 0; j < 2; ++j) {
            const int q = tid + 512 * j, i = q >> 4, f = q & 15, c0 = h * AN + 4 * f;
            const size_t m = (size_t)(d == 0 ? m0 + i : m0 + 63 - i);
            const float4 k4 = RW_U4(dk[j]), r4 = RW_U4(dr[j]), v4 = RW_U4(dv[j]);
            const float4 lw4 = RW_U4(dlw[j]), la4 = RW_U4(dla[j]);
            const float kx[4] = {k4.x, k4.y, k4.z, k4.w}, rx[4] = {r4.x, r4.y, r4.z, r4.w}, lw[4] = {lw4.x, lw4.y, lw4.z, lw4.w}, la[4] = {la4.x, la4.y, la4.z, la4.w};
            const float w0[4] = {w04.x, w04.y, w04.z, w04.w}, a0[4] = {a04.x, a04.y, a04.z, a04.w}, ka[4] = {ka4.x, ka4.y, ka4.z, ka4.w}, ks[4] = {ks4.x, ks4.y, ks4.z, ks4.w}, rk[4] = {rk4.x, rk4.y, rk4.z, rk4.w};
            float kk[4], ss = 0.f;
#pragma unroll
            for (int e = 0; e < 4; ++e) { kk[e] = kx[e] * ks[e]; ss += kk[e] * kk[e]; }
            ss = dsum16(ss);
            const float rs = 1.0f / sqrtf(ss + L2_EPS);
            float al[4], kd[4], lg[4], bon = 0.f;
#pragma unroll
            for (int e = 0; e < 4; ++e) {
                kk[e] *= rs;
                lg[e] = -fexp_(-softplusf_(-(w0[e] + lw[e])) - 0.5f);
                const float a = sigmoidf_(a0[e] + la[e]);
                kd[e] = kx[e] * (1.0f + (a - 1.0f) * ka[e]); al[e] = kk[e] * a;
                bon += rx[e] * kd[e] * rk[e];
            }
            bon = dsum16(bon);
            if (f == 0) rwb[(m * 2 + d) * AH + h] = bon;
            *(float4*)(F + A_TK + i * TP + 4 * f) = make_float4(kk[0], kk[1], kk[2], kk[3]);
            *(float4*)(F + A_TA + i * TP + 4 * f) = make_float4(al[0], al[1], al[2], al[3]);
            *(float4*)(F + A_TKK + i * TP + 4 * f) = make_float4(kd[0], kd[1], kd[2], kd[3]);
            *(float4*)(F + A_TR + i * TP + 4 * f) = r4;
            *(float4*)(F + A_TV + i * TP + 4 * f) = v4;
            *(float4*)(F + A_TB + i * TP + 4 * f) = make_float4(lg[0], lg[1], lg[2], lg[3]);
        }
    }
    __syncthreads();
    {
        const int c = tid & 63, part = tid >> 6;
        float bs = 0.f;
#pragma unroll
        for (int t = 0; t < 8; ++t) bs += F[A_TB + (8 * part + t) * TP + c];
        F[A_TRK + part * TP + c] = bs;
        __syncthreads();
        float lp = 0.f, tot = 0.f;
#pragma unroll
        for (int q = 0; q < 8; ++q) { const float v = F[A_TRK + q * TP + c]; lp += q < part ? v : 0.f; tot += v; }
#pragma unroll
        for (int t = 0; t < 8; ++t) {
            const int tt = 8 * part + t;
            const float e_prev = fexp_(lp);
            lp += F[A_TB + tt * TP + c];
            const float e = fexp_(lp), ei = fexp_(-lp);
            F[A_TK + tt * TP + c] *= e_prev; F[A_TA + tt * TP + c] *= ei; F[A_TKK + tt * TP + c] *= ei; F[A_TR + tt * TP + c] *= e;
        }
        if (part == 0) { const float pc = fexp_(tot); F[A_PC + c] = pc; *(float*)(out + SL_PC + c * 4) = pc; }
    }
    __syncthreads();
    for (int item = wv; item < 42; item += 8) {
        if (item >= 40) {
            const int ti = (item - 40) * 2, tj = ti + 1;
#pragma unroll
            for (int reg = 0; reg < 4; ++reg) { const int i = 16 * ti + (lane >> 4) * 4 + reg, j = 16 * tj + (lane & 15);
                *(unsigned short*)(out + SL_RAN + (i * 64 + (j & ~15) + swap23(j & 15)) * 2) = 0; }
            continue;
        }
        const int mat = item / 10, L10 = item % 10;
        int ti = 0, rem = L10; while (rem > ti) { rem -= ti + 1; ++ti; }
        const int tj = rem;
        const f32x4v acc = mat < 2 ? tile_xyT_bf(F + A_TK, F + (mat == 0 ? A_TA : A_TKK), ti, tj, lane)
                                   : tile_xyT_bf(F + A_TR, F + (mat == 2 ? A_TA : A_TKK), ti, tj, lane);
#pragma unroll
        for (int reg = 0; reg < 4; ++reg) {
            const int i = 16 * ti + (lane >> 4) * 4 + reg, j = 16 * tj + (lane & 15);
            if (mat == 0) F[A_AT + j * TP + gdnc::npos(i)] = i > j ? acc[reg] : 0.f;
            else if (mat == 1) F[A_TB + i * TP + j] = i > j ? acc[reg] : 0.f;
            else if (mat == 2) *(unsigned short*)(out + SL_RAN + (i * 64 + (j & ~15) + swap23(j & 15)) * 2) = f2a(i >= j ? -acc[reg] : 0.f);
            else F[A_TRK + i * TP + j] = i >= j ? acc[reg] : 0.f;
        }
    }
    for (int item = wv; item < 12; item += 8) {
        const int mat = item / 6, L6 = item % 6;
        int tj = 1, rem = L6; while (rem >= tj) { rem -= tj; ++tj; }
        const int ti = rem;
        if (mat < 2) {
#pragma unroll
            for (int reg = 0; reg < 4; ++reg) F[(mat == 0 ? A_TB : A_TRK) + (16 * ti + (lane >> 4) * 4 + reg) * TP + 16 * tj + (lane & 15)] = 0.f;
        }
    }
    {
#pragma unroll
        for (int j = 0; j < 1; ++j) {
            const int c = tid, i = c >> 3, pos = (c & 7) * 8, g16 = pos & ~15, hh = (pos >> 3) & 1;
            const float4 a = *(const float4*)(F + A_TR + i * TP + g16 + 4 * hh), b = *(const float4*)(F + A_TR + i * TP + g16 + 8 + 4 * hh);
            *(uint4*)(out + SL_RT + (i * 64 + pos) * 2) = make_uint4(cvtpk_c(a.x, a.y), cvtpk_c(a.z, a.w), cvtpk_c(b.x, b.y), cvtpk_c(b.z, b.w));
        }
        {
            const int c = tid, dk = c >> 3, pos = (c & 7) * 8, g16 = pos & ~15, hh = (pos >> 3) & 1;
            const float pc = -F[A_PC + dk];
            float v8[8];
#pragma unroll
            for (int e = 0; e < 8; ++e) { const int tok = g16 + 8 * (e >> 2) + 4 * hh + (e & 3); v8[e] = F[A_TA + tok * TP + dk] * pc; }
            *(uint4*)(out + SL_AHT + (dk * 64 + pos) * 2) = make_uint4(cvtpk_c(v8[0], v8[1]), cvtpk_c(v8[2], v8[3]), cvtpk_c(v8[4], v8[5]), cvtpk_c(v8[6], v8[7]));
        }
    }
    __syncthreads();
    for (int item = wv; item < 48; item += 8) {
        const int mat = item >> 4, ti = (item >> 2) & 3, tj = item & 3;
        f32x4v acc;
        if (mat == 0) acc = tile_xv_bf(F + A_TB, F + A_TV, ti, tj, lane);
        else if (mat == 1) acc = tile_xv_bf(F + A_TRK, F + A_TV, ti, tj, lane);
        else acc = tile_xTv_bf(F + A_TKK, F + A_TV, ti, tj, lane);
#pragma unroll
        for (int reg = 0; reg < 4; ++reg) {
            const int i = 16 * ti + (lane >> 4) * 4 + reg, j = 16 * tj + (lane & 15);
            if (mat == 0) F[A_TR + i * TP + j] = acc[reg];
            else if (mat == 1) *(unsigned short*)(out + SL_Y0 + (i * 64 + j) * 2) = f2a(acc[reg]);
            else *(float*)(out + SL_G + (i * 64 + j) * 4) = acc[reg] * F[A_PC + i];
        }
    }
    __syncthreads();
    unsigned short* Xs = (unsigned short*)(F + A_TV);
    if (__builtin_amdgcn_readfirstlane(tid >> 8) == 0) {
        float xa[16], xb[16];
        const int sq = tid & 3, scol = tid >> 2;
#pragma unroll
        for (int ii = 0; ii < 16; ++ii) { xa[ii] = F[A_TK + scol + (4 * ii + sq) * TP]; xb[ii] = F[A_TR + scol + (4 * ii + sq) * TP]; }
        gdnc::solve_quad2(F + A_AT, TP, xa, xb, sq);
        const int pcol = (scol & ~15) + swap23(scol & 15);
#pragma unroll
        for (int ii = 0; ii < 16; ++ii) { Xs[(4 * ii + sq) * 128 + pcol] = f2a(-xa[ii]); Xs[(4 * ii + sq) * 128 + 64 + scol] = f2a(xb[ii]); }
    }
    __syncthreads();
#pragma unroll
    for (int j = 0; j < 2; ++j) {
        const int c = tid + 512 * j, i = c >> 4, cc = c & 15;
        const uint4 v = *(const uint4*)(Xs + i * 128 + cc * 8);
        *(uint4*)(out + (cc < 8 ? SL_WN + (i * 64 + cc * 8) * 2 : SL_UT + (i * 64 + (cc - 8) * 8) * 2)) = v;
    }
}

constexpr int BP = 144;
constexpr int B_WN = 0, B_RT = 64 * BP, B_AHT = 2 * 64 * BP, B_RAN = 3 * 64 * BP, B_UT = 4 * 64 * BP, B_Y0 = B_UT + 8192, B_G = B_Y0 + 8192, B_PC = B_G + 16384, B_DIR = B_PC + 256;
constexpr int PB_LDS = 2 * B_DIR;
static_assert((SEQ / 64) % 2 == 0 && (DSEQ / 64) % 2 == 0, "chain_dir runs the chunks in pairs");
constexpr int PD_LDS = 2 * B_DIR;
__device__ __forceinline__ int rd_dst(int q) {
    if (q < 3072) { const int img = q >> 9, row = (q & 511) >> 3, pc = q & 7;
        return img == 0 ? B_WN + row * BP + pc * 16 : img == 1 ? B_UT + row * 128 + pc * 16 : img == 2 ? B_RT + row * BP + pc * 16 : img == 3 ? B_AHT + row * BP + pc * 16
             : img == 4 ? B_RAN + row * BP + pc * 16 : B_Y0 + row * 128 + pc * 16; }
    return q < 4096 ? B_G + (q - 3072) * 16 : B_PC + (q - 4096) * 16;
}
__device__ __forceinline__ void chain_dir(const P& p, int l, int s, int d, int h, char* lds) {
    int tid_ = TIDX; asm volatile("" : "+v"(tid_));
    const int tid = tid_, lane = tid & 63, wv = __builtin_amdgcn_readfirstlane(tid >> 6), r = lane & 31, hi = lane >> 5;
    const int T = seq_len(s), base = seq_start(s), nc = T / 64;
    const unsigned char* rch = p.ws + WS_RCH;
    act_t* yb = (act_t*)(p.ws + WS_RWY);
#define RD_SLOT(c) (rch + (size_t)((((base >> 6) + (d == 0 ? (c) : nc - 1 - (c))) * 2 + d) * AH + h) * SLOT_B)
    __syncthreads();
    if (wv < 2) __builtin_amdgcn_s_setprio(3);
    if (wv >= 2) {
        const int st = tid - 128;
        int ldst[11];
#pragma unroll
        for (int j = 0; j < 11; ++j) { const int q = st + 384 * j; ldst[j] = rd_dst(q < 4112 ? q : 0); }
        const bool tail = st < 4112 - 10 * 384;
        uint4 sa0, sa1, sa2, sa3, sa4, sa5, sa6, sa7, sa8, sa9, sa10 = make_uint4(0, 0, 0, 0), sb0, sb1, sb2, sb3, sb4, sb5, sb6, sb7, sb8, sb9, sb10 = make_uint4(0, 0, 0, 0);
#define RD_LOAD(c, X) do { const uint4* a_ = (const uint4*)RD_SLOT(c) + st; \
            X##0 = gdnc::ldnt16(a_ + 0); X##1 = gdnc::ldnt16(a_ + 384); X##2 = gdnc::ldnt16(a_ + 768); X##3 = gdnc::ldnt16(a_ + 1152); X##4 = gdnc::ldnt16(a_ + 1536); X##5 = gdnc::ldnt16(a_ + 1920); X##6 = gdnc::ldnt16(a_ + 2304); X##7 = gdnc::ldnt16(a_ + 2688); X##8 = gdnc::ldnt16(a_ + 3072); X##9 = gdnc::ldnt16(a_ + 3456); if (tail) X##10 = gdnc::ldnt16(a_ + 3840); } while (0)
#define RD_STORE(buf, X) do { char* b_ = lds + (buf) * B_DIR; *(uint4*)(b_ + ldst[0]) = X##0; *(uint4*)(b_ + ldst[1]) = X##1; *(uint4*)(b_ + ldst[2]) = X##2; *(uint4*)(b_ + ldst[3]) = X##3; \
            *(uint4*)(b_ + ldst[4]) = X##4; *(uint4*)(b_ + ldst[5]) = X##5; *(uint4*)(b_ + ldst[6]) = X##6; *(uint4*)(b_ + ldst[7]) = X##7; *(uint4*)(b_ + ldst[8]) = X##8; *(uint4*)(b_ + ldst[9]) = X##9; \
            if (tail) *(uint4*)(b_ + ldst[10]) = X##10; } while (0)
        RD_LOAD(0, sa); RD_STORE(0, sa); RD_LOAD(1, sa); if (2 < nc) RD_LOAD(2, sb);
        __syncthreads();
#define RD_SITER(cc, X) do { const int c = (cc); if (c + 1 < nc) RD_STORE((c + 1) & 1, X); if (c + 3 < nc) RD_LOAD(c + 3, X); __syncthreads(); } while (0)
        for (int c2 = 0; c2 < nc; c2 += 2) { RD_SITER(c2, sa); RD_SITER(c2 + 1, sb); }
#undef RD_LOAD
#undef RD_STORE
#undef RD_SITER
    } else {
        const int vb = (wv & 1) * 32;
        f32x16 Z[2];
        if (s >= NB) {
            const float* s0 = p.state_rwkv + ((((size_t)(s - NB) * L + l) * 2 + d) * AH + h) * AN * AN + (size_t)(vb + r) * AN;
#pragma unroll
            for (int t = 0; t < 2; ++t)
#pragma unroll
                for (int i = 0; i < 16; ++i) Z[t][i] = s0[32 * t + crow(i, hi)];
        } else {
#pragma unroll
            for (int t = 0; t < 2; ++t)
#pragma unroll
                for (int i = 0; i < 16; ++i) Z[t][i] = 0.f;
        }
        __syncthreads();
#define RD_COMPUTE \
        if (wv < 2) { \
            bf16x8 Zb[2][2]; \
_Pragma("unroll") \
            for (int t = 0; t < 2; ++t) { Zb[t][0] = pack8(Z[t], 0); Zb[t][1] = pack8(Z[t], 1); } \
            f32x16 U[2]; \
_Pragma("unroll") \
            for (int a = 0; a < 2; ++a) { \
                f32x16 acc = {}; \
_Pragma("unroll") \
                for (int t = 0; t < 2; ++t) \
_Pragma("unroll") \
                    for (int k = 0; k < 2; ++k) acc = __builtin_amdgcn_mfma_f32_32x32x16_bf16(*(const bf16x8*)(LB + B_WN + (32 * a + r) * BP + (32 * t + 16 * k + 8 * hi) * 2), Zb[t][k], acc, 0, 0, 0); \
_Pragma("unroll") \
                for (int i = 0; i < 16; ++i) U[a][i] = a2f(*(const unsigned short*)(LB + B_UT + (32 * a + crow(i, hi)) * 128 + (vb + r) * 2)) - acc[i]; \
            } \
            bf16x8 Ub[2][2]; \
_Pragma("unroll") \
            for (int b = 0; b < 2; ++b) { Ub[b][0] = pack8(U[b], 0); Ub[b][1] = pack8(U[b], 1); } \
_Pragma("unroll") \
            for (int a = 0; a < 2; ++a) { \
                f32x16 acc = {}; \
_Pragma("unroll") \
                for (int t = 0; t < 2; ++t) \
_Pragma("unroll") \
                    for (int k = 0; k < 2; ++k) acc = __builtin_amdgcn_mfma_f32_32x32x16_bf16(*(const bf16x8*)(LB + B_RT + (32 * a + r) * BP + (32 * t + 16 * k + 8 * hi) * 2), Zb[t][k], acc, 0, 0, 0); \
_Pragma("unroll") \
                for (int b = 0; b <= a; ++b) \
_Pragma("unroll") \
                    for (int k = 0; k < 2; ++k) acc = __builtin_amdgcn_mfma_f32_32x32x16_bf16(*(const bf16x8*)(LB + B_RAN + (32 * a + r) * BP + (32 * b + 16 * k + 8 * hi) * 2), Ub[b][k], acc, 0, 0, 0); \
_Pragma("unroll") \
                for (int i = 0; i < 16; ++i) { \
                    const int it = 64 * c + 32 * a + crow(i, hi); \
                    const size_t m = (size_t)(d == 0 ? base + it : base + T - 1 - it); \
                    yb[(m * 2 + d) * AW + h * AN + vb + r] = f2a(acc[i] + a2f(*(const unsigned short*)(LB + B_Y0 + (32 * a + crow(i, hi)) * 128 + (vb + r) * 2))); \
                } \
            } \
_Pragma("unroll") \
            for (int t = 0; t < 2; ++t) { \
_Pragma("unroll") \
                for (int i = 0; i < 16; ++i) { const int dk = 32 * t + crow(i, hi); Z[t][i] = Z[t][i] * *(const float*)(LB + B_PC + dk * 4) + *(const float*)(LB + B_G + (dk * 64 + vb + r) * 4); } \
_Pragma("unroll") \
                for (int b = 0; b < 2; ++b) \
_Pragma("unroll") \
                    for (int k = 0; k < 2; ++k) Z[t] = __builtin_amdgcn_mfma_f32_32x32x16_bf16(*(const bf16x8*)(LB + B_AHT + (32 * t + r) * BP + (32 * b + 16 * k + 8 * hi) * 2), Ub[b][k], Z[t], 0, 0, 0); \
            } \
        }

        for (int c = 0; c < nc; ++c) {
            const char* LB = lds + (c & 1) * B_DIR;
            RD_COMPUTE
            __syncthreads();
        }
        if (s < NB) {
            float* so = p.out + O_SR + ((((size_t)s * L + l) * 2 + d) * AH + h) * AN * AN + (size_t)(vb + r) * AN;
#pragma unroll
            for (int t = 0; t < 2; ++t)
#pragma unroll
                for (int i = 0; i < 16; ++i) so[32 * t + crow(i, hi)] = Z[t][i];
        }
#undef RD_COMPUTE
    }
#undef RD_SLOT
    __builtin_amdgcn_s_setprio(0);
}
}
constexpr int MX_RW_LAT = NDB * AH * 2, MX_G2_LAT = NDB * 2 * CH * 2, MX_AT_LAT = AT_NU_LAT, MX_GD_CTX = NB * 2 * CH * 2, MX_RW_CTX = NB * AH * 2, MX_AT_CTX = AT_NU_CTX;
constexpr int MX_TOTAL = MX_RW_LAT + MX_G2_LAT + MX_AT_LAT + MX_GD_CTX + MX_RW_CTX + MX_AT_CTX;
__device__ __forceinline__ void ph_mixers(const P& p, int l, char* lds, int misc_off, int round = 0) {
    unsigned* head = (unsigned*)(p.ws + WS_CTL + 32768) + (l + round * L) * 64;
    volatile __attribute__((address_space(3))) unsigned* slot = (volatile __attribute__((address_space(3))) unsigned*)((__attribute__((address_space(3))) char*)lds + misc_off + 16);
    for (;;) {
        __syncthreads();
        if (TIDX == 0) *slot = __hip_atomic_fetch_add(head, 1u, __ATOMIC_RELAXED, __HIP_MEMORY_SCOPE_AGENT);
        __syncthreads();
        int t = (int)*slot;
        t = __builtin_amdgcn_readfirstlane(t);
        if (t >= MX_TOTAL) break;
        if (t < MX_RW_LAT) { const int u = t; rwkc::chain_dir(p, l, NB + u / (2 * AH), (u / AH) % 2, u % AH, lds);
            if (DUPMASK & 32) rwkc::chain_dir(p, l, NB + u / (2 * AH), (u / AH) % 2, u % AH, lds); continue; } t -= MX_RW_LAT;
        if (t < MX_G2_LAT) { const int u = t; gdnc::chain_half(p, l, NB + u / (CH * 4), (u / (2 * CH)) % 2, (u / 2) % CH, u % 2, lds); continue; } t -= MX_G2_LAT;
        if (t < MX_AT_LAT) { attn_unit(p, t, lds); if (DUPMASK & 128) attn_unit(p, t, lds); continue; } t -= MX_AT_LAT;
        if (t < MX_GD_CTX) { const int u = t; gdnc::chain_half(p, l, u / (CH * 4), (u / (2 * CH)) % 2, (u / 2) % CH, u % 2, lds); continue; } t -= MX_GD_CTX;
        if (t < MX_RW_CTX) { const int u = t; rwkc::chain_dir(p, l, u / (2 * AH), (u / AH) % 2, u % AH, lds); continue; } t -= MX_RW_CTX;
        attn_unit(p, AT_NU_LAT + t, lds);
    }
}
namespace fastp {
template <int CTRL> __device__ __forceinline__ float dppf(float x) { return __int_as_float(__builtin_amdgcn_update_dpp(0, __float_as_int(x), CTRL, 0xf, 0xf, true)); }
template <int XORM> __device__ __forceinline__ float swzx(float x) { return __int_as_float(__builtin_amdgcn_ds_swizzle(__float_as_int(x), (XORM << 10) | 0x1f)); }
__device__ __forceinline__ float sum4(float x) { x += dppf<0xB1>(x); x += dppf<0x4E>(x); return x; }
__device__ __forceinline__ float sum16(float x) { x = sum4(x); x += dppf<0x124>(x); x += dppf<0x128>(x); return x; }
__device__ __forceinline__ float wsum(float x) {
    x = sum16(x); x += swzx<16>(x);
    auto rr = __builtin_amdgcn_permlane32_swap(__float_as_uint(x), __float_as_uint(x), false, false);
    return __uint_as_float(rr[0]) + __uint_as_float(rr[1]);
}
template <int N> __device__ __forceinline__ float gsumN(float x) {
    static_assert(N == 8 || N == 16 || N == 32, "group size");
    if (N == 8) { x = sum4(x); x += swzx<4>(x); return x; }
    x = sum16(x);
    if (N == 32) x += swzx<16>(x);
    return x;
}
#define gsum(x, n) gsumN<n>(x)
__device__ __forceinline__ uint2 pk4(float a, float b, float c, float d) { return make_uint2(mk2(a, b), mk2(c, d)); }
struct WaveId { int gw, nw, lane; };
__device__ __forceinline__ WaveId wave_id() {
    int tid = TIDX; asm volatile("" : "+v"(tid));
    WaveId w; w.lane = tid & 63; w.gw = __builtin_amdgcn_readfirstlane((tid >> 6) * (int)gridDim.x + (int)blockIdx.x); w.nw = (int)gridDim.x * (NTHR_ / 64); return w;
}

static_assert(D % 256 == 0, "row sweep");
__device__ __forceinline__ void ldx8(const unsigned short* p, float (&v)[8]) {
    const uint4 u = *(const uint4*)p;
    v[0] = __uint_as_float(u.x << 16); v[1] = __uint_as_float(u.x & 0xffff0000u); v[2] = __uint_as_float(u.y << 16); v[3] = __uint_as_float(u.y & 0xffff0000u);
    v[4] = __uint_as_float(u.z << 16); v[5] = __uint_as_float(u.z & 0xffff0000u); v[6] = __uint_as_float(u.w << 16); v[7] = __uint_as_float(u.w & 0xffff0000u);
}
static_assert(D % 512 == 0, "row sweep (8 per lane)");
__device__ __forceinline__ void norm_rows(const P& p, int l, int which) {
    const WaveId w = wave_id();
    const unsigned short* x = (const unsigned short*)(p.ws + WS_X); act_t* h = (act_t*)(p.ws + WS_H);
    const float* g = (which == 0 ? p.norm1_g : p.norm2_g) + (size_t)l * D;
    float A[D / 512][8], B[D / 512][8]; int cond_cur = -1;
    uint4 nx[D / 512];
    int m = w.gw;
    {   const unsigned short* xr = x + (size_t)(m < MTOK ? m : 0) * D;
#pragma unroll
        for (int j = 0; j < D / 512; ++j) nx[j] = *(const uint4*)(xr + j * 512 + w.lane * 8); }
    for (; m < MTOK; m += w.nw) {
        uint4 cur[D / 512];
#pragma unroll
        for (int j = 0; j < D / 512; ++j) { cur[j] = nx[j]; asm volatile("" : "+v"(cur[j].x), "+v"(cur[j].y), "+v"(cur[j].z), "+v"(cur[j].w)); }
        {   const int mn = m + w.nw < MTOK ? m + w.nw : m; const unsigned short* xr = x + (size_t)mn * D;
#pragma unroll
            for (int j = 0; j < D / 512; ++j) nx[j] = *(const uint4*)(xr + j * 512 + w.lane * 8); }
        __builtin_amdgcn_sched_barrier(0);
        const int cond = cond_of_seq(seq_of(m));
        if (cond != cond_cur) {
            cond_cur = cond;
            const float* sh = modp(p, l, cond, which * 3 + 0); const float* sc = modp(p, l, cond, which * 3 + 1);
#pragma unroll
            for (int j = 0; j < D / 512; ++j) { const int c = j * 512 + w.lane * 8;
                const float4 ga = *(const float4*)(g + c), gb = *(const float4*)(g + c + 4), s1a = *(const float4*)(sc + c), s1b = *(const float4*)(sc + c + 4), s0a = *(const float4*)(sh + c), s0b = *(const float4*)(sh + c + 4);
                A[j][0] = ga.x * (1.f + s1a.x); A[j][1] = ga.y * (1.f + s1a.y); A[j][2] = ga.z * (1.f + s1a.z); A[j][3] = ga.w * (1.f + s1a.w);
                A[j][4] = gb.x * (1.f + s1b.x); A[j][5] = gb.y * (1.f + s1b.y); A[j][6] = gb.z * (1.f + s1b.z); A[j][7] = gb.w * (1.f + s1b.w);
                B[j][0] = s0a.x; B[j][1] = s0a.y; B[j][2] = s0a.z; B[j][3] = s0a.w; B[j][4] = s0b.x; B[j][5] = s0b.y; B[j][6] = s0b.z; B[j][7] = s0b.w; }
        }
        float v[D / 512][8]; float ss = 0.f;
#pragma unroll
        for (int j = 0; j < D / 512; ++j) { const uint4 u = cur[j];
            v[j][0] = __uint_as_float(u.x << 16); v[j][1] = __uint_as_float(u.x & 0xffff0000u); v[j][2] = __uint_as_float(u.y << 16); v[j][3] = __uint_as_float(u.y & 0xffff0000u);
            v[j][4] = __uint_as_float(u.z << 16); v[j][5] = __uint_as_float(u.z & 0xffff0000u); v[j][6] = __uint_as_float(u.w << 16); v[j][7] = __uint_as_float(u.w & 0xffff0000u);
#pragma unroll
            for (int e = 0; e < 8; ++e) ss += v[j][e] * v[j][e]; }
        ss = wsum(ss);
        const float rs = 1.0f / sqrtf(ss / D + RMS_EPS);
#pragma unroll
        for (int j = 0; j < D / 512; ++j) { const int c = j * 512 + w.lane * 8;
            const uint2 lo = pk4(v[j][0] * rs * A[j][0] + B[j][0], v[j][1] * rs * A[j][1] + B[j][1], v[j][2] * rs * A[j][2] + B[j][2], v[j][3] * rs * A[j][3] + B[j][3]);
            const uint2 hi = pk4(v[j][4] * rs * A[j][4] + B[j][4], v[j][5] * rs * A[j][5] + B[j][5], v[j][6] * rs * A[j][6] + B[j][6], v[j][7] * rs * A[j][7] + B[j][7]);
            *(uint4*)(h + (size_t)m * D + c) = make_uint4(lo.x, lo.y, hi.x, hi.y); }
    }
}
__device__ __forceinline__ void final_rows(const P& p) {
    const WaveId w = wave_id();
    const unsigned short* x = (const unsigned short*)(p.ws + WS_X);
    for (int m = w.gw; m < MTOK; m += w.nw) {
        const unsigned short* xr = x + (size_t)m * D;
        float v[D / 512][8]; float ss = 0.f;
#pragma unroll
        for (int j = 0; j < D / 512; ++j) { ldx8(xr + j * 512 + w.lane * 8, v[j]);
#pragma unroll
            for (int e = 0; e < 8; ++e) ss += v[j][e] * v[j][e]; }
        ss = wsum(ss);
        const float rs = 1.0f / sqrtf(ss / D + RMS_EPS);
#pragma unroll
        for (int j = 0; j < D / 512; ++j) { const int c = j * 512 + w.lane * 8; const float4 ga = *(const float4*)(p.final_norm_g + c), gb = *(const float4*)(p.final_norm_g + c + 4);
            *(float4*)(p.out + O_YP + (size_t)m * D + c) = make_float4(v[j][0] * rs * ga.x, v[j][1] * rs * ga.y, v[j][2] * rs * ga.z, v[j][3] * rs * ga.w);
            *(float4*)(p.out + O_YP + (size_t)m * D + c + 4) = make_float4(v[j][4] * rs * gb.x, v[j][5] * rs * gb.y, v[j][6] * rs * gb.z, v[j][7] * rs * gb.w); }
    }
}

static_assert(2 * DL == 128 && 2 * IL == 128 && GL == 128 && QR == 512 && KVR == 512 && ROPE == 64 && GC == 1536 && CH == 4, "prep_rows layout");
__device__ __forceinline__ void prep_rows(const P& p, int l) {
    const WaveId w = wave_id(); const int lane = w.lane;
    const act_t* pp = (const act_t*)(p.ws + WS_PP);
    act_t* lin = (act_t*)(p.ws + WS_LIN); act_t* cqn = (act_t*)(p.ws + WS_CQN); act_t* ckvn = (act_t*)(p.ws + WS_CKVN); act_t* kr = (act_t*)(p.ws + WS_KR);
    const float2* ropetab = (const float2*)(p.ws + WS_ROPE);
    for (int m = w.gw; m < MKV; m += w.nw) {
        if (m >= MTOK) {
            const int r = m - MTOK, b = r / PAST, j0 = r % PAST;
            const float* ck = p.cache_ckv + (((size_t)b * L + l) * PAST + j0) * KVR;
            const float4 a = *(const float4*)(ck + lane * 8), c4 = *(const float4*)(ck + lane * 8 + 4);
            *(uint4*)(ckvn + (size_t)m * KVR + lane * 8) = make_uint4(mk2(a.x, a.y), mk2(a.z, a.w), mk2(c4.x, c4.y), mk2(c4.z, c4.w));
            kr[(size_t)m * ROPE + lane] = f2a(p.cache_kpe[(((size_t)b * L + l) * PAST + j0) * ROPE + lane]);
            continue;
        }
        const act_t* pr = pp + (size_t)m * INP;
        const int s = seq_of(m), base = seq_start(s), t = m - base, T = seq_len(s);
        {
            const float2 a = ldp2(pr + OFF_WLO + 2 * lane), b = ldp2(pr + OFF_ALO + 2 * lane), c = ldp2(pr + OFF_GLO + 2 * lane);
            act_t* lo = lin + (size_t)m * LINK;
            *(unsigned*)(lo + 2 * lane) = mk2(ftanh_(a.x), ftanh_(a.y)); *(unsigned*)(lo + 128 + 2 * lane) = mk2(b.x, b.y); *(unsigned*)(lo + 256 + 2 * lane) = mk2(sigmoidf_(c.x), sigmoidf_(c.y));
        }
        {
            const float4 a = ldp4(pr + OFF_CQ + lane * 8), b = ldp4(pr + OFF_CQ + lane * 8 + 4);
            float ss = wsum(a.x * a.x + a.y * a.y + a.z * a.z + a.w * a.w + b.x * b.x + b.y * b.y + b.z * b.z + b.w * b.w);
            float rs = 1.0f / sqrtf(ss / QR + RMS_EPS);
            const float* g = p.mla_qnorm_g + (size_t)l * QR + lane * 8; const float4 g0 = *(const float4*)g, g1 = *(const float4*)(g + 4);
            *(uint4*)(cqn + (size_t)m * QR + lane * 8) = make_uint4(mk2(a.x * rs * g0.x, a.y * rs * g0.y), mk2(a.z * rs * g0.z, a.w * rs * g0.w), mk2(b.x * rs * g1.x, b.y * rs * g1.y), mk2(b.z * rs * g1.z, b.w * rs * g1.w));
            const float4 c = ldp4(pr + OFF_CKV + lane * 8), d = ldp4(pr + OFF_CKV + lane * 8 + 4);
            ss = wsum(c.x * c.x + c.y * c.y + c.z * c.z + c.w * c.w + d.x * d.x + d.y * d.y + d.z * d.z + d.w * d.w);
            rs = 1.0f / sqrtf(ss / KVR + RMS_EPS);
            const float* g2 = p.mla_kvnorm_g + (size_t)l * KVR + lane * 8; const float4 h0 = *(const float4*)g2, h1 = *(const float4*)(g2 + 4);
            const float4 o0 = make_float4(c.x * rs * h0.x, c.y * rs * h0.y, c.z * rs * h0.z, c.w * rs * h0.w), o1 = make_float4(d.x * rs * h1.x, d.y * rs * h1.y, d.z * rs * h1.z, d.w * rs * h1.w);
            *(uint4*)(ckvn + (size_t)m * KVR + lane * 8) = make_uint4(mk2(o0.x, o0.y), mk2(o0.z, o0.w), mk2(o1.x, o1.y), mk2(o1.z, o1.w));
            if (s < NB) { float* oc = p.out + O_CK + (((size_t)s * L + l) * SEQ + t) * KVR + lane * 8; *(float4*)oc = o0; *(float4*)(oc + 4) = o1; }
            if (lane < ROPE / 2) {
                const float2 xe = ldp2(pr + OFF_KPE + 2 * lane);
                if (s < NB) { *(unsigned*)(kr + (size_t)m * ROPE + 2 * lane) = mk2(xe.x, xe.y); *(float2*)(p.out + O_KP + (((size_t)s * L + l) * SEQ + t) * ROPE + 2 * lane) = xe; }
                else { const float2 cs = ropetab[(size_t)t * (ROPE / 2) + lane]; *(unsigned*)(kr + (size_t)m * ROPE + 2 * lane) = mk2(xe.x * cs.x - xe.y * cs.y, xe.x * cs.y + xe.y * cs.x); }
            }
        }
    }
}

static_assert(CW == 512 && DV == 128, "post_rows layout");
__device__ __forceinline__ void post_rows(const P& p, int l) {
    const WaveId w = wave_id(); const int lane = w.lane;
    const act_t* pp = (const act_t*)(p.ws + WS_PP);
    const float* rwb = (const float*)(p.ws + WS_RWB); const act_t* gb = (const act_t*)(p.ws + WS_LORA) + 4 * AW;     const act_t* yb = (const act_t*)(p.ws + WS_RWY);
    const act_t* go = (const act_t*)(p.ws + WS_GO);
    act_t* ymix = (act_t*)(p.ws + WS_YMIX);
    for (int m = w.gw; m < MTOK; m += w.nw) {
        const act_t* pr = pp + (size_t)m * INP;
        const int c0 = 8 * lane, h = lane >> 3;
        {
            float y[8], v[8];
#define LD8B(dst, ptr) do { const float4 a_ = ldp4(ptr), b_ = ldp4((ptr) + 4); dst[0] = a_.x; dst[1] = a_.y; dst[2] = a_.z; dst[3] = a_.w; dst[4] = b_.x; dst[5] = b_.y; dst[6] = b_.z; dst[7] = b_.w; } while (0)
#define LD8(dst, ptr) do { const float4 a_ = *(const float4*)(ptr), b_ = *(const float4*)((ptr) + 4); dst[0] = a_.x; dst[1] = a_.y; dst[2] = a_.z; dst[3] = a_.w; dst[4] = b_.x; dst[5] = b_.y; dst[6] = b_.z; dst[7] = b_.w; } while (0)
            { float y1[8]; LD8B(y, yb + ((size_t)m * 2 + 0) * AW + c0); LD8B(y1, yb + ((size_t)m * 2 + 1) * AW + c0);
#pragma unroll
              for (int j = 0; j < 8; ++j) y[j] += y1[j]; }
            { const float4 a_ = ldp4(pr + OFF_V + c0), b_ = ldp4(pr + OFF_V + c0 + 4); v[0] = a_.x; v[1] = a_.y; v[2] = a_.z; v[3] = a_.w; v[4] = b_.x; v[5] = b_.y; v[6] = b_.z; v[7] = b_.w; }
            float mu = 0.f;
#pragma unroll
            for (int j = 0; j < 8; ++j) mu += y[j];
            mu = gsum(mu, 8) * (1.0f / AN);
            float var = 0.f;
#pragma unroll
            for (int j = 0; j < 8; ++j) { const float t = y[j] - mu; var += t * t; }
            var = gsum(var, 8) * (1.0f / AN);
            const float rstd = 1.0f / sqrtf(var + LNX_EPS);
            const float bon = rwb[((size_t)m * 2 + 0) * AH + h] + rwb[((size_t)m * 2 + 1) * AH + h];
            float g[8]; { const float4 a_ = ldp4(gb + (size_t)m * LORAN + c0), b_ = ldp4(gb + (size_t)m * LORAN + c0 + 4); g[0] = a_.x; g[1] = a_.y; g[2] = a_.z; g[3] = a_.w; g[4] = b_.x; g[5] = b_.y; g[6] = b_.z; g[7] = b_.w; }
            float o[8];
#pragma unroll
            for (int j = 0; j < 8; ++j) o[j] = ((y[j] - mu) * rstd * p.rwkv_lnx_g[(size_t)l * AW + c0 + j] + p.rwkv_lnx_b[(size_t)l * AW + c0 + j] + bon * v[j]) * g[j];
            *(uint4*)(ymix + (size_t)m * MIXW + c0) = make_uint4(mk2(o[0], o[1]), mk2(o[2], o[3]), mk2(o[4], o[5]), mk2(o[6], o[7]));
        }
        {
            float o[8], z[8];
            { float o1[8]; LD8B(o, go + ((size_t)m * 2 + 0) * CW + c0); LD8B(o1, go + ((size_t)m * 2 + 1) * CW + c0);
#pragma unroll
              for (int j = 0; j < 8; ++j) o[j] += o1[j]; }
            { const float4 a_ = ldp4(pr + OFF_GZ + c0), b_ = ldp4(pr + OFF_GZ + c0 + 4); z[0] = a_.x; z[1] = a_.y; z[2] = a_.z; z[3] = a_.w; z[4] = b_.x; z[5] = b_.y; z[6] = b_.z; z[7] = b_.w; }
            float ss = 0.f;
#pragma unroll
            for (int j = 0; j < 8; ++j) ss += o[j] * o[j];
            ss = gsum(ss, 16);
            const float rs = 1.0f / sqrtf(ss / DV + RMS_EPS);
            float r[8];
#pragma unroll
            for (int j = 0; j < 8; ++j) r[j] = o[j] * rs * p.gdn_norm_g[(size_t)l * DV + (c0 & 127) + j] * siluf_(z[j]);
            *(uint4*)(ymix + (size_t)m * MIXW + AW + BW + c0) = make_uint4(mk2(r[0], r[1]), mk2(r[2], r[3]), mk2(r[4], r[5]), mk2(r[6], r[7]));
#undef LD8
#undef LD8B
        }
    }
}

static_assert(DFF % 8 == 0, "ffn_act8");
__device__ __forceinline__ void ffn_act8(const P& p, int l, long gt, long gs) {
    const act_t* up = (const act_t*)(p.ws + WS_UP); act_t* act = (act_t*)(p.ws + WS_ACT);
    const float* w = p.ffn_conv + (size_t)l * 3 * DFF;
    for (long idx = gt; idx < (long)MTOK * (DFF / 8); idx += gs) {
        const int m = (int)(idx / (DFF / 8)), c = (int)(idx % (DFF / 8)) * 8;
        const int s = seq_of(m), base = seq_start(s), t = m - base, T = seq_len(s);
        const uint4 g1 = *(const uint4*)(up + (size_t)m * NUP + c), vv = *(const uint4*)(up + (size_t)m * NUP + DFF + c);
        uint4 g0 = make_uint4(0, 0, 0, 0), g2 = make_uint4(0, 0, 0, 0);
        if (t > 0) g0 = *(const uint4*)(up + (size_t)(m - 1) * NUP + c);
        if (t < T - 1) g2 = *(const uint4*)(up + (size_t)(m + 1) * NUP + c);
        const unsigned a0[4] = {g0.x, g0.y, g0.z, g0.w}, a1[4] = {g1.x, g1.y, g1.z, g1.w}, a2[4] = {g2.x, g2.y, g2.z, g2.w}, av[4] = {vv.x, vv.y, vv.z, vv.w};
        unsigned o[4];
#pragma unroll
        for (int j = 0; j < 4; ++j) {
            const float lo = w[c + 2 * j] * lo2(a0[j]) + w[DFF + c + 2 * j] * lo2(a1[j]) + w[2 * DFF + c + 2 * j] * lo2(a2[j]);
            const float hi = w[c + 2 * j + 1] * hi2(a0[j]) + w[DFF + c + 2 * j + 1] * hi2(a1[j]) + w[2 * DFF + c + 2 * j + 1] * hi2(a2[j]);
            o[j] = mk2(siluf_(lo) * lo2(av[j]), siluf_(hi) * hi2(av[j]));
        }
        *(uint4*)(act + (size_t)m * DFF + c) = make_uint4(o[0], o[1], o[2], o[3]);
    }
}

__device__ __forceinline__ void ffn_fix(const P& p, int l, long gt, long gs) {
    const float* side = (const float*)(p.ws + WS_SIDE); act_t* act = (act_t*)(p.ws + WS_ACT);
    const float* w = p.ffn_conv + (size_t)l * 3 * DFF;
    for (long idx = gt; idx < (long)(MTOK / 64) * 2 * (DFF / 8); idx += gs) {
        const int c = (int)(idx % (DFF / 8)) * 8, be = (int)(idx / (DFF / 8)), b = be >> 1, e = be & 1;
        const int m = 64 * b + (e ? 63 : 0);
        const int s = seq_of(m), t = m - seq_start(s), T = seq_len(s);
        const float* sb = side + (size_t)b * 6 * DFF + c;
        float g0[8], g1[8], g2[8], vv[8];
#define LD8S(dst, ptr) do { const float4 a_ = *(const float4*)(ptr), b_ = *(const float4*)((ptr) + 4); dst[0] = a_.x; dst[1] = a_.y; dst[2] = a_.z; dst[3] = a_.w; dst[4] = b_.x; dst[5] = b_.y; dst[6] = b_.z; dst[7] = b_.w; } while (0)
#pragma unroll
        for (int j = 0; j < 8; ++j) { g0[j] = 0.f; g2[j] = 0.f; }
        if (e == 0) { LD8S(g1, sb); LD8S(g2, sb + DFF); LD8S(vv, sb + 4 * DFF); if (t > 0) LD8S(g0, sb - 6 * DFF + 3 * DFF); }
        else { LD8S(g1, sb + 3 * DFF); LD8S(g0, sb + 2 * DFF); LD8S(vv, sb + 5 * DFF); if (t < T - 1) LD8S(g2, sb + 6 * DFF); }
#undef LD8S
        float o[8];
#pragma unroll
        for (int j = 0; j < 8; ++j) o[j] = siluf_(w[c + j] * g0[j] + w[DFF + c + j] * g1[j] + w[2 * DFF + c + j] * g2[j]) * vv[j];
        *(uint4*)(act + (size_t)m * DFF + c) = make_uint4(mk2(o[0], o[1]), mk2(o[2], o[3]), mk2(o[4], o[5]), mk2(o[6], o[7]));
    }
}

template <class Src>
__device__ __forceinline__ void conv_tile_load(const Src& src, int K, int N, int unit, int tid, float4 (&v)[2]) {
    const int nk = K / 64, ku = unit % nk, nu = unit / nk, k0 = ku * 64, n0 = nu * 64;
#pragma unroll
    for (int pass = 0; pass < 2; ++pass) {
        const int kk = pass * 32 + (tid >> 4), n4 = (tid & 15) * 4;
        v[pass] = make_float4(0.f, 0.f, 0.f, 0.f);
        if (n0 + n4 < N) v[pass] = src(k0 + kk, n0 + n4);
    }
}
__device__ __forceinline__ void conv_tile_store(int K, act_t* Wt, int unit, int tid, const float4 (&v)[2], char* lds) {
    float* tile = (float*)lds;
    const int nk = K / 64, ku = unit % nk, nu = unit / nk, k0 = ku * 64, n0 = nu * 64;
    asm volatile("s_waitcnt lgkmcnt(0)" ::: "memory"); __builtin_amdgcn_s_barrier(); asm volatile("" ::: "memory");
#pragma unroll
    for (int pass = 0; pass < 2; ++pass) {
        const int kk = pass * 32 + (tid >> 4), n4 = (tid & 15) * 4;
        tile[kk * 65 + n4] = v[pass].x; tile[kk * 65 + n4 + 1] = v[pass].y; tile[kk * 65 + n4 + 2] = v[pass].z; tile[kk * 65 + n4 + 3] = v[pass].w;
    }
    asm volatile("s_waitcnt lgkmcnt(0)" ::: "memory"); __builtin_amdgcn_s_barrier(); asm volatile("" ::: "memory");
    const int n = tid >> 3, k8 = (tid & 7) * 8;
    unsigned o[4];
#pragma unroll
    for (int j = 0; j < 4; ++j) o[j] = mk2(tile[(k8 + 2 * j) * 65 + n], tile[(k8 + 2 * j + 1) * 65 + n]);
    *(uint4*)(Wt + (size_t)(n0 + n) * K + k0 + k8) = make_uint4(o[0], o[1], o[2], o[3]);
}
typedef float f32x4nt __attribute__((ext_vector_type(4)));
__device__ __forceinline__ float4 ldnt4(const float* p) { const f32x4nt v = __builtin_nontemporal_load((const f32x4nt*)p); return make_float4(v[0], v[1], v[2], v[3]); }
struct SrcPlain { const float* W; int N; __device__ __forceinline__ float4 operator()(int k, int n) const { return ldnt4(W + (size_t)k * N + n); } };
struct SrcUpPerm { const float* W; int N; __device__ __forceinline__ float4 operator()(int k, int n) const {
        const int nl = n & 255, col = nl < 128 ? (n >> 8) * 128 + nl : DFF + (n >> 8) * 128 + nl - 128; return ldnt4(W + (size_t)k * N + col); } };
struct SrcLora { const float* w2; const float* a2; const float* g2;
    __device__ __forceinline__ float4 operator()(int k, int n) const {
        const int jb = n / AW, c = n % AW; const float* s = nullptr;
        if (jb < 2) { if (k >= jb * DL && k < (jb + 1) * DL) s = w2 + ((size_t)jb * DL + (k - jb * DL)) * AW + c; }
        else if (jb < 4) { const int d = jb - 2; if (k >= 2 * DL + d * IL && k < 2 * DL + (d + 1) * IL) s = a2 + ((size_t)d * IL + (k - 2 * DL - d * IL)) * AW + c; }
        else { if (k >= 2 * DL + 2 * IL) s = g2 + (size_t)(k - 2 * DL - 2 * IL) * AW + c; }
        return s ? *(const float4*)s : make_float4(0.f, 0.f, 0.f, 0.f);
    } };

__device__ __forceinline__ void adaln_unit(const P& p, int unit, char* lds) {
    int tid = TIDX; asm volatile("" : "+v"(tid));
    float* sil = (float*)lds;
    float* part = sil + NCOND * D;
    const int l = unit / (6 * D / 64), j0 = (unit % (6 * D / 64)) * 64;
    __syncthreads();
    for (int i = tid; i < NCOND * D; i += NTHR_) { const int c = i / D, k = i % D; sil[i] = siluf_(c == 0 ? p.c_ctx[k] : p.c[(size_t)(c - 1) * D + k]); }
    __syncthreads();
    const int cg = tid & 15, rs = tid >> 4;
    float4 acc[NCOND];
#pragma unroll
    for (int c = 0; c < NCOND; ++c) acc[c] = make_float4(0.f, 0.f, 0.f, 0.f);
    const float* wp = p.ada_w + ((size_t)l * D) * 6 * D + j0 + 4 * cg;
    for (int i0 = rs * (D / 32); i0 < (rs + 1) * (D / 32); i0 += 16) {
        float4 wv[16];
#pragma unroll
        for (int e = 0; e < 16; ++e) wv[e] = ldnt4(wp + (size_t)(i0 + e) * 6 * D);
        __builtin_amdgcn_sched_barrier(0);
#pragma unroll
        for (int e = 0; e < 16; e += 4) asm volatile("" : "+v"(wv[e].x), "+v"(wv[e].y), "+v"(wv[e].z), "+v"(wv[e].w), "+v"(wv[e + 1].x), "+v"(wv[e + 1].y), "+v"(wv[e + 1].z), "+v"(wv[e + 1].w),
                                                          "+v"(wv[e + 2].x), "+v"(wv[e + 2].y), "+v"(wv[e + 2].z), "+v"(wv[e + 2].w), "+v"(wv[e + 3].x), "+v"(wv[e + 3].y), "+v"(wv[e + 3].z), "+v"(wv[e + 3].w));
#pragma unroll
        for (int e = 0; e < 16; ++e)
#pragma unroll
            for (int c = 0; c < NCOND; ++c) { const float s = sil[c * D + i0 + e]; acc[c].x += s * wv[e].x; acc[c].y += s * wv[e].y; acc[c].z += s * wv[e].z; acc[c].w += s * wv[e].w; }
    }
#pragma unroll
    for (int c = 0; c < NCOND; ++c) { float* pp_ = part + ((rs * 64 + 4 * cg) * NCOND + c); pp_[0] = acc[c].x; pp_[NCOND] = acc[c].y; pp_[2 * NCOND] = acc[c].z; pp_[3 * NCOND] = acc[c].w; }
    __syncthreads();
    if (tid < 64 * NCOND) {
        const int c = tid / 64, j = tid % 64; float sacc = 0.f;
#pragma unroll 8
        for (int q = 0; q < 32; ++q) sacc += part[(q * 64 + j) * NCOND + c];
        float* mod = (float*)(p.ws + WS_MOD);
        mod[((size_t)(l * NCOND + c) * 6) * D + j0 + j] = sacc + p.ada_b[(size_t)l * 6 * D + j0 + j];
    }
}
}
struct EpiResid {
    static constexpr bool PERM = true, AFTER_DRAIN = false;
    unsigned short* X; int ldc; const float* mod_l; int which;
    __device__ __forceinline__ void operator()(const pg8::f32x4 (&acc)[2][2][4][2], const pg8::Unit& u, int wr, int wc, int fr, int fq) const {
        using pg8::f32x4; using pg8::u32x4; using pg8::BM; using pg8::HALF;
        const int row0 = u.pm * BM + wr * 64 + fr, col0 = u.pn * BM + wc * 32 + 8 * fq;
        const int cond = cond_of_seq(seq_of(u.pm * BM));
        const float* gate = mod_l + ((size_t)cond * 6 + which) * D;
        f32x4 gv[2][2];
#pragma unroll
        for (int bj = 0; bj < 2; ++bj)
#pragma unroll
            for (int n = 0; n < 2; ++n) gv[bj][n] = *(const f32x4*)(gate + col0 + bj * HALF + 4 * n);
        u32x4 o[2][4][2];
#pragma unroll
        for (int ai = 0; ai < 2; ++ai)
#pragma unroll
            for (int m = 0; m < 4; ++m)
#pragma unroll
                for (int bj = 0; bj < 2; ++bj) o[ai][m][bj] = *(const u32x4*)(X + (size_t)(row0 + ai * HALF + m * 16) * ldc + col0 + bj * HALF);
        __builtin_amdgcn_sched_barrier(0);
#pragma unroll
        for (int ai = 0; ai < 2; ++ai)
#pragma unroll
            for (int m = 0; m < 4; ++m) { unsigned short* rowp = X + (size_t)(row0 + ai * HALF + m * 16) * ldc + col0;
#pragma unroll
                for (int bj = 0; bj < 2; ++bj) {
                    const u32x4 ov = o[ai][m][bj];
                    const f32x4 x0 = {__uint_as_float(ov.x << 16), __uint_as_float(ov.x & 0xffff0000u), __uint_as_float(ov.y << 16), __uint_as_float(ov.y & 0xffff0000u)};
                    const f32x4 x1 = {__uint_as_float(ov.z << 16), __uint_as_float(ov.z & 0xffff0000u), __uint_as_float(ov.w << 16), __uint_as_float(ov.w & 0xffff0000u)};
                    const f32x4 v0 = x0 + gv[bj][0] * acc[ai][bj][m][0], v1 = x1 + gv[bj][1] * acc[ai][bj][m][1];
                    u32x4 w; w.x = pg8::cvt_pk_bf16(v0[0], v0[1]); w.y = pg8::cvt_pk_bf16(v0[2], v0[3]); w.z = pg8::cvt_pk_bf16(v1[0], v1[1]); w.w = pg8::cvt_pk_bf16(v1[2], v1[3]);
                    *(u32x4*)(rowp + bj * HALF) = w; } }
    }
};

struct EpiFfnAct {
    static constexpr bool PERM = true, AFTER_DRAIN = false;
    pg8::bf16_t* ACT; float* side; const float* cw;
    __device__ __forceinline__ void operator()(const pg8::f32x4 (&acc)[2][2][4][2], const pg8::Unit& u, int wr, int wc, int, int) const {
        using pg8::f32x4; using pg8::u32x4; using pg8::BM; using pg8::HALF;
        unsigned lane_; asm volatile("v_mbcnt_lo_u32_b32 %0, -1, 0\n\tv_mbcnt_hi_u32_b32 %0, -1, %0" : "=v"(lane_));
        const int fr = (int)(lane_ & 15u), fq = (int)(lane_ >> 4);
        const int colA = u.pn * 128 + wc * 32 + 8 * fq;
        f32x4 w0[2], w1[2], w2[2];
#pragma unroll
        for (int n = 0; n < 2; ++n) { w0[n] = *(const f32x4*)(cw + colA + 4 * n); w1[n] = *(const f32x4*)(cw + DFF + colA + 4 * n); w2[n] = *(const f32x4*)(cw + 2 * DFF + colA + 4 * n); }
        const bool first = fr == 0, last = fr == 15;
#pragma unroll
        for (int ai = 0; ai < 2; ++ai) {
            const int row_b = u.pm * BM + ai * HALF + wr * 64, blk = row_b >> 6;
            f32x4 R[4][2], Ln[4][2];
#pragma unroll
            for (int m = 0; m < 4; ++m)
#pragma unroll
                for (int n = 0; n < 2; ++n)
#pragma unroll
                    for (int e = 0; e < 4; ++e) { R[m][n][e] = fastp::dppf<0x121>(acc[ai][0][m][n][e]); Ln[m][n][e] = fastp::dppf<0x12F>(acc[ai][0][m][n][e]); }
#pragma unroll
            for (int m = 0; m < 4; ++m) {
                u32x4 wout;
#pragma unroll
                for (int n = 0; n < 2; ++n) {
                    f32x4 o;
#pragma unroll
                    for (int e = 0; e < 4; ++e) {
                        const float pv = first ? (m > 0 ? R[m > 0 ? m - 1 : 0][n][e] : 0.f) : R[m][n][e];
                        const float nx = last ? (m < 3 ? Ln[m < 3 ? m + 1 : 3][n][e] : 0.f) : Ln[m][n][e];
                        o[e] = siluf_(w0[n][e] * pv + w1[n][e] * acc[ai][0][m][n][e] + w2[n][e] * nx) * acc[ai][1][m][n][e];
                    }
                    if (n == 0) { wout.x = pg8::cvt_pk_bf16(o[0], o[1]); wout.y = pg8::cvt_pk_bf16(o[2], o[3]); } else { wout.z = pg8::cvt_pk_bf16(o[0], o[1]); wout.w = pg8::cvt_pk_bf16(o[2], o[3]); }
                }
                *(u32x4*)(ACT + (size_t)(row_b + m * 16 + fr) * DFF + colA) = wout;
            }
            float* sb = side + (size_t)blk * 6 * DFF + colA;
            if (fr <= 1) { *(f32x4*)(sb + fr * DFF) = acc[ai][0][0][0]; *(f32x4*)(sb + fr * DFF + 4) = acc[ai][0][0][1]; }
            if (fr >= 14) { *(f32x4*)(sb + (fr - 12) * DFF) = acc[ai][0][3][0]; *(f32x4*)(sb + (fr - 12) * DFF + 4) = acc[ai][0][3][1]; }
            if (first) { *(f32x4*)(sb + 4 * DFF) = acc[ai][1][0][0]; *(f32x4*)(sb + 4 * DFF + 4) = acc[ai][1][0][1]; }
            if (last) { *(f32x4*)(sb + 5 * DFF) = acc[ai][1][3][0]; *(f32x4*)(sb + 5 * DFF + 4) = acc[ai][1][3][1]; }
        }
    }
};

constexpr int NTHR = 512;
constexpr int LDS_BYTES = 147456;
constexpr int LDS_MISC = LDS_BYTES - 64;
constexpr int LDS_USABLE = TID_TAB_OFF;
static_assert(LDS_BYTES == LDS_TOTAL_BYTES, "tidx.h");
static_assert(NTHR == NTHR_ && att::SHM_ATTN <= LDS_USABLE && pg8::STAGE_BYTES <= LDS_USABLE && gdnc::PA_LDS <= LDS_USABLE && gdnc::PH_LDS <= LDS_USABLE && rwkc::PA_LDS <= LDS_USABLE && rwkc::PD_LDS <= LDS_USABLE, "LDS map");
constexpr int PH_PER_LAYER = 11, N_PHASES = 2 + L * PH_PER_LAYER;

struct Args { P p; int ph_lo, ph_hi, use_bar, pad; };

template <class Epi>
__device__ __forceinline__ void run_gemm(PG8_LAS unsigned char* lds, const act_t* A, const act_t* Bt, int M, int N, int K, const Epi& E) {
    pg8::Gemm g{A, Bt, M, N, K, K}; pg8::StaticOrder S; S.init(M, N, (int)gridDim.x, (int)blockIdx.x);
    pg8::gemm_phase<Epi, pg8::StaticOrder, false>(lds, g, S, E, nullptr);
}

constexpr int CV_T_IN = (D / 64) * (INP / 64), CV_T_UQ = (QR / 64) * (NQ / 64), CV_T_UK = (KVR / 64) * (BH * NOPE / 64), CV_T_UV = (KVR / 64) * (BH * VD / 64), CV_T_OUT = (MIXW / 64) * (D / 64),
              CV_T_UP = (D / 64) * (NUP / 64), CV_T_DN = (DFF / 64) * (D / 64), CV_T_LO = (LINK / 64) * (LORAN / 64), CV_TL = CV_T_IN + CV_T_UQ + CV_T_UK + CV_T_UV + CV_T_OUT + CV_T_UP + CV_T_DN + CV_T_LO;
constexpr int AD_PER_LAYER = 6 * D / 64;
__device__ __forceinline__ void layer_prep(const P& p, int ll, int t_lo, int t_hi, bool with_adaln, int w, int nw, char* lds) {
    act_t* ww_ = (act_t*)(p.ws + WS_WT) + (size_t)ll * WT_LAYER;
    if (with_adaln) for (int u = w; u < AD_PER_LAYER; u += nw) fastp::adaln_unit(p, ll * AD_PER_LAYER + u, lds);
    int tidc = TIDX; asm volatile("" : "+v"(tidc));
    asm volatile("" : "+s"(w), "+s"(t_lo));
    float4 vcur[2], vnxt[2];
#define CV_DISPATCH(ridx, OP_PLAIN, OP_LORA, OP_UP) do { int r_ = (ridx); \
        if (r_ < CV_T_IN) { OP_PLAIN(p.w_in + (size_t)ll * D * INC, INC, D, INC, ww_ + WT_IN, r_); break; } r_ -= CV_T_IN; \
        if (r_ < CV_T_UQ) { OP_PLAIN(p.mla_w_uq + (size_t)ll * QR * NQ, NQ, QR, NQ, ww_ + WT_UQ, r_); break; } r_ -= CV_T_UQ; \
        if (r_ < CV_T_UK) { OP_PLAIN(p.mla_w_uk + (size_t)ll * KVR * BH * NOPE, BH * NOPE, KVR, BH * NOPE, ww_ + WT_UKV, r_); break; } r_ -= CV_T_UK; \
        if (r_ < CV_T_UV) { OP_PLAIN(p.mla_w_uv + (size_t)ll * KVR * BH * VD, BH * VD, KVR, BH * VD, ww_ + WT_UKV + (size_t)BH * NOPE * KVR, r_); break; } r_ -= CV_T_UV; \
        if (r_ < CV_T_OUT) { OP_PLAIN(p.w_out + (size_t)ll * MIXW * D, D, MIXW, D, ww_ + WT_OUT, r_); break; } r_ -= CV_T_OUT; \
        if (r_ < CV_T_UP) { OP_UP(p.ffn_up + (size_t)ll * D * NUP, NUP, D, NUP, ww_ + WT_UP, r_); break; } r_ -= CV_T_UP; \
        if (r_ < CV_T_DN) { OP_PLAIN(p.ffn_down + (size_t)ll * DFF * D, D, DFF, D, ww_ + WT_DOWN, r_); break; } r_ -= CV_T_DN; \
        OP_LORA(ww_ + WT_LORA, r_); } while (0)
#define CV_LOAD_PLAIN(W_, ldw_, K_, N_, Wt_, u_) fastp::conv_tile_load(fastp::SrcPlain{W_, ldw_}, K_, N_, u_, tidc, vnxt)
#define CV_LOAD_UP(W_, ldw_, K_, N_, Wt_, u_) fastp::conv_tile_load(fastp::SrcUpPerm{W_, ldw_}, K_, N_, u_, tidc, vnxt)
#define CV_LOAD_LORA(Wt_, u_) fastp::conv_tile_load(fastp::SrcLora{p.rwkv_w2 + (size_t)ll * 2 * DL * AW, p.rwkv_a2 + (size_t)ll * 2 * IL * AW, p.rwkv_g2 + (size_t)ll * GL * AW}, LINK, LORAN, u_, tidc, vnxt)
#define CV_STORE_PLAIN(W_, ldw_, K_, N_, Wt_, u_) fastp::conv_tile_store(K_, Wt_, u_, tidc, vcur, lds)
#define CV_STORE_LORA(Wt_, u_) fastp::conv_tile_store(LINK, Wt_, u_, tidc, vcur, lds)
    const int first = t_lo + w;
    float4 vn1[2], vn2[2];
    vn1[0] = vn1[1] = vn2[0] = vn2[1] = make_float4(0.f, 0.f, 0.f, 0.f);
    if (first < t_hi) { CV_DISPATCH(first, CV_LOAD_PLAIN, CV_LOAD_LORA, CV_LOAD_UP); vn1[0] = vnxt[0]; vn1[1] = vnxt[1]; }
    if (first + nw < t_hi) { CV_DISPATCH(first + nw, CV_LOAD_PLAIN, CV_LOAD_LORA, CV_LOAD_UP); vn2[0] = vnxt[0]; vn2[1] = vnxt[1]; }
    for (int gi = first; gi < t_hi; gi += nw) {
        vcur[0] = vn1[0]; vcur[1] = vn1[1]; vn1[0] = vn2[0]; vn1[1] = vn2[1];
        if (gi + 2 * nw < t_hi) { CV_DISPATCH(gi + 2 * nw, CV_LOAD_PLAIN, CV_LOAD_LORA, CV_LOAD_UP); vn2[0] = vnxt[0]; vn2[1] = vnxt[1]; }
        CV_DISPATCH(gi, CV_STORE_PLAIN, CV_STORE_LORA, CV_STORE_PLAIN);
    }
#undef CV_DISPATCH
#undef CV_LOAD_PLAIN
#undef CV_LOAD_LORA
#undef CV_LOAD_UP
#undef CV_STORE_PLAIN
#undef CV_STORE_LORA
}
constexpr int CVQ = 16, CVQ_TASKS = (CV_TL + CVQ - 1) / CVQ;
__device__ __forceinline__ void conv_queue(const P& p, int ll, char* lds, int misc_off) {
    if (ll >= L) return;
    unsigned* head = (unsigned*)(p.ws + WS_CTL + 32768) + (2 * L + ll) * 64;
    volatile __attribute__((address_space(3))) unsigned* slot = (volatile __attribute__((address_space(3))) unsigned*)((__attribute__((address_space(3))) char*)lds + misc_off + 16);
    for (;;) {
        __syncthreads();
        if (TIDX == 0) *slot = __hip_atomic_fetch_add(head, 1u, __ATOMIC_RELAXED, __HIP_MEMORY_SCOPE_AGENT);
        __syncthreads();
        int t = __builtin_amdgcn_readfirstlane((int)*slot);
        if (t >= AD_PER_LAYER + CVQ_TASKS) break;
        if (t < AD_PER_LAYER) { fastp::adaln_unit(p, ll * AD_PER_LAYER + t, lds); continue; }
        t -= AD_PER_LAYER;
        const int lo = t * CVQ, hi = lo + CVQ < CV_TL ? lo + CVQ : CV_TL;
        layer_prep(p, ll, lo, hi, false, 0, 1, lds);
    }
}
struct Ctx { long gt, gt2, gs; PG8_LAS unsigned char* lds; };
template <int K> __device__ __forceinline__ void phase_body(const P& p, int l, const Ctx& c) {
    const long gt = c.gt, gt2 = c.gt2, gs = c.gs;
    act_t* wt = (act_t*)(p.ws + WS_WT);
    const act_t* w = wt + (size_t)l * WT_LAYER;
    const float* mod_l = (const float*)(p.ws + WS_MOD) + (size_t)l * NCOND * 6 * D;
    if constexpr (K == 0) {
        uint2* x = (uint2*)(p.ws + WS_X);
        for (long i = gt; i < (long)MTOK * D / 4; i += gs) { const float4 v = i < (long)MCTX * D / 4 ? ((const float4*)p.x_prompt)[i] : ((const float4*)p.x_sample)[i - (long)MCTX * D / 4]; x[i] = fastp::pk4(v.x, v.y, v.z, v.w); }
        float* rt = (float*)(p.ws + WS_ROPE);
        for (long i = gt; i < (long)DSEQ * (ROPE / 2); i += gs) { float cs, sn; rope_angle((int)(i / (ROPE / 2)), (int)(i % (ROPE / 2)), cs, sn); rt[2 * i] = cs; rt[2 * i + 1] = sn; }
        for (int u = blockIdx.x; u < AD_PER_LAYER; u += gridDim.x) fastp::adaln_unit(p, u, (char*)c.lds);
        layer_prep(p, 0, 0, CV_TL, false, (int)blockIdx.x, (int)gridDim.x, (char*)c.lds);
    }
    if constexpr (K == 1) fastp::norm_rows(p, l, 0);
    if constexpr (K == 2) { pg8::EpiBf16<0> E{(pg8::bf16_t*)(p.ws + WS_PP), INP, nullptr, 0, 0}; run_gemm(c.lds, (const act_t*)(p.ws + WS_H), w + WT_IN, MTOK, INP, D, E); }
    if constexpr (K == 3) fastp::prep_rows(p, l);
    if constexpr (K == 41) { pg8::EpiBf16<0> E{(pg8::bf16_t*)(p.ws + WS_QF), NQ, nullptr, 0, 0}; run_gemm(c.lds, (const act_t*)(p.ws + WS_CQN), w + WT_UQ, MTOK, NQ, QR, E); }
    if constexpr (K == 42) { pg8::EpiBf16<0> E{(pg8::bf16_t*)(p.ws + WS_KVUP), NKV, nullptr, 0, 0}; run_gemm(c.lds, (const act_t*)(p.ws + WS_CKVN), w + WT_UKV, MKV, NKV, KVR, E); }
    if constexpr (K == 43) { pg8::EpiBf16<0> E{(pg8::bf16_t*)(p.ws + WS_LORA), LORAN, nullptr, 0, 0}; run_gemm(c.lds, (const act_t*)(p.ws + WS_LIN), w + WT_LORA, MTOK, LORAN, LINK, E); }
    if constexpr (K == 46) { for (int rep = 0; rep < ((DUPMASK & 256) ? 2 : 1); ++rep) for (int u = (int)gridDim.x - 1 - (int)blockIdx.x; u < gdnc::NSLOT; u += gridDim.x) gdnc::prep_chunk(p, l, u, (char*)c.lds); }
    if constexpr (K == 45) { for (int rep = 0; rep < ((DUPMASK & 512) ? 2 : 1); ++rep) for (int u = blockIdx.x; u < rwkc::NSLOT; u += gridDim.x) rwkc::prep_chunk(p, l, u, (char*)c.lds); }
    if constexpr (K == 50) ph_mixers(p, l, (char*)c.lds, LDS_MISC);
    if constexpr (K == 52) ph_mixers(p, l, (char*)c.lds, LDS_MISC, 1);
    if constexpr (K == 53) conv_queue(p, l + 1, (char*)c.lds, LDS_MISC);
    if constexpr (K == 6) fastp::post_rows(p, l);
    if constexpr (K == 7) { EpiResid E{(unsigned short*)(p.ws + WS_X), D, mod_l, 2}; run_gemm(c.lds, (const act_t*)(p.ws + WS_YMIX), w + WT_OUT, MTOK, D, MIXW, E); }
    if constexpr (K == 8) fastp::norm_rows(p, l, 1);
    if constexpr (K == 9) { EpiFfnAct E{(pg8::bf16_t*)(p.ws + WS_ACT), (float*)(p.ws + WS_SIDE), p.ffn_conv + (size_t)l * 3 * DFF}; run_gemm(c.lds, (const act_t*)(p.ws + WS_H), w + WT_UP, MTOK, NUP, D, E); }
    if constexpr (K == 10) fastp::ffn_fix(p, l, gt, gs);
    if constexpr (K == 11) { EpiResid E{(unsigned short*)(p.ws + WS_X), D, mod_l, 5}; run_gemm(c.lds, (const act_t*)(p.ws + WS_ACT), w + WT_DOWN, MTOK, D, DFF, E); }
    if constexpr (K == 12) fastp::final_rows(p);
}
__device__ __forceinline__ Ctx make_ctx(PG8_LAS unsigned char* lds) {
    Ctx c; const int wv = TIDX >> 6, lane = TIDX & 63;
    c.gs = (long)gridDim.x * NTHR;
    c.gt = ((long)wv * gridDim.x + blockIdx.x) * 64 + lane;
    c.gt2 = (c.gt + c.gs / 2) % c.gs;
    c.lds = lds; return c;
}
#if N_LAUNCH_MODE == 1
template <int K> __device__ __forceinline__ void phase_site(int l, PG8_LAS unsigned char* lds) {
    const __attribute__((address_space(4))) P* kp = (const __attribute__((address_space(4))) P*)__builtin_amdgcn_kernarg_segment_ptr();
    asm volatile("" : "+s"(kp));
    P p;
#if defined(__HIP_DEVICE_COMPILE__)
    p = *kp;
#endif
    int tid = TIDX, bid = blockIdx.x, nb = gridDim.x;
    asm volatile("" : "+v"(tid), "+s"(bid), "+s"(nb));
    Ctx c; const int wv = tid >> 6, lane = tid & 63;
    c.gs = (long)nb * NTHR;
    c.gt = ((long)wv * nb + bid) * 64 + lane;
    c.gt2 = (c.gt + c.gs / 2) % c.gs;
    c.lds = lds;
    phase_body<K>(p, l, c);
}
#ifndef DUPMASK
#define DUPMASK 0
#endif
#define DUP(bit, ...) do { if (DUPMASK & (1 << (bit))) { __VA_ARGS__; } } while (0)
__device__ __forceinline__ void grid_bar(PG8_LAS unsigned char* lds) {
    const __attribute__((address_space(4))) P* kp = (const __attribute__((address_space(4))) P*)__builtin_amdgcn_kernarg_segment_ptr();
    asm volatile("" : "+s"(kp));
    XcdBarrier b; b.bar = (unsigned*)(kp->ws + WS_CTL); b.x = xb_xcc_id(); b.st = (volatile LAS unsigned*)(lds + LDS_MISC);
    xcd_barrier(b);
    if (DUPMASK & 2048) xcd_barrier(b);
}
__global__ void __launch_bounds__(NTHR, 2) fwd(Args a) {
    extern __shared__ __attribute__((aligned(16))) unsigned char lds_raw[];
    PG8_LAS unsigned char* lds = (PG8_LAS unsigned char*)lds_raw;
    volatile LAS unsigned* misc = (volatile LAS unsigned*)(lds + LDS_MISC);
    if (threadIdx.x < 4) misc[threadIdx.x] = 0u;
    if ((threadIdx.x & 63) == 0) *(volatile LAS int*)(lds + TID_TAB_OFF + 4 * hw_slot()) = (int)(threadIdx.x >> 6);
    __syncthreads();
    (void)xcd_barrier_post((unsigned*)(a.p.ws + WS_CTL), misc);
    phase_site<0>(0, lds); DUP(4, phase_site<0>(0, lds)); grid_bar(lds);
    for (int l = 0; l < L; ++l) {
        phase_site<1>(l, lds); DUP(0, phase_site<1>(l, lds)); grid_bar(lds);
        phase_site<2>(l, lds); DUP(1, phase_site<2>(l, lds)); grid_bar(lds);
        phase_site<3>(l, lds); DUP(0, phase_site<3>(l, lds)); grid_bar(lds);
        phase_site<41>(l, lds); phase_site<42>(l, lds); phase_site<43>(l, lds); DUP(1, phase_site<41>(l, lds); phase_site<42>(l, lds); phase_site<43>(l, lds)); phase_site<46>(l, lds); grid_bar(lds);
        phase_site<45>(l, lds); grid_bar(lds);
        phase_site<50>(l, lds); phase_site<53>(l, lds); DUP(10, grid_bar(lds); phase_site<52>(l, lds)); grid_bar(lds);
        phase_site<6>(l, lds); DUP(0, phase_site<6>(l, lds)); grid_bar(lds);
        phase_site<7>(l, lds); grid_bar(lds);
        phase_site<8>(l, lds); DUP(0, phase_site<8>(l, lds)); grid_bar(lds);
        phase_site<9>(l, lds); DUP(1, phase_site<9>(l, lds)); grid_bar(lds);
        phase_site<10>(l, lds); DUP(0, phase_site<10>(l, lds)); grid_bar(lds);
        phase_site<11>(l, lds); grid_bar(lds);
    }
    phase_site<12>(0, lds);
}
#endif


extern "C" void kernel_launch(void* const* d_in, const int* in_sizes, int n_in, void* d_out, int out_size, void* d_ws, size_t ws_size, hipStream_t stream) {
    static int grid = 0;
    if (grid == 0) {
        if (n_in != 37 || (size_t)out_size != O_END || ws_size < WS_END) { fprintf(stderr, "kernel_launch: unexpected sizes n_in %d out %d ws %zu (need %zu)\n", n_in, out_size, ws_size, (size_t)WS_END); grid = -1; return; }
        int dev = 0, cus = 0, per_cu = 0;
        if (hipGetDevice(&dev) != hipSuccess || hipDeviceGetAttribute(&cus, hipDeviceAttributeMultiprocessorCount, dev) != hipSuccess) { grid = -1; return; }
#if N_LAUNCH_MODE == 1
        bool ok = hipFuncSetAttribute((const void*)fwd, hipFuncAttributeMaxDynamicSharedMemorySize, LDS_BYTES) == hipSuccess;
        if (hipOccupancyMaxActiveBlocksPerMultiprocessor(&per_cu, (const void*)fwd, NTHR, LDS_BYTES) != hipSuccess || per_cu < 1) fprintf(stderr, "kernel_launch: occupancy query says %d\n", per_cu);
#endif
        if (!ok) { fprintf(stderr, "kernel_launch: hipFuncSetAttribute failed\n"); grid = -1; return; }
        (void)per_cu; (void)hipGetLastError();
        grid = cus;
    }
    if (grid < 0) return;
    (void)hipMemsetAsync((char*)d_ws + WS_CTL, 0, WS_CTL_BYTES, stream);
    Args a{};
    const float** pin = (const float**)&a.p;
    for (int i = 0; i < 37; ++i) pin[i] = (const float*)d_in[i];
    a.p.out = (float*)d_out; a.p.ws = (unsigned char*)d_ws;
    a.pad = 0;
#if N_LAUNCH_MODE == 1
    a.ph_lo = 0; a.ph_hi = N_PHASES; a.use_bar = 1;
    hipLaunchKernelGGL(fwd, dim3(grid), dim3(NTHR), LDS_BYTES, stream, a);
#endif
}
```

```cpp
#include <hip/hip_runtime.h>
#include <cstdio>
#define N_LAUNCH_MODE 1
#define DUPMASK 0
#define HD __device__ __attribute__((always_inline))
#define UNROLL _Pragma("unroll")
#define CBAR asm volatile("" ::: "memory")
#define ATT_SDEPTH 1
#define ATT_NQREG 6
constexpr int NTHR_ = 512;
typedef float4 f4;
HD inline f4 ldf4(const float* p) { return *(const float4*)p; }
constexpr int LDS_TOTAL_BYTES = 147456, TID_TAB_OFF = LDS_TOTAL_BYTES - 64 - 256;
__device__ __forceinline__ unsigned hw_slot() { return (unsigned)__builtin_amdgcn_s_getreg((5 << 11) | 4) & 63u; }
__device__ __forceinline__ int tidx_() {
    const int w = *(volatile __attribute__((address_space(3))) int*)(__attribute__((address_space(3))) char*)(unsigned long)(TID_TAB_OFF + 4u * hw_slot());
    int lane; asm volatile("v_mbcnt_lo_u32_b32 %0, -1, 0\n\tv_mbcnt_hi_u32_b32 %0, -1, %0" : "=v"(lane));
    return (__builtin_amdgcn_readfirstlane(w) << 6) | lane;
}
#define TIDX tidx_()
namespace cfg {
#ifdef SMALL_CFG
constexpr int D = 128, NB = 2, SEQ = 128, L = 2, NDB = 2, DSEQ = 256, PAST = 128, GRIDW = 16;
constexpr int AH = 2, AN = 64, DL = 16, IL = 16, GL = 32;
constexpr int BH = 2, QR = 64, KVR = 64, NOPE = 32, ROPE = 16, VD = 32;
constexpr int CH = 2, DK = 32, DV = 32, CHUNK = 64;
constexpr int DFF = 192;
#else
constexpr int D = 2048, NB = 16, SEQ = 256, L = 4, NDB = 2, DSEQ = 4096, PAST = 256, GRIDW = 64;
constexpr int AH = 8, AN = 64, DL = 64, IL = 64, GL = 128;
constexpr int BH = 8, QR = 512, KVR = 512, NOPE = 128, ROPE = 64, VD = 128;
constexpr int CH = 4, DK = 128, DV = 128, CHUNK = 64;
constexpr int DFF = 5632;
#endif
constexpr int AW = AH * AN, BW = BH * VD, CW = CH * DV, QKD = NOPE + ROPE, MIXW = AW + BW + CW;
constexpr int OFF_R = 0, OFF_K = AW, OFF_V = 2 * AW, OFF_WLO = 3 * AW, OFF_ALO = OFF_WLO + 2 * DL, OFF_GLO = OFF_ALO + 2 * IL,
              OFF_CQ = OFF_GLO + GL, OFF_CKV = OFF_CQ + QR, OFF_KPE = OFF_CKV + KVR, OFF_GQ = OFF_KPE + ROPE, OFF_GK = OFF_GQ + CH * DK,
              OFF_GV = OFF_GK + CH * DK, OFF_GZ = OFF_GV + CW, OFF_GB = OFF_GZ + CW, OFF_GA = OFF_GB + 2 * CH, INC = OFF_GA + 2 * CH;
constexpr int INP = (INC + 255) / 256 * 256;
constexpr int NSEQ = NB + NDB, MCTX = NB * SEQ, MLAT = NDB * DSEQ, MTOK = MCTX + MLAT, MKV = MTOK + NDB * PAST, NCOND = 1 + NDB;
constexpr int NQ = BH * QKD, NKV = BH * NOPE + BH * VD, NUP = 2 * DFF, GC = 2 * CH * DK + CW;
constexpr int LINK = 2 * DL + 2 * IL + GL, LORAN = 5 * AW;
constexpr float RMS_EPS = 1e-6f, LNX_EPS = 64e-5f, L2_EPS = 1e-6f, ROPE_BASE = 10000.0f;
}
using namespace cfg;

#ifdef HOSTEMU
typedef float act_t;
struct act2 { float x, y; };
HD inline float a2f(act_t a) { return a; }
HD inline act_t f2a(float f) { return f; }
HD inline act2 ld2(const act_t* p) { act2 r; r.x = p[0]; r.y = p[1]; return r; }
HD inline act2 mk2(float x, float y) { act2 r; r.x = x; r.y = y; return r; }
HD inline float dot2(act2 a, act2 b, float c) { return c + a.x * b.x + a.y * b.y; }
HD inline float lo2(act2 a) { return a.x; }
HD inline float hi2(act2 a) { return a.y; }
#else
typedef unsigned short act_t;
typedef unsigned act2;
HD inline float a2f(act_t a) { return __uint_as_float(((unsigned)a) << 16); }
HD inline act_t f2a(float f) { unsigned u = __float_as_uint(f); return (act_t)((u + 0x7fffu + ((u >> 16) & 1u)) >> 16); }
HD inline act2 ld2(const act_t* p) { return *(const unsigned*)p; }
HD inline act2 mk2(float x, float y) { return (unsigned)f2a(x) | ((unsigned)f2a(y) << 16); }
HD inline float lo2(act2 a) { return __uint_as_float(a << 16); }
HD inline float hi2(act2 a) { return __uint_as_float(a & 0xffff0000u); }
typedef __bf16 bf16x2_t __attribute__((ext_vector_type(2)));
HD inline float dot2(act2 a, act2 b, float c) { return __builtin_amdgcn_fdot2_f32_bf16(__builtin_bit_cast(bf16x2_t, a), __builtin_bit_cast(bf16x2_t, b), c, false); }
HD inline float ldp1(const act_t* p) { return a2f(*p); }
HD inline float2 ldp2(const act_t* p) { const unsigned u = *(const unsigned*)p; return make_float2(lo2(u), hi2(u)); }
HD inline float4 ldp4(const act_t* p) { const uint2 u = *(const uint2*)p; return make_float4(lo2(u.x), hi2(u.x), lo2(u.y), hi2(u.y)); }
#endif

struct P {
    const float *x_prompt, *x_sample, *state_rwkv, *state_gdn, *cache_ckv, *cache_kpe, *c, *c_ctx, *ada_w, *ada_b, *norm1_g, *w_in,
        *rwkv_w0, *rwkv_w2, *rwkv_a0, *rwkv_a2, *rwkv_g2, *rwkv_kk, *rwkv_ka, *rwkv_rk, *rwkv_lnx_g, *rwkv_lnx_b, *mla_qnorm_g, *mla_w_uq,
        *mla_kvnorm_g, *mla_w_uk, *mla_w_uv, *gdn_conv, *gdn_a_log, *gdn_dt_bias, *gdn_norm_g, *w_out, *norm2_g, *ffn_up, *ffn_conv, *ffn_down,
        *final_norm_g;
    float* out;
    unsigned char* ws;
};

constexpr size_t O_YP = 0, O_YS = O_YP + (size_t)MCTX * D, O_SR = O_YS + (size_t)MLAT * D, O_SG = O_SR + (size_t)NB * L * 2 * AH * AN * AN,
                 O_CK = O_SG + (size_t)NB * L * 2 * CH * DK * DV, O_KP = O_CK + (size_t)NB * L * SEQ * KVR, O_END = O_KP + (size_t)NB * L * SEQ * ROPE;

constexpr size_t al256(size_t x) { return (x + 255) / 256 * 256; }
constexpr size_t WS_CTL = 0, WS_CTL_BYTES = 64 * 1024;
constexpr size_t WS_MOD = WS_CTL + WS_CTL_BYTES;
constexpr size_t WS_ROPE = al256(WS_MOD + (size_t)L * NCOND * 6 * D * 4);
constexpr size_t WS_X = al256(WS_ROPE + (size_t)DSEQ * ROPE * 4);
constexpr size_t WS_H = al256(WS_X + (size_t)MTOK * D * 4);
constexpr size_t WS_YMIX = al256(WS_H + (size_t)MTOK * D * sizeof(act_t));
constexpr size_t WT_IN = 0, WT_UQ = WT_IN + (size_t)INP * D, WT_UKV = WT_UQ + (size_t)NQ * QR, WT_OUT = WT_UKV + (size_t)NKV * KVR,
                 WT_UP = WT_OUT + (size_t)D * MIXW, WT_DOWN = WT_UP + (size_t)NUP * D, WT_LORA = WT_DOWN + (size_t)D * DFF, WT_LAYER = WT_LORA + (size_t)LORAN * LINK;
constexpr size_t WS_WT = al256(WS_YMIX + (size_t)MTOK * MIXW * sizeof(act_t));
constexpr size_t WS_U0 = al256(WS_WT + (size_t)L * WT_LAYER * 2);
constexpr size_t WS_PP = WS_U0;
#ifdef HOSTEMU
constexpr size_t WS_RWDEC = al256(WS_PP + (size_t)MTOK * INP * 4);
constexpr size_t WS_RWKDIR = al256(WS_RWDEC + (size_t)MTOK * 2 * AW * 4);
constexpr size_t WS_RWKKA = al256(WS_RWKDIR + (size_t)MTOK * 2 * AW * 4);
constexpr size_t WS_RWKK = al256(WS_RWKKA + (size_t)MTOK * 2 * AW * 4);
#ifdef HOSTEMU
constexpr size_t WS_RWG = al256(WS_RWKK + (size_t)MTOK * AW * 4);
constexpr size_t WS_RWY = al256(WS_RWG + (size_t)MTOK * AW * 4);
#else
constexpr size_t WS_RWY = al256(WS_RWKK + (size_t)MTOK * AW * 4);
constexpr size_t WS_RWG = WS_H;
#endif
constexpr size_t WS_CQN = al256(WS_RWY + (size_t)MTOK * 2 * AW * 4);
constexpr size_t WS_CKVN = al256(WS_CQN + (size_t)MTOK * QR * sizeof(act_t));
constexpr size_t WS_KR = al256(WS_CKVN + (size_t)MKV * KVR * sizeof(act_t));
constexpr size_t WS_QF = al256(WS_KR + (size_t)MKV * ROPE * sizeof(act_t));
constexpr size_t WS_KVUP = al256(WS_QF + (size_t)MTOK * NQ * sizeof(act_t));
constexpr size_t WS_GBG = al256(WS_KVUP + (size_t)MKV * NKV * sizeof(act_t));
constexpr size_t WS_GO = al256(WS_GBG + (size_t)MTOK * 2 * CH * 4 * 4);
constexpr size_t WS_GCONV = al256(WS_GO + (size_t)MTOK * 2 * CW * 4);
constexpr size_t WS_LIN = al256(WS_GCONV + (size_t)MTOK * GC * 4);
constexpr size_t WS_LORA = al256(WS_LIN + (size_t)MTOK * LINK * sizeof(act_t));
constexpr size_t WS_GCH = al256(WS_LORA + (size_t)MTOK * LORAN * 4);
constexpr size_t WS_RCH = WS_GCONV;
static_assert((size_t)(MTOK / 64) * 2 * AH * 65792 <= WS_GCH - WS_GCONV, "RWKV chunk slots must fit the dead prep buffers");
constexpr size_t WS_MIX_END = al256(WS_GCH + (size_t)(MTOK / 64) * 2 * CH * 73984);
#else
constexpr size_t WS_RWB = al256(WS_PP + (size_t)MTOK * INP * 4);
constexpr size_t WS_RWY = al256(WS_RWB + (size_t)MTOK * 2 * AH * 4);
constexpr size_t WS_RWG = WS_H;
constexpr size_t WS_CQN = al256(WS_RWY + (size_t)MTOK * 2 * AW * 4);
constexpr size_t WS_CKVN = al256(WS_CQN + (size_t)MTOK * QR * sizeof(act_t));
constexpr size_t WS_KR = al256(WS_CKVN + (size_t)MKV * KVR * sizeof(act_t));
constexpr size_t WS_QF = al256(WS_KR + (size_t)MKV * ROPE * sizeof(act_t));
constexpr size_t WS_KVUP = al256(WS_QF + (size_t)MTOK * NQ * sizeof(act_t));
constexpr size_t WS_GBG = al256(WS_KVUP + (size_t)MKV * NKV * sizeof(act_t));
constexpr size_t WS_GO = al256(WS_GBG + (size_t)MTOK * 2 * CH * 4 * 4);
constexpr size_t WS_LORA = al256(WS_GO + (size_t)MTOK * 2 * CW * 4);
constexpr size_t WS_GCH = al256(WS_LORA + (size_t)MTOK * LORAN * 4);
constexpr size_t WS_GCONV = al256(WS_GCH + (size_t)(MTOK / 64) * 2 * CH * 73984);
constexpr size_t WS_LIN = al256(WS_GCONV + (size_t)MTOK * GC * 4);
constexpr size_t WS_RCH = WS_GCONV;
constexpr size_t WS_MIX_END = al256(WS_RCH + (size_t)(MTOK / 64) * 2 * AH * 65792);
static_assert(WS_LIN + (size_t)MTOK * LINK * sizeof(act_t) <= WS_MIX_END, "LoRA inputs inside the RWKV slot region");
constexpr size_t WS_RWDEC = WS_RWY, WS_RWKDIR = WS_RWY, WS_RWKKA = WS_RWY, WS_RWKK = WS_RWY;
#endif
constexpr size_t WS_UP = WS_U0;
constexpr size_t WS_ACT = al256(WS_UP + (size_t)MTOK * NUP * sizeof(act_t));
constexpr size_t WS_FFN_END = al256(WS_ACT + (size_t)MTOK * DFF * sizeof(act_t));
constexpr size_t WS_SIDE = WS_MIX_END > WS_FFN_END ? WS_MIX_END : WS_FFN_END;
constexpr size_t WS_END = WS_SIDE + (size_t)(MTOK / 64) * 6 * DFF * 4;

HD inline int seq_of(int m) { return m < MCTX ? m / SEQ : NB + (m - MCTX) / DSEQ; }
HD inline int seq_start(int s) { return s < NB ? s * SEQ : MCTX + (s - NB) * DSEQ; }
HD inline int seq_len(int s) { return s < NB ? SEQ : DSEQ; }
HD inline int cond_of_seq(int s) { return s < NB ? 0 : 1 + (s - NB); }
#ifdef HOSTEMU
HD inline float fexp_(float x) { return expf(x); }
HD inline float sigmoidf_(float x) { return 1.0f / (1.0f + expf(-x)); }
HD inline float siluf_(float x) { return x / (1.0f + expf(-x)); }
HD inline float softplusf_(float x) { return fmaxf(x, 0.0f) + log1pf(expf(-fabsf(x))); }
HD inline float ftanh_(float x) { return tanhf(x); }
#else
HD inline float fexp_(float x) { return __builtin_amdgcn_exp2f(x * 1.4426950408889634f); }
HD inline float sigmoidf_(float x) { return __builtin_amdgcn_rcpf(1.0f + fexp_(-x)); }
HD inline float siluf_(float x) { return x * sigmoidf_(x); }
HD inline float softplusf_(float x) { return fmaxf(x, 0.0f) + 0.6931471805599453f * __builtin_amdgcn_logf(1.0f + fexp_(-fabsf(x))); }
HD inline float ftanh_(float x) { return 2.0f * sigmoidf_(2.0f * x) - 1.0f; }
#endif
HD inline const float* modp(const P& p, int l, int cond, int which) { return (const float*)(p.ws + WS_MOD) + ((size_t)(l * NCOND + cond) * 6 + which) * D; }

HD inline void rope_angle(int t, int i, float& cs, float& sn) {
    const int nf = ROPE / 4; const int row = t / GRIDW, col = t % GRIDW;
    const int f = i < nf ? i : i - nf;
    const float inv = powf(ROPE_BASE, -(float)f / (float)nf);
    const float ang = (float)(i < nf ? row : col) * inv;
    cs = cosf(ang); sn = sinf(ang);
}
HD inline void ph_init(const P& p, long gt, long gs) {
    float* x = (float*)(p.ws + WS_X);
    for (long i = gt; i < (long)MTOK * D; i += gs) x[i] = i < (long)MCTX * D ? p.x_prompt[i] : p.x_sample[i - (long)MCTX * D];
    float* rt = (float*)(p.ws + WS_ROPE);
    for (long i = gt; i < (long)DSEQ * (ROPE / 2); i += gs) { float cs, sn; rope_angle((int)(i / (ROPE / 2)), (int)(i % (ROPE / 2)), cs, sn); rt[2 * i] = cs; rt[2 * i + 1] = sn; }
    float* mod = (float*)(p.ws + WS_MOD);
    for (long idx = gt; idx < (long)L * 6 * D; idx += gs) {
        const int l = (int)(idx / (6 * D)), j = (int)(idx % (6 * D));
        float acc[NCOND];
        UNROLL for (int c = 0; c < NCOND; ++c) acc[c] = 0.f;
        for (int i = 0; i < D; ++i) {
            const float w = p.ada_w[((size_t)l * D + i) * 6 * D + j];
            acc[0] += siluf_(p.c_ctx[i]) * w;
            UNROLL for (int c = 1; c < NCOND; ++c) acc[c] += siluf_(p.c[(size_t)(c - 1) * D + i]) * w;
        }
        const float b = p.ada_b[(size_t)l * 6 * D + j];
        UNROLL for (int c = 0; c < NCOND; ++c) mod[((size_t)(l * NCOND + c) * 6) * D + j] = acc[c] + b;
    }
}

HD inline void ph_norm(const P& p, int l, int which, long gt, long gs) {
    const float* x = (const float*)(p.ws + WS_X);
    act_t* h = (act_t*)(p.ws + WS_H);
    const float* g = (which == 0 ? p.norm1_g : p.norm2_g) + (size_t)l * D;
    for (long m = gt; m < MTOK; m += gs) {
        const int cond = cond_of_seq(seq_of((int)m));
        const float* sh = modp(p, l, cond, which * 3 + 0);
        const float* sc = modp(p, l, cond, which * 3 + 1);
        const float* xr = x + (size_t)m * D;
        float ss = 0.f;
        for (int j = 0; j < D; ++j) ss += xr[j] * xr[j];
        const float rs = 1.0f / sqrtf(ss / D + RMS_EPS);
        for (int j = 0; j < D; ++j) h[(size_t)m * D + j] = f2a(xr[j] * rs * g[j] * (1.0f + sc[j]) + sh[j]);
    }
}

HD inline void ph_rwkv_prep(const P& p, int l, long gt, long gs) {
    const float* pp = (const float*)(p.ws + WS_PP);
    float* dec = (float*)(p.ws + WS_RWDEC); float* kdir = (float*)(p.ws + WS_RWKDIR); float* kka = (float*)(p.ws + WS_RWKKA);
    float* kkb = (float*)(p.ws + WS_RWKK); float* gb = (float*)(p.ws + WS_RWG);
    for (long idx = gt; idx < (long)MTOK * AW; idx += gs) {
        const int m = (int)(idx / AW), c = (int)(idx % AW), h = c / AN;
        const float* pr = pp + (size_t)m * INP;
        const float* kksc = p.rwkv_kk + (size_t)l * AW;
        float ss = 0.f;
        for (int j = 0; j < AN; ++j) { const float t = pr[OFF_K + h * AN + j] * kksc[h * AN + j]; ss += t * t; }
        const float kraw = pr[OFF_K + c];
        const float kk = kraw * kksc[c] / sqrtf(ss + L2_EPS);
        kkb[(size_t)m * AW + c] = kk;
        for (int d = 0; d < 2; ++d) {
            float wpre = p.rwkv_w0[((size_t)l * 2 + d) * AW + c];
            for (int r = 0; r < DL; ++r) wpre += tanhf(pr[OFF_WLO + d * DL + r]) * p.rwkv_w2[(((size_t)l * 2 + d) * DL + r) * AW + c];
            const float logw = -expf(-softplusf_(-wpre) - 0.5f);
            float apre = p.rwkv_a0[((size_t)l * 2 + d) * AW + c];
            for (int r = 0; r < IL; ++r) apre += pr[OFF_ALO + d * IL + r] * p.rwkv_a2[(((size_t)l * 2 + d) * IL + r) * AW + c];
            const float a = sigmoidf_(apre);
            const size_t o = ((size_t)m * 2 + d) * AW + c;
            dec[o] = expf(logw);
            kdir[o] = kraw * (1.0f + (a - 1.0f) * p.rwkv_ka[(size_t)l * AW + c]);
            kka[o] = kk * a;
        }
        float g = 0.f;
        for (int r = 0; r < GL; ++r) g += sigmoidf_(pr[OFF_GLO + r]) * p.rwkv_g2[((size_t)l * GL + r) * AW + c];
        gb[(size_t)m * AW + c] = g;
    }
}

HD inline void ph_rwkv_scan(const P& p, int l, long gt, long gs) {
    const float* pp = (const float*)(p.ws + WS_PP);
    const float* dec = (const float*)(p.ws + WS_RWDEC); const float* kdir = (const float*)(p.ws + WS_RWKDIR); const float* kka = (const float*)(p.ws + WS_RWKKA);
    const float* kkb = (const float*)(p.ws + WS_RWKK); float* yb = (float*)(p.ws + WS_RWY);
    for (long idx = gt; idx < (long)NSEQ * 2 * AH * AN; idx += gs) {
        const int i = (int)(idx % AN), h = (int)((idx / AN) % AH), d = (int)((idx / (AN * AH)) % 2), s = (int)(idx / (AN * AH * 2));
        float S[AN];
        if (s >= NB) { const float* s0 = p.state_rwkv + (((((size_t)(s - NB) * L + l) * 2 + d) * AH + h) * AN + i) * AN; UNROLL for (int k = 0; k < AN; ++k) S[k] = s0[k]; }
        else { UNROLL for (int k = 0; k < AN; ++k) S[k] = 0.f; }
        const int T = seq_len(s), base = seq_start(s);
        for (int step = 0; step < T; ++step) {
            const int m = base + (d == 0 ? step : T - 1 - step);
            const float* pr = pp + (size_t)m * INP;
            const float* kk = kkb + (size_t)m * AW + h * AN;
            const size_t o = ((size_t)m * 2 + d) * AW + h * AN;
            float sa = 0.f;
            UNROLL for (int k = 0; k < AN; k += 4) { const f4 t = ldf4(kk + k); sa -= S[k] * t.x + S[k + 1] * t.y + S[k + 2] * t.z + S[k + 3] * t.w; }
            const float vi = pr[OFF_V + h * AN + i];
            float y = 0.f;
            UNROLL for (int k = 0; k < AN; k += 4) {
                const f4 w4 = ldf4(dec + o + k), a4 = ldf4(kka + o + k), k4 = ldf4(kdir + o + k), r4 = ldf4(pr + OFF_R + h * AN + k);
                S[k] = S[k] * w4.x + sa * a4.x + vi * k4.x; y += S[k] * r4.x;
                S[k + 1] = S[k + 1] * w4.y + sa * a4.y + vi * k4.y; y += S[k + 1] * r4.y;
                S[k + 2] = S[k + 2] * w4.z + sa * a4.z + vi * k4.z; y += S[k + 2] * r4.z;
                S[k + 3] = S[k + 3] * w4.w + sa * a4.w + vi * k4.w; y += S[k + 3] * r4.w;
            }
            yb[o + i] = y;
        }
        if (s < NB) { float* so = p.out + O_SR + (((((size_t)s * L + l) * 2 + d) * AH + h) * AN + i) * AN; UNROLL for (int k = 0; k < AN; ++k) so[k] = S[k]; }
    }
}

HD inline void ph_rwkv_post(const P& p, int l, long gt, long gs) {
    const float* pp = (const float*)(p.ws + WS_PP);
    const float* kdir = (const float*)(p.ws + WS_RWKDIR); const float* gb = (const float*)(p.ws + WS_RWG); const float* yb = (const float*)(p.ws + WS_RWY);
    act_t* ymix = (act_t*)(p.ws + WS_YMIX);
    for (long idx = gt; idx < (long)MTOK * AW; idx += gs) {
        const int m = (int)(idx / AW), c = (int)(idx % AW), h = c / AN;
        const float* pr = pp + (size_t)m * INP;
        const float* y0 = yb + ((size_t)m * 2 + 0) * AW + h * AN; const float* y1 = yb + ((size_t)m * 2 + 1) * AW + h * AN;
        float mu = 0.f;
        for (int j = 0; j < AN; ++j) mu += y0[j] + y1[j];
        mu /= AN;
        float var = 0.f;
        for (int j = 0; j < AN; ++j) { const float t = y0[j] + y1[j] - mu; var += t * t; }
        var /= AN;
        const float yc = yb[((size_t)m * 2 + 0) * AW + c] + yb[((size_t)m * 2 + 1) * AW + c];
        float y = (yc - mu) / sqrtf(var + LNX_EPS) * p.rwkv_lnx_g[(size_t)l * AW + c] + p.rwkv_lnx_b[(size_t)l * AW + c];
        float bon = 0.f;
        for (int d = 0; d < 2; ++d) for (int j = 0; j < AN; ++j)
            bon += pr[OFF_R + h * AN + j] * kdir[((size_t)m * 2 + d) * AW + h * AN + j] * p.rwkv_rk[((size_t)l * AH + h) * AN + j];
        y += bon * pr[OFF_V + c];
        ymix[(size_t)m * MIXW + c] = f2a(y * gb[(size_t)m * AW + c]);
    }
}

HD inline void ph_mla_prep(const P& p, int l, long gt, long gs) {
    const float* pp = (const float*)(p.ws + WS_PP);
    act_t* cqn = (act_t*)(p.ws + WS_CQN); act_t* ckvn = (act_t*)(p.ws + WS_CKVN); act_t* kr = (act_t*)(p.ws + WS_KR);
    for (long m = gt; m < MKV; m += gs) {
        if (m < MTOK) {
            const float* pr = pp + (size_t)m * INP;
            const int s = seq_of((int)m), t = (int)m - seq_start(s);
            float ss = 0.f;
            for (int j = 0; j < QR; ++j) ss += pr[OFF_CQ + j] * pr[OFF_CQ + j];
            float rs = 1.0f / sqrtf(ss / QR + RMS_EPS);
            for (int j = 0; j < QR; ++j) cqn[(size_t)m * QR + j] = f2a(pr[OFF_CQ + j] * rs * p.mla_qnorm_g[(size_t)l * QR + j]);
            ss = 0.f;
            for (int j = 0; j < KVR; ++j) ss += pr[OFF_CKV + j] * pr[OFF_CKV + j];
            rs = 1.0f / sqrtf(ss / KVR + RMS_EPS);
            for (int j = 0; j < KVR; ++j) {
                const float v = pr[OFF_CKV + j] * rs * p.mla_kvnorm_g[(size_t)l * KVR + j];
                ckvn[(size_t)m * KVR + j] = f2a(v);
                if (s < NB) p.out[O_CK + (((size_t)s * L + l) * SEQ + t) * KVR + j] = v;
            }
            if (s < NB) {
                for (int j = 0; j < ROPE; ++j) { const float v = pr[OFF_KPE + j]; kr[(size_t)m * ROPE + j] = f2a(v); p.out[O_KP + (((size_t)s * L + l) * SEQ + t) * ROPE + j] = v; }
            } else {
                for (int i = 0; i < ROPE / 2; ++i) {
                    float cs, sn; rope_angle(t, i, cs, sn);
                    const float xe = pr[OFF_KPE + 2 * i], xo = pr[OFF_KPE + 2 * i + 1];
                    kr[(size_t)m * ROPE + 2 * i] = f2a(xe * cs - xo * sn); kr[(size_t)m * ROPE + 2 * i + 1] = f2a(xe * sn + xo * cs);
                }
            }
        } else {
            const int r = (int)m - MTOK, b = r / PAST, j0 = r % PAST;
            const float* ck = p.cache_ckv + (((size_t)b * L + l) * PAST + j0) * KVR;
            for (int j = 0; j < KVR; ++j) ckvn[(size_t)m * KVR + j] = f2a(ck[j]);
            const float* kp = p.cache_kpe + (((size_t)b * L + l) * PAST + j0) * ROPE;
            for (int j = 0; j < ROPE; ++j) kr[(size_t)m * ROPE + j] = f2a(kp[j]);
        }
    }
}

constexpr int VSL = 32, NVS = VD / VSL;
HD inline void ph_attn(const P& p, int l, long gt, long gs) {
    (void)l;
    const act_t* qf = (const act_t*)(p.ws + WS_QF); const act_t* kvup = (const act_t*)(p.ws + WS_KVUP); const act_t* kr = (const act_t*)(p.ws + WS_KR);
    act_t* ymix = (act_t*)(p.ws + WS_YMIX);
    const float scale = 1.0f / sqrtf((float)QKD);
    for (long idx = gt; idx < (long)MTOK * BH * NVS; idx += gs) {
        const int m = (int)(idx % MTOK), vs = (int)((idx / MTOK) % NVS), h = (int)(idx / ((long)MTOK * NVS));
        const int s = seq_of(m), base = seq_start(s), t = m - base, T = seq_len(s);
        const bool lat = s >= NB;
        act2 q[QKD / 2];
        const act_t* qr = qf + (size_t)m * NQ + h * QKD;
        UNROLL for (int i = 0; i < NOPE / 2; ++i) q[i] = ld2(qr + 2 * i);
        UNROLL for (int i = 0; i < ROPE / 2; ++i) {
            const act2 v = ld2(qr + NOPE + 2 * i);
            if (lat) { float cs, sn; rope_angle(t, i, cs, sn); const float xe = lo2(v), xo = hi2(v); q[NOPE / 2 + i] = mk2(xe * cs - xo * sn, xe * sn + xo * cs); }
            else q[NOPE / 2 + i] = v;
        }
        float mx = -1e30f, sum = 0.f, acc[VSL];
        UNROLL for (int e = 0; e < VSL; ++e) acc[e] = 0.f;
        const int nk = T + (lat ? PAST : 0);
        for (int j = 0; j < nk; ++j) {
            const size_t krow = j < T ? (size_t)(base + j) : (size_t)(MTOK + (s - NB) * PAST + (j - T));
            const act_t* kn = kvup + krow * NKV + h * NOPE;
            const act_t* kp = kr + krow * ROPE;
            float sc = 0.f;
            UNROLL for (int i = 0; i < NOPE / 2; ++i) { if ((i & 15) == 0) CBAR; sc = dot2(q[i], ld2(kn + 2 * i), sc); }
            UNROLL for (int i = 0; i < ROPE / 2; ++i) { if ((i & 15) == 0) CBAR; sc = dot2(q[NOPE / 2 + i], ld2(kp + 2 * i), sc); }
            CBAR;
            sc *= scale;
            if (sc > mx) { const float corr = expf(mx - sc); sum *= corr; UNROLL for (int e = 0; e < VSL; ++e) acc[e] *= corr; mx = sc; }
            const float pe = expf(sc - mx);
            sum += pe;
            const act_t* vv = kvup + krow * NKV + BH * NOPE + h * VD + vs * VSL;
            UNROLL for (int e = 0; e < VSL; e += 2) { const act2 v2 = ld2(vv + e); acc[e] += pe * lo2(v2); acc[e + 1] += pe * hi2(v2); }
        }
        const float inv = 1.0f / sum;
        UNROLL for (int e = 0; e < VSL; ++e) ymix[(size_t)m * MIXW + AW + h * VD + vs * VSL + e] = f2a(acc[e] * inv);
    }
}

HD inline void ph_gdn_conv(const P& p, int l, long gt, long gs) {
    const float* pp = (const float*)(p.ws + WS_PP);
    float* gc = (float*)(p.ws + WS_GCONV);
    for (long idx = gt; idx < (long)MTOK * GC; idx += gs) {
        const int m = (int)(idx / GC), c = (int)(idx % GC);
        const int s = seq_of(m), base = seq_start(s), t = m - base, T = seq_len(s);
        const float* w = p.gdn_conv + (size_t)l * 3 * GC;
        float a = w[GC + c] * pp[(size_t)m * INP + OFF_GQ + c];
        if (t > 0) a += w[c] * pp[(size_t)(m - 1) * INP + OFF_GQ + c];
        if (t < T - 1) a += w[2 * GC + c] * pp[(size_t)(m + 1) * INP + OFF_GQ + c];
        gc[(size_t)m * GC + c] = siluf_(a);
    }
}
HD inline void ph_gdn_norm(const P& p, int l, long gt, long gs) {
    const float* pp = (const float*)(p.ws + WS_PP);
    float* gc = (float*)(p.ws + WS_GCONV); float* bg = (float*)(p.ws + WS_GBG);
    for (long idx = gt; idx < (long)MTOK * 4 * CH; idx += gs) {
        const int m = (int)(idx / (4 * CH)), j = (int)(idx % (4 * CH));
        if (j < 2 * CH) {
            float* v = gc + (size_t)m * GC + j * DK;
            float ss = 0.f;
            for (int e = 0; e < DK; ++e) ss += v[e] * v[e];
            const float rs = (1.0f / sqrtf(ss + L2_EPS)) * (j < CH ? 1.0f / sqrtf((float)DK) : 1.0f);
            for (int e = 0; e < DK; ++e) v[e] *= rs;
        } else {
            const int dh = j - 2 * CH;
            const float* pr = pp + (size_t)m * INP;
            const float beta = sigmoidf_(pr[OFF_GB + dh]);
            const float g = -expf(p.gdn_a_log[(size_t)l * 2 * CH + dh]) * softplusf_(pr[OFF_GA + dh] + p.gdn_dt_bias[(size_t)l * 2 * CH + dh]);
            bg[((size_t)m * 2 * CH + dh) * 4 + 0] = beta; bg[((size_t)m * 2 * CH + dh) * 4 + 1] = g;
        }
    }
}
HD inline void ph_gdn_scan(const P& p, int l, long gt, long gs) {
    const float* gc = (const float*)(p.ws + WS_GCONV); const float* bg = (const float*)(p.ws + WS_GBG); float* go = (float*)(p.ws + WS_GO);
    for (long idx = gt; idx < (long)NSEQ * 2 * CH * DV; idx += gs) {
        const int e = (int)(idx % DV), h = (int)((idx / DV) % CH), d = (int)((idx / (DV * CH)) % 2), s = (int)(idx / (DV * CH * 2));
        float S[DK];
        if (s >= NB) { const float* s0 = p.state_gdn + ((((size_t)(s - NB) * L + l) * 2 + d) * CH + h) * DK * DV + e; UNROLL for (int k = 0; k < DK; ++k) S[k] = s0[(size_t)k * DV]; }
        else { UNROLL for (int k = 0; k < DK; ++k) S[k] = 0.f; }
        const int T = seq_len(s), base = seq_start(s);
        for (int step = 0; step < T; ++step) {
            const int m = base + (d == 0 ? step : T - 1 - step);
            const float* q = gc + (size_t)m * GC + h * DK; const float* k = gc + (size_t)m * GC + CH * DK + h * DK;
            const float v = gc[(size_t)m * GC + 2 * CH * DK + h * DV + e];
            const float beta = bg[((size_t)m * 2 * CH + d * CH + h) * 4 + 0], eg = expf(bg[((size_t)m * 2 * CH + d * CH + h) * 4 + 1]);
            float kS = 0.f;
            UNROLL for (int j = 0; j < DK; j += 4) { if ((j & 15) == 0) CBAR; const f4 t = ldf4(k + j); kS += t.x * S[j] + t.y * S[j + 1] + t.z * S[j + 2] + t.w * S[j + 3]; }
            const float coef = beta * (v - eg * kS);
            float o = 0.f;
            UNROLL for (int j = 0; j < DK; j += 4) {
                if ((j & 15) == 0) CBAR;
                const f4 t = ldf4(k + j), u = ldf4(q + j);
                S[j] = eg * S[j] + t.x * coef; o += u.x * S[j];
                S[j + 1] = eg * S[j + 1] + t.y * coef; o += u.y * S[j + 1];
                S[j + 2] = eg * S[j + 2] + t.z * coef; o += u.z * S[j + 2];
                S[j + 3] = eg * S[j + 3] + t.w * coef; o += u.w * S[j + 3];
            }
            go[((size_t)m * 2 + d) * CW + h * DV + e] = o;
        }
        if (s < NB) { float* so = p.out + O_SG + ((((size_t)s * L + l) * 2 + d) * CH + h) * DK * DV + e; UNROLL for (int k = 0; k < DK; ++k) so[(size_t)k * DV] = S[k]; }
    }
}
HD inline void ph_gdn_post(const P& p, int l, long gt, long gs) {
    const float* pp = (const float*)(p.ws + WS_PP); const float* go = (const float*)(p.ws + WS_GO);
    act_t* ymix = (act_t*)(p.ws + WS_YMIX);
    for (long idx = gt; idx < (long)MTOK * CH; idx += gs) {
        const int m = (int)(idx / CH), h = (int)(idx % CH);
        const float* o0 = go + ((size_t)m * 2 + 0) * CW + h * DV; const float* o1 = go + ((size_t)m * 2 + 1) * CW + h * DV;
        float ss = 0.f;
        for (int e = 0; e < DV; ++e) { const float t = o0[e] + o1[e]; ss += t * t; }
        const float rs = 1.0f / sqrtf(ss / DV + RMS_EPS);
        for (int e = 0; e < DV; ++e) {
            const float z = pp[(size_t)m * INP + OFF_GZ + h * DV + e];
            ymix[(size_t)m * MIXW + AW + BW + h * DV + e] = f2a((o0[e] + o1[e]) * rs * p.gdn_norm_g[(size_t)l * DV + e] * siluf_(z));
        }
    }
}
HD inline void ph_ffn_act(const P& p, int l, long gt, long gs) {
    const act_t* up = (const act_t*)(p.ws + WS_UP); act_t* act = (act_t*)(p.ws + WS_ACT);
    for (long idx = gt; idx < (long)MTOK * DFF; idx += gs) {
        const int m = (int)(idx / DFF), c = (int)(idx % DFF);
        const int s = seq_of(m), base = seq_start(s), t = m - base, T = seq_len(s);
        const float* w = p.ffn_conv + (size_t)l * 3 * DFF;
        float a = w[DFF + c] * a2f(up[(size_t)m * NUP + c]);
        if (t > 0) a += w[c] * a2f(up[(size_t)(m - 1) * NUP + c]);
        if (t < T - 1) a += w[2 * DFF + c] * a2f(up[(size_t)(m + 1) * NUP + c]);
        act[(size_t)m * DFF + c] = f2a(siluf_(a) * a2f(up[(size_t)m * NUP + DFF + c]));
    }
}
HD inline void ph_final(const P& p, long gt, long gs) {
    const float* x = (const float*)(p.ws + WS_X);
    for (long m = gt; m < MTOK; m += gs) {
        const float* xr = x + (size_t)m * D;
        float ss = 0.f;
        for (int j = 0; j < D; ++j) ss += xr[j] * xr[j];
        const float rs = 1.0f / sqrtf(ss / D + RMS_EPS);
        for (int j = 0; j < D; ++j) p.out[O_YP + (size_t)m * D + j] = xr[j] * rs * p.final_norm_g[j];
    }
}
HD inline void ph_gemm_naive(const P& p, const act_t* A, int lda, const float* W, int ldw, int M, int N, int K, int mode, float* Cf, act_t* Ca, int ldc, int l, int which,
                             long gt, long gs) {
    for (long idx = gt; idx < (long)M * N; idx += gs) {
        const int m = (int)(idx / N), n = (int)(idx % N);
        float acc = 0.f;
        for (int k = 0; k < K; ++k) acc += a2f(A[(size_t)m * lda + k]) * W[(size_t)k * ldw + n];
        if (mode == 0) Cf[(size_t)m * ldc + n] = acc;
        else if (mode == 1) Ca[(size_t)m * ldc + n] = f2a(acc);
        else { const float* gate = modp(p, l, cond_of_seq(seq_of(m)), which); Cf[(size_t)m * ldc + n] += gate[n] * acc; }
    }
}
namespace pg8 {
#define PG8_LAS __attribute__((address_space(3)))
typedef unsigned short bf16_t;
typedef short bf16x8 __attribute__((ext_vector_type(8)));
typedef float f32x4 __attribute__((ext_vector_type(4)));
typedef unsigned u32x4 __attribute__((ext_vector_type(4)));
constexpr int BM = 256, BK = 64, HALF = 128, HTB = HALF * BK * 2  , STAGE_BYTES = 8 * HTB, NXCD = 8, WGM = 8;

__host__ __device__ __forceinline__ int lds_byte(int r, int c) { const int st = (r >> 4) * 2 + (c >> 5), rr = r & 15, cc = c & 31, ob = rr * 64 + cc * 2; return st * 1024 + (ob ^ (((ob >> 9) & 1) << 5)); }
__host__ __device__ __forceinline__ void stage_rc(int b, int& R, int& C) { const int st = b / 1024, sb = b % 1024, swz = sb ^ (((sb >> 9) & 1) << 5); R = (st >> 1) * 16 + swz / 64; C = (st & 1) * 32 + (swz % 64) / 2; }
__host__ __device__ __forceinline__ int perm32(int rho) { const int n = rho >> 4, i = rho & 15; return 8 * (i >> 2) + 4 * n + (i & 3); }

struct Unit { int pm, pn; };
struct Gemm { const bf16_t* A; const bf16_t* Bt; int M, N, K, ld; };

struct StaticOrder {
    int nM, nN, nwg, G, c;
    __host__ __device__ void init(int M, int N, int G_, int c_) { nM = M / BM; nN = N / BM; nwg = nM * nN; G = G_; c = c_; }
    __host__ __device__ bool next(int i, Unit& u) const {
        const long L = (long)i * G + c; if (L >= nwg) return false;
        int wgid = (int)L; { const int q = nwg / NXCD, r = nwg % NXCD, xcd = wgid % NXCD, off = wgid / NXCD; wgid = (xcd < r ? xcd * (q + 1) : r * (q + 1) + (xcd - r) * q) + off; }
        const int nig = WGM * nN, gid = wgid / nig, fm = gid * WGM, gsz = (nM - fm) < WGM ? (nM - fm) : WGM;
        u.pm = fm + ((wgid % nig) % gsz); u.pn = (wgid % nig) / gsz; return true;
    }
    __device__ __forceinline__ void a_ready(const Unit&) const {}
    __device__ __forceinline__ void done(const Unit&) const {}
};
struct CountedOrder : StaticOrder {
    const unsigned* ready; unsigned need; unsigned* tmo;
    __device__ __forceinline__ void a_ready(const Unit& u) const {
        if (TIDX < 64) {
            const unsigned long long t0 = __builtin_amdgcn_s_memrealtime(); unsigned polls = 0;
            while ((unsigned)__builtin_amdgcn_readfirstlane(__hip_atomic_load(ready + 64 * u.pm, __ATOMIC_RELAXED, __HIP_MEMORY_SCOPE_AGENT)) < need) {
                if ((++polls & 255u) == 0u && __builtin_amdgcn_readfirstlane(__hip_atomic_load(tmo, __ATOMIC_RELAXED, __HIP_MEMORY_SCOPE_AGENT)) != 0u) break;
                if (__builtin_amdgcn_s_memrealtime() - t0 > 2000000ull) {
                    if (TIDX == 0) { unsigned expect = 0u; __hip_atomic_compare_exchange_strong(tmo + 1, &expect, 0x600u | (unsigned)(u.pm & 0xff), __ATOMIC_RELAXED, __ATOMIC_RELAXED, __HIP_MEMORY_SCOPE_AGENT); __hip_atomic_store(tmo, 1u, __ATOMIC_RELAXED, __HIP_MEMORY_SCOPE_AGENT); }
                    break; }
                __builtin_amdgcn_s_sleep(2); }
            __builtin_amdgcn_fence(__ATOMIC_ACQUIRE, "agent");
            asm volatile("s_waitcnt vmcnt(0)" ::: "memory");
        }
#if !defined(BROKEN_HOOK_NO_BARRIER)
        asm volatile("" ::: "memory"); __builtin_amdgcn_s_barrier(); asm volatile("" ::: "memory");
#endif
    }
};

__device__ __forceinline__ unsigned cvt_pk_bf16(float lo, float hi) { unsigned r; asm volatile("v_cvt_pk_bf16_f32 %0, %1, %2" : "=v"(r) : "v"(lo), "v"(hi)); return r; }
typedef float f32x2 __attribute__((ext_vector_type(2)));
__device__ __forceinline__ f32x2 gelu_pk(f32x2 v) {
    const f32x2 av = __builtin_elementwise_abs(v), d = av * 0.2316418882f + 1.0f;
    f32x2 t; t.x = __builtin_amdgcn_rcpf(d.x); t.y = __builtin_amdgcn_rcpf(d.y);
    f32x2 q = t * 0.5307027145f + (-0.7265760135f); q = q * t + 0.7107068705f; q = q * t + (-0.142248368f); q = q * t + 0.127414796f; q = q * t;
    const f32x2 s = (v * v) * (-0.72134752044f);
    f32x2 e; e.x = __builtin_amdgcn_exp2f(s.x); e.y = __builtin_amdgcn_exp2f(s.y);
    const f32x2 m = v * (q * e), r = v - m;
    f32x2 o; o.x = v.x < 0.f ? m.x : r.x; o.y = v.y < 0.f ? m.y : r.y; return o;
}

struct EpiF32 {
    static constexpr bool PERM = false, AFTER_DRAIN = false;
    float* C; int ldc; const float* bias;
    __device__ __forceinline__ void operator()(const f32x4 (&acc)[2][2][4][2], const Unit& u, int wr, int wc, int fr, int fq) const {
        const int row0 = u.pm * BM + wr * 64 + fr, col0 = u.pn * BM + wc * 32 + 4 * fq;
        f32x4 bv[2][2];
#pragma unroll
        for (int bj = 0; bj < 2; ++bj)
#pragma unroll
            for (int n = 0; n < 2; ++n) bv[bj][n] = bias ? *(const f32x4*)(bias + col0 + bj * HALF + n * 16) : (f32x4){0.f, 0.f, 0.f, 0.f};
#pragma unroll
        for (int ai = 0; ai < 2; ++ai)
#pragma unroll
            for (int m = 0; m < 4; ++m) { float* rowp = C + (size_t)(row0 + ai * HALF + m * 16) * ldc + col0;
#pragma unroll
                for (int bj = 0; bj < 2; ++bj)
#pragma unroll
                    for (int n = 0; n < 2; ++n) *(f32x4*)(rowp + bj * HALF + n * 16) = acc[ai][bj][m][n] + bv[bj][n]; }
    }
};
template <int ACT  > struct EpiBf16 {
    static constexpr bool PERM = true, AFTER_DRAIN = false;
    bf16_t* O; int ldc; const float* bias; int split_cols; size_t split_stride;
    __device__ __forceinline__ void operator()(const f32x4 (&acc)[2][2][4][2], const Unit& u, int wr, int wc, int fr, int fq) const {
        const int row0 = u.pm * BM + wr * 64 + fr; int colt = u.pn * BM; bf16_t* base = O;
        if (split_cols) { const int t = colt / split_cols; base += (size_t)t * split_stride; colt -= t * split_cols; }
        const int col0 = colt + wc * 32 + 8 * fq, bcol0 = u.pn * BM + wc * 32 + 8 * fq;
        f32x4 bv[2][2];
#pragma unroll
        for (int bj = 0; bj < 2; ++bj)
#pragma unroll
            for (int n = 0; n < 2; ++n) bv[bj][n] = bias ? *(const f32x4*)(bias + bcol0 + bj * HALF + 4 * n) : (f32x4){0.f, 0.f, 0.f, 0.f};
#pragma unroll
        for (int ai = 0; ai < 2; ++ai)
#pragma unroll
            for (int m = 0; m < 4; ++m) { bf16_t* rowp = base + (size_t)(row0 + ai * HALF + m * 16) * ldc + col0;
#pragma unroll
                for (int bj = 0; bj < 2; ++bj) { f32x4 v0 = acc[ai][bj][m][0] + bv[bj][0], v1 = acc[ai][bj][m][1] + bv[bj][1];
                    if (ACT == 1) { f32x2 a = gelu_pk((f32x2){v0[0], v0[1]}), b = gelu_pk((f32x2){v0[2], v0[3]}), c = gelu_pk((f32x2){v1[0], v1[1]}), d = gelu_pk((f32x2){v1[2], v1[3]});
                        v0 = (f32x4){a.x, a.y, b.x, b.y}; v1 = (f32x4){c.x, c.y, d.x, d.y}; }
                    if (ACT == 2) {
#pragma unroll
                        for (int j = 0; j < 4; ++j) { v0[j] = 0.5f * v0[j] * (1.0f + erff(v0[j] * 0.70710678f)); v1[j] = 0.5f * v1[j] * (1.0f + erff(v1[j] * 0.70710678f)); } }
                    u32x4 w; w.x = cvt_pk_bf16(v0[0], v0[1]); w.y = cvt_pk_bf16(v0[2], v0[3]); w.z = cvt_pk_bf16(v1[0], v1[1]); w.w = cvt_pk_bf16(v1[2], v1[3]);
                    *(u32x4*)(rowp + bj * HALF) = w; } }
    }
};

template <class Epi, class Sched, bool STAMP = false>
__device__ __forceinline__ void gemm_phase(PG8_LAS unsigned char* lds, const Gemm g, const Sched& S, const Epi& E, unsigned long long* stamps) {
    int tid_ = TIDX; asm volatile("" : "+v"(tid_));
    const int tid = tid_, wid = __builtin_amdgcn_readfirstlane(tid >> 6), lane = tid & 63, wr = wid >> 2, wc = wid & 3, fr = lane & 15, fq = lane >> 4;
    const int K = g.ld, nt = g.K / BK;
    int ts_lo = 0, ts_hi = 0, nts = 0; const unsigned long long rt_entry = STAMP ? (unsigned long long)wall_clock64() : 0ull;
#define PG8_STAMP() do { if (STAMP && wid == 0 && nts < 64) { const unsigned long long _c = (unsigned long long)clock64(); \
        ts_lo = (lane == nts) ? (int)(unsigned)_c : ts_lo; ts_hi = (lane == nts) ? (int)(unsigned)(_c >> 32) : ts_hi; ++nts; } } while (0)
    PG8_STAMP();
    unsigned voffA[2], voffB[2];
#pragma unroll
    for (int i = 0; i < 2; ++i) { int R, C; stage_rc(tid * 16 + i * 8192, R, C); const int Rb = Epi::PERM ? ((R & ~31) + perm32(R & 31)) : R;
        voffA[i] = (unsigned)(R * K + C) * 2u; voffB[i] = (unsigned)(Rb * K + C) * 2u; }
    const size_t kstep = (size_t)(BK * 2);
    const size_t hstep = (size_t)HALF * K * 2;
    const size_t tstep = 2 * hstep;
    const unsigned ldsw = (unsigned)wid * 1024u;
    const int aoff = lds_byte(wr * 64 + fr, fq * 8), boff = lds_byte(wc * 32 + fr, fq * 8);
#define PG8_SA(b, h) (((b) * 2 + (h)) * HTB)
#define PG8_SB(b, h) ((4 + (b) * 2 + (h)) * HTB)
#define PG8_STAGE(bufoff, gbase, voff) do { _Pragma("unroll") for (int _i = 0; _i < 2; ++_i) \
        __builtin_amdgcn_global_load_lds((const unsigned*)((const char*)(gbase) + (voff)[_i]), (PG8_LAS unsigned*)(lds + (bufoff) + ldsw + _i * 8192), 16, 0, 0); } while (0)
#define PG8_LDA(dst, b, h) do { _Pragma("unroll") for (int m = 0; m < 4; ++m) _Pragma("unroll") for (int k = 0; k < 2; ++k) dst[m][k] = *(const PG8_LAS bf16x8*)(lds + PG8_SA(b, h) + aoff + m * 2048 + k * 1024); } while (0)
#define PG8_LDB(dst, b, h) do { _Pragma("unroll") for (int n = 0; n < 2; ++n) _Pragma("unroll") for (int k = 0; k < 2; ++k) dst[n][k] = *(const PG8_LAS bf16x8*)(lds + PG8_SB(b, h) + boff + n * 2048 + k * 1024); } while (0)
#define PG8_MMA(ai, bj, At, Bt) do { __builtin_amdgcn_s_setprio(1); _Pragma("unroll") for (int m = 0; m < 4; ++m) _Pragma("unroll") for (int n = 0; n < 2; ++n) _Pragma("unroll") for (int k = 0; k < 2; ++k) \
        acc[ai][bj][m][n] = __builtin_amdgcn_mfma_f32_16x16x32_bf16(Bt[n][k], At[m][k], acc[ai][bj][m][n], 0, 0, 0); __builtin_amdgcn_s_setprio(0); } while (0)
#define PG8_WAIT_V(n) asm volatile("s_waitcnt vmcnt(" #n ")" ::: "memory")
#define PG8_WAIT_L(n) asm volatile("s_waitcnt lgkmcnt(" #n ")" ::: "memory")
#define PG8_BAR __builtin_amdgcn_s_barrier()
#define PG8_SCHED __builtin_amdgcn_sched_barrier(0)
    Unit cur, nxt; int ui = 0;
    if (!S.next(0, cur)) return;
    f32x4 acc[2][2][4][2];
#pragma unroll
    for (int a = 0; a < 2; ++a)
#pragma unroll
        for (int b = 0; b < 2; ++b)
#pragma unroll
            for (int m = 0; m < 4; ++m)
#pragma unroll
                for (int n = 0; n < 2; ++n) acc[a][b][m][n] = (f32x4){0.f, 0.f, 0.f, 0.f};
    bf16x8 At[4][2], B0[2][2], B1[2][2];
    const char* cA = (const char*)g.A + (size_t)cur.pm * tstep; const char* cB = (const char*)g.Bt + (size_t)cur.pn * tstep;
    S.a_ready(cur);
    PG8_STAGE(PG8_SB(0, 0), cB, voffB); PG8_STAGE(PG8_SA(0, 0), cA, voffA); PG8_STAGE(PG8_SB(0, 1), cB + hstep, voffB); PG8_STAGE(PG8_SA(0, 1), cA + hstep, voffA);
    if (wr == 1) PG8_BAR;
    PG8_WAIT_V(4); PG8_BAR;
    PG8_STAGE(PG8_SB(1, 0), cB + kstep, voffB); PG8_STAGE(PG8_SA(1, 0), cA + kstep, voffA); PG8_STAGE(PG8_SB(1, 1), cB + hstep + kstep, voffB);
    PG8_WAIT_V(6); PG8_BAR;
    PG8_STAMP();
    for (;;) {
        const bool has_next = S.next(ui + 1, nxt);
        const char* nA = has_next ? (const char*)g.A + (size_t)nxt.pm * tstep : cA; const char* nB = has_next ? (const char*)g.Bt + (size_t)nxt.pn * tstep : cB;
        for (int t = 0; t < nt; t += 2) {
            const bool last = (t == nt - 2);
            const char* a1 = cA + (size_t)(t + 1) * kstep;
            const char* a2 = last ? nA : cA + (size_t)(t + 2) * kstep; const char* b2 = last ? nB : cB + (size_t)(t + 2) * kstep;
            const char* a3 = a2 + kstep; const char* b3 = b2 + kstep;
            if (last && has_next) S.a_ready(nxt);
            PG8_LDB(B0, 0, 0); PG8_SCHED; PG8_LDA(At, 0, 0); PG8_STAGE(PG8_SA(1, 1), a1 + hstep, voffA);
            PG8_WAIT_L(8); PG8_BAR; PG8_WAIT_L(0); PG8_MMA(0, 0, At, B0); PG8_BAR; PG8_SCHED;
            PG8_LDB(B1, 0, 1); PG8_STAGE(PG8_SB(0, 0), b2, voffB);
            PG8_BAR; PG8_WAIT_L(0); PG8_MMA(0, 1, At, B1); PG8_BAR;
            PG8_LDA(At, 0, 1); PG8_STAGE(PG8_SA(0, 0), a2, voffA);
            PG8_BAR; PG8_WAIT_L(0); PG8_MMA(1, 0, At, B0); PG8_BAR; PG8_SCHED;
            PG8_STAGE(PG8_SB(0, 1), b2 + hstep, voffB);
            PG8_WAIT_V(6); PG8_BAR; PG8_MMA(1, 1, At, B1); PG8_BAR;
            PG8_LDB(B0, 1, 0); PG8_SCHED; PG8_LDA(At, 1, 0); PG8_STAGE(PG8_SA(0, 1), a2 + hstep, voffA);
            PG8_WAIT_L(8); PG8_BAR; PG8_WAIT_L(0); PG8_MMA(0, 0, At, B0); PG8_BAR; PG8_SCHED;
            PG8_LDB(B1, 1, 1); PG8_STAGE(PG8_SB(1, 0), b3, voffB);
            PG8_BAR; PG8_WAIT_L(0); PG8_MMA(0, 1, At, B1); PG8_BAR;
            PG8_LDA(At, 1, 1); PG8_STAGE(PG8_SA(1, 0), a3, voffA);
            PG8_BAR; PG8_WAIT_L(0); PG8_MMA(1, 0, At, B0); PG8_BAR; PG8_SCHED;
            PG8_STAGE(PG8_SB(1, 1), b3 + hstep, voffB);
            PG8_WAIT_V(6); PG8_BAR; PG8_MMA(1, 1, At, B1); PG8_BAR;
        }
        PG8_STAMP();
        if constexpr (!Epi::AFTER_DRAIN) { E(acc, cur, wr, wc, fr, fq); S.done(cur); }
        PG8_STAMP();
        if (!has_next) break;
#pragma unroll
        for (int a = 0; a < 2; ++a)
#pragma unroll
            for (int b = 0; b < 2; ++b)
#pragma unroll
                for (int m = 0; m < 4; ++m)
#pragma unroll
                    for (int n = 0; n < 2; ++n) acc[a][b][m][n] = (f32x4){0.f, 0.f, 0.f, 0.f};
        cur = nxt; cA = nA; cB = nB; ++ui;
    }
    PG8_WAIT_V(0);
    if (wr == 0) PG8_BAR;
    PG8_BAR;
    if constexpr (Epi::AFTER_DRAIN) { E.fused(acc, cur, wr, wc, fr, fq, lds, wid, lane); S.done(cur); }
    PG8_STAMP();
    if (STAMP && wid == 0) { stamps[lane] = lane < nts ? (((unsigned long long)(unsigned)ts_hi << 32) | (unsigned)ts_lo) : 0ull;
        if (lane == 62) stamps[62] = rt_entry; if (lane == 63) stamps[63] = (unsigned long long)wall_clock64(); }
#undef PG8_STAMP
#undef PG8_SA
#undef PG8_SB
#undef PG8_STAGE
#undef PG8_LDA
#undef PG8_LDB
#undef PG8_MMA
#undef PG8_WAIT_V
#undef PG8_WAIT_L
#undef PG8_BAR
#undef PG8_SCHED
}
}
#define XB_TMO      128
#define XB_XCNT(j)  (256  + 64 * (j))
#define XB_XSUB(j)  (1280 + 64 * (j))
#define XB_XGEN(j)  (2304 + 64 * (j))
#define XB_TOP      3328
#define XB_TOPGEN   3392
#define XCD_BAR_WORDS 3456
#define XB_SPIN_CAP (1u << 22)
#define LAS __attribute__((address_space(3)))

__device__ __forceinline__ unsigned xb_ld(unsigned* p)              { return __hip_atomic_load(p, __ATOMIC_RELAXED, __HIP_MEMORY_SCOPE_AGENT); }
__device__ __forceinline__ unsigned xb_add(unsigned* p, unsigned v) { return __hip_atomic_fetch_add(p, v, __ATOMIC_RELAXED, __HIP_MEMORY_SCOPE_AGENT); }
__device__ __forceinline__ unsigned xb_xcc_id() { return (unsigned)__builtin_amdgcn_s_getreg((3 << 11) | 20) & 0xFu; }
#define XB_SPIN(cond, bar) do { unsigned _sp = 0; while (cond) { __builtin_amdgcn_s_sleep(1); \
    if ((++_sp & 255u) == 0u) { if (xb_ld(&(bar)[XB_TMO])) break; if (_sp > XB_SPIN_CAP) { atomicAdd(&(bar)[XB_TMO], 1u); break; } } } } while (0)

struct XcdBarrier {
    unsigned* bar; unsigned x;
    volatile LAS unsigned* st;
};

__device__ __forceinline__ XcdBarrier xcd_barrier_post(unsigned* bar, volatile LAS unsigned* st) {
    XcdBarrier b; b.bar = bar; b.x = xb_xcc_id(); b.st = st;
    if (TIDX == 0) (void)xb_add(&bar[XB_XCNT(b.x)], 1u);
    return b;
}
__device__ __forceinline__ void xcd_barrier_complete(unsigned* bar, unsigned x, unsigned& nloc, unsigned& nx) {
    const unsigned G = gridDim.x * gridDim.y * gridDim.z;
    unsigned sum, cnt, mine, sp = 0u;
    for (;;) {
        sum = 0u; cnt = 0u; mine = 0u;
#pragma unroll
        for (unsigned j = 0; j < 16; ++j) { const unsigned c = xb_ld(&bar[XB_XCNT(j)]); sum += c; cnt += (c > 0u) ? 1u : 0u; mine = (j == x) ? c : mine; }
        if (sum == G) break;
        __builtin_amdgcn_s_sleep(1);
        if ((++sp & 255u) == 0u) { if (xb_ld(&bar[XB_TMO])) break; if (sp > XB_SPIN_CAP) { atomicAdd(&bar[XB_TMO], 1u); break; } }
    }
    nloc = mine > 0u ? mine : 1u; nx = cnt > 0u ? cnt : 1u;
}

__device__ __forceinline__ void xcd_barrier(const XcdBarrier& b) {
    asm volatile("s_waitcnt vmcnt(0)" ::: "memory");
    __syncthreads();
    if (TIDX == 0) {
        unsigned* bar = b.bar;
        __builtin_amdgcn_s_waitcnt(0);
        unsigned nloc = b.st[0], nx = b.st[1];
        if (nloc == 0u) { xcd_barrier_complete(bar, b.x, nloc, nx); b.st[0] = nloc; b.st[1] = nx; }
        const unsigned old = xb_add(&bar[XB_XSUB(b.x)], 1u);
        const unsigned gen = old / nloc;
        if (old + 1u == (gen + 1u) * nloc) {
            __builtin_amdgcn_fence(__ATOMIC_RELEASE, "agent");
            asm volatile("s_waitcnt vmcnt(0)" ::: "memory");
            const unsigned og = xb_add(&bar[XB_TOP], 1u);
            const unsigned tg = og / nx;
            if (og + 1u == (tg + 1u) * nx) xb_add(&bar[XB_TOPGEN], 1u);
            else XB_SPIN(xb_ld(&bar[XB_TOPGEN]) == tg, bar);
            __builtin_amdgcn_fence(__ATOMIC_ACQUIRE, "agent");
            xb_add(&bar[XB_XGEN(b.x)], 1u);
            asm volatile("s_waitcnt vmcnt(0)" ::: "memory");
        } else {
            XB_SPIN(xb_ld(&bar[XB_XGEN(b.x)]) == gen, bar);
            __builtin_amdgcn_fence(__ATOMIC_ACQUIRE, "agent");
            asm volatile("s_waitcnt vmcnt(0)" ::: "memory");
        }
    }
    __syncthreads();
}
namespace att {
constexpr int DQK = QKD, DV_ = VD, NW = 8, QBLK = 32, KVBLK = 64;
static_assert(DQK == 192 && DV_ == 128 && NOPE == 128 && ROPE == 64, "attention body is written for 128 + 64 / 128");
constexpr float SCALE = 0.07216878364870322f;
constexpr float THR = 8.f;
constexpr int SDEPTH = ATT_SDEPTH;
constexpr int NQREG = ATT_NQREG, NQLDS = DQK / 16 - NQREG;
static_assert(NQREG <= NOPE / 16 && NQREG >= 0, "rope fragments live in LDS");
constexpr int KPITCH = DQK * 2;
constexpr size_t SHM_V = KVBLK * DV_ * 2, SHM_K = KVBLK * KPITCH, SHM_QR = 2 * SHM_V + 2 * SHM_K + NW * 64 * 4, SHM_ATTN = SHM_QR + NW * (DQK / 16 - ATT_NQREG) * 1024;
using bf16x8 = __attribute__((ext_vector_type(8))) short;
using s16x4  = __attribute__((ext_vector_type(4))) short;
using f32x16 = __attribute__((ext_vector_type(16))) float;
using u32x4  = __attribute__((ext_vector_type(4))) unsigned;
#define KSWZ(row, colB) ((row) * att::KPITCH + ((colB) ^ (((row) & 7) << 4)))
#define SBAR() __builtin_amdgcn_sched_barrier(0)
__device__ __forceinline__ int crow(int r, int hi) { return (r & 3) + 8 * (r >> 2) + 4 * hi; }
__device__ __forceinline__ unsigned cvtpk(float lo, float hi) { unsigned r; asm volatile("v_cvt_pk_bf16_f32 %0, %1, %2" : "=v"(r) : "v"(lo), "v"(hi)); return r; }

__device__ __forceinline__ void partialSM(f32x16& p0, f32x16& p1, float& m_reg, float& mn, float& alpha) {
  constexpr float C = SCALE * 1.4426950408889634f;
  float pmax = p0[0];
#pragma unroll
  for (int r = 1; r < 16; ++r) pmax = fmaxf(pmax, p0[r]);
#pragma unroll
  for (int r = 0; r < 16; ++r) pmax = fmaxf(pmax, p1[r]);
  { auto rr = __builtin_amdgcn_permlane32_swap(__float_as_uint(pmax), __float_as_uint(pmax), false, false);
    pmax = fmaxf(__uint_as_float(rr[0]), __uint_as_float(rr[1])); }
  if (__builtin_expect(__all(pmax - m_reg <= THR / SCALE), 1)) { mn = m_reg; alpha = 1.f; }
  else { mn = fmaxf(m_reg, pmax); alpha = __builtin_amdgcn_exp2f((m_reg - mn) * C); m_reg = mn; }
  float mnC = -mn * C;
#pragma unroll
  for (int r = 0; r < 16; ++r) p0[r] = fmaf(p0[r], C, mnC);
#pragma unroll
  for (int r = 0; r < 16; ++r) p1[r] = fmaf(p1[r], C, mnC);
#pragma unroll
  for (int r = 0; r < 16; ++r) p0[r] = __builtin_amdgcn_exp2f(p0[r]);
}
__device__ __forceinline__ void finishSM(f32x16& p0, f32x16& p1, float alpha, float& l_reg, bf16x8& pa0, bf16x8& pa1, bf16x8& pa2, bf16x8& pa3) {
#pragma unroll
  for (int r = 0; r < 16; ++r) p1[r] = __builtin_amdgcn_exp2f(p1[r]);
  float ps = 0;
#pragma unroll
  for (int r = 0; r < 16; ++r) ps += p0[r];
#pragma unroll
  for (int r = 0; r < 16; ++r) ps += p1[r];
  { auto rr = __builtin_amdgcn_permlane32_swap(__float_as_uint(ps), __float_as_uint(ps), false, false);
    ps = __uint_as_float(rr[0]) + __uint_as_float(rr[1]); }
  l_reg = l_reg * alpha + ps;
#define PK4(P, BASE, OUT) do { unsigned a0 = cvtpk(P[BASE + 0], P[BASE + 1]), a1 = cvtpk(P[BASE + 2], P[BASE + 3]);   \
    unsigned b0 = cvtpk(P[BASE + 4], P[BASE + 5]), b1 = cvtpk(P[BASE + 6], P[BASE + 7]);                              \
    auto r0 = __builtin_amdgcn_permlane32_swap(a0, b0, false, false); auto r1 = __builtin_amdgcn_permlane32_swap(a1, b1, false, false); \
    u32x4 w = {r0[0], r1[0], r0[1], r1[1]}; OUT = *reinterpret_cast<bf16x8*>(&w); } while (0)
  PK4(p0, 0, pa0); PK4(p0, 8, pa1); PK4(p1, 0, pa2); PK4(p1, 8, pa3);
#undef PK4
}
__device__ __forceinline__ void qkt(f32x16& p0, f32x16& p1, const char* Ks, const bf16x8* qr, const char* qx, int r32, int hi) {
  p0 = f32x16{}; p1 = f32x16{};
#pragma unroll
  for (int d0 = 0; d0 < DQK / 16; ++d0) { int cb = (d0 * 16 + hi * 8) * 2;
    bf16x8 b0 = *reinterpret_cast<const bf16x8*>(Ks + KSWZ(r32, cb));
    bf16x8 b1 = *reinterpret_cast<const bf16x8*>(Ks + KSWZ(32 + r32, cb));
    const bf16x8 q = d0 < NQREG ? qr[d0 < NQREG ? d0 : 0] : *reinterpret_cast<const bf16x8*>(qx + (d0 - NQREG) * 1024);
    p0 = __builtin_amdgcn_mfma_f32_32x32x16_bf16(b0, q, p0, 0, 0, 0);
    p1 = __builtin_amdgcn_mfma_f32_32x32x16_bf16(b1, q, p1, 0, 0, 0); }
}
__device__ __forceinline__ int v_st(int k, int c) { const int kk = (k & ~0xC) | ((k & 4) << 1) | ((k & 8) >> 1); return ((kk >> 3) * 4 + (c >> 5)) * 512 + ((kk & 7) * 32 + (c & 31)) * 2; }
__device__ __forceinline__ int v_rd_base(int lane) { return ((lane & 3) << 3) | (((lane >> 2) & 3) << 6) | (((lane >> 4) & 1) << 5) | (((lane >> 5) & 1) << 8); }
constexpr int v_rd_off(int d0, int ks, int half) { return d0 * 512 + ks * 4096 + half * 2048; }
template <int OFF> __device__ __forceinline__ s16x4 tr_read(int vb) {
  s16x4 r; asm volatile("ds_read_b64_tr_b16 %0, %1 offset:%2" : "=&v"(r) : "v"(vb), "i"(OFF) : "memory"); return r;
}
template <int D0> __device__ __forceinline__ void pv_one(f32x16& od, int vb, bf16x8 pa0, bf16x8 pa1, bf16x8 pa2, bf16x8 pa3) {
  const s16x4 l0 = tr_read<v_rd_off(D0, 0, 0)>(vb), h0 = tr_read<v_rd_off(D0, 0, 1)>(vb), l1 = tr_read<v_rd_off(D0, 1, 0)>(vb), h1 = tr_read<v_rd_off(D0, 1, 1)>(vb);
  const s16x4 l2 = tr_read<v_rd_off(D0, 2, 0)>(vb), h2 = tr_read<v_rd_off(D0, 2, 1)>(vb), l3 = tr_read<v_rd_off(D0, 3, 0)>(vb), h3 = tr_read<v_rd_off(D0, 3, 1)>(vb);
  asm volatile("s_waitcnt lgkmcnt(0)" ::: "memory"); SBAR();
#define PK(L, H) (bf16x8){L[0], L[1], L[2], L[3], H[0], H[1], H[2], H[3]}
  od = __builtin_amdgcn_mfma_f32_32x32x16_bf16(pa0, PK(l0, h0), od, 0, 0, 0);
  od = __builtin_amdgcn_mfma_f32_32x32x16_bf16(pa1, PK(l1, h1), od, 0, 0, 0);
  od = __builtin_amdgcn_mfma_f32_32x32x16_bf16(pa2, PK(l2, h2), od, 0, 0, 0);
  od = __builtin_amdgcn_mfma_f32_32x32x16_bf16(pa3, PK(l3, h3), od, 0, 0, 0);
#undef PK
}
__device__ __forceinline__ void pv_d0(f32x16* o, int vb, bf16x8 pa0, bf16x8 pa1, bf16x8 pa2, bf16x8 pa3) {
  pv_one<0>(o[0], vb, pa0, pa1, pa2, pa3); pv_one<1>(o[1], vb, pa0, pa1, pa2, pa3); pv_one<2>(o[2], vb, pa0, pa1, pa2, pa3); pv_one<3>(o[3], vb, pa0, pa1, pa2, pa3);
}

__device__ __forceinline__ void attn_mla_body(const act_t* __restrict__ Qb, const float2* __restrict__ ropetab, const act_t* __restrict__ Kn, const act_t* __restrict__ Kp,
                                              const act_t* __restrict__ Vh, act_t* __restrict__ Ob, int r0, int nt0, int r1, int NT, char* lds) {
  int tid_ = TIDX; asm volatile("" : "+v"(tid_));
  const int tid = tid_, wid = tid >> 6, lane = tid & 63, r32 = lane & 31, hi = lane >> 5;
  char* V_lds = lds; char* K_lds = lds + 2 * SHM_V;
  float* ws = (float*)(lds + 2 * SHM_V + 2 * SHM_K) + wid * 64; float* li_l = ws; float* al_l = ws + 32;
  float m_reg = -1e30f, l_reg = 0; f32x16 o[4] = {}; bf16x8 qr[NQREG > 0 ? NQREG : 1];
  const act_t* Qw = Qb + (long)(wid * QBLK + r32) * NQ + hi * 8;
  char* qx = lds + SHM_QR + wid * (NQLDS * 1024) + lane * 16;
#pragma unroll
  for (int d0 = 0; d0 < NQREG; ++d0) qr[d0] = *reinterpret_cast<const bf16x8*>(Qw + d0 * 16);
  {
    u32x4 qt[DQK / 16 - NQREG];
#pragma unroll
    for (int d0 = NQREG; d0 < DQK / 16; ++d0) qt[d0 - NQREG] = *reinterpret_cast<const u32x4*>(Qw + d0 * 16);
    const float2* rt = (ropetab ? ropetab : reinterpret_cast<const float2*>(Qb)) + (long)(wid * QBLK + r32) * (ROPE / 2);
    float4 cs4[ROPE / 16][2];
#pragma unroll
    for (int d = 0; d < ROPE / 16; ++d) { cs4[d][0] = *reinterpret_cast<const float4*>(__builtin_assume_aligned(rt + d * 8 + hi * 4, 16)); cs4[d][1] = *reinterpret_cast<const float4*>(__builtin_assume_aligned(rt + d * 8 + hi * 4 + 2, 16)); }
    __builtin_amdgcn_sched_barrier(0);
#pragma unroll
    for (int d = 0; d < ROPE / 16; ++d) {
      asm volatile("" : "+v"(cs4[d][0].x), "+v"(cs4[d][0].y), "+v"(cs4[d][0].z), "+v"(cs4[d][0].w), "+v"(cs4[d][1].x), "+v"(cs4[d][1].y), "+v"(cs4[d][1].z), "+v"(cs4[d][1].w)); }
#pragma unroll
    for (int d0 = NQREG; d0 < NOPE / 16; ++d0) *reinterpret_cast<u32x4*>(qx + (d0 - NQREG) * 1024) = qt[d0 - NQREG];
#pragma unroll
    for (int d0 = NOPE / 16; d0 < DQK / 16; ++d0) {
      u32x4 w = qt[d0 - NQREG];
      {
        const int d = d0 - NOPE / 16; const bool rot = ropetab != nullptr;
        const float2 cs[4] = {make_float2(cs4[d][0].x, cs4[d][0].y), make_float2(cs4[d][0].z, cs4[d][0].w), make_float2(cs4[d][1].x, cs4[d][1].y), make_float2(cs4[d][1].z, cs4[d][1].w)};
#pragma unroll
        for (int j = 0; j < 4; ++j) {
          const float c = rot ? cs[j].x : 1.0f, s = rot ? cs[j].y : 0.0f;
          const float xe = __uint_as_float(w[j] << 16), xo = __uint_as_float(w[j] & 0xffff0000u);
          w[j] = cvtpk(xe * c - xo * s, xe * s + xo * c);
        }
      }
      *reinterpret_cast<u32x4*>(qx + (d0 - NQREG) * 1024) = w;
    }
    asm volatile("s_waitcnt lgkmcnt(0)" ::: "memory");
  }
  const int sr = tid >> 4, sc = (tid & 15) * 8, vst0 = v_st(sr, sc);
  const int pr = tid >> 3, pc = (tid & 7) * 8;
  const int vb0 = (int)(uintptr_t)V_lds + v_rd_base(lane);
  struct { bf16x8 vs0, vs1, ks0, ks1, kp; } sr_[SDEPTH];
#define KROW(j) __builtin_amdgcn_readfirstlane((j) < nt0 ? r0 + (j) * KVBLK : r1 + ((j) - nt0) * KVBLK)
  const unsigned ov0 = sr * NKV + sc, opp = pr * ROPE + pc; const int kst0 = KSWZ(sr, sc * 2), kstp = KSWZ(pr, (NOPE + pc) * 2);
#define SLOAD(i, j) do { const int kr_ = KROW(j); const act_t* vt_ = Vh + (size_t)kr_ * NKV; const act_t* kt_ = Kn + (size_t)kr_ * NKV; const act_t* pt_ = Kp + (size_t)kr_ * ROPE; \
    sr_[i].vs0 = *reinterpret_cast<const bf16x8*>(vt_ + ov0); sr_[i].vs1 = *reinterpret_cast<const bf16x8*>(vt_ + 32 * NKV + ov0); \
    sr_[i].ks0 = *reinterpret_cast<const bf16x8*>(kt_ + ov0); sr_[i].ks1 = *reinterpret_cast<const bf16x8*>(kt_ + 32 * NKV + ov0); \
    sr_[i].kp = *reinterpret_cast<const bf16x8*>(pt_ + opp); } while (0)
#define SWRITE(b, i) do { *(bf16x8*)(V_lds + (b) * SHM_V + vst0) = sr_[i].vs0; *(bf16x8*)(V_lds + (b) * SHM_V + 8192 + vst0) = sr_[i].vs1; \
    *(bf16x8*)(K_lds + (b) * SHM_K + kst0) = sr_[i].ks0; *(bf16x8*)(K_lds + (b) * SHM_K + 32 * KPITCH + kst0) = sr_[i].ks1; \
    *(bf16x8*)(K_lds + (b) * SHM_K + kstp) = sr_[i].kp; } while (0)
#define SWAIT() do { if constexpr (SDEPTH == 2) asm volatile("s_waitcnt vmcnt(5)" ::: "memory"); else asm volatile("s_waitcnt vmcnt(0)" ::: "memory"); } while (0)
#define RESC(a) do { if (__any((a) < 1.f)) { if (hi == 0) al_l[r32] = (a); asm volatile("s_waitcnt lgkmcnt(0)" ::: "memory"); \
    _Pragma("unroll") for (int d = 0; d < 4; ++d) _Pragma("unroll") for (int r = 0; r < 16; ++r) o[d][r] *= al_l[crow(r, hi)]; } } while (0)
  f32x16 pA0, pA1, pB0, pB1; float mnA, mnB, alA, alB; bf16x8 pa0, pa1, pa2, pa3;
  constexpr int SE = 0, SO = SDEPTH - 1;
  SLOAD(SE, 0); asm volatile("s_waitcnt vmcnt(0)" ::: "memory"); SWRITE(0, SE); __syncthreads();
  qkt(pA0, pA1, K_lds, qr, qx, r32, hi); partialSM(pA0, pA1, m_reg, mnA, alA);
  SLOAD(SO, 1); if constexpr (SDEPTH == 2) { if (2 < NT) SLOAD(SE, 2); }
  SWAIT(); SWRITE(1, SO); __syncthreads();
  for (int j = 1; j + 1 < NT; j += 2) {
    SBAR(); qkt(pB0, pB1, K_lds + SHM_K, qr, qx, r32, hi);
    finishSM(pA0, pA1, alA, l_reg, pa0, pa1, pa2, pa3); SBAR();
    SLOAD(SO, j + SDEPTH); SBAR();
    pv_d0(o, vb0, pa0, pa1, pa2, pa3); partialSM(pB0, pB1, m_reg, mnB, alB);
    __syncthreads(); SWAIT(); SWRITE(0, SE);
    RESC(alB); __syncthreads();
    SBAR(); qkt(pA0, pA1, K_lds, qr, qx, r32, hi);
    finishSM(pB0, pB1, alB, l_reg, pa0, pa1, pa2, pa3); SBAR();
    if (SDEPTH == 1 || j + 3 < NT) SLOAD(SE, j + 1 + SDEPTH); SBAR();
    pv_d0(o, vb0 + (int)SHM_V, pa0, pa1, pa2, pa3); partialSM(pA0, pA1, m_reg, mnA, alA);
    __syncthreads(); SWAIT(); SWRITE(1, SO);
    RESC(alA); __syncthreads();
  }
  SBAR(); qkt(pB0, pB1, K_lds + SHM_K, qr, qx, r32, hi);
  finishSM(pA0, pA1, alA, l_reg, pa0, pa1, pa2, pa3); SBAR();
  pv_d0(o, vb0, pa0, pa1, pa2, pa3); partialSM(pB0, pB1, m_reg, mnB, alB);
  __syncthreads(); RESC(alB);
  finishSM(pB0, pB1, alB, l_reg, pa0, pa1, pa2, pa3); SBAR();
  pv_d0(o, vb0 + (int)SHM_V, pa0, pa1, pa2, pa3);
  if (hi == 0) li_l[r32] = l_reg; asm volatile("s_waitcnt lgkmcnt(0)" ::: "memory");
  float rli[16];
#pragma unroll
  for (int r = 0; r < 16; ++r) rli[r] = __builtin_amdgcn_rcpf(li_l[crow(r, hi)]);
  act_t* Ow = Ob + (long)(wid * QBLK) * MIXW;
#pragma unroll
  for (int r = 0; r < 16; ++r) { int orow = crow(r, hi);
#pragma unroll
    for (int d0 = 0; d0 < 4; ++d0) Ow[(long)orow * MIXW + d0 * 32 + r32] = f2a(o[d0][r] * rli[r]); }
#undef KROW
#undef SLOAD
#undef SWRITE
#undef SWAIT
#undef RESC
}
}

constexpr int AT_QB_LAT = DSEQ / 256, AT_NU_LAT = NDB * BH * AT_QB_LAT, AT_NU_CTX = NB * BH * (SEQ / 256);
__device__ __forceinline__ void attn_unit(const P& p, int u, char* lds) {
    const act_t* qf = (const act_t*)(p.ws + WS_QF); const act_t* kvup = (const act_t*)(p.ws + WS_KVUP); const act_t* kr = (const act_t*)(p.ws + WS_KR);
    act_t* ymix = (act_t*)(p.ws + WS_YMIX); const float2* ropetab = (const float2*)(p.ws + WS_ROPE);
    int s, h, qb;
    if (u < AT_NU_LAT) { qb = u % AT_QB_LAT; h = (u / AT_QB_LAT) % BH; s = NB + u / (AT_QB_LAT * BH); }
    else { const int v = u - AT_NU_LAT; qb = 0; h = v % BH; s = v / BH; }
    const int base = seq_start(s), T = seq_len(s), m0 = base + qb * 256;
    const bool lat = s >= NB;
    att::attn_mla_body(qf + (size_t)m0 * NQ + h * QKD, lat ? ropetab + (size_t)(qb * 256) * (ROPE / 2) : nullptr, kvup + h * NOPE, kr, kvup + BH * NOPE + h * VD,
                       ymix + (size_t)m0 * MIXW + AW + h * VD, base, T / 64, lat ? MTOK + (s - NB) * PAST : 0, (T + (lat ? PAST : 0)) / 64, lds);
    __syncthreads();
}
namespace gdnc {
using bf16x8 = __attribute__((ext_vector_type(8))) short;
using f32x16 = __attribute__((ext_vector_type(16))) float;
using f32x4v = __attribute__((ext_vector_type(4))) float;
using u32x4 = __attribute__((ext_vector_type(4))) unsigned;
__device__ __forceinline__ uint4 ldnt16(const uint4* p) { const u32x4 v = __builtin_nontemporal_load((const u32x4*)p); return make_uint4(v[0], v[1], v[2], v[3]); }
typedef float f32x2c __attribute__((ext_vector_type(2)));
typedef __bf16 bf16x2c __attribute__((ext_vector_type(2)));
__device__ __forceinline__ unsigned cvtpk_c(float lo, float hi) { f32x2c v = {lo, hi}; bf16x2c b = __builtin_convertvector(v, bf16x2c); return __builtin_bit_cast(unsigned, b); }
__device__ __forceinline__ int swap23(int x) { return (x & ~12) | ((x & 4) << 1) | ((x & 8) >> 1); }
__device__ __forceinline__ int crow(int r, int hi) { return (r & 3) + 8 * (r >> 2) + 4 * hi; }

__device__ __forceinline__ int npos(int i) { return 16 * (i & 3) + (i >> 2); }
template <int QP> __device__ __forceinline__ float quad_bcast(float v) { return __int_as_float(__builtin_amdgcn_update_dpp(0, __float_as_int(v), QP, 0xf, 0xf, true)); }
__device__ __forceinline__ void solve_quad(const float* Nt, int ntp, float (&x)[16], int q) {
    const float* nrow = Nt + 16 * q;
    int zo = 0;
#pragma unroll
    for (int j = 0; j < 63; ++j) {
        const float xo = x[j >> 2];
        const float xj = (j & 3) == 0 ? quad_bcast<0x00>(xo) : (j & 3) == 1 ? quad_bcast<0x55>(xo) : (j & 3) == 2 ? quad_bcast<0xAA>(xo) : quad_bcast<0xFF>(xo);
        const f32x2c xj2 = {-xj, -xj};
#pragma unroll
        for (int i4 = j >> 4; i4 < 4; ++i4) {
            const f32x4v n4 = *(const f32x4v*)(nrow + j * ntp + 4 * i4 + zo);
            if (4 * i4 + 1 >= (j >> 2)) { f32x2c a = {x[4 * i4], x[4 * i4 + 1]}; a = __builtin_elementwise_fma((f32x2c){n4[0], n4[1]}, xj2, a); x[4 * i4] = a[0]; x[4 * i4 + 1] = a[1]; }
            { f32x2c b = {x[4 * i4 + 2], x[4 * i4 + 3]}; b = __builtin_elementwise_fma((f32x2c){n4[2], n4[3]}, xj2, b); x[4 * i4 + 2] = b[0]; x[4 * i4 + 3] = b[1]; }
        }
        if ((j & 1) == 1) asm volatile("" : "+v"(zo) : "v"(xj));
    }
}
__device__ __forceinline__ void solve_quad2(const float* Nt, int ntp, float (&xa)[16], float (&xb)[16], int q) {
    const float* nrow = Nt + 16 * q;
    int zo = 0;
#pragma unroll
    for (int j = 0; j < 63; ++j) {
        const float ao = xa[j >> 2], bo = xb[j >> 2];
        const float aj = (j & 3) == 0 ? quad_bcast<0x00>(ao) : (j & 3) == 1 ? quad_bcast<0x55>(ao) : (j & 3) == 2 ? quad_bcast<0xAA>(ao) : quad_bcast<0xFF>(ao);
        const float bj = (j & 3) == 0 ? quad_bcast<0x00>(bo) : (j & 3) == 1 ? quad_bcast<0x55>(bo) : (j & 3) == 2 ? quad_bcast<0xAA>(bo) : quad_bcast<0xFF>(bo);
        const f32x2c aj2 = {-aj, -aj}, bj2 = {-bj, -bj};
#pragma unroll
        for (int i4 = j >> 4; i4 < 4; ++i4) {
            const f32x4v n4 = *(const f32x4v*)(nrow + j * ntp + 4 * i4 + zo);
            const f32x2c nlo = {n4[0], n4[1]}, nhi = {n4[2], n4[3]};
            if (4 * i4 + 1 >= (j >> 2)) {
                f32x2c a = {xa[4 * i4], xa[4 * i4 + 1]}; a = __builtin_elementwise_fma(nlo, aj2, a); xa[4 * i4] = a[0]; xa[4 * i4 + 1] = a[1];
                f32x2c b = {xb[4 * i4], xb[4 * i4 + 1]}; b = __builtin_elementwise_fma(nlo, bj2, b); xb[4 * i4] = b[0]; xb[4 * i4 + 1] = b[1];
            }
            { f32x2c a = {xa[4 * i4 + 2], xa[4 * i4 + 3]}; a = __builtin_elementwise_fma(nhi, aj2, a); xa[4 * i4 + 2] = a[0]; xa[4 * i4 + 3] = a[1];
              f32x2c b = {xb[4 * i4 + 2], xb[4 * i4 + 3]}; b = __builtin_elementwise_fma(nhi, bj2, b); xb[4 * i4 + 2] = b[0]; xb[4 * i4 + 3] = b[1]; }
        }
        if ((j & 7) == 7) asm volatile("" : "+v"(zo) : "v"(aj), "v"(bj));
    }
}
template <int CTRL> __device__ __forceinline__ float gdpp(float x) { return __int_as_float(__builtin_amdgcn_update_dpp(0, __float_as_int(x), CTRL, 0xf, 0xf, true)); }
__device__ __forceinline__ float psum32(float x) {
    x += gdpp<0xB1>(x); x += gdpp<0x4E>(x); x += gdpp<0x124>(x); x += gdpp<0x128>(x);
    return x + __int_as_float(__builtin_amdgcn_ds_swizzle(__float_as_int(x), (16 << 10) | 0x1f));
}
constexpr int SL_W = 0, SL_U = 16384, SL_QD = 32768, SL_KDT = 49152, SL_QK = 65536, SL_GT = 73728, SLOT_B = 73984;
constexpr int NSLOT = (MTOK / 64) * 2 * CH;
static_assert(DK == 128 && DV == 128 && CHUNK == 64, "gdnc layout");

constexpr int PA_KP = 132, PA_NP = 68;
constexpr int PA_N = 0, PA_GAM = PA_N + 64 * PA_NP, PA_BET = PA_GAM + 64, PA_EG = PA_BET + 64, PA_EGL = PA_EG + 64, PA_ONE = PA_EGL + 64, PA_K = PA_ONE + 128, PA_Q = PA_K + 64 * PA_KP, PA_V = PA_Q + 64 * PA_KP, PA_END = PA_V + 64 * PA_KP;
constexpr int PA_LDS = PA_END * 4;
__device__ __forceinline__ void prep_chunk(const P& p, int l, int slot, char* lds) {
    int tid_ = TIDX; asm volatile("" : "+v"(tid_));
    const int tid = tid_, lane = tid & 63, wv = __builtin_amdgcn_readfirstlane(tid >> 6);
    const int h = slot % CH, d = (slot / CH) % 2, m0 = (slot / (2 * CH)) * 64;
    const act_t* pp = (const act_t*)(p.ws + WS_PP);
    unsigned char* out = p.ws + WS_GCH + (size_t)slot * SLOT_B;
    float* F = (float*)lds;
    __syncthreads();
    {
        const float* wc = p.gdn_conv + (size_t)l * 3 * GC;
        const int sq = seq_of(m0), sbase = seq_start(sq), send = sbase + seq_len(sq);
        const int f = tid & 31, i0 = tid >> 5;
        uint2 xr[12][3]; float4 wt[3][3];
#pragma unroll
        for (int arr = 0; arr < 3; ++arr) { const int ch = (arr == 0 ? CH * DK : arr == 1 ? 0 : 2 * CH * DK) + h * DK + 4 * f;
#pragma unroll
            for (int tap = 0; tap < 3; ++tap) wt[arr][tap] = *(const float4*)(wc + tap * GC + ch); }
#pragma unroll
        for (int j = 0; j < 12; ++j) {
            const int arr = j >> 2, i = i0 + 16 * (j & 3);
            const int m = d == 0 ? m0 + i : m0 + 63 - i;
            const int ch = (arr == 0 ? CH * DK : arr == 1 ? 0 : 2 * CH * DK) + h * DK + 4 * f;
            const act_t* pr = pp + (size_t)m * INP + OFF_GQ + ch;
            xr[j][1] = *(const uint2*)pr; xr[j][0] = *(const uint2*)(pr - (m > sbase ? INP : 0)); xr[j][2] = *(const uint2*)(pr + (m < send - 1 ? INP : 0));
        }
        __builtin_amdgcn_sched_barrier(0);
#pragma unroll
        for (int j = 0; j < 12; ++j) asm volatile("" : "+v"(xr[j][0].x), "+v"(xr[j][0].y), "+v"(xr[j][1].x), "+v"(xr[j][1].y), "+v"(xr[j][2].x), "+v"(xr[j][2].y));
#pragma unroll
        for (int arr = 0; arr < 3; ++arr) asm volatile("" : "+v"(wt[arr][0].x), "+v"(wt[arr][0].y), "+v"(wt[arr][0].z), "+v"(wt[arr][0].w), "+v"(wt[arr][1].x), "+v"(wt[arr][1].y), "+v"(wt[arr][1].z), "+v"(wt[arr][1].w),
                                                                   "+v"(wt[arr][2].x), "+v"(wt[arr][2].y), "+v"(wt[arr][2].z), "+v"(wt[arr][2].w));
#pragma unroll
        for (int j = 0; j < 12; ++j) {
            const int arr = j >> 2, i = i0 + 16 * (j & 3);
            const int m = d == 0 ? m0 + i : m0 + 63 - i;
            const float s0 = m > sbase ? 1.0f : 0.0f, s2 = m < send - 1 ? 1.0f : 0.0f;
            const float4 w0 = wt[arr][0], w1 = wt[arr][1], w2 = wt[arr][2];
            const float4 x0 = make_float4(lo2(xr[j][0].x) * s0, hi2(xr[j][0].x) * s0, lo2(xr[j][0].y) * s0, hi2(xr[j][0].y) * s0);
            const float4 x1 = make_float4(lo2(xr[j][1].x), hi2(xr[j][1].x), lo2(xr[j][1].y), hi2(xr[j][1].y));
            const float4 x2 = make_float4(lo2(xr[j][2].x) * s2, hi2(xr[j][2].x) * s2, lo2(xr[j][2].y) * s2, hi2(xr[j][2].y) * s2);
            const float4 a = make_float4(w1.x * x1.x + w0.x * x0.x + w2.x * x2.x, w1.y * x1.y + w0.y * x0.y + w2.y * x2.y, w1.z * x1.z + w0.z * x0.z + w2.z * x2.z, w1.w * x1.w + w0.w * x0.w + w2.w * x2.w);
            float4 v = make_float4(siluf_(a.x), siluf_(a.y), siluf_(a.z), siluf_(a.w));
            if (arr < 2) {
                float ss = v.x * v.x + v.y * v.y + v.z * v.z + v.w * v.w;
                ss = psum32(ss);
                const float rs = (1.0f / sqrtf(ss + L2_EPS)) * (arr == 1 ? 0.08838834764831845f : 1.0f);
                v = make_float4(v.x * rs, v.y * rs, v.z * rs, v.w * rs);
            }
            *(float4*)(F + (arr == 0 ? PA_K : arr == 1 ? PA_Q : PA_V) + i * PA_KP + 4 * f) = v;
        }
        if (tid < 64) {
            const size_t m = (size_t)(d == 0 ? m0 + tid : m0 + 63 - tid);
            const act_t* pr = pp + m * INP;
            const int dh = d * CH + h;
            F[PA_BET + tid] = sigmoidf_(ldp1(pr + OFF_GB + dh));
            F[PA_GAM + tid] = -fexp_(p.gdn_a_log[(size_t)l * 2 * CH + dh]) * softplusf_(ldp1(pr + OFF_GA + dh) + p.gdn_dt_bias[(size_t)l * 2 * CH + dh]);
            F[PA_ONE + tid] = 1.0f;
        }
    }
    __syncthreads();
    if (tid < 64) {
        float g = 0.f, gl = 0.f;
#pragma unroll 8
        for (int j = 0; j < 64; ++j) { const float v = F[PA_GAM + j]; g += j <= tid ? v : 0.f; gl += v; }
        F[PA_EG + tid] = fexp_(g); F[PA_EGL + tid] = fexp_(gl - g); F[PA_ONE + 64 + tid] = g;
        if (tid == 63) *(float*)(out + SL_GT) = fexp_(g);
    }
    __syncthreads();
    if (tid < 64) F[PA_GAM + tid] = F[PA_ONE + 64 + tid];
    __syncthreads();
    for (int item = wv; item < 22; item += 8) {
        if (item >= 20) {
            const int ti = (item - 20) * 2, tj = ti + 1;
#pragma unroll
            for (int reg = 0; reg < 4; ++reg) { const int i = 16 * ti + (lane >> 4) * 4 + reg, j = 16 * tj + (lane & 15);
                *(unsigned short*)(out + SL_QK + (i * 64 + (j & ~15) + swap23(j & 15)) * 2) = 0; }
            continue;
        }
        const int mat = item / 10, L10 = item % 10;
        int ti = 0, rem = L10; while (rem > ti) { rem -= ti + 1; ++ti; }
        const int tj = rem;
        const float* X = F + (mat == 0 ? PA_K : PA_Q) + (16 * ti + (lane & 15)) * PA_KP + (lane >> 4);
        const float* Y = F + PA_K + (16 * tj + (lane & 15)) * PA_KP + (lane >> 4);
        f32x4v acc = {0.f, 0.f, 0.f, 0.f};
#pragma unroll 8
        for (int s = 0; s < 32; ++s) acc = __builtin_amdgcn_mfma_f32_16x16x4f32(X[4 * s], Y[4 * s], acc, 0, 0, 0);
#pragma unroll
        for (int reg = 0; reg < 4; ++reg) {
            const int i = 16 * ti + (lane >> 4) * 4 + reg, j = 16 * tj + (lane & 15);
            const float dec = fexp_(F[PA_GAM + i] - F[PA_GAM + j]);
            if (mat == 0) F[PA_N + j * PA_NP + npos(i)] = i > j ? F[PA_BET + i] * acc[reg] * dec : 0.f;
            else *(unsigned short*)(out + SL_QK + (i * 64 + (j & ~15) + swap23(j & 15)) * 2) = f2a(i >= j ? acc[reg] * dec : 0.f);
        }
    }
    __syncthreads();
    float xa[16], xb[16];
    {
        const int q = tid & 3, col = tid >> 2;
        const float* ksrc = F + PA_K + col; const float* vsrc = F + PA_V + col;
#pragma unroll
        for (int ii = 0; ii < 16; ++ii) { const int i = 4 * ii + q; const float b = F[PA_BET + i]; xa[ii] = b * ksrc[i * PA_KP] * F[PA_EG + i]; xb[ii] = b * vsrc[i * PA_KP]; }
        solve_quad2(F + PA_N, PA_NP, xa, xb, q);
    }
    {
#pragma unroll
        for (int j = 0; j < 2; ++j) {
            const int c = tid + 512 * j, i = c >> 4, pos = (c & 15) * 8, g16 = pos & ~15, hh = (pos >> 3) & 1;
            const float e = F[PA_EG + i];
            const float4 a = *(const float4*)(F + PA_Q + i * PA_KP + g16 + 4 * hh), b = *(const float4*)(F + PA_Q + i * PA_KP + g16 + 8 + 4 * hh);
            *(uint4*)(out + SL_QD + (i * 128 + pos) * 2) = make_uint4(cvtpk_c(a.x * e, a.y * e), cvtpk_c(a.z * e, a.w * e), cvtpk_c(b.x * e, b.y * e), cvtpk_c(b.z * e, b.w * e));
        }
#pragma unroll
        for (int j = 0; j < 2; ++j) {
            const int c = tid + 512 * j, dk = c >> 3, pos = (c & 7) * 8, g16 = pos & ~15, hh = (pos >> 3) & 1;
            float v8[8];
#pragma unroll
            for (int e = 0; e < 8; ++e) { const int tok = g16 + 8 * (e >> 2) + 4 * hh + (e & 3); v8[e] = F[PA_K + tok * PA_KP + dk] * F[PA_EGL + tok]; }
            *(uint4*)(out + SL_KDT + (dk * 64 + pos) * 2) = make_uint4(cvtpk_c(v8[0], v8[1]), cvtpk_c(v8[2], v8[3]), cvtpk_c(v8[4], v8[5]), cvtpk_c(v8[6], v8[7]));
        }
    }
    __syncthreads();
    unsigned short* Xs = (unsigned short*)(F + PA_V);
    {
        const int q = tid & 3, ca = tid >> 2, cb = 128 + (tid >> 2), pa = (ca & ~15) + swap23(ca & 15);
#pragma unroll
        for (int ii = 0; ii < 16; ++ii) { Xs[(4 * ii + q) * 256 + pa] = f2a(xa[ii]); Xs[(4 * ii + q) * 256 + cb] = f2a(xb[ii]); }
    }
    __syncthreads();
#pragma unroll
    for (int j = 0; j < 4; ++j) {
        const int c = tid + 512 * j, i = c >> 5, cc = c & 31;
        const uint4 v = *(const uint4*)(Xs + i * 256 + cc * 8);
        *(uint4*)(out + (cc < 16 ? SL_W + (i * 128 + cc * 8) * 2 : SL_U + (i * 128 + (cc - 16) * 8) * 2)) = v;
    }
}

constexpr int PB_WP = 272, PB_KP = 144;
constexpr int PB_W = 0, PB_QD = 64 * PB_WP, PB_KDT = 2 * 64 * PB_WP, PB_QK = PB_KDT + 128 * PB_KP, PB_U = PB_QK + 64 * PB_KP, PB_LDS = PB_U + 64 * 256;
__device__ __forceinline__ bf16x8 pack8(const f32x16& x, int s) {
    u32x4 w = {cvtpk_c(x[8 * s], x[8 * s + 1]), cvtpk_c(x[8 * s + 2], x[8 * s + 3]), cvtpk_c(x[8 * s + 4], x[8 * s + 5]), cvtpk_c(x[8 * s + 6], x[8 * s + 7])};
    return __builtin_bit_cast(bf16x8, w);
}
static_assert((SEQ / 64) % 2 == 0 && (DSEQ / 64) % 2 == 0, "chain_half runs the chunks in pairs");
constexpr int PH_BUF = PB_U + 64 * 128, PH_LDS = 2 * PH_BUF;
__device__ __forceinline__ int gh_dst(int q, int half, int& src) {
    if (q < 3584) {
        const int reg = q < 1024 ? 0 : q < 2048 ? 2 : q < 3072 ? 3 : 4, idx = q < 3072 ? (q & 1023) : q - 3072;
        src = reg * 1024 + idx;
        return reg == 0 ? PB_W + (idx >> 4) * PB_WP + (idx & 15) * 16 : reg == 2 ? PB_QD + (idx >> 4) * PB_WP + (idx & 15) * 16 : reg == 3 ? PB_KDT + (idx >> 3) * PB_KP + (idx & 7) * 16 : PB_QK + (idx >> 3) * PB_KP + (idx & 7) * 16;
    }
    const int idx = q - 3584, row = idx >> 3, pc = idx & 7;
    src = 1024 + row * 16 + half * 8 + pc;
    return PB_U + row * 128 + pc * 16;
}
__device__ __forceinline__ void chain_half(const P& p, int l, int s, int d, int h, int half, char* lds) {
    int tid_ = TIDX; asm volatile("" : "+v"(tid_));
    const int tid = tid_, lane = tid & 63, wv = __builtin_amdgcn_readfirstlane(tid >> 6), r = lane & 31, hi = lane >> 5;
    const int T = seq_len(s), base = seq_start(s), nc = T / 64;
    const unsigned char* gch = p.ws + WS_GCH;
    act_t* go = (act_t*)(p.ws + WS_GO);
#define GH_SLOT(c) (gch + (size_t)((((base >> 6) + (d == 0 ? (c) : nc - 1 - (c))) * 2 + d) * CH + h) * SLOT_B)
    __syncthreads();
    if (wv < 2) __builtin_amdgcn_s_setprio(3);
    if (wv >= 2) {
        const int st = tid - 128;
        int ldst[11], lsrc[11];
#pragma unroll
        for (int j = 0; j < 11; ++j) { const int q = st + 384 * j; int sc; ldst[j] = gh_dst(q < 4096 ? q : 0, half, sc); lsrc[j] = sc; }
        const bool tail = st < 4096 - 10 * 384;
        uint4 sa0, sa1, sa2, sa3, sa4, sa5, sa6, sa7, sa8, sa9, sa10 = make_uint4(0, 0, 0, 0), sb0, sb1, sb2, sb3, sb4, sb5, sb6, sb7, sb8, sb9, sb10 = make_uint4(0, 0, 0, 0);
#define GH_LOAD(c, X) do { const uint4* a_ = (const uint4*)GH_SLOT(c); \
            X##0 = ldnt16(a_ + lsrc[0]); X##1 = ldnt16(a_ + lsrc[1]); X##2 = ldnt16(a_ + lsrc[2]); X##3 = ldnt16(a_ + lsrc[3]); X##4 = ldnt16(a_ + lsrc[4]); X##5 = ldnt16(a_ + lsrc[5]); X##6 = ldnt16(a_ + lsrc[6]); X##7 = ldnt16(a_ + lsrc[7]); X##8 = ldnt16(a_ + lsrc[8]); X##9 = ldnt16(a_ + lsrc[9]); \
            if (tail) X##10 = ldnt16(a_ + lsrc[10]); } while (0)
#define GH_STORE(buf, X) do { char* b_ = lds + (buf) * PH_BUF; *(uint4*)(b_ + ldst[0]) = X##0; *(uint4*)(b_ + ldst[1]) = X##1; *(uint4*)(b_ + ldst[2]) = X##2; *(uint4*)(b_ + ldst[3]) = X##3; \
            *(uint4*)(b_ + ldst[4]) = X##4; *(uint4*)(b_ + ldst[5]) = X##5; *(uint4*)(b_ + ldst[6]) = X##6; *(uint4*)(b_ + ldst[7]) = X##7; *(uint4*)(b_ + ldst[8]) = X##8; *(uint4*)(b_ + ldst[9]) = X##9; \
            if (tail) *(uint4*)(b_ + ldst[10]) = X##10; } while (0)
        GH_LOAD(0, sa); GH_STORE(0, sa); GH_LOAD(1, sa); if (2 < nc) GH_LOAD(2, sb);
        __syncthreads();
#define GH_SITER(cc, X) do { const int c = (cc); if (c + 1 < nc) GH_STORE((c + 1) & 1, X); if (c + 3 < nc) GH_LOAD(c + 3, X); __syncthreads(); } while (0)
        for (int c2 = 0; c2 < nc; c2 += 2) { GH_SITER(c2, sa); GH_SITER(c2 + 1, sb); }
#undef GH_LOAD
#undef GH_STORE
#undef GH_SITER
    } else {
        f32x16 S[4];
        const int col = 64 * half + 32 * wv + r;
        if (s >= NB) {
            const float* s0 = p.state_gdn + ((((size_t)(s - NB) * L + l) * 2 + d) * CH + h) * DK * DV + col;
#pragma unroll
            for (int t = 0; t < 4; ++t)
#pragma unroll
                for (int i = 0; i < 16; ++i) S[t][i] = s0[(size_t)(32 * t + crow(i, hi)) * DV];
        } else {
#pragma unroll
            for (int t = 0; t < 4; ++t)
#pragma unroll
                for (int i = 0; i < 16; ++i) S[t][i] = 0.f;
        }
        __syncthreads();
#define GH_COMPUTE \
        { \
            const float gt = *(const float*)(GH_SLOT(c) + SL_GT); \
            bf16x8 Sb[4][2]; \
_Pragma("unroll") \
            for (int t = 0; t < 4; ++t) { Sb[t][0] = pack8(S[t], 0); Sb[t][1] = pack8(S[t], 1); } \
            f32x16 vn[2]; \
_Pragma("unroll") \
            for (int a = 0; a < 2; ++a) { \
                f32x16 acc = {}; \
_Pragma("unroll") \
                for (int t = 0; t < 4; ++t) \
_Pragma("unroll") \
                    for (int k = 0; k < 2; ++k) acc = __builtin_amdgcn_mfma_f32_32x32x16_bf16(*(const bf16x8*)(LB + PB_W + (32 * a + r) * PB_WP + (32 * t + 16 * k + 8 * hi) * 2), Sb[t][k], acc, 0, 0, 0); \
_Pragma("unroll") \
                for (int i = 0; i < 16; ++i) vn[a][i] = a2f(*(const unsigned short*)(LB + PB_U + (32 * a + crow(i, hi)) * 128 + (32 * wv + r) * 2)) - acc[i]; \
            } \
            bf16x8 Vb[2][2]; \
_Pragma("unroll") \
            for (int b = 0; b < 2; ++b) { Vb[b][0] = pack8(vn[b], 0); Vb[b][1] = pack8(vn[b], 1); } \
_Pragma("unroll") \
            for (int a = 0; a < 2; ++a) { \
                f32x16 acc = {}; \
_Pragma("unroll") \
                for (int t = 0; t < 4; ++t) \
_Pragma("unroll") \
                    for (int k = 0; k < 2; ++k) acc = __builtin_amdgcn_mfma_f32_32x32x16_bf16(*(const bf16x8*)(LB + PB_QD + (32 * a + r) * PB_WP + (32 * t + 16 * k + 8 * hi) * 2), Sb[t][k], acc, 0, 0, 0); \
_Pragma("unroll") \
                for (int b = 0; b <= a; ++b) \
_Pragma("unroll") \
                    for (int k = 0; k < 2; ++k) acc = __builtin_amdgcn_mfma_f32_32x32x16_bf16(*(const bf16x8*)(LB + PB_QK + (32 * a + r) * PB_KP + (32 * b + 16 * k + 8 * hi) * 2), Vb[b][k], acc, 0, 0, 0); \
_Pragma("unroll") \
                for (int i = 0; i < 16; ++i) { \
                    const int it = 64 * c + 32 * a + crow(i, hi); \
                    const size_t m = (size_t)(d == 0 ? base + it : base + T - 1 - it); \
                    go[(m * 2 + d) * CW + h * DV + 64 * half + 32 * wv + r] = f2a(acc[i]); \
                } \
            } \
_Pragma("unroll") \
            for (int t = 0; t < 4; ++t) { \
_Pragma("unroll") \
                for (int i = 0; i < 16; ++i) S[t][i] *= gt; \
_Pragma("unroll") \
                for (int b = 0; b < 2; ++b) \
_Pragma("unroll") \
                    for (int k = 0; k < 2; ++k) S[t] = __builtin_amdgcn_mfma_f32_32x32x16_bf16(*(const bf16x8*)(LB + PB_KDT + (32 * t + r) * PB_KP + (32 * b + 16 * k + 8 * hi) * 2), Vb[b][k], S[t], 0, 0, 0); \
            } \
        }

        for (int c = 0; c < nc; ++c) {
            const char* LB = lds + (c & 1) * PH_BUF;
            GH_COMPUTE
            __syncthreads();
        }
        if (s < NB) {
            float* so = p.out + O_SG + ((((size_t)s * L + l) * 2 + d) * CH + h) * DK * DV + col;
#pragma unroll
            for (int t = 0; t < 4; ++t)
#pragma unroll
                for (int i = 0; i < 16; ++i) so[(size_t)(32 * t + crow(i, hi)) * DV] = S[t][i];
        }
#undef GH_COMPUTE
    }
#undef GH_SLOT
    __builtin_amdgcn_s_setprio(0);
}
}
namespace rwkc {
using gdnc::bf16x8; using gdnc::f32x16; using gdnc::f32x4v; using gdnc::cvtpk_c; using gdnc::swap23; using gdnc::crow; using gdnc::pack8; using gdnc::solve_quad;
constexpr int SL_WN = 0, SL_UT = 8192, SL_RT = 16384, SL_AHT = 24576, SL_RAN = 32768, SL_Y0 = 40960, SL_G = 49152, SL_PC = 65536, SLOT_B = 65792;
constexpr int NSLOT = (MTOK / 64) * 2 * AH;
static_assert(AN == 64 && CHUNK == 64, "rwkc layout");
template <int CTRL> __device__ __forceinline__ float ddpp(float x) { return __int_as_float(__builtin_amdgcn_update_dpp(0, __float_as_int(x), CTRL, 0xf, 0xf, true)); }
__device__ __forceinline__ float dsum16(float x) { x += ddpp<0xB1>(x); x += ddpp<0x4E>(x); x += ddpp<0x124>(x); x += ddpp<0x128>(x); return x; }

constexpr int TP = 68;
constexpr int TSZ = 64 * TP;
constexpr int A_AT = 0, A_PC = TSZ, A_TK = A_PC + 64, A_TA = A_TK + TSZ, A_TKK = A_TA + TSZ, A_TR = A_TKK + TSZ, A_TV = A_TR + TSZ, A_TB = A_TV + TSZ, A_TRK = A_TB + TSZ, A_END = A_TRK + TSZ;
constexpr int PA_LDS = A_END * 4;
__device__ __forceinline__ f32x4v tile_xyT(const float* X, const float* Y, int ti, int tj, int lane) {
    const float* xp = X + (16 * ti + (lane & 15)) * TP + (lane >> 4); const float* yp = Y + (16 * tj + (lane & 15)) * TP + (lane >> 4);
    float xv[16], yv[16];
#pragma unroll
    for (int s = 0; s < 16; ++s) { xv[s] = xp[4 * s]; yv[s] = yp[4 * s]; }
    __builtin_amdgcn_sched_barrier(0);
    f32x4v acc = {0.f, 0.f, 0.f, 0.f};
#pragma unroll
    for (int s = 0; s < 16; ++s) acc = __builtin_amdgcn_mfma_f32_16x16x4f32(xv[s], yv[s], acc, 0, 0, 0);
    return acc;
}
__device__ __forceinline__ f32x4v tile_xv(const float* X, const float* V, int ti, int tj, int lane) {
    const float* xp = X + (16 * ti + (lane & 15)) * TP + (lane >> 4); const float* vp = V + (lane >> 4) * TP + 16 * tj + (lane & 15);
    f32x4v acc = {0.f, 0.f, 0.f, 0.f};
#pragma unroll
    for (int s = 0; s < 16; ++s) acc = __builtin_amdgcn_mfma_f32_16x16x4f32(xp[4 * s], vp[4 * s * TP], acc, 0, 0, 0);
    return acc;
}
__device__ __forceinline__ f32x4v tile_xTv(const float* X, const float* V, int ti, int tj, int lane) {
    const float* xp = X + (lane >> 4) * TP + 16 * ti + (lane & 15); const float* vp = V + (lane >> 4) * TP + 16 * tj + (lane & 15);
    f32x4v acc = {0.f, 0.f, 0.f, 0.f};
#pragma unroll
    for (int s = 0; s < 16; ++s) acc = __builtin_amdgcn_mfma_f32_16x16x4f32(xp[4 * s * TP], vp[4 * s * TP], acc, 0, 0, 0);
    return acc;
}
__device__ __forceinline__ bf16x8 cvt8(const float4 a, const float4 b) { gdnc::u32x4 w = {cvtpk_c(a.x, a.y), cvtpk_c(a.z, a.w), cvtpk_c(b.x, b.y), cvtpk_c(b.z, b.w)}; return __builtin_bit_cast(bf16x8, w); }
__device__ __forceinline__ bf16x8 cvt8s(const float* p, int stride) {
    gdnc::u32x4 w = {cvtpk_c(p[0], p[stride]), cvtpk_c(p[2 * stride], p[3 * stride]), cvtpk_c(p[4 * stride], p[5 * stride]), cvtpk_c(p[6 * stride], p[7 * stride])}; return __builtin_bit_cast(bf16x8, w); }
__device__ __forceinline__ void ld8s(const float* p, int stride, float (&v)[8]) {
#pragma unroll
    for (int e = 0; e < 8; ++e) v[e] = p[e * stride];
}
__device__ __forceinline__ bf16x8 pk8(const float (&v)[8]) { gdnc::u32x4 w = {cvtpk_c(v[0], v[1]), cvtpk_c(v[2], v[3]), cvtpk_c(v[4], v[5]), cvtpk_c(v[6], v[7])}; return __builtin_bit_cast(bf16x8, w); }
__device__ __forceinline__ f32x4v tile_xyT_bf(const float* X, const float* Y, int ti, int tj, int lane) {
    const float* xp = X + (16 * ti + (lane & 15)) * TP + 8 * (lane >> 4); const float* yp = Y + (16 * tj + (lane & 15)) * TP + 8 * (lane >> 4);
    const float4 x0 = *(const float4*)xp, x1 = *(const float4*)(xp + 4), x2 = *(const float4*)(xp + 32), x3 = *(const float4*)(xp + 36);
    const float4 y0 = *(const float4*)yp, y1 = *(const float4*)(yp + 4), y2 = *(const float4*)(yp + 32), y3 = *(const float4*)(yp + 36);
    __builtin_amdgcn_sched_barrier(0);
    f32x4v acc = {0.f, 0.f, 0.f, 0.f};
    acc = __builtin_amdgcn_mfma_f32_16x16x32_bf16(cvt8(x0, x1), cvt8(y0, y1), acc, 0, 0, 0);
    acc = __builtin_amdgcn_mfma_f32_16x16x32_bf16(cvt8(x2, x3), cvt8(y2, y3), acc, 0, 0, 0);
    return acc;
}
__device__ __forceinline__ f32x4v tile_xv_bf(const float* X, const float* V, int ti, int tj, int lane) {
    const float* xp = X + (16 * ti + (lane & 15)) * TP + 8 * (lane >> 4); const float* vp = V + 8 * (lane >> 4) * TP + 16 * tj + (lane & 15);
    const float4 x0 = *(const float4*)xp, x1 = *(const float4*)(xp + 4), x2 = *(const float4*)(xp + 32), x3 = *(const float4*)(xp + 36);
    float v0[8], v1[8]; ld8s(vp, TP, v0); ld8s(vp + 32 * TP, TP, v1);
    __builtin_amdgcn_sched_barrier(0);
    f32x4v acc = {0.f, 0.f, 0.f, 0.f};
    acc = __builtin_amdgcn_mfma_f32_16x16x32_bf16(cvt8(x0, x1), pk8(v0), acc, 0, 0, 0);
    acc = __builtin_amdgcn_mfma_f32_16x16x32_bf16(cvt8(x2, x3), pk8(v1), acc, 0, 0, 0);
    return acc;
}
__device__ __forceinline__ f32x4v tile_xTv_bf(const float* X, const float* V, int ti, int tj, int lane) {
    const float* xp = X + 8 * (lane >> 4) * TP + 16 * ti + (lane & 15); const float* vp = V + 8 * (lane >> 4) * TP + 16 * tj + (lane & 15);
    float a0[8], a1[8], v0[8], v1[8]; ld8s(xp, TP, a0); ld8s(xp + 32 * TP, TP, a1); ld8s(vp, TP, v0); ld8s(vp + 32 * TP, TP, v1);
    __builtin_amdgcn_sched_barrier(0);
    f32x4v acc = {0.f, 0.f, 0.f, 0.f};
    acc = __builtin_amdgcn_mfma_f32_16x16x32_bf16(pk8(a0), pk8(v0), acc, 0, 0, 0);
    acc = __builtin_amdgcn_mfma_f32_16x16x32_bf16(pk8(a1), pk8(v1), acc, 0, 0, 0);
    return acc;
}
__device__ __forceinline__ void prep_chunk(const P& p, int l, int slot, char* lds) {
    int tid_ = TIDX; asm volatile("" : "+v"(tid_));
    const int tid = tid_, lane = tid & 63, wv = __builtin_amdgcn_readfirstlane(tid >> 6);
    const int h = slot % AH, d = (slot / AH) % 2, m0 = (slot / (2 * AH)) * 64;
    const act_t* pp = (const act_t*)(p.ws + WS_PP);
    unsigned char* out = p.ws + WS_RCH + (size_t)slot * SLOT_B;
    float* F = (float*)lds;
    __syncthreads();
    {
        const act_t* lora = (const act_t*)(p.ws + WS_LORA);
        float* rwb = (float*)(p.ws + WS_RWB);
        uint2 dk[2], dr[2], dv[2], dlw[2], dla[2];
        const int f_ = tid & 15, c0_ = h * AN + 4 * f_;
#pragma unroll
        for (int j = 0; j < 2; ++j) {
            const int i = (tid + 512 * j) >> 4; const size_t m = (size_t)(d == 0 ? m0 + i : m0 + 63 - i);
            const act_t* pr = pp + m * INP; const act_t* lr = lora + m * LORAN;
            dk[j] = *(const uint2*)(pr + OFF_K + c0_); dr[j] = *(const uint2*)(pr + OFF_R + c0_); dv[j] = *(const uint2*)(pr + OFF_V + c0_);
            dlw[j] = *(const uint2*)(lr + d * AW + c0_); dla[j] = *(const uint2*)(lr + (2 + d) * AW + c0_);
        }
        float4 w04 = *(const float4*)(p.rwkv_w0 + ((size_t)l * 2 + d) * AW + c0_), a04 = *(const float4*)(p.rwkv_a0 + ((size_t)l * 2 + d) * AW + c0_);
        float4 ka4 = *(const float4*)(p.rwkv_ka + (size_t)l * AW + c0_), ks4 = *(const float4*)(p.rwkv_kk + (size_t)l * AW + c0_), rk4 = *(const float4*)(p.rwkv_rk + ((size_t)l * AH + h) * AN + 4 * f_);
        __builtin_amdgcn_sched_barrier(0);
#pragma unroll
        for (int j = 0; j < 2; ++j) asm volatile("" : "+v"(dk[j].x), "+v"(dk[j].y), "+v"(dr[j].x), "+v"(dr[j].y), "+v"(dv[j].x), "+v"(dv[j].y), "+v"(dlw[j].x), "+v"(dlw[j].y), "+v"(dla[j].x), "+v"(dla[j].y));
        asm volatile("" : "+v"(w04.x), "+v"(w04.y), "+v"(w04.z), "+v"(w04.w), "+v"(a04.x), "+v"(a04.y), "+v"(a04.z), "+v"(a04.w), "+v"(ka4.x), "+v"(ka4.y), "+v"(ka4.z), "+v"(ka4.w));
        asm volatile("" : "+v"(ks4.x), "+v"(ks4.y), "+v"(ks4.z), "+v"(ks4.w), "+v"(rk4.x), "+v"(rk4.y), "+v"(rk4.z), "+v"(rk4.w));
#define RW_U4(u) make_float4(lo2((u).x), hi2((u).x), lo2((u).y), hi2((u).y))
#pragma unroll
        for (int j = 0; j < 2; ++j) {
            const int q = tid + 512 * j, i = q >> 4, f = q & 15, c0 = h * AN + 4 * f;
            const size_t m = (size_t)(d == 0 ? m0 + i : m0 + 63 - i);
            const float4 k4 = RW_U4(dk[j]), r4 = RW_U4(dr[j]), v4 = RW_U4(dv[j]);
            const float4 lw4 = RW_U4(dlw[j]), la4 = RW_U4(dla[j]);
            const float kx[4] = {k4.x, k4.y, k4.z, k4.w}, rx[4] = {r4.x, r4.y, r4.z, r4.w}, lw[4] = {lw4.x, lw4.y, lw4.z, lw4.w}, la[4] = {la4.x, la4.y, la4.z, la4.w};
            const float w0[4] = {w04.x, w04.y, w04.z, w04.w}, a0[4] = {a04.x, a04.y, a04.z, a04.w}, ka[4] = {ka4.x, ka4.y, ka4.z, ka4.w}, ks[4] = {ks4.x, ks4.y, ks4.z, ks4.w}, rk[4] = {rk4.x, rk4.y, rk4.z, rk4.w};
            float kk[4], ss = 0.f;
#pragma unroll
            for (int e = 0; e < 4; ++e) { kk[e] = kx[e] * ks[e]; ss += kk[e] * kk[e]; }
            ss = dsum16(ss);
            const float rs = 1.0f / sqrtf(ss + L2_EPS);
            float al[4], kd[4], lg[4], bon = 0.f;
#pragma unroll
            for (int e = 0; e < 4; ++e) {
                kk[e] *= rs;
                lg[e] = -fexp_(-softplusf_(-(w0[e] + lw[e])) - 0.5f);
                const float a = sigmoidf_(a0[e] + la[e]);
                kd[e] = kx[e] * (1.0f + (a - 1.0f) * ka[e]); al[e] = kk[e] * a;
                bon += rx[e] * kd[e] * rk[e];
            }
            bon = dsum16(bon);
            if (f == 0) rwb[(m * 2 + d) * AH + h] = bon;
            *(float4*)(F + A_TK + i * TP + 4 * f) = make_float4(kk[0], kk[1], kk[2], kk[3]);
            *(float4*)(F + A_TA + i * TP + 4 * f) = make_float4(al[0], al[1], al[2], al[3]);
            *(float4*)(F + A_TKK + i * TP + 4 * f) = make_float4(kd[0], kd[1], kd[2], kd[3]);
            *(float4*)(F + A_TR + i * TP + 4 * f) = r4;
            *(float4*)(F + A_TV + i * TP + 4 * f) = v4;
            *(float4*)(F + A_TB + i * TP + 4 * f) = make_float4(lg[0], lg[1], lg[2], lg[3]);
        }
    }
    __syncthreads();
    {
        const int c = tid & 63, part = tid >> 6;
        float bs = 0.f;
#pragma unroll
        for (int t = 0; t < 8; ++t) bs += F[A_TB + (8 * part + t) * TP + c];
        F[A_TRK + part * TP + c] = bs;
        __syncthreads();
        float lp = 0.f, tot = 0.f;
#pragma unroll
        for (int q = 0; q < 8; ++q) { const float v = F[A_TRK + q * TP + c]; lp += q < part ? v : 0.f; tot += v; }
#pragma unroll
        for (int t = 0; t < 8; ++t) {
            const int tt = 8 * part + t;
            const float e_prev = fexp_(lp);
            lp += F[A_TB + tt * TP + c];
            const float e = fexp_(lp), ei = fexp_(-lp);
            F[A_TK + tt * TP + c] *= e_prev; F[A_TA + tt * TP + c] *= ei; F[A_TKK + tt * TP + c] *= ei; F[A_TR + tt * TP + c] *= e;
        }
        if (part == 0) { const float pc = fexp_(tot); F[A_PC + c] = pc; *(float*)(out + SL_PC + c * 4) = pc; }
    }
    __syncthreads();
    for (int item = wv; item < 42; item += 8) {
        if (item >= 40) {
            const int ti = (item - 40) * 2, tj = ti + 1;
#pragma unroll
            for (int reg = 0; reg < 4; ++reg) { const int i = 16 * ti + (lane >> 4) * 4 + reg, j = 16 * tj + (lane & 15);
                *(unsigned short*)(out + SL_RAN + (i * 64 + (j & ~15) + swap23(j & 15)) * 2) = 0; }
            continue;
        }
        const int mat = item / 10, L10 = item % 10;
        int ti = 0, rem = L10; while (rem > ti) { rem -= ti + 1; ++ti; }
        const int tj = rem;
        const f32x4v acc = mat < 2 ? tile_xyT_bf(F + A_TK, F + (mat == 0 ? A_TA : A_TKK), ti, tj, lane)
                                   : tile_xyT_bf(F + A_TR, F + (mat == 2 ? A_TA : A_TKK), ti, tj, lane);
#pragma unroll
        for (int reg = 0; reg < 4; ++reg) {
            const int i = 16 * ti + (lane >> 4) * 4 + reg, j = 16 * tj + (lane & 15);
            if (mat == 0) F[A_AT + j * TP + gdnc::npos(i)] = i > j ? acc[reg] : 0.f;
            else if (mat == 1) F[A_TB + i * TP + j] = i > j ? acc[reg] : 0.f;
            else if (mat == 2) *(unsigned short*)(out + SL_RAN + (i * 64 + (j & ~15) + swap23(j & 15)) * 2) = f2a(i >= j ? -acc[reg] : 0.f);
            else F[A_TRK + i * TP + j] = i >= j ? acc[reg] : 0.f;
        }
    }
    for (int item = wv; item < 12; item += 8) {
        const int mat = item / 6, L6 = item % 6;
        int tj = 1, rem = L6; while (rem >= tj) { rem -= tj; ++tj; }
        const int ti = rem;
        if (mat < 2) {
#pragma unroll
            for (int reg = 0; reg < 4; ++reg) F[(mat == 0 ? A_TB : A_TRK) + (16 * ti + (lane >> 4) * 4 + reg) * TP + 16 * tj + (lane & 15)] = 0.f;
        }
    }
    {
#pragma unroll
        for (int j = 0; j < 1; ++j) {
            const int c = tid, i = c >> 3, pos = (c & 7) * 8, g16 = pos & ~15, hh = (pos >> 3) & 1;
            const float4 a = *(const float4*)(F + A_TR + i * TP + g16 + 4 * hh), b = *(const float4*)(F + A_TR + i * TP + g16 + 8 + 4 * hh);
            *(uint4*)(out + SL_RT + (i * 64 + pos) * 2) = make_uint4(cvtpk_c(a.x, a.y), cvtpk_c(a.z, a.w), cvtpk_c(b.x, b.y), cvtpk_c(b.z, b.w));
        }
        {
            const int c = tid, dk = c >> 3, pos = (c & 7) * 8, g16 = pos & ~15, hh = (pos >> 3) & 1;
            const float pc = -F[A_PC + dk];
            float v8[8];
#pragma unroll
            for (int e = 0; e < 8; ++e) { const int tok = g16 + 8 * (e >> 2) + 4 * hh + (e & 3); v8[e] = F[A_TA + tok * TP + dk] * pc; }
            *(uint4*)(out + SL_AHT + (dk * 64 + pos) * 2) = make_uint4(cvtpk_c(v8[0], v8[1]), cvtpk_c(v8[2], v8[3]), cvtpk_c(v8[4], v8[5]), cvtpk_c(v8[6], v8[7]));
        }
    }
    __syncthreads();
    for (int item = wv; item < 48; item += 8) {
        const int mat = item >> 4, ti = (item >> 2) & 3, tj = item & 3;
        f32x4v acc;
        if (mat == 0) acc = tile_xv_bf(F + A_TB, F + A_TV, ti, tj, lane);
        else if (mat == 1) acc = tile_xv_bf(F + A_TRK, F + A_TV, ti, tj, lane);
        else acc = tile_xTv_bf(F + A_TKK, F + A_TV, ti, tj, lane);
#pragma unroll
        for (int reg = 0; reg < 4; ++reg) {
            const int i = 16 * ti + (lane >> 4) * 4 + reg, j = 16 * tj + (lane & 15);
            if (mat == 0) F[A_TR + i * TP + j] = acc[reg];
            else if (mat == 1) *(unsigned short*)(out + SL_Y0 + (i * 64 + j) * 2) = f2a(acc[reg]);
            else *(float*)(out + SL_G + (i * 64 + j) * 4) = acc[reg] * F[A_PC + i];
        }
    }
    __syncthreads();
    unsigned short* Xs = (unsigned short*)(F + A_TV);
    if (__builtin_amdgcn_readfirstlane(tid >> 8) == 0) {
        float xa[16], xb[16];
        const int sq = tid & 3, scol = tid >> 2;
#pragma unroll
        for (int ii = 0; ii < 16; ++ii) { xa[ii] = F[A_TK + scol + (4 * ii + sq) * TP]; xb[ii] = F[A_TR + scol + (4 * ii + sq) * TP]; }
        gdnc::solve_quad2(F + A_AT, TP, xa, xb, sq);
        const int pcol = (scol & ~15) + swap23(scol & 15);
#pragma unroll
        for (int ii = 0; ii < 16; ++ii) { Xs[(4 * ii + sq) * 128 + pcol] = f2a(-xa[ii]); Xs[(4 * ii + sq) * 128 + 64 + scol] = f2a(xb[ii]); }
    }
    __syncthreads();
#pragma unroll
    for (int j = 0; j < 2; ++j) {
        const int c = tid + 512 * j, i = c >> 4, cc = c & 15;
        const uint4 v = *(const uint4*)(Xs + i * 128 + cc * 8);
        *(uint4*)(out + (cc < 8 ? SL_WN + (i * 64 + cc * 8) * 2 : SL_UT + (i * 64 + (cc - 8) * 8) * 2)) = v;
    }
}

constexpr int BP = 144;
constexpr int B_WN = 0, B_RT = 64 * BP, B_AHT = 2 * 64 * BP, B_RAN = 3 * 64 * BP, B_UT = 4 * 64 * BP, B_Y0 = B_UT + 8192, B_G = B_Y0 + 8192, B_PC = B_G + 16384, B_DIR = B_PC + 256;
constexpr int PB_LDS = 2 * B_DIR;
static_assert((SEQ / 64) % 2 == 0 && (DSEQ / 64) % 2 == 0, "chain_dir runs the chunks in pairs");
constexpr int PD_LDS = 2 * B_DIR;
__device__ __forceinline__ int rd_dst(int q) {
    if (q < 3072) { const int img = q >> 9, row = (q & 511) >> 3, pc = q & 7;
        return img == 0 ? B_WN + row * BP + pc * 16 : img == 1 ? B_UT + row * 128 + pc * 16 : img == 2 ? B_RT + row * BP + pc * 16 : img == 3 ? B_AHT + row * BP + pc * 16
             : img == 4 ? B_RAN + row * BP + pc * 16 : B_Y0 + row * 128 + pc * 16; }
    return q < 4096 ? B_G + (q - 3072) * 16 : B_PC + (q - 4096) * 16;
}
__device__ __forceinline__ void chain_dir(const P& p, int l, int s, int d, int h, char* lds) {
    int tid_ = TIDX; asm volatile("" : "+v"(tid_));
    const int tid = tid_, lane = tid & 63, wv = __builtin_amdgcn_readfirstlane(tid >> 6), r = lane & 31, hi = lane >> 5;
    const int T = seq_len(s), base = seq_start(s), nc = T / 64;
    const unsigned char* rch = p.ws + WS_RCH;
    act_t* yb = (act_t*)(p.ws + WS_RWY);
#define RD_SLOT(c) (rch + (size_t)((((base >> 6) + (d == 0 ? (c) : nc - 1 - (c))) * 2 + d) * AH + h) * SLOT_B)
    __syncthreads();
    if (wv < 2) __builtin_amdgcn_s_setprio(3);
    if (wv >= 2) {
        const int st = tid - 128;
        int ldst[11];
#pragma unroll
        for (int j = 0; j < 11; ++j) { const int q = st + 384 * j; ldst[j] = rd_dst(q < 4112 ? q : 0); }
        const bool tail = st < 4112 - 10 * 384;
        uint4 sa0, sa1, sa2, sa3, sa4, sa5, sa6, sa7, sa8, sa9, sa10 = make_uint4(0, 0, 0, 0), sb0, sb1, sb2, sb3, sb4, sb5, sb6, sb7, sb8, sb9, sb10 = make_uint4(0, 0, 0, 0);
#define RD_LOAD(c, X) do { const uint4* a_ = (const uint4*)RD_SLOT(c) + st; \
            X##0 = gdnc::ldnt16(a_ + 0); X##1 = gdnc::ldnt16(a_ + 384); X##2 = gdnc::ldnt16(a_ + 768); X##3 = gdnc::ldnt16(a_ + 1152); X##4 = gdnc::ldnt16(a_ + 1536); X##5 = gdnc::ldnt16(a_ + 1920); X##6 = gdnc::ldnt16(a_ + 2304); X##7 = gdnc::ldnt16(a_ + 2688); X##8 = gdnc::ldnt16(a_ + 3072); X##9 = gdnc::ldnt16(a_ + 3456); if (tail) X##10 = gdnc::ldnt16(a_ + 3840); } while (0)
#define RD_STORE(buf, X) do { char* b_ = lds + (buf) * B_DIR; *(uint4*)(b_ + ldst[0]) = X##0; *(uint4*)(b_ + ldst[1]) = X##1; *(uint4*)(b_ + ldst[2]) = X##2; *(uint4*)(b_ + ldst[3]) = X##3; \
            *(uint4*)(b_ + ldst[4]) = X##4; *(uint4*)(b_ + ldst[5]) = X##5; *(uint4*)(b_ + ldst[6]) = X##6; *(uint4*)(b_ + ldst[7]) = X##7; *(uint4*)(b_ + ldst[8]) = X##8; *(uint4*)(b_ + ldst[9]) = X##9; \
            if (tail) *(uint4*)(b_ + ldst[10]) = X##10; } while (0)
        RD_LOAD(0, sa); RD_STORE(0, sa); RD_LOAD(1, sa); if (2 < nc) RD_LOAD(2, sb);
        __syncthreads();
#define RD_SITER(cc, X) do { const int c = (cc); if (c + 1 < nc) RD_STORE((c + 1) & 1, X); if (c + 3 < nc) RD_LOAD(c + 3, X); __syncthreads(); } while (0)
        for (int c2 = 0; c2 < nc; c2 += 2) { RD_SITER(c2, sa); RD_SITER(c2 + 1, sb); }
#undef RD_LOAD
#undef RD_STORE
#undef RD_SITER
    } else {
        const int vb = (wv & 1) * 32;
        f32x16 Z[2];
        if (s >= NB) {
            const float* s0 = p.state_rwkv + ((((size_t)(s - NB) * L + l) * 2 + d) * AH + h) * AN * AN + (size_t)(vb + r) * AN;
#pragma unroll
            for (int t = 0; t < 2; ++t)
#pragma unroll
                for (int i = 0; i < 16; ++i) Z[t][i] = s0[32 * t + crow(i, hi)];
        } else {
#pragma unroll
            for (int t = 0; t < 2; ++t)
#pragma unroll
                for (int i = 0; i < 16; ++i) Z[t][i] = 0.f;
        }
        __syncthreads();
#define RD_COMPUTE \
        if (wv < 2) { \
            bf16x8 Zb[2][2]; \
_Pragma("unroll") \
            for (int t = 0; t < 2; ++t) { Zb[t][0] = pack8(Z[t], 0); Zb[t][1] = pack8(Z[t], 1); } \
            f32x16 U[2]; \
_Pragma("unroll") \
            for (int a = 0; a < 2; ++a) { \
                f32x16 acc = {}; \
_Pragma("unroll") \
                for (int t = 0; t < 2; ++t) \
_Pragma("unroll") \
                    for (int k = 0; k < 2; ++k) acc = __builtin_amdgcn_mfma_f32_32x32x16_bf16(*(const bf16x8*)(LB + B_WN + (32 * a + r) * BP + (32 * t + 16 * k + 8 * hi) * 2), Zb[t][k], acc, 0, 0, 0); \
_Pragma("unroll") \
                for (int i = 0; i < 16; ++i) U[a][i] = a2f(*(const unsigned short*)(LB + B_UT + (32 * a + crow(i, hi)) * 128 + (vb + r) * 2)) - acc[i]; \
            } \
            bf16x8 Ub[2][2]; \
_Pragma("unroll") \
            for (int b = 0; b < 2; ++b) { Ub[b][0] = pack8(U[b], 0); Ub[b][1] = pack8(U[b], 1); } \
_Pragma("unroll") \
            for (int a = 0; a < 2; ++a) { \
                f32x16 acc = {}; \
_Pragma("unroll") \
                for (int t = 0; t < 2; ++t) \
_Pragma("unroll") \
                    for (int k = 0; k < 2; ++k) acc = __builtin_amdgcn_mfma_f32_32x32x16_bf16(*(const bf16x8*)(LB + B_RT + (32 * a + r) * BP + (32 * t + 16 * k + 8 * hi) * 2), Zb[t][k], acc, 0, 0, 0); \
_Pragma("unroll") \
                for (int b = 0; b <= a; ++b) \
_Pragma("unroll") \
                    for (int k = 0; k < 2; ++k) acc = __builtin_amdgcn_mfma_f32_32x32x16_bf16(*(const bf16x8*)(LB + B_RAN + (32 * a + r) * BP + (32 * b + 16 * k + 8 * hi) * 2), Ub[b][k], acc, 0, 0, 0); \
_Pragma("unroll") \
                for (int i = 0; i < 16; ++i) { \
                    const int it = 64 * c + 32 * a + crow(i, hi); \
                    const size_t m = (size_t)(d == 0 ? base + it : base + T - 1 - it); \
                    yb[(m * 2 + d) * AW + h * AN + vb + r] = f2a(acc[i] + a2f(*(const unsigned short*)(LB + B_Y0 + (32 * a + crow(i, hi)) * 128 + (vb + r) * 2))); \
                } \
            } \
_Pragma("unroll") \
            for (int t = 0; t < 2; ++t) { \
_Pragma("unroll") \
                for (int i = 0; i < 16; ++i) { const int dk = 32 * t + crow(i, hi); Z[t][i] = Z[t][i] * *(const float*)(LB + B_PC + dk * 4) + *(const float*)(LB + B_G + (dk * 64 + vb + r) * 4); } \
_Pragma("unroll") \
                for (int b = 0; b < 2; ++b) \
_Pragma("unroll") \
                    for (int k = 0; k < 2; ++k) Z[t] = __builtin_amdgcn_mfma_f32_32x32x16_bf16(*(const bf16x8*)(LB + B_AHT + (32 * t + r) * BP + (32 * b + 16 * k + 8 * hi) * 2), Ub[b][k], Z[t], 0, 0, 0); \
            } \
        }

        for (int c = 0; c < nc; ++c) {
            const char* LB = lds + (c & 1) * B_DIR;
            RD_COMPUTE
            __syncthreads();
        }
        if (s < NB) {
            float* so = p.out + O_SR + ((((size_t)s * L + l) * 2 + d) * AH + h) * AN * AN + (size_t)(vb + r) * AN;
#pragma unroll
            for (int t = 0; t < 2; ++t)
#pragma unroll
                for (int i = 0; i < 16; ++i) so[32 * t + crow(i, hi)] = Z[t][i];
        }
#undef RD_COMPUTE
    }
#undef RD_SLOT
    __builtin_amdgcn_s_setprio(0);
}
}
constexpr int MX_RW_LAT = NDB * AH * 2, MX_G2_LAT = NDB * 2 * CH * 2, MX_AT_LAT = AT_NU_LAT, MX_GD_CTX = NB * 2 * CH * 2, MX_RW_CTX = NB * AH * 2, MX_AT_CTX = AT_NU_CTX;
constexpr int MX_TOTAL = MX_RW_LAT + MX_G2_LAT + MX_AT_LAT + MX_GD_CTX + MX_RW_CTX + MX_AT_CTX;
__device__ __forceinline__ void ph_mixers(const P& p, int l, char* lds, int misc_off, int round = 0) {
    unsigned* head = (unsigned*)(p.ws + WS_CTL + 32768) + (l + round * L) * 64;
    volatile __attribute__((address_space(3))) unsigned* slot = (volatile __attribute__((address_space(3))) unsigned*)((__attribute__((address_space(3))) char*)lds + misc_off + 16);
    for (;;) {
        asm volatile("s_waitcnt lgkmcnt(0)" ::: "memory"); __builtin_amdgcn_s_barrier(); asm volatile("" ::: "memory");
        if (TIDX == 0) *slot = __hip_atomic_fetch_add(head, 1u, __ATOMIC_RELAXED, __HIP_MEMORY_SCOPE_AGENT);
        asm volatile("s_waitcnt lgkmcnt(0)" ::: "memory"); __builtin_amdgcn_s_barrier(); asm volatile("" ::: "memory");
        int t = (int)*slot;
        t = __builtin_amdgcn_readfirstlane(t);
        if (t >= MX_TOTAL) break;
        if (t < MX_RW_LAT) { const int u = t; rwkc::chain_dir(p, l, NB + u / (2 * AH), (u / AH) % 2, u % AH, lds);
            if (DUPMASK & 32) rwkc::chain_dir(p, l, NB + u / (2 * AH), (u / AH) % 2, u % AH, lds); continue; } t -= MX_RW_LAT;
        if (t < MX_G2_LAT) { const int u = t; gdnc::chain_half(p, l, NB + u / (CH * 4), (u / (2 * CH)) % 2, (u / 2) % CH, u % 2, lds); continue; } t -= MX_G2_LAT;
        if (t < MX_AT_LAT) { attn_unit(p, t, lds); if (DUPMASK & 128) attn_unit(p, t, lds); continue; } t -= MX_AT_LAT;
        if (t < MX_GD_CTX) { const int u = t; gdnc::chain_half(p, l, u / (CH * 4), (u / (2 * CH)) % 2, (u / 2) % CH, u % 2, lds); continue; } t -= MX_GD_CTX;
        if (t < MX_RW_CTX) { const int u = t; rwkc::chain_dir(p, l, u / (2 * AH), (u / AH) % 2, u % AH, lds); continue; } t -= MX_RW_CTX;
        attn_unit(p, AT_NU_LAT + t, lds);
    }
}
namespace fastp {
template <int CTRL> __device__ __forceinline__ float dppf(float x) { return __int_as_float(__builtin_amdgcn_update_dpp(0, __float_as_int(x), CTRL, 0xf, 0xf, true)); }
template <int XORM> __device__ __forceinline__ float swzx(float x) { return __int_as_float(__builtin_amdgcn_ds_swizzle(__float_as_int(x), (XORM << 10) | 0x1f)); }
__device__ __forceinline__ float sum4(float x) { x += dppf<0xB1>(x); x += dppf<0x4E>(x); return x; }
__device__ __forceinline__ float sum16(float x) { x = sum4(x); x += dppf<0x124>(x); x += dppf<0x128>(x); return x; }
__device__ __forceinline__ float wsum(float x) {
    x = sum16(x); x += swzx<16>(x);
    auto rr = __builtin_amdgcn_permlane32_swap(__float_as_uint(x), __float_as_uint(x), false, false);
    return __uint_as_float(rr[0]) + __uint_as_float(rr[1]);
}
template <int N> __device__ __forceinline__ float gsumN(float x) {
    static_assert(N == 8 || N == 16 || N == 32, "group size");
    if (N == 8) { x = sum4(x); x += swzx<4>(x); return x; }
    x = sum16(x);
    if (N == 32) x += swzx<16>(x);
    return x;
}
#define gsum(x, n) gsumN<n>(x)
__device__ __forceinline__ uint2 pk4(float a, float b, float c, float d) { return make_uint2(mk2(a, b), mk2(c, d)); }
struct WaveId { int gw, nw, lane; };
__device__ __forceinline__ WaveId wave_id() {
    int tid = TIDX; asm volatile("" : "+v"(tid));
    WaveId w; w.lane = tid & 63; w.gw = __builtin_amdgcn_readfirstlane((tid >> 6) * (int)gridDim.x + (int)blockIdx.x); w.nw = (int)gridDim.x * (NTHR_ / 64); return w;
}

static_assert(D % 256 == 0, "row sweep");
__device__ __forceinline__ void ldx8(const unsigned short* p, float (&v)[8]) {
    const uint4 u = *(const uint4*)p;
    v[0] = __uint_as_float(u.x << 16); v[1] = __uint_as_float(u.x & 0xffff0000u); v[2] = __uint_as_float(u.y << 16); v[3] = __uint_as_float(u.y & 0xffff0000u);
    v[4] = __uint_as_float(u.z << 16); v[5] = __uint_as_float(u.z & 0xffff0000u); v[6] = __uint_as_float(u.w << 16); v[7] = __uint_as_float(u.w & 0xffff0000u);
}
static_assert(D % 512 == 0, "row sweep (8 per lane)");
__device__ __forceinline__ void norm_rows(const P& p, int l, int which) {
    const WaveId w = wave_id();
    const unsigned short* x = (const unsigned short*)(p.ws + WS_X); act_t* h = (act_t*)(p.ws + WS_H);
    const float* g = (which == 0 ? p.norm1_g : p.norm2_g) + (size_t)l * D;
    float A[D / 512][8], B[D / 512][8]; int cond_cur = -1;
    uint4 nx[D / 512];
    int m = w.gw;
    {   const unsigned short* xr = x + (size_t)(m < MTOK ? m : 0) * D;
#pragma unroll
        for (int j = 0; j < D / 512; ++j) nx[j] = *(const uint4*)(xr + j * 512 + w.lane * 8); }
    for (; m < MTOK; m += w.nw) {
        uint4 cur[D / 512];
#pragma unroll
        for (int j = 0; j < D / 512; ++j) { cur[j] = nx[j]; asm volatile("" : "+v"(cur[j].x), "+v"(cur[j].y), "+v"(cur[j].z), "+v"(cur[j].w)); }
        {   const int mn = m + w.nw < MTOK ? m + w.nw : m; const unsigned short* xr = x + (size_t)mn * D;
#pragma unroll
            for (int j = 0; j < D / 512; ++j) nx[j] = *(const uint4*)(xr + j * 512 + w.lane * 8); }
        __builtin_amdgcn_sched_barrier(0);
        const int cond = cond_of_seq(seq_of(m));
        if (cond != cond_cur) {
            cond_cur = cond;
            const float* sh = modp(p, l, cond, which * 3 + 0); const float* sc = modp(p, l, cond, which * 3 + 1);
#pragma unroll
            for (int j = 0; j < D / 512; ++j) { const int c = j * 512 + w.lane * 8;
                const float4 ga = *(const float4*)(g + c), gb = *(const float4*)(g + c + 4), s1a = *(const float4*)(sc + c), s1b = *(const float4*)(sc + c + 4), s0a = *(const float4*)(sh + c), s0b = *(const float4*)(sh + c + 4);
                A[j][0] = ga.x * (1.f + s1a.x); A[j][1] = ga.y * (1.f + s1a.y); A[j][2] = ga.z * (1.f + s1a.z); A[j][3] = ga.w * (1.f + s1a.w);
                A[j][4] = gb.x * (1.f + s1b.x); A[j][5] = gb.y * (1.f + s1b.y); A[j][6] = gb.z * (1.f + s1b.z); A[j][7] = gb.w * (1.f + s1b.w);
                B[j][0] = s0a.x; B[j][1] = s0a.y; B[j][2] = s0a.z; B[j][3] = s0a.w; B[j][4] = s0b.x; B[j][5] = s0b.y; B[j][6] = s0b.z; B[j][7] = s0b.w; }
        }
        float v[D / 512][8]; float ss = 0.f;
#pragma unroll
        for (int j = 0; j < D / 512; ++j) { const uint4 u = cur[j];
            v[j][0] = __uint_as_float(u.x << 16); v[j][1] = __uint_as_float(u.x & 0xffff0000u); v[j][2] = __uint_as_float(u.y << 16); v[j][3] = __uint_as_float(u.y & 0xffff0000u);
            v[j][4] = __uint_as_float(u.z << 16); v[j][5] = __uint_as_float(u.z & 0xffff0000u); v[j][6] = __uint_as_float(u.w << 16); v[j][7] = __uint_as_float(u.w & 0xffff0000u);
#pragma unroll
            for (int e = 0; e < 8; ++e) ss += v[j][e] * v[j][e]; }
        ss = wsum(ss);
        const float rs = 1.0f / sqrtf(ss / D + RMS_EPS);
#pragma unroll
        for (int j = 0; j < D / 512; ++j) { const int c = j * 512 + w.lane * 8;
            const uint2 lo = pk4(v[j][0] * rs * A[j][0] + B[j][0], v[j][1] * rs * A[j][1] + B[j][1], v[j][2] * rs * A[j][2] + B[j][2], v[j][3] * rs * A[j][3] + B[j][3]);
            const uint2 hi = pk4(v[j][4] * rs * A[j][4] + B[j][4], v[j][5] * rs * A[j][5] + B[j][5], v[j][6] * rs * A[j][6] + B[j][6], v[j][7] * rs * A[j][7] + B[j][7]);
            *(uint4*)(h + (size_t)m * D + c) = make_uint4(lo.x, lo.y, hi.x, hi.y); }
    }
}
__device__ __forceinline__ void final_rows(const P& p) {
    const WaveId w = wave_id();
    const unsigned short* x = (const unsigned short*)(p.ws + WS_X);
    for (int m = w.gw; m < MTOK; m += w.nw) {
        const unsigned short* xr = x + (size_t)m * D;
        float v[D / 512][8]; float ss = 0.f;
#pragma unroll
        for (int j = 0; j < D / 512; ++j) { ldx8(xr + j * 512 + w.lane * 8, v[j]);
#pragma unroll
            for (int e = 0; e < 8; ++e) ss += v[j][e] * v[j][e]; }
        ss = wsum(ss);
        const float rs = 1.0f / sqrtf(ss / D + RMS_EPS);
#pragma unroll
        for (int j = 0; j < D / 512; ++j) { const int c = j * 512 + w.lane * 8; const float4 ga = *(const float4*)(p.final_norm_g + c), gb = *(const float4*)(p.final_norm_g + c + 4);
            *(float4*)(p.out + O_YP + (size_t)m * D + c) = make_float4(v[j][0] * rs * ga.x, v[j][1] * rs * ga.y, v[j][2] * rs * ga.z, v[j][3] * rs * ga.w);
            *(float4*)(p.out + O_YP + (size_t)m * D + c + 4) = make_float4(v[j][4] * rs * gb.x, v[j][5] * rs * gb.y, v[j][6] * rs * gb.z, v[j][7] * rs * gb.w); }
    }
}

static_assert(2 * DL == 128 && 2 * IL == 128 && GL == 128 && QR == 512 && KVR == 512 && ROPE == 64 && GC == 1536 && CH == 4, "prep_rows layout");
__device__ __forceinline__ void prep_rows(const P& p, int l) {
    const WaveId w = wave_id(); const int lane = w.lane;
    const act_t* pp = (const act_t*)(p.ws + WS_PP);
    act_t* lin = (act_t*)(p.ws + WS_LIN); act_t* cqn = (act_t*)(p.ws + WS_CQN); act_t* ckvn = (act_t*)(p.ws + WS_CKVN); act_t* kr = (act_t*)(p.ws + WS_KR);
    const float2* ropetab = (const float2*)(p.ws + WS_ROPE);
    for (int m = w.gw; m < MKV; m += w.nw) {
        if (m >= MTOK) {
            const int r = m - MTOK, b = r / PAST, j0 = r % PAST;
            const float* ck = p.cache_ckv + (((size_t)b * L + l) * PAST + j0) * KVR;
            const float4 a = *(const float4*)(ck + lane * 8), c4 = *(const float4*)(ck + lane * 8 + 4);
            *(uint4*)(ckvn + (size_t)m * KVR + lane * 8) = make_uint4(mk2(a.x, a.y), mk2(a.z, a.w), mk2(c4.x, c4.y), mk2(c4.z, c4.w));
            kr[(size_t)m * ROPE + lane] = f2a(p.cache_kpe[(((size_t)b * L + l) * PAST + j0) * ROPE + lane]);
            continue;
        }
        const act_t* pr = pp + (size_t)m * INP;
        const int s = seq_of(m), base = seq_start(s), t = m - base, T = seq_len(s);
        {
            const float2 a = ldp2(pr + OFF_WLO + 2 * lane), b = ldp2(pr + OFF_ALO + 2 * lane), c = ldp2(pr + OFF_GLO + 2 * lane);
            act_t* lo = lin + (size_t)m * LINK;
            *(unsigned*)(lo + 2 * lane) = mk2(ftanh_(a.x), ftanh_(a.y)); *(unsigned*)(lo + 128 + 2 * lane) = mk2(b.x, b.y); *(unsigned*)(lo + 256 + 2 * lane) = mk2(sigmoidf_(c.x), sigmoidf_(c.y));
        }
        {
            const float4 a = ldp4(pr + OFF_CQ + lane * 8), b = ldp4(pr + OFF_CQ + lane * 8 + 4);
            float ss = wsum(a.x * a.x + a.y * a.y + a.z * a.z + a.w * a.w + b.x * b.x + b.y * b.y + b.z * b.z + b.w * b.w);
            float rs = 1.0f / sqrtf(ss / QR + RMS_EPS);
            const float* g = p.mla_qnorm_g + (size_t)l * QR + lane * 8; const float4 g0 = *(const float4*)g, g1 = *(const float4*)(g + 4);
            *(uint4*)(cqn + (size_t)m * QR + lane * 8) = make_uint4(mk2(a.x * rs * g0.x, a.y * rs * g0.y), mk2(a.z * rs * g0.z, a.w * rs * g0.w), mk2(b.x * rs * g1.x, b.y * rs * g1.y), mk2(b.z * rs * g1.z, b.w * rs * g1.w));
            const float4 c = ldp4(pr + OFF_CKV + lane * 8), d = ldp4(pr + OFF_CKV + lane * 8 + 4);
            ss = wsum(c.x * c.x + c.y * c.y + c.z * c.z + c.w * c.w + d.x * d.x + d.y * d.y + d.z * d.z + d.w * d.w);
            rs = 1.0f / sqrtf(ss / KVR + RMS_EPS);
            const float* g2 = p.mla_kvnorm_g + (size_t)l * KVR + lane * 8; const float4 h0 = *(const float4*)g2, h1 = *(const float4*)(g2 + 4);
            const float4 o0 = make_float4(c.x * rs * h0.x, c.y * rs * h0.y, c.z * rs * h0.z, c.w * rs * h0.w), o1 = make_float4(d.x * rs * h1.x, d.y * rs * h1.y, d.z * rs * h1.z, d.w * rs * h1.w);
            *(uint4*)(ckvn + (size_t)m * KVR + lane * 8) = make_uint4(mk2(o0.x, o0.y), mk2(o0.z, o0.w), mk2(o1.x, o1.y), mk2(o1.z, o1.w));
            if (s < NB) { float* oc = p.out + O_CK + (((size_t)s * L + l) * SEQ + t) * KVR + lane * 8; *(float4*)oc = o0; *(float4*)(oc + 4) = o1; }
            if (lane < ROPE / 2) {
                const float2 xe = ldp2(pr + OFF_KPE + 2 * lane);
                if (s < NB) { *(unsigned*)(kr + (size_t)m * ROPE + 2 * lane) = mk2(xe.x, xe.y); *(float2*)(p.out + O_KP + (((size_t)s * L + l) * SEQ + t) * ROPE + 2 * lane) = xe; }
                else { const float2 cs = ropetab[(size_t)t * (ROPE / 2) + lane]; *(unsigned*)(kr + (size_t)m * ROPE + 2 * lane) = mk2(xe.x * cs.x - xe.y * cs.y, xe.x * cs.y + xe.y * cs.x); }
            }
        }
    }
}

static_assert(CW == 512 && DV == 128, "post_rows layout");
__device__ __forceinline__ void post_rows(const P& p, int l) {
    const WaveId w = wave_id(); const int lane = w.lane;
    const act_t* pp = (const act_t*)(p.ws + WS_PP);
    const float* rwb = (const float*)(p.ws + WS_RWB); const act_t* gb = (const act_t*)(p.ws + WS_LORA) + 4 * AW;     const act_t* yb = (const act_t*)(p.ws + WS_RWY);
    const act_t* go = (const act_t*)(p.ws + WS_GO);
    act_t* ymix = (act_t*)(p.ws + WS_YMIX);
    for (int m = w.gw; m < MTOK; m += w.nw) {
        const act_t* pr = pp + (size_t)m * INP;
        const int c0 = 8 * lane, h = lane >> 3;
        {
            float y[8], v[8];
#define LD8B(dst, ptr) do { const float4 a_ = ldp4(ptr), b_ = ldp4((ptr) + 4); dst[0] = a_.x; dst[1] = a_.y; dst[2] = a_.z; dst[3] = a_.w; dst[4] = b_.x; dst[5] = b_.y; dst[6] = b_.z; dst[7] = b_.w; } while (0)
#define LD8(dst, ptr) do { const float4 a_ = *(const float4*)(ptr), b_ = *(const float4*)((ptr) + 4); dst[0] = a_.x; dst[1] = a_.y; dst[2] = a_.z; dst[3] = a_.w; dst[4] = b_.x; dst[5] = b_.y; dst[6] = b_.z; dst[7] = b_.w; } while (0)
            { float y1[8]; LD8B(y, yb + ((size_t)m * 2 + 0) * AW + c0); LD8B(y1, yb + ((size_t)m * 2 + 1) * AW + c0);
#pragma unroll
              for (int j = 0; j < 8; ++j) y[j] += y1[j]; }
            { const float4 a_ = ldp4(pr + OFF_V + c0), b_ = ldp4(pr + OFF_V + c0 + 4); v[0] = a_.x; v[1] = a_.y; v[2] = a_.z; v[3] = a_.w; v[4] = b_.x; v[5] = b_.y; v[6] = b_.z; v[7] = b_.w; }
            float mu = 0.f;
#pragma unroll
            for (int j = 0; j < 8; ++j) mu += y[j];
            mu = gsum(mu, 8) * (1.0f / AN);
            float var = 0.f;
#pragma unroll
            for (int j = 0; j < 8; ++j) { const float t = y[j] - mu; var += t * t; }
            var = gsum(var, 8) * (1.0f / AN);
            const float rstd = 1.0f / sqrtf(var + LNX_EPS);
            const float bon = rwb[((size_t)m * 2 + 0) * AH + h] + rwb[((size_t)m * 2 + 1) * AH + h];
            float g[8]; { const float4 a_ = ldp4(gb + (size_t)m * LORAN + c0), b_ = ldp4(gb + (size_t)m * LORAN + c0 + 4); g[0] = a_.x; g[1] = a_.y; g[2] = a_.z; g[3] = a_.w; g[4] = b_.x; g[5] = b_.y; g[6] = b_.z; g[7] = b_.w; }
            float o[8];
#pragma unroll
            for (int j = 0; j < 8; ++j) o[j] = ((y[j] - mu) * rstd * p.rwkv_lnx_g[(size_t)l * AW + c0 + j] + p.rwkv_lnx_b[(size_t)l * AW + c0 + j] + bon * v[j]) * g[j];
            *(uint4*)(ymix + (size_t)m * MIXW + c0) = make_uint4(mk2(o[0], o[1]), mk2(o[2], o[3]), mk2(o[4], o[5]), mk2(o[6], o[7]));
        }
        {
            float o[8], z[8];
            { float o1[8]; LD8B(o, go + ((size_t)m * 2 + 0) * CW + c0); LD8B(o1, go + ((size_t)m * 2 + 1) * CW + c0);
#pragma unroll
              for (int j = 0; j < 8; ++j) o[j] += o1[j]; }
            { const float4 a_ = ldp4(pr + OFF_GZ + c0), b_ = ldp4(pr + OFF_GZ + c0 + 4); z[0] = a_.x; z[1] = a_.y; z[2] = a_.z; z[3] = a_.w; z[4] = b_.x; z[5] = b_.y; z[6] = b_.z; z[7] = b_.w; }
            float ss = 0.f;
#pragma unroll
            for (int j = 0; j < 8; ++j) ss += o[j] * o[j];
            ss = gsum(ss, 16);
            const float rs = 1.0f / sqrtf(ss / DV + RMS_EPS);
            float r[8];
#pragma unroll
            for (int j = 0; j < 8; ++j) r[j] = o[j] * rs * p.gdn_norm_g[(size_t)l * DV + (c0 & 127) + j] * siluf_(z[j]);
            *(uint4*)(ymix + (size_t)m * MIXW + AW + BW + c0) = make_uint4(mk2(r[0], r[1]), mk2(r[2], r[3]), mk2(r[4], r[5]), mk2(r[6], r[7]));
#undef LD8
#undef LD8B
        }
    }
}

static_assert(DFF % 8 == 0, "ffn_act8");
__device__ __forceinline__ void ffn_act8(const P& p, int l, long gt, long gs) {
    const act_t* up = (const act_t*)(p.ws + WS_UP); act_t* act = (act_t*)(p.ws + WS_ACT);
    const float* w = p.ffn_conv + (size_t)l * 3 * DFF;
    for (long idx = gt; idx < (long)MTOK * (DFF / 8); idx += gs) {
        const int m = (int)(idx / (DFF / 8)), c = (int)(idx % (DFF / 8)) * 8;
        const int s = seq_of(m), base = seq_start(s), t = m - base, T = seq_len(s);
        const uint4 g1 = *(const uint4*)(up + (size_t)m * NUP + c), vv = *(const uint4*)(up + (size_t)m * NUP + DFF + c);
        uint4 g0 = make_uint4(0, 0, 0, 0), g2 = make_uint4(0, 0, 0, 0);
        if (t > 0) g0 = *(const uint4*)(up + (size_t)(m - 1) * NUP + c);
        if (t < T - 1) g2 = *(const uint4*)(up + (size_t)(m + 1) * NUP + c);
        const unsigned a0[4] = {g0.x, g0.y, g0.z, g0.w}, a1[4] = {g1.x, g1.y, g1.z, g1.w}, a2[4] = {g2.x, g2.y, g2.z, g2.w}, av[4] = {vv.x, vv.y, vv.z, vv.w};
        unsigned o[4];
#pragma unroll
        for (int j = 0; j < 4; ++j) {
            const float lo = w[c + 2 * j] * lo2(a0[j]) + w[DFF + c + 2 * j] * lo2(a1[j]) + w[2 * DFF + c + 2 * j] * lo2(a2[j]);
            const float hi = w[c + 2 * j + 1] * hi2(a0[j]) + w[DFF + c + 2 * j + 1] * hi2(a1[j]) + w[2 * DFF + c + 2 * j + 1] * hi2(a2[j]);
            o[j] = mk2(siluf_(lo) * lo2(av[j]), siluf_(hi) * hi2(av[j]));
        }
        *(uint4*)(act + (size_t)m * DFF + c) = make_uint4(o[0], o[1], o[2], o[3]);
    }
}

__device__ __forceinline__ void ffn_fix(const P& p, int l, long gt, long gs) {
    const float* side = (const float*)(p.ws + WS_SIDE); act_t* act = (act_t*)(p.ws + WS_ACT);
    const float* w = p.ffn_conv + (size_t)l * 3 * DFF;
    for (long idx = gt; idx < (long)(MTOK / 64) * 2 * (DFF / 8); idx += gs) {
        const int c = (int)(idx % (DFF / 8)) * 8, be = (int)(idx / (DFF / 8)), b = be >> 1, e = be & 1;
        const int m = 64 * b + (e ? 63 : 0);
        const int s = seq_of(m), t = m - seq_start(s), T = seq_len(s);
        const float* sb = side + (size_t)b * 6 * DFF + c;
        float g0[8], g1[8], g2[8], vv[8];
#define LD8S(dst, ptr) do { const float4 a_ = *(const float4*)(ptr), b_ = *(const float4*)((ptr) + 4); dst[0] = a_.x; dst[1] = a_.y; dst[2] = a_.z; dst[3] = a_.w; dst[4] = b_.x; dst[5] = b_.y; dst[6] = b_.z; dst[7] = b_.w; } while (0)
#pragma unroll
        for (int j = 0; j < 8; ++j) { g0[j] = 0.f; g2[j] = 0.f; }
        if (e == 0) { LD8S(g1, sb); LD8S(g2, sb + DFF); LD8S(vv, sb + 4 * DFF); if (t > 0) LD8S(g0, sb - 6 * DFF + 3 * DFF); }
        else { LD8S(g1, sb + 3 * DFF); LD8S(g0, sb + 2 * DFF); LD8S(vv, sb + 5 * DFF); if (t < T - 1) LD8S(g2, sb + 6 * DFF); }
#undef LD8S
        float o[8];
#pragma unroll
        for (int j = 0; j < 8; ++j) o[j] = siluf_(w[c + j] * g0[j] + w[DFF + c + j] * g1[j] + w[2 * DFF + c + j] * g2[j]) * vv[j];
        *(uint4*)(act + (size_t)m * DFF + c) = make_uint4(mk2(o[0], o[1]), mk2(o[2], o[3]), mk2(o[4], o[5]), mk2(o[6], o[7]));
    }
}

template <class Src>
__device__ __forceinline__ void conv_tile_load(const Src& src, int K, int N, int unit, int tid, float4 (&v)[2]) {
    const int nk = K / 64, ku = unit % nk, nu = unit / nk, k0 = ku * 64, n0 = nu * 64;
#pragma unroll
    for (int pass = 0; pass < 2; ++pass) {
        const int kk = pass * 32 + (tid >> 4), n4 = (tid & 15) * 4;
        v[pass] = make_float4(0.f, 0.f, 0.f, 0.f);
        if (n0 + n4 < N) v[pass] = src(k0 + kk, n0 + n4);
    }
}
__device__ __forceinline__ void conv_tile_store(int K, act_t* Wt, int unit, int tid, const float4 (&v)[2], char* lds) {
    float* tile = (float*)lds;
    const int nk = K / 64, ku = unit % nk, nu = unit / nk, k0 = ku * 64, n0 = nu * 64;
    asm volatile("s_waitcnt lgkmcnt(0)" ::: "memory"); __builtin_amdgcn_s_barrier(); asm volatile("" ::: "memory");
#pragma unroll
    for (int pass = 0; pass < 2; ++pass) {
        const int kk = pass * 32 + (tid >> 4), n4 = (tid & 15) * 4;
        tile[kk * 65 + n4] = v[pass].x; tile[kk * 65 + n4 + 1] = v[pass].y; tile[kk * 65 + n4 + 2] = v[pass].z; tile[kk * 65 + n4 + 3] = v[pass].w;
    }
    asm volatile("s_waitcnt lgkmcnt(0)" ::: "memory"); __builtin_amdgcn_s_barrier(); asm volatile("" ::: "memory");
    const int n = tid >> 3, k8 = (tid & 7) * 8;
    unsigned o[4];
#pragma unroll
    for (int j = 0; j < 4; ++j) o[j] = mk2(tile[(k8 + 2 * j) * 65 + n], tile[(k8 + 2 * j + 1) * 65 + n]);
    *(uint4*)(Wt + (size_t)(n0 + n) * K + k0 + k8) = make_uint4(o[0], o[1], o[2], o[3]);
}
typedef float f32x4nt __attribute__((ext_vector_type(4)));
__device__ __forceinline__ float4 ldnt4(const float* p) { const f32x4nt v = __builtin_nontemporal_load((const f32x4nt*)p); return make_float4(v[0], v[1], v[2], v[3]); }
struct SrcPlain { const float* W; int N; __device__ __forceinline__ float4 operator()(int k, int n) const { return ldnt4(W + (size_t)k * N + n); } };
struct SrcUpPerm { const float* W; int N; __device__ __forceinline__ float4 operator()(int k, int n) const {
        const int nl = n & 255, col = nl < 128 ? (n >> 8) * 128 + nl : DFF + (n >> 8) * 128 + nl - 128; return ldnt4(W + (size_t)k * N + col); } };
struct SrcLora { const float* w2; const float* a2; const float* g2;
    __device__ __forceinline__ float4 operator()(int k, int n) const {
        const int jb = n / AW, c = n % AW; const float* s = nullptr;
        if (jb < 2) { if (k >= jb * DL && k < (jb + 1) * DL) s = w2 + ((size_t)jb * DL + (k - jb * DL)) * AW + c; }
        else if (jb < 4) { const int d = jb - 2; if (k >= 2 * DL + d * IL && k < 2 * DL + (d + 1) * IL) s = a2 + ((size_t)d * IL + (k - 2 * DL - d * IL)) * AW + c; }
        else { if (k >= 2 * DL + 2 * IL) s = g2 + (size_t)(k - 2 * DL - 2 * IL) * AW + c; }
        return s ? *(const float4*)s : make_float4(0.f, 0.f, 0.f, 0.f);
    } };

__device__ __forceinline__ void adaln_unit(const P& p, int unit, char* lds) {
    int tid = TIDX; asm volatile("" : "+v"(tid));
    float* sil = (float*)lds;
    float* part = sil + NCOND * D;
    const int l = unit / (6 * D / 64), j0 = (unit % (6 * D / 64)) * 64;
    __syncthreads();
    for (int i = tid; i < NCOND * D; i += NTHR_) { const int c = i / D, k = i % D; sil[i] = siluf_(c == 0 ? p.c_ctx[k] : p.c[(size_t)(c - 1) * D + k]); }
    __syncthreads();
    const int cg = tid & 15, rs = tid >> 4;
    float4 acc[NCOND];
#pragma unroll
    for (int c = 0; c < NCOND; ++c) acc[c] = make_float4(0.f, 0.f, 0.f, 0.f);
    const float* wp = p.ada_w + ((size_t)l * D) * 6 * D + j0 + 4 * cg;
    for (int i0 = rs * (D / 32); i0 < (rs + 1) * (D / 32); i0 += 16) {
        float4 wv[16];
#pragma unroll
        for (int e = 0; e < 16; ++e) wv[e] = ldnt4(wp + (size_t)(i0 + e) * 6 * D);
        __builtin_amdgcn_sched_barrier(0);
#pragma unroll
        for (int e = 0; e < 16; e += 4) asm volatile("" : "+v"(wv[e].x), "+v"(wv[e].y), "+v"(wv[e].z), "+v"(wv[e].w), "+v"(wv[e + 1].x), "+v"(wv[e + 1].y), "+v"(wv[e + 1].z), "+v"(wv[e + 1].w),
                                                          "+v"(wv[e + 2].x), "+v"(wv[e + 2].y), "+v"(wv[e + 2].z), "+v"(wv[e + 2].w), "+v"(wv[e + 3].x), "+v"(wv[e + 3].y), "+v"(wv[e + 3].z), "+v"(wv[e + 3].w));
#pragma unroll
        for (int e = 0; e < 16; ++e)
#pragma unroll
            for (int c = 0; c < NCOND; ++c) { const float s = sil[c * D + i0 + e]; acc[c].x += s * wv[e].x; acc[c].y += s * wv[e].y; acc[c].z += s * wv[e].z; acc[c].w += s * wv[e].w; }
    }
#pragma unroll
    for (int c = 0; c < NCOND; ++c) { float* pp_ = part + ((rs * 64 + 4 * cg) * NCOND + c); pp_[0] = acc[c].x; pp_[NCOND] = acc[c].y; pp_[2 * NCOND] = acc[c].z; pp_[3 * NCOND] = acc[c].w; }
    __syncthreads();
    if (tid < 64 * NCOND) {
        const int c = tid / 64, j = tid % 64; float sacc = 0.f;
#pragma unroll 8
        for (int q = 0; q < 32; ++q) sacc += part[(q * 64 + j) * NCOND + c];
        float* mod = (float*)(p.ws + WS_MOD);
        mod[((size_t)(l * NCOND + c) * 6) * D + j0 + j] = sacc + p.ada_b[(size_t)l * 6 * D + j0 + j];
    }
}
}
struct EpiResid {
    static constexpr bool PERM = true, AFTER_DRAIN = false;
    unsigned short* X; int ldc; const float* mod_l; int which;
    __device__ __forceinline__ void operator()(const pg8::f32x4 (&acc)[2][2][4][2], const pg8::Unit& u, int wr, int wc, int fr, int fq) const {
        using pg8::f32x4; using pg8::u32x4; using pg8::BM; using pg8::HALF;
        const int row0 = u.pm * BM + wr * 64 + fr, col0 = u.pn * BM + wc * 32 + 8 * fq;
        const int cond = cond_of_seq(seq_of(u.pm * BM));
        const float* gate = mod_l + ((size_t)cond * 6 + which) * D;
        f32x4 gv[2][2];
#pragma unroll
        for (int bj = 0; bj < 2; ++bj)
#pragma unroll
            for (int n = 0; n < 2; ++n) gv[bj][n] = *(const f32x4*)(gate + col0 + bj * HALF + 4 * n);
        u32x4 o[2][4][2];
#pragma unroll
        for (int ai = 0; ai < 2; ++ai)
#pragma unroll
            for (int m = 0; m < 4; ++m)
#pragma unroll
                for (int bj = 0; bj < 2; ++bj) o[ai][m][bj] = *(const u32x4*)(X + (size_t)(row0 + ai * HALF + m * 16) * ldc + col0 + bj * HALF);
        __builtin_amdgcn_sched_barrier(0);
#pragma unroll
        for (int ai = 0; ai < 2; ++ai)
#pragma unroll
            for (int m = 0; m < 4; ++m) { unsigned short* rowp = X + (size_t)(row0 + ai * HALF + m * 16) * ldc + col0;
#pragma unroll
                for (int bj = 0; bj < 2; ++bj) {
                    const u32x4 ov = o[ai][m][bj];
                    const f32x4 x0 = {__uint_as_float(ov.x << 16), __uint_as_float(ov.x & 0xffff0000u), __uint_as_float(ov.y << 16), __uint_as_float(ov.y & 0xffff0000u)};
                    const f32x4 x1 = {__uint_as_float(ov.z << 16), __uint_as_float(ov.z & 0xffff0000u), __uint_as_float(ov.w << 16), __uint_as_float(ov.w & 0xffff0000u)};
                    const f32x4 v0 = x0 + gv[bj][0] * acc[ai][bj][m][0], v1 = x1 + gv[bj][1] * acc[ai][bj][m][1];
                    u32x4 w; w.x = pg8::cvt_pk_bf16(v0[0], v0[1]); w.y = pg8::cvt_pk_bf16(v0[2], v0[3]); w.z = pg8::cvt_pk_bf16(v1[0], v1[1]); w.w = pg8::cvt_pk_bf16(v1[2], v1[3]);
                    *(u32x4*)(rowp + bj * HALF) = w; } }
    }
};

struct EpiFfnAct {
    static constexpr bool PERM = true, AFTER_DRAIN = false;
    pg8::bf16_t* ACT; float* side; const float* cw;
    __device__ __forceinline__ void operator()(const pg8::f32x4 (&acc)[2][2][4][2], const pg8::Unit& u, int wr, int wc, int, int) const {
        using pg8::f32x4; using pg8::u32x4; using pg8::BM; using pg8::HALF;
        unsigned lane_; asm volatile("v_mbcnt_lo_u32_b32 %0, -1, 0\n\tv_mbcnt_hi_u32_b32 %0, -1, %0" : "=v"(lane_));
        const int fr = (int)(lane_ & 15u), fq = (int)(lane_ >> 4);
        const int colA = u.pn * 128 + wc * 32 + 8 * fq;
        f32x4 w0[2], w1[2], w2[2];
#pragma unroll
        for (int n = 0; n < 2; ++n) { w0[n] = *(const f32x4*)(cw + colA + 4 * n); w1[n] = *(const f32x4*)(cw + DFF + colA + 4 * n); w2[n] = *(const f32x4*)(cw + 2 * DFF + colA + 4 * n); }
        const bool first = fr == 0, last = fr == 15;
#pragma unroll
        for (int ai = 0; ai < 2; ++ai) {
            const int row_b = u.pm * BM + ai * HALF + wr * 64, blk = row_b >> 6;
            f32x4 R[4][2], Ln[4][2];
#pragma unroll
            for (int m = 0; m < 4; ++m)
#pragma unroll
                for (int n = 0; n < 2; ++n)
#pragma unroll
                    for (int e = 0; e < 4; ++e) { R[m][n][e] = fastp::dppf<0x121>(acc[ai][0][m][n][e]); Ln[m][n][e] = fastp::dppf<0x12F>(acc[ai][0][m][n][e]); }
#pragma unroll
            for (int m = 0; m < 4; ++m) {
                u32x4 wout;
#pragma unroll
                for (int n = 0; n < 2; ++n) {
                    f32x4 o;
#pragma unroll
                    for (int e = 0; e < 4; ++e) {
                        const float pv = first ? (m > 0 ? R[m > 0 ? m - 1 : 0][n][e] : 0.f) : R[m][n][e];
                        const float nx = last ? (m < 3 ? Ln[m < 3 ? m + 1 : 3][n][e] : 0.f) : Ln[m][n][e];
                        o[e] = siluf_(w0[n][e] * pv + w1[n][e] * acc[ai][0][m][n][e] + w2[n][e] * nx) * acc[ai][1][m][n][e];
                    }
                    if (n == 0) { wout.x = pg8::cvt_pk_bf16(o[0], o[1]); wout.y = pg8::cvt_pk_bf16(o[2], o[3]); } else { wout.z = pg8::cvt_pk_bf16(o[0], o[1]); wout.w = pg8::cvt_pk_bf16(o[2], o[3]); }
                }
                *(u32x4*)(ACT + (size_t)(row_b + m * 16 + fr) * DFF + colA) = wout;
            }
            float* sb = side + (size_t)blk * 6 * DFF + colA;
            if (fr <= 1) { *(f32x4*)(sb + fr * DFF) = acc[ai][0][0][0]; *(f32x4*)(sb + fr * DFF + 4) = acc[ai][0][0][1]; }
            if (fr >= 14) { *(f32x4*)(sb + (fr - 12) * DFF) = acc[ai][0][3][0]; *(f32x4*)(sb + (fr - 12) * DFF + 4) = acc[ai][0][3][1]; }
            if (first) { *(f32x4*)(sb + 4 * DFF) = acc[ai][1][0][0]; *(f32x4*)(sb + 4 * DFF + 4) = acc[ai][1][0][1]; }
            if (last) { *(f32x4*)(sb + 5 * DFF) = acc[ai][1][3][0]; *(f32x4*)(sb + 5 * DFF + 4) = acc[ai][1][3][1]; }
        }
    }
};

constexpr int NTHR = 512;
constexpr int LDS_BYTES = 147456;
constexpr int LDS_MISC = LDS_BYTES - 64;
constexpr int LDS_USABLE = TID_TAB_OFF;
static_assert(LDS_BYTES == LDS_TOTAL_BYTES, "tidx.h");
static_assert(NTHR == NTHR_ && att::SHM_ATTN <= LDS_USABLE && pg8::STAGE_BYTES <= LDS_USABLE && gdnc::PA_LDS <= LDS_USABLE && gdnc::PH_LDS <= LDS_USABLE && rwkc::PA_LDS <= LDS_USABLE && rwkc::PD_LDS <= LDS_USABLE, "LDS map");
constexpr int PH_PER_LAYER = 11, N_PHASES = 2 + L * PH_PER_LAYER;

struct Args { P p; int ph_lo, ph_hi, use_bar, pad; };

template <class Epi>
__device__ __forceinline__ void run_gemm(PG8_LAS unsigned char* lds, const act_t* A, const act_t* Bt, int M, int N, int K, const Epi& E) {
    pg8::Gemm g{A, Bt, M, N, K, K}; pg8::StaticOrder S; S.init(M, N, (int)gridDim.x, (int)blockIdx.x);
    pg8::gemm_phase<Epi, pg8::StaticOrder, false>(lds, g, S, E, nullptr);
}

constexpr int CV_T_IN = (D / 64) * (INP / 64), CV_T_UQ = (QR / 64) * (NQ / 64), CV_T_UK = (KVR / 64) * (BH * NOPE / 64), CV_T_UV = (KVR / 64) * (BH * VD / 64), CV_T_OUT = (MIXW / 64) * (D / 64),
              CV_T_UP = (D / 64) * (NUP / 64), CV_T_DN = (DFF / 64) * (D / 64), CV_T_LO = (LINK / 64) * (LORAN / 64), CV_TL = CV_T_IN + CV_T_UQ + CV_T_UK + CV_T_UV + CV_T_OUT + CV_T_UP + CV_T_DN + CV_T_LO;
constexpr int AD_PER_LAYER = 6 * D / 64;
__device__ __forceinline__ void layer_prep(const P& p, int ll, int t_lo, int t_hi, bool with_adaln, int w, int nw, char* lds) {
    act_t* ww_ = (act_t*)(p.ws + WS_WT) + (size_t)ll * WT_LAYER;
    if (with_adaln) for (int u = w; u < AD_PER_LAYER; u += nw) fastp::adaln_unit(p, ll * AD_PER_LAYER + u, lds);
    int tidc = TIDX; asm volatile("" : "+v"(tidc));
    asm volatile("" : "+s"(w), "+s"(t_lo));
    float4 vcur[2], vnxt[2];
#define CV_DISPATCH(ridx, OP_PLAIN, OP_LORA, OP_UP) do { int r_ = (ridx); \
        if (r_ < CV_T_IN) { OP_PLAIN(p.w_in + (size_t)ll * D * INC, INC, D, INC, ww_ + WT_IN, r_); break; } r_ -= CV_T_IN; \
        if (r_ < CV_T_UQ) { OP_PLAIN(p.mla_w_uq + (size_t)ll * QR * NQ, NQ, QR, NQ, ww_ + WT_UQ, r_); break; } r_ -= CV_T_UQ; \
        if (r_ < CV_T_UK) { OP_PLAIN(p.mla_w_uk + (size_t)ll * KVR * BH * NOPE, BH * NOPE, KVR, BH * NOPE, ww_ + WT_UKV, r_); break; } r_ -= CV_T_UK; \
        if (r_ < CV_T_UV) { OP_PLAIN(p.mla_w_uv + (size_t)ll * KVR * BH * VD, BH * VD, KVR, BH * VD, ww_ + WT_UKV + (size_t)BH * NOPE * KVR, r_); break; } r_ -= CV_T_UV; \
        if (r_ < CV_T_OUT) { OP_PLAIN(p.w_out + (size_t)ll * MIXW * D, D, MIXW, D, ww_ + WT_OUT, r_); break; } r_ -= CV_T_OUT; \
        if (r_ < CV_T_UP) { OP_UP(p.ffn_up + (size_t)ll * D * NUP, NUP, D, NUP, ww_ + WT_UP, r_); break; } r_ -= CV_T_UP; \
        if (r_ < CV_T_DN) { OP_PLAIN(p.ffn_down + (size_t)ll * DFF * D, D, DFF, D, ww_ + WT_DOWN, r_); break; } r_ -= CV_T_DN; \
        OP_LORA(ww_ + WT_LORA, r_); } while (0)
#define CV_LOAD_PLAIN(W_, ldw_, K_, N_, Wt_, u_) fastp::conv_tile_load(fastp::SrcPlain{W_, ldw_}, K_, N_, u_, tidc, vnxt)
#define CV_LOAD_UP(W_, ldw_, K_, N_, Wt_, u_) fastp::conv_tile_load(fastp::SrcUpPerm{W_, ldw_}, K_, N_, u_, tidc, vnxt)
#define CV_LOAD_LORA(Wt_, u_) fastp::conv_tile_load(fastp::SrcLora{p.rwkv_w2 + (size_t)ll * 2 * DL * AW, p.rwkv_a2 + (size_t)ll * 2 * IL * AW, p.rwkv_g2 + (size_t)ll * GL * AW}, LINK, LORAN, u_, tidc, vnxt)
#define CV_STORE_PLAIN(W_, ldw_, K_, N_, Wt_, u_) fastp::conv_tile_store(K_, Wt_, u_, tidc, vcur, lds)
#define CV_STORE_LORA(Wt_, u_) fastp::conv_tile_store(LINK, Wt_, u_, tidc, vcur, lds)
    const int first = t_lo + w;
    float4 vn1[2], vn2[2];
    vn1[0] = vn1[1] = vn2[0] = vn2[1] = make_float4(0.f, 0.f, 0.f, 0.f);
    if (first < t_hi) { CV_DISPATCH(first, CV_LOAD_PLAIN, CV_LOAD_LORA, CV_LOAD_UP); vn1[0] = vnxt[0]; vn1[1] = vnxt[1]; }
    if (first + nw < t_hi) { CV_DISPATCH(first + nw, CV_LOAD_PLAIN, CV_LOAD_LORA, CV_LOAD_UP); vn2[0] = vnxt[0]; vn2[1] = vnxt[1]; }
    for (int gi = first; gi < t_hi; gi += nw) {
        vcur[0] = vn1[0]; vcur[1] = vn1[1]; vn1[0] = vn2[0]; vn1[1] = vn2[1];
        if (gi + 2 * nw < t_hi) { CV_DISPATCH(gi + 2 * nw, CV_LOAD_PLAIN, CV_LOAD_LORA, CV_LOAD_UP); vn2[0] = vnxt[0]; vn2[1] = vnxt[1]; }
        CV_DISPATCH(gi, CV_STORE_PLAIN, CV_STORE_LORA, CV_STORE_PLAIN);
    }
#undef CV_DISPATCH
#undef CV_LOAD_PLAIN
#undef CV_LOAD_LORA
#undef CV_LOAD_UP
#undef CV_STORE_PLAIN
#undef CV_STORE_LORA
}
constexpr int CVQ = 16, CVQ_TASKS = (CV_TL + CVQ - 1) / CVQ;
__device__ __forceinline__ void conv_queue(const P& p, int ll, char* lds, int misc_off) {
    if (ll >= L) return;
    unsigned* head = (unsigned*)(p.ws + WS_CTL + 32768) + (2 * L + ll) * 64;
    volatile __attribute__((address_space(3))) unsigned* slot = (volatile __attribute__((address_space(3))) unsigned*)((__attribute__((address_space(3))) char*)lds + misc_off + 16);
    for (;;) {
        asm volatile("s_waitcnt lgkmcnt(0)" ::: "memory"); __builtin_amdgcn_s_barrier(); asm volatile("" ::: "memory");
        if (TIDX == 0) *slot = __hip_atomic_fetch_add(head, 1u, __ATOMIC_RELAXED, __HIP_MEMORY_SCOPE_AGENT);
        asm volatile("s_waitcnt lgkmcnt(0)" ::: "memory"); __builtin_amdgcn_s_barrier(); asm volatile("" ::: "memory");
        int t = __builtin_amdgcn_readfirstlane((int)*slot);
        if (t >= AD_PER_LAYER + CVQ_TASKS) break;
        if (t < AD_PER_LAYER) { fastp::adaln_unit(p, ll * AD_PER_LAYER + t, lds); continue; }
        t -= AD_PER_LAYER;
        const int lo = t * CVQ, hi = lo + CVQ < CV_TL ? lo + CVQ : CV_TL;
        layer_prep(p, ll, lo, hi, false, 0, 1, lds);
    }
}
struct Ctx { long gt, gt2, gs; PG8_LAS unsigned char* lds; };
template <int K> __device__ __forceinline__ void phase_body(const P& p, int l, const Ctx& c) {
    const long gt = c.gt, gt2 = c.gt2, gs = c.gs;
    act_t* wt = (act_t*)(p.ws + WS_WT);
    const act_t* w = wt + (size_t)l * WT_LAYER;
    const float* mod_l = (const float*)(p.ws + WS_MOD) + (size_t)l * NCOND * 6 * D;
    if constexpr (K == 0) {
        uint2* x = (uint2*)(p.ws + WS_X);
        for (long i = gt; i < (long)MTOK * D / 4; i += gs) { const float4 v = i < (long)MCTX * D / 4 ? ((const float4*)p.x_prompt)[i] : ((const float4*)p.x_sample)[i - (long)MCTX * D / 4]; x[i] = fastp::pk4(v.x, v.y, v.z, v.w); }
        float* rt = (float*)(p.ws + WS_ROPE);
        for (long i = gt; i < (long)DSEQ * (ROPE / 2); i += gs) { float cs, sn; rope_angle((int)(i / (ROPE / 2)), (int)(i % (ROPE / 2)), cs, sn); rt[2 * i] = cs; rt[2 * i + 1] = sn; }
        for (int u = blockIdx.x; u < AD_PER_LAYER; u += gridDim.x) fastp::adaln_unit(p, u, (char*)c.lds);
        layer_prep(p, 0, 0, CV_TL, false, (int)blockIdx.x, (int)gridDim.x, (char*)c.lds);
    }
    if constexpr (K == 1) fastp::norm_rows(p, l, 0);
    if constexpr (K == 2) { pg8::EpiBf16<0> E{(pg8::bf16_t*)(p.ws + WS_PP), INP, nullptr, 0, 0}; run_gemm(c.lds, (const act_t*)(p.ws + WS_H), w + WT_IN, MTOK, INP, D, E); }
    if constexpr (K == 3) fastp::prep_rows(p, l);
    if constexpr (K == 41) { pg8::EpiBf16<0> E{(pg8::bf16_t*)(p.ws + WS_QF), NQ, nullptr, 0, 0}; run_gemm(c.lds, (const act_t*)(p.ws + WS_CQN), w + WT_UQ, MTOK, NQ, QR, E); }
    if constexpr (K == 42) { pg8::EpiBf16<0> E{(pg8::bf16_t*)(p.ws + WS_KVUP), NKV, nullptr, 0, 0}; run_gemm(c.lds, (const act_t*)(p.ws + WS_CKVN), w + WT_UKV, MKV, NKV, KVR, E); }
    if constexpr (K == 43) { pg8::EpiBf16<0> E{(pg8::bf16_t*)(p.ws + WS_LORA), LORAN, nullptr, 0, 0}; run_gemm(c.lds, (const act_t*)(p.ws + WS_LIN), w + WT_LORA, MTOK, LORAN, LINK, E); }
    if constexpr (K == 46) { for (int rep = 0; rep < ((DUPMASK & 256) ? 2 : 1); ++rep) for (int u = (int)gridDim.x - 1 - (int)blockIdx.x; u < gdnc::NSLOT; u += gridDim.x) gdnc::prep_chunk(p, l, u, (char*)c.lds); }
    if constexpr (K == 45) { for (int rep = 0; rep < ((DUPMASK & 512) ? 2 : 1); ++rep) for (int u = blockIdx.x; u < rwkc::NSLOT; u += gridDim.x) rwkc::prep_chunk(p, l, u, (char*)c.lds); }
    if constexpr (K == 50) ph_mixers(p, l, (char*)c.lds, LDS_MISC);
    if constexpr (K == 52) ph_mixers(p, l, (char*)c.lds, LDS_MISC, 1);
    if constexpr (K == 53) conv_queue(p, l + 1, (char*)c.lds, LDS_MISC);
    if constexpr (K == 6) fastp::post_rows(p, l);
    if constexpr (K == 7) { EpiResid E{(unsigned short*)(p.ws + WS_X), D, mod_l, 2}; run_gemm(c.lds, (const act_t*)(p.ws + WS_YMIX), w + WT_OUT, MTOK, D, MIXW, E); }
    if constexpr (K == 8) fastp::norm_rows(p, l, 1);
    if constexpr (K == 9) { EpiFfnAct E{(pg8::bf16_t*)(p.ws + WS_ACT), (float*)(p.ws + WS_SIDE), p.ffn_conv + (size_t)l * 3 * DFF}; run_gemm(c.lds, (const act_t*)(p.ws + WS_H), w + WT_UP, MTOK, NUP, D, E); }
    if constexpr (K == 10) fastp::ffn_fix(p, l, gt, gs);
    if constexpr (K == 11) { EpiResid E{(unsigned short*)(p.ws + WS_X), D, mod_l, 5}; run_gemm(c.lds, (const act_t*)(p.ws + WS_ACT), w + WT_DOWN, MTOK, D, DFF, E); }
    if constexpr (K == 12) fastp::final_rows(p);
}
__device__ __forceinline__ Ctx make_ctx(PG8_LAS unsigned char* lds) {
    Ctx c; const int wv = TIDX >> 6, lane = TIDX & 63;
    c.gs = (long)gridDim.x * NTHR;
    c.gt = ((long)wv * gridDim.x + blockIdx.x) * 64 + lane;
    c.gt2 = (c.gt + c.gs / 2) % c.gs;
    c.lds = lds; return c;
}
#if N_LAUNCH_MODE == 1
template <int K> __device__ __forceinline__ void phase_site(int l, PG8_LAS unsigned char* lds) {
    const __attribute__((address_space(4))) P* kp = (const __attribute__((address_space(4))) P*)__builtin_amdgcn_kernarg_segment_ptr();
    asm volatile("" : "+s"(kp));
    P p;
#if defined(__HIP_DEVICE_COMPILE__)
    p = *kp;
#endif
    int tid = TIDX, bid = blockIdx.x, nb = gridDim.x;
    asm volatile("" : "+v"(tid), "+s"(bid), "+s"(nb));
    Ctx c; const int wv = tid >> 6, lane = tid & 63;
    c.gs = (long)nb * NTHR;
    c.gt = ((long)wv * nb + bid) * 64 + lane;
    c.gt2 = (c.gt + c.gs / 2) % c.gs;
    c.lds = lds;
    phase_body<K>(p, l, c);
}
#ifndef DUPMASK
#define DUPMASK 0
#endif
#define DUP(bit, ...) do { if (DUPMASK & (1 << (bit))) { __VA_ARGS__; } } while (0)
__device__ __forceinline__ void grid_bar(PG8_LAS unsigned char* lds) {
    const __attribute__((address_space(4))) P* kp = (const __attribute__((address_space(4))) P*)__builtin_amdgcn_kernarg_segment_ptr();
    asm volatile("" : "+s"(kp));
    XcdBarrier b; b.bar = (unsigned*)(kp->ws + WS_CTL); b.x = xb_xcc_id(); b.st = (volatile LAS unsigned*)(lds + LDS_MISC);
    xcd_barrier(b);
    if (DUPMASK & 2048) xcd_barrier(b);
}
__global__ void __launch_bounds__(NTHR, 2) fwd(Args a) {
    extern __shared__ __attribute__((aligned(16))) unsigned char lds_raw[];
    PG8_LAS unsigned char* lds = (PG8_LAS unsigned char*)lds_raw;
    volatile LAS unsigned* misc = (volatile LAS unsigned*)(lds + LDS_MISC);
    if (threadIdx.x < 4) misc[threadIdx.x] = 0u;
    if ((threadIdx.x & 63) == 0) *(volatile LAS int*)(lds + TID_TAB_OFF + 4 * hw_slot()) = (int)(threadIdx.x >> 6);
    __syncthreads();
    (void)xcd_barrier_post((unsigned*)(a.p.ws + WS_CTL), misc);
    phase_site<0>(0, lds); DUP(4, phase_site<0>(0, lds)); grid_bar(lds);
    for (int l = 0; l < L; ++l) {
        phase_site<1>(l, lds); DUP(0, phase_site<1>(l, lds)); grid_bar(lds);
        phase_site<2>(l, lds); DUP(1, phase_site<2>(l, lds)); grid_bar(lds);
        phase_site<3>(l, lds); DUP(0, phase_site<3>(l, lds)); grid_bar(lds);
        phase_site<41>(l, lds); phase_site<42>(l, lds); phase_site<43>(l, lds); DUP(1, phase_site<41>(l, lds); phase_site<42>(l, lds); phase_site<43>(l, lds)); phase_site<46>(l, lds); grid_bar(lds);
        phase_site<45>(l, lds); grid_bar(lds);
        phase_site<50>(l, lds); phase_site<53>(l, lds); DUP(10, grid_bar(lds); phase_site<52>(l, lds)); grid_bar(lds);
        phase_site<6>(l, lds); DUP(0, phase_site<6>(l, lds)); grid_bar(lds);
        phase_site<7>(l, lds); grid_bar(lds);
        phase_site<8>(l, lds); DUP(0, phase_site<8>(l, lds)); grid_bar(lds);
        phase_site<9>(l, lds); DUP(1, phase_site<9>(l, lds)); grid_bar(lds);
        phase_site<10>(l, lds); DUP(0, phase_site<10>(l, lds)); grid_bar(lds);
        phase_site<11>(l, lds); grid_bar(lds);
    }
    phase_site<12>(0, lds);
}
#endif


extern "C" void kernel_launch(void* const* d_in, const int* in_sizes, int n_in, void* d_out, int out_size, void* d_ws, size_t ws_size, hipStream_t stream) {
    static int grid = 0;
    if (grid == 0) {
        if (n_in != 37 || (size_t)out_size != O_END || ws_size < WS_END) { fprintf(stderr, "kernel_launch: unexpected sizes n_in %d out %d ws %zu (need %zu)\n", n_in, out_size, ws_size, (size_t)WS_END); grid = -1; return; }
        int dev = 0, cus = 0, per_cu = 0;
        if (hipGetDevice(&dev) != hipSuccess || hipDeviceGetAttribute(&cus, hipDeviceAttributeMultiprocessorCount, dev) != hipSuccess) { grid = -1; return; }
#if N_LAUNCH_MODE == 1
        bool ok = hipFuncSetAttribute((const void*)fwd, hipFuncAttributeMaxDynamicSharedMemorySize, LDS_BYTES) == hipSuccess;
        if (hipOccupancyMaxActiveBlocksPerMultiprocessor(&per_cu, (const void*)fwd, NTHR, LDS_BYTES) != hipSuccess || per_cu < 1) fprintf(stderr, "kernel_launch: occupancy query says %d\n", per_cu);
#endif
        if (!ok) { fprintf(stderr, "kernel_launch: hipFuncSetAttribute failed\n"); grid = -1; return; }
        (void)per_cu; (void)hipGetLastError();
        grid = cus;
    }
    if (grid < 0) return;
    (void)hipMemsetAsync((char*)d_ws + WS_CTL, 0, WS_CTL_BYTES, stream);
    Args a{};
    const float** pin = (const float**)&a.p;
    for (int i = 0; i < 37; ++i) pin[i] = (const float*)d_in[i];
    a.p.out = (float*)d_out; a.p.ws = (unsigned char*)d_ws;
    a.pad = 0;
#if N_LAUNCH_MODE == 1
    a.ph_lo = 0; a.ph_hi = N_PHASES; a.use_bar = 1;
    hipLaunchKernelGGL(fwd, dim3(grid), dim3(NTHR), LDS_BYTES, stream, a);
#endif
}
```
